# Optimizing an MI355X kernel written in HIP

```python
import math
import jax, jax.numpy as jnp
from jax import lax
import numpy as np

D_MODEL = 1024
BATCH = 8
SEQ = 2048
DEPTH = 1

HEAD_DIM = 64
A_Q_HEADS = 8
A_KV_HEADS = 2
A_GROUPS = A_Q_HEADS // A_KV_HEADS
A_WIDTH = A_Q_HEADS * HEAD_DIM
B_HEADS = 8
B_WIDTH = B_HEADS * HEAD_DIM
IDX_HEADS = 8
IDX_DIM = 32
WINDOW = 128
BLOCK = 128
TOPK_MAX = 256
N_BUCKETS = 32
MAX_DISTANCE = 128
RMS_EPS = 1e-6
SPLIT_SIZES = (
    A_WIDTH,
    A_KV_HEADS * HEAD_DIM,
    A_KV_HEADS * HEAD_DIM,
    A_WIDTH,
    B_WIDTH,
    B_WIDTH,
    B_WIDTH,
    B_WIDTH,
    IDX_HEADS * IDX_DIM,
    IDX_DIM,
    IDX_HEADS,
    2 * D_MODEL,
)
IN_WIDTH = sum(SPLIT_SIZES)

kernel_name = "hybrid_swa_sink_dsa_gated_block"


def rms_norm(x, g):
    xf = x.astype(jnp.float32)
    xf = xf * lax.rsqrt(jnp.mean(xf * xf, axis=-1, keepdims=True) + RMS_EPS)
    return (xf * g.astype(jnp.float32)).astype(x.dtype)


def t5_bucket(n):
    n = jnp.maximum(n, 0)
    max_exact = N_BUCKETS // 2
    nf = jnp.maximum(n, 1).astype(jnp.float32)
    large = max_exact + (jnp.log(nf / max_exact) / math.log(MAX_DISTANCE / max_exact)
                         * (N_BUCKETS - max_exact)).astype(jnp.int32)
    large = jnp.minimum(large, N_BUCKETS - 1)
    return jnp.where(n < max_exact, n, large)


def swa_sink_attention(q, k, v, sinks, table_a):
    B, S = q.shape[0], q.shape[1]
    nb = S // BLOCK
    qb = q.reshape(B, nb, BLOCK, A_KV_HEADS, A_GROUPS, HEAD_DIM)

    def band(t):
        tp = jnp.pad(t, ((0, 0), (BLOCK, 0), (0, 0), (0, 0)))
        prev = tp[:, :S].reshape(B, nb, BLOCK, A_KV_HEADS, HEAD_DIM)
        cur = t.reshape(B, nb, BLOCK, A_KV_HEADS, HEAD_DIM)
        return jnp.concatenate([prev, cur], axis=2)

    kb, vb = band(k), band(v)
    scores = jnp.einsum('bnqhgd,bnkhd->bnhgqk', qb, kb,
                        preferred_element_type=jnp.float32) * (HEAD_DIM ** -0.5)
    t_loc = jnp.arange(BLOCK)[:, None]
    s_loc = jnp.arange(2 * BLOCK)[None, :]
    dist = t_loc + BLOCK - s_loc
    bias = table_a.astype(jnp.float32)[t5_bucket(dist)]
    bias = bias.transpose(2, 0, 1).reshape(A_KV_HEADS, A_GROUPS, BLOCK, 2 * BLOCK)
    blk = jnp.arange(nb)[:, None, None]
    valid = (dist >= 0) & (dist < WINDOW) & (blk * BLOCK - BLOCK + s_loc >= 0)
    scores = jnp.where(valid[None, :, None, None], scores + bias, -jnp.inf)
    sink = jnp.broadcast_to(
        sinks.astype(jnp.float32).reshape(A_KV_HEADS, A_GROUPS)[None, None, :, :, None, None],
        scores.shape[:-1] + (1,))
    probs = jax.nn.softmax(jnp.concatenate([scores, sink], axis=-1), axis=-1)[..., :-1]
    out = jnp.einsum('bnhgqk,bnkhd->bnqhgd', probs.astype(v.dtype), vb)
    return out.reshape(B, S, A_Q_HEADS * HEAD_DIM)


def dsa_attention(q, k, v, q_idx, k_idx, w_idx, table_b):
    B, S = q.shape[0], q.shape[1]
    nb = S // BLOCK
    top_k = min(TOPK_MAX, S // 4)
    k_flat = k.reshape(B, S, B_HEADS * HEAD_DIM)
    v_flat = v.reshape(B, S, B_HEADS * HEAD_DIM)
    key_pos = jnp.arange(S)
    gather = jax.vmap(lambda table, ix: table[ix])

    def one_block(args):
        i, qblk, qiblk, wblk = args
        t = i * BLOCK + jnp.arange(BLOCK)
        dots = jnp.einsum('bqhe,bse->bqhs', qiblk, k_idx,
                          preferred_element_type=jnp.float32) * (IDX_DIM ** -0.5)
        w = wblk.astype(jnp.float32) * (IDX_HEADS ** -0.5)
        score_idx = jnp.einsum('bqh,bqhs->bqs', w, jax.nn.relu(dots))
        causal = key_pos[None, :] <= t[:, None]
        score_idx = jnp.where(causal[None], score_idx, -jnp.inf)
        _, idx = lax.top_k(score_idx, top_k)
        valid = idx <= t[None, :, None]
        kg = gather(k_flat, idx).reshape(B, BLOCK, top_k, B_HEADS, HEAD_DIM)
        vg = gather(v_flat, idx).reshape(B, BLOCK, top_k, B_HEADS, HEAD_DIM)
        sc = jnp.einsum('bqhd,bqkhd->bhqk', qblk, kg,
                        preferred_element_type=jnp.float32) * (HEAD_DIM ** -0.5)
        bias = table_b.astype(jnp.float32)[t5_bucket(t[None, :, None] - idx)]
        sc = jnp.where(valid[:, None], sc + bias.transpose(0, 3, 1, 2), -jnp.inf)
        p = jax.nn.softmax(sc, axis=-1)
        return jnp.einsum('bhqk,bqkhd->bqhd', p.astype(v.dtype), vg)

    def to_blocks(t):
        return jnp.moveaxis(t.reshape((B, nb, BLOCK) + t.shape[2:]), 1, 0)

    outs = lax.map(one_block, (jnp.arange(nb), to_blocks(q), to_blocks(q_idx), to_blocks(w_idx)))
    return jnp.moveaxis(outs, 0, 1).reshape(B, S, B_HEADS * HEAD_DIM)


def setup_inputs(seed: int = 0) -> dict:
    key = jax.random.key(seed)
    ks = jax.random.split(key, 12)
    f32 = jnp.float32
    return {
        "x": jax.random.normal(ks[0], (BATCH, SEQ, D_MODEL), f32),
        "norm_g": 1.0 + 0.05 * jax.random.normal(ks[1], (DEPTH, D_MODEL), f32),
        "w_in": jax.random.normal(ks[2], (DEPTH, D_MODEL, IN_WIDTH), f32) * D_MODEL ** -0.5,
        "qnorm_a": 1.0 + 0.05 * jax.random.normal(ks[3], (DEPTH, HEAD_DIM), f32),
        "knorm_a": 1.0 + 0.05 * jax.random.normal(ks[4], (DEPTH, HEAD_DIM), f32),
        "sinks_a": 0.5 * jax.random.normal(ks[5], (DEPTH, A_Q_HEADS), f32),
        "qnorm_b": 1.0 + 0.05 * jax.random.normal(ks[6], (DEPTH, HEAD_DIM), f32),
        "knorm_b": 1.0 + 0.05 * jax.random.normal(ks[7], (DEPTH, HEAD_DIM), f32),
        "rel_bias": 0.5 * jax.random.normal(ks[8], (N_BUCKETS, A_Q_HEADS + B_HEADS), f32),
        "w_proj_a": jax.random.normal(ks[9], (DEPTH, A_WIDTH, D_MODEL), f32) * A_WIDTH ** -0.5,
        "w_proj_b": jax.random.normal(ks[10], (DEPTH, B_WIDTH, D_MODEL), f32) * B_WIDTH ** -0.5,
        "w_out": jax.random.normal(ks[11], (DEPTH, D_MODEL, D_MODEL), f32) * D_MODEL ** -0.5,
    }


def reference(x, norm_g, w_in, qnorm_a, knorm_a, sinks_a, qnorm_b, knorm_b, rel_bias,
              w_proj_a, w_proj_b, w_out):
    B, S = x.shape[0], x.shape[1]
    offsets = [int(o) for o in np.cumsum(SPLIT_SIZES)[:-1]]
    table_a = rel_bias[:, :A_Q_HEADS]
    table_b = rel_bias[:, A_Q_HEADS:]
    for l in range(DEPTH):
        h = rms_norm(x, norm_g[l])
        proj = jnp.einsum('bsd,de->bse', h, w_in[l])
        (qa, ka, va, za, qb, kb, vb, zb, qi, ki, wi, gates) = jnp.split(proj, offsets, axis=-1)
        qa = rms_norm(qa.reshape(B, S, A_Q_HEADS, HEAD_DIM), qnorm_a[l])
        ka = rms_norm(ka.reshape(B, S, A_KV_HEADS, HEAD_DIM), knorm_a[l])
        va = va.reshape(B, S, A_KV_HEADS, HEAD_DIM)
        ya = swa_sink_attention(qa, ka, va, sinks_a[l], table_a) * jax.nn.silu(za)
        qb = rms_norm(qb.reshape(B, S, B_HEADS, HEAD_DIM), qnorm_b[l])
        kb = rms_norm(kb.reshape(B, S, B_HEADS, HEAD_DIM), knorm_b[l])
        vb = vb.reshape(B, S, B_HEADS, HEAD_DIM)
        qi = qi.reshape(B, S, IDX_HEADS, IDX_DIM)
        yb = dsa_attention(qb, kb, vb, qi, ki, wi, table_b) * jax.nn.silu(zb)
        g = jax.nn.sigmoid(gates.astype(jnp.float32)).astype(x.dtype)
        merged = (g[..., :D_MODEL] * jnp.einsum('bse,ed->bsd', ya, w_proj_a[l])
                  + g[..., D_MODEL:] * jnp.einsum('bse,ed->bsd', yb, w_proj_b[l]))
        x = x + jnp.einsum('bsd,de->bse', merged, w_out[l])
    return x
```

```cpp
#include <hip/hip_runtime.h>
#include <cstdio>
#include <cstdint>
#include <cmath>

namespace nv {
constexpr int NB = 8, S = 2048, D = 1024, INW = 5672;
constexpr int O_QA = 0, O_KA = 512, O_VA = 640, O_ZA = 768, O_QB = 1280, O_KB = 1792, O_VB = 2304, O_ZB = 2816, O_QI = 3328, O_KI = 3584, O_WI = 3616, O_GA = 3624, O_GB = 4648;
constexpr float EPS = 1e-6f;

__device__ __forceinline__ float wave_sum(float v) {
#pragma unroll
    for (int o = 1; o < 64; o <<= 1) v += __shfl_xor(v, o);
    return v;
}
__device__ __forceinline__ float wave_max(float v) {
#pragma unroll
    for (int o = 1; o < 64; o <<= 1) v = fmaxf(v, __shfl_xor(v, o));
    return v;
}
__device__ __forceinline__ int t5_bucket(int n) {
    if (n < 16) return n < 0 ? 0 : n;
    int l = 16 + (int)(logf((float)n / 16.0f) / logf(8.0f) * 16.0f);
    return l > 31 ? 31 : l;
}

__global__ void k_rmsnorm(const float* __restrict__ x, const float* __restrict__ g, float* __restrict__ h, int rows) {
    const int row = blockIdx.x * 4 + (threadIdx.x >> 6), lane = threadIdx.x & 63;
    if (row >= rows) return;
    const float* xr = x + (size_t)row * D;
    float v[16]; float ss = 0.f;
#pragma unroll
    for (int j = 0; j < 16; ++j) { v[j] = xr[lane + 64 * j]; ss += v[j] * v[j]; }
    ss = wave_sum(ss);
    const float r = rsqrtf(ss * (1.0f / D) + EPS);
#pragma unroll
    for (int j = 0; j < 16; ++j) h[(size_t)row * D + lane + 64 * j] = v[j] * r * g[lane + 64 * j];
}

__global__ void __launch_bounds__(256) k_sgemm(const float* __restrict__ A, const float* __restrict__ Bm, float* __restrict__ C, int N, int K, int lda, int ldb, int ldc) {
    __shared__ float As[16][65];
    __shared__ float Bs[16][64];
    const int tid = threadIdx.x, tx = tid & 15, ty = tid >> 4;
    const int row0 = blockIdx.y * 64, col0 = blockIdx.x * 64;
    float acc[4][4] = {};
    for (int k0 = 0; k0 < K; k0 += 16) {
#pragma unroll
        for (int i = 0; i < 4; ++i) { const int idx = tid + 256 * i, r = idx >> 4, kk = idx & 15; As[kk][r] = A[(size_t)(row0 + r) * lda + k0 + kk]; }
#pragma unroll
        for (int i = 0; i < 4; ++i) { const int idx = tid + 256 * i, kk = idx >> 6, c = idx & 63; Bs[kk][c] = (col0 + c < N) ? Bm[(size_t)(k0 + kk) * ldb + col0 + c] : 0.f; }
        __syncthreads();
#pragma unroll
        for (int kk = 0; kk < 16; ++kk) {
            float a[4], b[4];
#pragma unroll
            for (int i = 0; i < 4; ++i) { a[i] = As[kk][ty * 4 + i]; b[i] = Bs[kk][tx * 4 + i]; }
#pragma unroll
            for (int i = 0; i < 4; ++i)
#pragma unroll
                for (int j = 0; j < 4; ++j) acc[i][j] = fmaf(a[i], b[j], acc[i][j]);
        }
        __syncthreads();
    }
#pragma unroll
    for (int i = 0; i < 4; ++i)
#pragma unroll
        for (int j = 0; j < 4; ++j) { const int c = col0 + tx * 4 + j; if (c < N) C[(size_t)(row0 + ty * 4 + i) * ldc + c] = acc[i][j]; }
}

__global__ void k_headnorm(float* __restrict__ proj, int col_off, int nheads, const float* __restrict__ gain, int rows) {
    const int w = blockIdx.x * 4 + (threadIdx.x >> 6), lane = threadIdx.x & 63;
    if (w >= rows * nheads) return;
    const int t = w / nheads, hh = w % nheads;
    float* p = proj + (size_t)t * INW + col_off + hh * 64 + lane;
    const float v = *p;
    const float ss = wave_sum(v * v);
    *p = v * rsqrtf(ss * (1.0f / 64.0f) + EPS) * gain[lane];
}

__global__ void __launch_bounds__(256) k_attnA(const float* __restrict__ proj, const float* __restrict__ sinks, const float* __restrict__ relb, float* __restrict__ ya) {
    __shared__ float qs[4][64];
    __shared__ float ps[4][128];
    const int wv = threadIdx.x >> 6, lane = threadIdx.x & 63;
    const int w = blockIdx.x * 4 + wv;
    const int t = w >> 3, h = w & 7, kvh = h >> 2;
    qs[wv][lane] = proj[(size_t)t * INW + O_QA + h * 64 + lane];
    __syncthreads();
    float sc[2];
#pragma unroll
    for (int i = 0; i < 2; ++i) {
        const int dist = lane + 64 * i, s = t - dist;
        float v = -INFINITY;
        if (s >= 0) {
            const float* kr = proj + (size_t)s * INW + O_KA + kvh * 64;
            float acc = 0.f;
            for (int d = 0; d < 64; ++d) acc = fmaf(qs[wv][d], kr[d], acc);
            v = acc * 0.125f + relb[t5_bucket(dist) * 16 + h];
        }
        sc[i] = v;
    }
    const float sink = sinks[h];
    float m = wave_max(fmaxf(sc[0], sc[1])); m = fmaxf(m, sink);
    const float e0 = (sc[0] == -INFINITY) ? 0.f : expf(sc[0] - m), e1 = (sc[1] == -INFINITY) ? 0.f : expf(sc[1] - m);
    const float l = wave_sum(e0 + e1) + expf(sink - m);
    ps[wv][lane] = e0 / l; ps[wv][64 + lane] = e1 / l;
    __syncthreads();
    float o = 0.f;
    for (int dist = 0; dist < 128; ++dist) { const int s = t - dist; if (s < 0) break; o = fmaf(ps[wv][dist], proj[(size_t)s * INW + O_VA + kvh * 64 + lane], o); }
    const float z = proj[(size_t)t * INW + O_ZA + h * 64 + lane];
    ya[(size_t)t * 512 + h * 64 + lane] = o * (z / (1.0f + expf(-z)));
}

__global__ void __launch_bounds__(256) k_idx_topk(const float* __restrict__ proj, unsigned* __restrict__ mask) {
    __shared__ float sc[S];
    __shared__ float qi[256];
    __shared__ float wi[8];
    __shared__ unsigned mw[64];
    const int t = blockIdx.x, tid = threadIdx.x, n = t + 1;
    if (tid < 64) mw[tid] = 0u;
    qi[tid] = proj[(size_t)t * INW + O_QI + tid];
    if (tid < 8) wi[tid] = proj[(size_t)t * INW + O_WI + tid] * 0.35355339059327373f;
    __syncthreads();
    if (n <= 256) {
        if (tid < 64) { const int lo = tid * 32; unsigned v = 0u; if (t >= lo + 31) v = 0xffffffffu; else if (t >= lo) v = (2u << (t - lo)) - 1u; mask[(size_t)t * 64 + tid] = v; }
        return;
    }
    for (int s = tid; s < n; s += 256) {
        const float* kr = proj + (size_t)s * INW + O_KI;
        float kv[32];
#pragma unroll
        for (int e = 0; e < 32; ++e) kv[e] = kr[e];
        float tot = 0.f;
#pragma unroll 1
        for (int hh = 0; hh < 8; ++hh) {
            float d = 0.f;
#pragma unroll
            for (int e = 0; e < 32; ++e) d = fmaf(qi[hh * 32 + e], kv[e], d);
            d *= 0.17677669529663687f;
            tot = fmaf(wi[hh], fmaxf(d, 0.f), tot);
        }
        sc[s] = tot;
    }
    __syncthreads();
    for (int s = tid; s < n; s += 256) {
        const float v = sc[s]; int rank = 0;
        for (int j = 0; j < n; ++j) { const float u = sc[j]; rank += (u > v || (u == v && j < s)) ? 1 : 0; }
        if (rank < 256) atomicOr(&mw[s >> 5], 1u << (s & 31));
    }
    __syncthreads();
    if (tid < 64) mask[(size_t)t * 64 + tid] = mw[tid];
}

__global__ void __launch_bounds__(256) k_attnB(const float* __restrict__ proj, const unsigned* __restrict__ mask, const float* __restrict__ relb, float* __restrict__ yb) {
    __shared__ float qs[4][64];
    __shared__ float ps[4][S];
    const int wv = threadIdx.x >> 6, lane = threadIdx.x & 63;
    const int w = blockIdx.x * 4 + wv;
    const int t = w >> 3, h = w & 7;
    qs[wv][lane] = proj[(size_t)t * INW + O_QB + h * 64 + lane];
    __syncthreads();
    float m = -INFINITY;
    const int nch = (t >> 6) + 1;
    for (int c = 0; c < nch; ++c) {
        const int s = c * 64 + lane;
        float v = -INFINITY;
        const unsigned wbits = mask[(size_t)t * 64 + (s >> 5)];
        if (s <= t && ((wbits >> (s & 31)) & 1u)) {
            const float* kr = proj + (size_t)s * INW + O_KB + h * 64;
            float acc = 0.f;
            for (int d = 0; d < 64; ++d) acc = fmaf(qs[wv][d], kr[d], acc);
            v = acc * 0.125f + relb[t5_bucket(t - s) * 16 + 8 + h];
        }
        ps[wv][s] = v; m = fmaxf(m, v);
    }
    m = wave_max(m);
    float l = 0.f;
    for (int c = 0; c < nch; ++c) { const int s = c * 64 + lane; const float v = ps[wv][s]; const float e = (v == -INFINITY) ? 0.f : expf(v - m); ps[wv][s] = e; l += e; }
    l = wave_sum(l);
    __syncthreads();
    float o = 0.f;
    for (int s = 0; s <= t; ++s) { const float p = ps[wv][s]; if (p != 0.f) o = fmaf(p, proj[(size_t)s * INW + O_VB + h * 64 + lane], o); }
    const float z = proj[(size_t)t * INW + O_ZB + h * 64 + lane];
    yb[(size_t)t * 512 + h * 64 + lane] = (o / l) * (z / (1.0f + expf(-z)));
}

__global__ void k_merge(const float* __restrict__ proj, const float* __restrict__ pa, const float* __restrict__ pb, float* __restrict__ merged, int rows) {
    const size_t i = (size_t)blockIdx.x * 256 + threadIdx.x;
    if (i >= (size_t)rows * D) return;
    const size_t t = i / D; const int d = (int)(i % D);
    const float ga = proj[t * INW + O_GA + d], gb = proj[t * INW + O_GB + d];
    merged[i] = pa[i] / (1.0f + expf(-ga)) + pb[i] / (1.0f + expf(-gb));
}
__global__ void k_addres(const float* __restrict__ x, const float* __restrict__ tmp, float* __restrict__ out, size_t n) {
    const size_t i = (size_t)blockIdx.x * 256 + threadIdx.x;
    if (i < n) out[i] = x[i] + tmp[i];
}
}

extern "C" void kernel_launch(void* const* d_in, const int* in_sizes, int n_in, void* d_out, int out_size, void* d_ws, size_t ws_size, hipStream_t stream) {
    using namespace nv;
    const float* x = (const float*)d_in[0]; const float* norm_g = (const float*)d_in[1]; const float* w_in = (const float*)d_in[2];
    const float* qna = (const float*)d_in[3]; const float* kna = (const float*)d_in[4]; const float* sinks = (const float*)d_in[5];
    const float* qnb = (const float*)d_in[6]; const float* knb = (const float*)d_in[7]; const float* relb = (const float*)d_in[8];
    const float* wpa = (const float*)d_in[9]; const float* wpb = (const float*)d_in[10]; const float* wout = (const float*)d_in[11];
    float* out = (float*)d_out;
    char* ws = (char*)d_ws; size_t off = 0;
    auto take = [&](size_t bytes) { char* p = ws + off; off += (bytes + 255) & ~(size_t)255; return p; };
    float* h = (float*)take((size_t)S * D * 4);
    float* proj = (float*)take((size_t)S * INW * 4);
    unsigned* mask = (unsigned*)take((size_t)S * 64 * 4);
    float* ya = (float*)take((size_t)S * 512 * 4);
    float* yb = (float*)take((size_t)S * 512 * 4);
    float* pa = (float*)take((size_t)S * D * 4);
    float* pb = (float*)take((size_t)S * D * 4);
    float* merged = (float*)take((size_t)S * D * 4);
    float* tmp = (float*)take((size_t)S * D * 4);
    if (off > ws_size) { fprintf(stderr, "ws too small\n"); return; }
    for (int b = 0; b < NB; ++b) {
        const float* xb = x + (size_t)b * S * D; float* ob = out + (size_t)b * S * D;
        k_rmsnorm<<<S / 4, 256, 0, stream>>>(xb, norm_g, h, S);
        k_sgemm<<<dim3((INW + 63) / 64, S / 64), 256, 0, stream>>>(h, w_in, proj, INW, D, D, INW, INW);
        k_headnorm<<<S * 8 / 4, 256, 0, stream>>>(proj, O_QA, 8, qna, S);
        k_headnorm<<<S * 2 / 4, 256, 0, stream>>>(proj, O_KA, 2, kna, S);
        k_headnorm<<<S * 8 / 4, 256, 0, stream>>>(proj, O_QB, 8, qnb, S);
        k_headnorm<<<S * 8 / 4, 256, 0, stream>>>(proj, O_KB, 8, knb, S);
        k_attnA<<<S * 8 / 4, 256, 0, stream>>>(proj, sinks, relb, ya);
        k_idx_topk<<<S, 256, 0, stream>>>(proj, mask);
        k_attnB<<<S * 8 / 4, 256, 0, stream>>>(proj, mask, relb, yb);
        k_sgemm<<<dim3(D / 64, S / 64), 256, 0, stream>>>(ya, wpa, pa, D, 512, 512, D, D);
        k_sgemm<<<dim3(D / 64, S / 64), 256, 0, stream>>>(yb, wpb, pb, D, 512, 512, D, D);
        k_merge<<<S * D / 256, 256, 0, stream>>>(proj, pa, pb, merged, S);
        k_sgemm<<<dim3(D / 64, S / 64), 256, 0, stream>>>(merged, wout, tmp, D, D, D, D, D);
        k_addres<<<S * D / 256, 256, 0, stream>>>(xb, tmp, ob, (size_t)S * D);
    }
}
```

```cpp
#include <hip/hip_runtime.h>
#include <hip/hip_cooperative_groups.h>
#include <cstdio>
#include <cstdint>
namespace cg = cooperative_groups;

#define LAS __attribute__((address_space(3)))
typedef _Float16 h16;
typedef _Float16 h16x2 __attribute__((ext_vector_type(2)));
typedef _Float16 h16x4 __attribute__((ext_vector_type(4)));
typedef _Float16 h16x8 __attribute__((ext_vector_type(8)));
typedef float f32x2 __attribute__((ext_vector_type(2)));
typedef float f32x4 __attribute__((ext_vector_type(4)));
typedef float f32x16 __attribute__((ext_vector_type(16)));
typedef unsigned u32x2 __attribute__((ext_vector_type(2)));
typedef unsigned u32x4 __attribute__((ext_vector_type(4)));
typedef short s16x4 __attribute__((ext_vector_type(4)));

__device__ __forceinline__ unsigned pkh(float lo, float hi) { const f32x2 v = {lo, hi}; const h16x2 h = __builtin_convertvector(v, h16x2); return __builtin_bit_cast(unsigned, h); }
__device__ __forceinline__ float sigmoidf_fast(float g) { g = fminf(fmaxf(g, -30.f), 30.f); return __builtin_amdgcn_rcpf(1.0f + __builtin_amdgcn_exp2f(-1.4426950408889634f * g)); }

constexpr int NBATCH = 8, SEQ = 2048, DM = 1024, MROWS = NBATCH * SEQ, INW = 5672;
constexpr int IDXP = 304;
constexpr float RMS_EPS = 1e-6f, LOG2E = 1.4426950408889634f, QSCALE = 0.125f * 1.4426950408889634f;
constexpr float HSCALE = 16.f, WSCALE = 64.f, INV_HW = 1.0f / (16.f * 64.f);
constexpr size_t MiB = 1u << 20;
constexpr size_t WS_H2 = 0;
constexpr size_t WS_Y = 0, WS_MG = 32 * MiB;
constexpr size_t WS_WIN = 64 * MiB;
constexpr size_t WS_WP = 77 * MiB, WS_WO = 79 * MiB;
constexpr size_t WS_QA = 81 * MiB, WS_KVA = 97 * MiB, WS_ZA = 105 * MiB, WS_QB = 121 * MiB, WS_KB = 137 * MiB, WS_VB = 153 * MiB, WS_ZB = 169 * MiB;
constexpr size_t WS_IDX = 185 * MiB, IDX_BYTES = (size_t)MROWS * IDXP * 4;
constexpr size_t WS_MASK = 242 * MiB;
constexpr size_t WS_END = 246 * MiB;
static_assert(WS_IDX + 3 * IDX_BYTES <= WS_MASK, "ws map");

namespace pg8 {
#define PG8_LAS __attribute__((address_space(3)))
constexpr int BM = 256, BK = 64, HALF = 128, HTB = HALF * BK * 2  , STAGE_BYTES = 8 * HTB, NXCD = 8, WGM = 8;

__host__ __device__ __forceinline__ int lds_byte(int r, int c) { const int st = (r >> 4) * 2 + (c >> 5), rr = r & 15, cc = c & 31, ob = rr * 64 + cc * 2; return st * 1024 + (ob ^ (((ob >> 9) & 1) << 5)); }
__host__ __device__ __forceinline__ void stage_rc(int b, int& R, int& C) { const int st = b / 1024, sb = b % 1024, swz = sb ^ (((sb >> 9) & 1) << 5); R = (st >> 1) * 16 + swz / 64; C = (st & 1) * 32 + (swz % 64) / 2; }
__host__ __device__ __forceinline__ int perm32(int rho) { const int n = rho >> 4, i = rho & 15; return 8 * (i >> 2) + 4 * n + (i & 3); }

struct Unit { int pm, pn; };

struct StaticOrder {
    int nM, nN, nwg, G, c;
    __host__ __device__ void init(int M, int N, int G_, int c_) { nM = M / BM; nN = N / BM; nwg = nM * nN; G = G_; c = c_; }
    __host__ __device__ bool next(int i, Unit& u) const {
        const long L = (long)i * G + c; if (L >= nwg) return false;
        int wgid = (int)L; { const int q = nwg / NXCD, r = nwg % NXCD, xcd = wgid % NXCD, off = wgid / NXCD; wgid = (xcd < r ? xcd * (q + 1) : r * (q + 1) + (xcd - r) * q) + off; }
        const int nig = WGM * nN, gid = wgid / nig, fm = gid * WGM, gsz = (nM - fm) < WGM ? (nM - fm) : WGM;
        u.pm = fm + ((wgid % nig) % gsz); u.pn = (wgid % nig) / gsz; return true;
    }
    __device__ __forceinline__ void a_ready(const Unit&) const {}
    __device__ __forceinline__ void done(const Unit&) const {}
};

struct GemmPlain { const h16* A; const h16* Bt; int lda, K;
    __device__ __forceinline__ const char* aptr(const Unit& u) const { return (const char*)(A + (size_t)u.pm * BM * lda); }
    __device__ __forceinline__ const char* bptr(const Unit& u) const { return (const char*)(Bt + (size_t)u.pn * BM * K); } };
struct GemmIn { const h16* H2; const h16* Wt; int lda, K;
    __device__ __forceinline__ const char* aptr(const Unit& u) const { return (const char*)(H2 + (size_t)u.pm * BM * lda + ((u.pn == 23 || u.pn == 24) ? 0 : 1024)); }
    __device__ __forceinline__ const char* bptr(const Unit& u) const { const int bt = u.pn < 23 ? u.pn : u.pn - 2; return (const char*)(Wt + (size_t)bt * BM * K); } };

struct EpiIn {
    static constexpr bool PERM = true, AFTER_DRAIN = false, MID = false;
    unsigned char* ws; h16* G;
    __device__ __forceinline__ void operator()(const f32x4 (&acc)[2][2][4][2], const Unit& u, int wr, int wc, int fr, int fq) const {
        const int pn = u.pn, row0 = u.pm * BM + wr * 64 + fr, cl = wc * 32 + 8 * fq;
        if (pn < 21) {
            h16* base; int ldc, colt;
            if (pn < 2)       { base = (h16*)(ws + WS_QA);  ldc = 512; colt = pn * 256; }
            else if (pn == 2) { base = (h16*)(ws + WS_KVA); ldc = 256; colt = 0; }
            else if (pn < 5)  { base = (h16*)(ws + WS_ZA);  ldc = 512; colt = (pn - 3) * 256; }
            else if (pn < 7)  { base = (h16*)(ws + WS_QB);  ldc = 512; colt = (pn - 5) * 256; }
            else if (pn < 9)  { base = (h16*)(ws + WS_KB);  ldc = 512; colt = (pn - 7) * 256; }
            else if (pn < 11) { base = (h16*)(ws + WS_VB);  ldc = 512; colt = (pn - 9) * 256; }
            else if (pn < 13) { base = (h16*)(ws + WS_ZB);  ldc = 512; colt = (pn - 11) * 256; }
            else              { base = G;                   ldc = 2048; colt = (pn - 13) * 256; }
#pragma unroll
            for (int ai = 0; ai < 2; ++ai)
#pragma unroll
                for (int m = 0; m < 4; ++m) { h16* rowp = base + (size_t)(row0 + ai * HALF + m * 16) * ldc + colt + cl;
#pragma unroll
                    for (int bj = 0; bj < 2; ++bj) { const f32x4 v0 = acc[ai][bj][m][0] * INV_HW, v1 = acc[ai][bj][m][1] * INV_HW;
                        u32x4 w; w.x = pkh(v0[0], v0[1]); w.y = pkh(v0[2], v0[3]); w.z = pkh(v1[0], v1[1]); w.w = pkh(v1[2], v1[3]);
                        *(u32x4*)(rowp + bj * HALF) = w; } }
        } else {
            const int term = (pn - 21) >> 1, colt = ((pn - 21) & 1) * 256 + cl;
            float* base = (float*)(ws + WS_IDX + (size_t)term * IDX_BYTES);
#pragma unroll
            for (int ai = 0; ai < 2; ++ai)
#pragma unroll
                for (int m = 0; m < 4; ++m) { float* rowp = base + (size_t)(row0 + ai * HALF + m * 16) * IDXP;
#pragma unroll
                    for (int bj = 0; bj < 2; ++bj)
#pragma unroll
                        for (int n = 0; n < 2; ++n) { const int c = colt + bj * HALF + 4 * n; if (c < IDXP) *(f32x4*)(rowp + c) = acc[ai][bj][m][n] * INV_HW; } }
        }
    }
};
struct EpiMerge {
    static constexpr bool PERM = true, AFTER_DRAIN = false, MID = true;
    const h16* G; h16* MG;
    __device__ __forceinline__ void mid(f32x4 (&acc)[2][2][4][2], const Unit& u, int wr, int wc, int fr, int fq) const {
        const int row0 = u.pm * BM + wr * 64 + fr, col0 = u.pn * BM + wc * 32 + 8 * fq;
#pragma unroll
        for (int ai = 0; ai < 2; ++ai)
#pragma unroll
            for (int m = 0; m < 4; ++m) { unsigned ro = (unsigned)(row0 + ai * HALF + m * 16); asm volatile("" : "+v"(ro)); const h16* gp = G + (size_t)ro * 2048 + col0;
#pragma unroll
                for (int bj = 0; bj < 2; ++bj) { const h16x8 ga = *(const h16x8*)(gp + bj * HALF), gb = *(const h16x8*)(gp + 1024 + bj * HALF);
#pragma unroll
                    for (int e = 0; e < 8; ++e) { const float a = fminf(fmaxf((float)ga[e], -30.f), 30.f), b = fminf(fmaxf((float)gb[e], -30.f), 30.f);
                        const float f = (1.0f + __builtin_amdgcn_exp2f(-LOG2E * b)) * __builtin_amdgcn_rcpf(1.0f + __builtin_amdgcn_exp2f(-LOG2E * a));
                        acc[ai][bj][m][e >> 2][e & 3] *= f; } }
                asm volatile("" ::: "memory"); }
    }
    __device__ __forceinline__ void operator()(const f32x4 (&acc)[2][2][4][2], const Unit& u, int wr, int wc, int fr, int fq) const {
        const int row0 = u.pm * BM + wr * 64 + fr, col0 = u.pn * BM + wc * 32 + 8 * fq;
#pragma unroll
        for (int ai = 0; ai < 2; ++ai)
#pragma unroll
            for (int m = 0; m < 4; ++m) { unsigned ro = (unsigned)(row0 + ai * HALF + m * 16); asm volatile("" : "+v"(ro)); const size_t r = (size_t)ro;
#pragma unroll
                for (int bj = 0; bj < 2; ++bj) { const h16x8 gb = *(const h16x8*)(G + r * 2048 + 1024 + col0 + bj * HALF);
                    float o[8];
#pragma unroll
                    for (int e = 0; e < 8; ++e) o[e] = acc[ai][bj][m][e >> 2][e & 3] * sigmoidf_fast((float)gb[e]);
                    u32x4 w; w.x = pkh(o[0], o[1]); w.y = pkh(o[2], o[3]); w.z = pkh(o[4], o[5]); w.w = pkh(o[6], o[7]);
                    *(u32x4*)(MG + r * 1024 + col0 + bj * HALF) = w; } }
    }
};
struct EpiOut {
    static constexpr bool PERM = true, AFTER_DRAIN = false, MID = false;
    const float* x; float* out;
    __device__ __forceinline__ void operator()(const f32x4 (&acc)[2][2][4][2], const Unit& u, int wr, int wc, int fr, int fq) const {
        const int row0 = u.pm * BM + wr * 64 + fr, col0 = u.pn * BM + wc * 32 + 8 * fq;
#pragma unroll
        for (int ai = 0; ai < 2; ++ai)
#pragma unroll
            for (int m = 0; m < 4; ++m) { const size_t off = (size_t)(row0 + ai * HALF + m * 16) * DM + col0;
#pragma unroll
                for (int bj = 0; bj < 2; ++bj)
#pragma unroll
                    for (int n = 0; n < 2; ++n) { const f32x4 xv = *(const f32x4*)(x + off + bj * HALF + 4 * n); *(f32x4*)(out + off + bj * HALF + 4 * n) = xv + acc[ai][bj][m][n]; }
                if (m & 1) asm volatile("" ::: "memory"); }
    }
};

template <class Epi, class Sched, class GemmT, bool ALIGN_EPI = false, bool SP2 = false>
__device__ __forceinline__ void gemm_phase(PG8_LAS unsigned char* lds, const GemmT g, const Sched& S, const Epi& E) {
    const int tid = threadIdx.x, wid = __builtin_amdgcn_readfirstlane(tid >> 6), lane = tid & 63, wr = wid >> 2, wc = wid & 3, fr = lane & 15, fq = lane >> 4;
    const int K = g.K, nt = K / BK;
    unsigned voffA[2], voffB[2];
#pragma unroll
    for (int i = 0; i < 2; ++i) { int R, C; stage_rc(tid * 16 + i * 8192, R, C); const int Rb = Epi::PERM ? ((R & ~31) + perm32(R & 31)) : R;
        voffA[i] = (unsigned)(R * g.lda + C) * 2u; voffB[i] = (unsigned)(Rb * K + C) * 2u; }
    const size_t kstep = (size_t)(BK * 2);
    const size_t hstepA = (size_t)HALF * g.lda * 2, hstepB = (size_t)HALF * K * 2;
    const unsigned ldsw = (unsigned)wid * 1024u;
    const int aoff = lds_byte(wr * 64 + fr, fq * 8), boff = lds_byte(wc * 32 + fr, fq * 8);
#define PG8_SA(b, h) (((b) * 2 + (h)) * HTB)
#define PG8_SB(b, h) ((4 + (b) * 2 + (h)) * HTB)
#define PG8_STAGE(bufoff, gbase, voff) do { _Pragma("unroll") for (int _i = 0; _i < 2; ++_i) \
        __builtin_amdgcn_global_load_lds((const unsigned*)((const char*)(gbase) + (voff)[_i]), (PG8_LAS unsigned*)(lds + (bufoff) + ldsw + _i * 8192), 16, 0, 0); } while (0)
#define PG8_LDA(dst, b, h) do { _Pragma("unroll") for (int m = 0; m < 4; ++m) _Pragma("unroll") for (int k = 0; k < 2; ++k) dst[m][k] = *(const PG8_LAS h16x8*)(lds + PG8_SA(b, h) + aoff + m * 2048 + k * 1024); } while (0)
#define PG8_LDB(dst, b, h) do { _Pragma("unroll") for (int n = 0; n < 2; ++n) _Pragma("unroll") for (int k = 0; k < 2; ++k) dst[n][k] = *(const PG8_LAS h16x8*)(lds + PG8_SB(b, h) + boff + n * 2048 + k * 1024); } while (0)
#define PG8_MMA(ai, bj, At, Bt) do { __builtin_amdgcn_s_setprio(1); _Pragma("unroll") for (int m = 0; m < 4; ++m) _Pragma("unroll") for (int n = 0; n < 2; ++n) _Pragma("unroll") for (int k = 0; k < 2; ++k) \
        acc[ai][bj][m][n] = __builtin_amdgcn_mfma_f32_16x16x32_f16(Bt[n][k], At[m][k], acc[ai][bj][m][n], 0, 0, 0); __builtin_amdgcn_s_setprio(0); } while (0)
#define PG8_WAIT_V(n) asm volatile("s_waitcnt vmcnt(" #n ")" ::: "memory")
#define PG8_WAIT_L(n) asm volatile("s_waitcnt lgkmcnt(" #n ")" ::: "memory")
#define PG8_BAR __builtin_amdgcn_s_barrier()
#define PG8_SCHED __builtin_amdgcn_sched_barrier(0)
    Unit cur, nxt; int ui = 0;
    if (!S.next(0, cur)) return;
    f32x4 acc[2][2][4][2];
#pragma unroll
    for (int a = 0; a < 2; ++a)
#pragma unroll
        for (int b = 0; b < 2; ++b)
#pragma unroll
            for (int m = 0; m < 4; ++m)
#pragma unroll
                for (int n = 0; n < 2; ++n) acc[a][b][m][n] = (f32x4){0.f, 0.f, 0.f, 0.f};
    h16x8 At[4][2], B0[2][2], B1[2][2];
    const char* cA = g.aptr(cur); const char* cB = g.bptr(cur);
    S.a_ready(cur);
    if constexpr (SP2) {
        PG8_STAGE(PG8_SB(0, 0), cB, voffB); PG8_STAGE(PG8_SB(0, 1), cB + hstepB, voffB); PG8_STAGE(PG8_SA(0, 0), cA, voffA); PG8_STAGE(PG8_SA(0, 1), cA + hstepA, voffA);
        if (wr == 1) PG8_BAR;
        PG8_WAIT_V(2); PG8_BAR;
        PG8_STAGE(PG8_SB(1, 0), cB + kstep, voffB); PG8_STAGE(PG8_SA(1, 0), cA + kstep, voffA); PG8_STAGE(PG8_SB(1, 1), cB + hstepB + kstep, voffB);
        PG8_WAIT_V(6); PG8_BAR;
    } else {
        PG8_STAGE(PG8_SB(0, 0), cB, voffB); PG8_STAGE(PG8_SA(0, 0), cA, voffA); PG8_STAGE(PG8_SB(0, 1), cB + hstepB, voffB); PG8_STAGE(PG8_SA(0, 1), cA + hstepA, voffA);
        if (wr == 1) PG8_BAR;
        PG8_WAIT_V(4); PG8_BAR;
        PG8_STAGE(PG8_SB(1, 0), cB + kstep, voffB); PG8_STAGE(PG8_SA(1, 0), cA + kstep, voffA); PG8_STAGE(PG8_SB(1, 1), cB + hstepB + kstep, voffB);
        PG8_WAIT_V(6); PG8_BAR;
    }
    for (;;) {
        const bool has_next = S.next(ui + 1, nxt);
        const char* nA = has_next ? g.aptr(nxt) : cA; const char* nB = has_next ? g.bptr(nxt) : cB;
        for (int t = 0; t < nt; t += 2) {
            const bool last = (t == nt - 2);
            const char* a1 = cA + (size_t)(t + 1) * kstep;
            const char* a2 = last ? nA : cA + (size_t)(t + 2) * kstep; const char* b2 = last ? nB : cB + (size_t)(t + 2) * kstep;
            const char* a3 = a2 + kstep; const char* b3 = b2 + kstep;
            if (last && has_next) S.a_ready(nxt);
            if constexpr (Epi::MID) { if (t == nt / 2) E.mid(acc, cur, wr, wc, fr, fq); }
            if constexpr (SP2) {
            PG8_LDB(B0, 0, 0); PG8_LDB(B1, 0, 1); PG8_SCHED; PG8_LDA(At, 0, 0); PG8_STAGE(PG8_SA(1, 1), a1 + hstepA, voffA);
            PG8_WAIT_V(8); PG8_WAIT_L(0); PG8_BAR; PG8_MMA(0, 0, At, B0); PG8_MMA(0, 1, At, B1); PG8_BAR; PG8_SCHED;
            PG8_LDA(At, 0, 1); PG8_STAGE(PG8_SB(0, 0), b2, voffB); PG8_STAGE(PG8_SB(0, 1), b2 + hstepB, voffB); PG8_STAGE(PG8_SA(0, 0), a2, voffA);
            PG8_WAIT_V(8); PG8_WAIT_L(0); PG8_BAR; PG8_MMA(1, 0, At, B0); PG8_MMA(1, 1, At, B1); PG8_BAR; PG8_SCHED;
            PG8_LDB(B0, 1, 0); PG8_LDB(B1, 1, 1); PG8_SCHED; PG8_LDA(At, 1, 0); PG8_STAGE(PG8_SA(0, 1), a2 + hstepA, voffA);
            PG8_WAIT_V(8); PG8_WAIT_L(0); PG8_BAR; PG8_MMA(0, 0, At, B0); PG8_MMA(0, 1, At, B1); PG8_BAR; PG8_SCHED;
            PG8_LDA(At, 1, 1); PG8_STAGE(PG8_SB(1, 0), b3, voffB); PG8_STAGE(PG8_SB(1, 1), b3 + hstepB, voffB); PG8_STAGE(PG8_SA(1, 0), a3, voffA);
            PG8_WAIT_V(8); PG8_WAIT_L(0); PG8_BAR; PG8_MMA(1, 0, At, B0); PG8_MMA(1, 1, At, B1); PG8_BAR; PG8_SCHED;
            } else {
            PG8_LDB(B0, 0, 0); PG8_SCHED; PG8_LDA(At, 0, 0); PG8_STAGE(PG8_SA(1, 1), a1 + hstepA, voffA);
            PG8_WAIT_L(8); PG8_BAR; PG8_WAIT_L(0); PG8_MMA(0, 0, At, B0); PG8_BAR; PG8_SCHED;
            PG8_LDB(B1, 0, 1); PG8_STAGE(PG8_SB(0, 0), b2, voffB);
            PG8_BAR; PG8_WAIT_L(0); PG8_MMA(0, 1, At, B1); PG8_BAR;
            PG8_LDA(At, 0, 1); PG8_STAGE(PG8_SA(0, 0), a2, voffA);
            PG8_BAR; PG8_WAIT_L(0); PG8_MMA(1, 0, At, B0); PG8_BAR; PG8_SCHED;
            PG8_STAGE(PG8_SB(0, 1), b2 + hstepB, voffB);
            PG8_WAIT_V(6); PG8_BAR; PG8_MMA(1, 1, At, B1); PG8_BAR;
            PG8_LDB(B0, 1, 0); PG8_SCHED; PG8_LDA(At, 1, 0); PG8_STAGE(PG8_SA(0, 1), a2 + hstepA, voffA);
            PG8_WAIT_L(8); PG8_BAR; PG8_WAIT_L(0); PG8_MMA(0, 0, At, B0); PG8_BAR; PG8_SCHED;
            PG8_LDB(B1, 1, 1); PG8_STAGE(PG8_SB(1, 0), b3, voffB);
            PG8_BAR; PG8_WAIT_L(0); PG8_MMA(0, 1, At, B1); PG8_BAR;
            PG8_LDA(At, 1, 1); PG8_STAGE(PG8_SA(1, 0), a3, voffA);
            PG8_BAR; PG8_WAIT_L(0); PG8_MMA(1, 0, At, B0); PG8_BAR; PG8_SCHED;
            PG8_STAGE(PG8_SB(1, 1), b3 + hstepB, voffB);
            PG8_WAIT_V(6); PG8_BAR; PG8_MMA(1, 1, At, B1); PG8_BAR;
            }
        }
        if constexpr (ALIGN_EPI) { if (wr == 0) PG8_BAR; }
        if constexpr (!Epi::AFTER_DRAIN) { E(acc, cur, wr, wc, fr, fq); S.done(cur); }
        if (!has_next) break;
#pragma unroll
        for (int a = 0; a < 2; ++a)
#pragma unroll
            for (int b = 0; b < 2; ++b)
#pragma unroll
                for (int m = 0; m < 4; ++m)
#pragma unroll
                    for (int n = 0; n < 2; ++n) acc[a][b][m][n] = (f32x4){0.f, 0.f, 0.f, 0.f};
        cur = nxt; cA = nA; cB = nB; ++ui;
        if constexpr (ALIGN_EPI) { if (wr == 1) PG8_BAR; }
    }
    PG8_WAIT_V(0);
    if constexpr (!ALIGN_EPI) { if (wr == 0) PG8_BAR; }
    PG8_BAR;
    if constexpr (Epi::AFTER_DRAIN) { E.fused(acc, cur, wr, wc, fr, fq, lds, wid, lane); S.done(cur); }
#undef PG8_SA
#undef PG8_SB
#undef PG8_STAGE
#undef PG8_LDA
#undef PG8_LDB
#undef PG8_MMA
#undef PG8_WAIT_V
#undef PG8_WAIT_L
#undef PG8_BAR
#undef PG8_SCHED
}
}

constexpr int NWAVES = 8, NTHREADS = 512;
constexpr int RING_BYTES = 131072, LDS_BYTES = 147456;
#define LDS_WAIT() asm volatile("s_waitcnt lgkmcnt(0)" ::: "memory")

struct Frame {
    LAS unsigned char* lds;
    int tid, lane, wave, vcu, G;
    unsigned char* ws;
    const float *x, *norm_g, *w_in, *qna, *kna, *sinks, *qnb, *knb, *relb, *wpa, *wpb, *wout;
    float* out;
};

__device__ __forceinline__ float wave_sum(float v) {
#pragma unroll
    for (int o = 1; o < 64; o <<= 1) v += __shfl_xor(v, o);
    return v;
}
__device__ __forceinline__ int t5_bucket(int n) {
    if (n < 16) return n < 0 ? 0 : n;
    const int l = 16 + (int)(logf((float)n * 0.0625f) / logf(8.0f) * 16.0f);
    return l > 31 ? 31 : l;
}

__device__ __forceinline__ int win_src_col(int n) { return n < 3328 ? n : (n < 5376 ? n + 296 : (n < 5672 ? n - 2048 : -1)); }
template <bool INPROJ>
__device__ __forceinline__ void p0_transpose_item(const float* W, int srcN, int k0, int n0, h16* WT, int ldk, int kdst0, LAS float* scr, int lane, float scale) {
    const int n = n0 + (lane & 31); const int col = INPROJ ? win_src_col(n) : n;
#pragma unroll 8
    for (int i = 0; i < 32; ++i) { const int kk = 2 * i + (lane >> 5); scr[kk * 33 + (lane & 31)] = (col >= 0) ? W[(size_t)(k0 + kk) * srcN + col] * scale : 0.f; }
    LDS_WAIT(); asm volatile("" ::: "memory");
    const int c = lane & 7;
#pragma unroll
    for (int j = 0; j < 4; ++j) { const int nn = (lane >> 3) + 8 * j; const LAS float* s = scr + (8 * c) * 33 + nn;
        float v[8];
#pragma unroll
        for (int e = 0; e < 8; ++e) v[e] = s[e * 33];
        u32x4 o; o.x = pkh(v[0], v[1]); o.y = pkh(v[2], v[3]); o.z = pkh(v[4], v[5]); o.w = pkh(v[6], v[7]);
        *(u32x4*)(WT + (size_t)(n0 + nn) * ldk + kdst0 + k0 + 8 * c) = o;
        if (INPROJ && n0 >= 5376) {
            float r[8];
#pragma unroll
            for (int e = 0; e < 8; ++e) r[e] = v[e] - (float)(h16)v[e];
            u32x4 q; q.x = pkh(r[0], r[1]); q.y = pkh(r[2], r[3]); q.z = pkh(r[4], r[5]); q.w = pkh(r[6], r[7]);
            *(u32x4*)(WT + (size_t)(n0 + nn + 512) * ldk + kdst0 + k0 + 8 * c) = q;
        } }
    LDS_WAIT(); asm volatile("" ::: "memory");
}
__device__ __forceinline__ void p0_norm_row(const float* xrow, const float* g, h16* orow, int lane) {
    f32x4 v[4]; float s = 0.f;
#pragma unroll
    for (int j = 0; j < 4; ++j) { v[j] = *((const f32x4*)xrow + lane + 64 * j); s += (v[j].x * v[j].x + v[j].y * v[j].y) + (v[j].z * v[j].z + v[j].w * v[j].w); }
    const float r = rsqrtf(wave_sum(s) * (1.0f / DM) + RMS_EPS);
#pragma unroll
    for (int j = 0; j < 4; ++j) { const f32x4 gg = *((const f32x4*)g + lane + 64 * j); const f32x4 hv = v[j] * r * gg * HSCALE;
        const h16 h0 = (h16)hv.x, h1 = (h16)hv.y, h2 = (h16)hv.z, h3 = (h16)hv.w;
        u32x2 hi, lo; hi.x = pkh(hv.x, hv.y); hi.y = pkh(hv.z, hv.w);
        lo.x = pkh(hv.x - (float)h0, hv.y - (float)h1); lo.y = pkh(hv.z - (float)h2, hv.w - (float)h3);
        *((u32x2*)(orow + 1024) + lane + 64 * j) = hi; *((u32x2*)orow + lane + 64 * j) = lo; }
}
__device__ __forceinline__ void p0_prologue(Frame& F) {
    LAS float* scr = (LAS float*)(F.lds + F.wave * 16384);
    const int gw = F.vcu * NWAVES + F.wave, NGW = F.G * NWAVES;
    h16* Win = (h16*)(F.ws + WS_WIN); h16* Wp = (h16*)(F.ws + WS_WP); h16* Wo = (h16*)(F.ws + WS_WO);
    constexpr int I_IN = 16 * 184, I_P = 8 * 32, I_O = 16 * 32;
    constexpr int NITEMS = I_IN + 2 * I_P + I_O;
    for (int it = gw; it < NITEMS; it += NGW) {
        int r = it;
        if (r < I_IN) { p0_transpose_item<true>(F.w_in, INW, 64 * (r / 184), 32 * (r % 184), Win, 1024, 0, scr, F.lane, WSCALE); continue; } r -= I_IN;
        if (r < I_P) { p0_transpose_item<false>(F.wpa, DM, 64 * (r / 32), 32 * (r % 32), Wp, 1024, 0, scr, F.lane, 1.f); continue; } r -= I_P;
        if (r < I_P) { p0_transpose_item<false>(F.wpb, DM, 64 * (r / 32), 32 * (r % 32), Wp, 1024, 512, scr, F.lane, 1.f); continue; } r -= I_P;
        p0_transpose_item<false>(F.wout, DM, 64 * (r / 32), 32 * (r % 32), Wo, 1024, 0, scr, F.lane, 1.f);
    }
    h16* H2 = (h16*)(F.ws + WS_H2);
    for (int m = gw; m < MROWS; m += NGW) p0_norm_row(F.x + (size_t)m * DM, F.norm_g, H2 + (size_t)m * 2048, F.lane);
}

__device__ __forceinline__ void headnorm_pass(Frame& F, h16* buf, int pitch, int ncols, const float* gain, float scale) {
    const int cpr = ncols / 8;
    const size_t total = (size_t)MROWS * cpr;
    const size_t gl = (size_t)(F.vcu * NTHREADS + F.tid), NG = (size_t)F.G * NTHREADS;
    const int c8 = (int)(gl & 7);
    float gn[8];
#pragma unroll
    for (int e = 0; e < 8; ++e) gn[e] = gain[c8 * 8 + e] * scale;
    for (size_t ci = gl; ci < total; ci += NG) {
        const size_t row = ci / cpr; const int ch = (int)(ci % cpr);
        h16* p = buf + row * pitch + ch * 8;
        const h16x8 v = *(const h16x8*)p; float f[8]; float ss = 0.f;
#pragma unroll
        for (int e = 0; e < 8; ++e) { f[e] = (float)v[e]; ss += f[e] * f[e]; }
        ss += __shfl_xor(ss, 1); ss += __shfl_xor(ss, 2); ss += __shfl_xor(ss, 4);
        const float r = rsqrtf(ss * (1.0f / 64.0f) + RMS_EPS);
        u32x4 o; o.x = pkh(f[0] * r * gn[0], f[1] * r * gn[1]); o.y = pkh(f[2] * r * gn[2], f[3] * r * gn[3]); o.z = pkh(f[4] * r * gn[4], f[5] * r * gn[5]); o.w = pkh(f[6] * r * gn[6], f[7] * r * gn[7]);
        *(u32x4*)p = o;
    }
}

constexpr size_t WS_QH = 32 * MiB, WS_QL = 40 * MiB, WS_KH = 48 * MiB, WS_KL = 49 * MiB, WS_WI = 50 * MiB;
__device__ __forceinline__ void idx_prepass(Frame& F) {
    const float* I1 = (const float*)(F.ws + WS_IDX); const float* I2 = (const float*)(F.ws + WS_IDX + IDX_BYTES); const float* I3 = (const float*)(F.ws + WS_IDX + 2 * IDX_BYTES);
    const int gw = F.vcu * NWAVES + F.wave, NGW = F.G * NWAVES, l = F.lane;
    for (int m = gw; m < MROWS; m += NGW) {
        if (l < 37) {
            const size_t o = (size_t)m * IDXP + 8 * l;
            const f32x4 a0 = *(const f32x4*)(I1 + o), a1 = *(const f32x4*)(I1 + o + 4), b0 = *(const f32x4*)(I2 + o), b1 = *(const f32x4*)(I2 + o + 4), c0 = *(const f32x4*)(I3 + o), c1 = *(const f32x4*)(I3 + o + 4);
            const f32x4 s0 = (a0 + b0) + c0, s1 = (a1 + b1) + c1;
            if (l < 36) {
                float v[8] = {s0[0] * 16.f, s0[1] * 16.f, s0[2] * 16.f, s0[3] * 16.f, s1[0] * 16.f, s1[1] * 16.f, s1[2] * 16.f, s1[3] * 16.f}; float r[8];
#pragma unroll
                for (int e = 0; e < 8; ++e) r[e] = v[e] - (float)(h16)v[e];
                u32x4 hi, lo; hi.x = pkh(v[0], v[1]); hi.y = pkh(v[2], v[3]); hi.z = pkh(v[4], v[5]); hi.w = pkh(v[6], v[7]);
                lo.x = pkh(r[0], r[1]); lo.y = pkh(r[2], r[3]); lo.z = pkh(r[4], r[5]); lo.w = pkh(r[6], r[7]);
                if (l < 32) { *(u32x4*)((h16*)(F.ws + WS_QH) + (size_t)m * 256 + 8 * l) = hi; *(u32x4*)((h16*)(F.ws + WS_QL) + (size_t)m * 256 + 8 * l) = lo; }
                else { *(u32x4*)((h16*)(F.ws + WS_KH) + (size_t)m * 32 + 8 * (l - 32)) = hi; *(u32x4*)((h16*)(F.ws + WS_KL) + (size_t)m * 32 + 8 * (l - 32)) = lo; }
            } else { float* w = (float*)(F.ws + WS_WI) + (size_t)m * 8; *(f32x4*)w = s0; *(f32x4*)(w + 4) = s1; }
        }
    }
}
constexpr int IX_HIST = 0, IX_ST = 65536, IX_OMASK = 65536 + 1024, IX_TMASK = IX_OMASK + 4096;
__device__ __forceinline__ void idx_item(Frame& F, int b, int g) {
    const int tid = F.tid, lane = F.lane, wid = F.wave, tok = lane & 15, fq = lane >> 4;
    const int t0 = g * 16;
    unsigned* gmask = (unsigned*)(F.ws + WS_MASK) + (size_t)(b * SEQ + t0) * 64;
    if (g < 16) {
        for (int i = tid; i < 1024; i += NTHREADS) { const int tk = i >> 6, w = i & 63, t = t0 + tk, lo = w * 32;
            gmask[i] = (t >= lo + 31) ? 0xffffffffu : (t >= lo ? ((2u << (t - lo)) - 1u) : 0u); }
        return;
    }
    LAS unsigned* hist = (LAS unsigned*)(F.lds + IX_HIST);
    LAS unsigned* st = (LAS unsigned*)(F.lds + IX_ST);
    LAS unsigned* omask = (LAS unsigned*)(F.lds + IX_OMASK);
    LAS unsigned* tmask = (LAS unsigned*)(F.lds + IX_TMASK);
    const int ntile = g + 1;
    const size_t qrow = (size_t)(b * SEQ + t0 + tok);
    h16x8 qhi[8], qlo[8];
#pragma unroll
    for (int h = 0; h < 8; ++h) { qhi[h] = *(const h16x8*)((const h16*)(F.ws + WS_QH) + qrow * 256 + h * 32 + fq * 8); qlo[h] = *(const h16x8*)((const h16*)(F.ws + WS_QL) + qrow * 256 + h * 32 + fq * 8); }
    const f32x4 w0 = *(const f32x4*)((const float*)(F.ws + WS_WI) + qrow * 8), w1 = *(const f32x4*)((const float*)(F.ws + WS_WI) + qrow * 8 + 4);
    const float wv[8] = {w0[0], w0[1], w0[2], w0[3], w1[0], w1[1], w1[2], w1[3]};
    if (tid < 16) { st[96 + tid] = 0xffffffffu; st[112 + tid] = 0u; } if (tid == 0) st[128] = 0u;
    for (int i = tid; i < 2048; i += NTHREADS) omask[i] = 0u;
    unsigned key[16][4];
    unsigned kmin = 0xffffffffu, kmax = 0u;
    const h16* khb = (const h16*)(F.ws + WS_KH) + (size_t)(b * SEQ + tok) * 32 + fq * 8; const h16* klb = (const h16*)(F.ws + WS_KL) + (size_t)(b * SEQ + tok) * 32 + fq * 8;
#pragma unroll
    for (int i = 0; i < 16; ++i) {
        int tile = wid + 8 * i; asm volatile("" : "+s"(tile));
        if (tile < ntile) {
            unsigned toff = (unsigned)tile * (16u * 32u); asm volatile("" : "+v"(toff));
            const h16x8 khi = *(const h16x8*)(khb + toff), klo = *(const h16x8*)(klb + toff);
            f32x4 sc = {0.f, 0.f, 0.f, 0.f};
#pragma unroll
            for (int h = 0; h < 8; ++h) {
                f32x4 a = __builtin_amdgcn_mfma_f32_16x16x32_f16(khi, qhi[h], (f32x4){0.f, 0.f, 0.f, 0.f}, 0, 0, 0);
                a = __builtin_amdgcn_mfma_f32_16x16x32_f16(khi, qlo[h], a, 0, 0, 0);
                a = __builtin_amdgcn_mfma_f32_16x16x32_f16(klo, qhi[h], a, 0, 0, 0);
#pragma unroll
                for (int r = 0; r < 4; ++r) sc[r] = fmaf(wv[h], fmaxf(a[r], 0.f), sc[r]);
            }
#pragma unroll
            for (int r = 0; r < 4; ++r) { const int s = tile * 16 + 4 * fq + r; const unsigned u = __float_as_uint(sc[r] + 0.0f);
                const unsigned k = (u >> 31) ? ~u : (u | 0x80000000u); const bool valid = s <= t0 + tok;
                key[i][r] = valid ? k : 0u; if (valid) { kmin = min(kmin, k); kmax = max(kmax, k); } }
        } else {
#pragma unroll
            for (int r = 0; r < 4; ++r) key[i][r] = 0u;
        }
        asm volatile("" ::: "memory");
    }
    __syncthreads();
    kmin = min(kmin, (unsigned)__shfl_xor((int)kmin, 16)); kmin = min(kmin, (unsigned)__shfl_xor((int)kmin, 32));
    kmax = max(kmax, (unsigned)__shfl_xor((int)kmax, 16)); kmax = max(kmax, (unsigned)__shfl_xor((int)kmax, 32));
    if (fq == 0) { atomicMin((unsigned*)&st[96 + tok], kmin); atomicMax((unsigned*)&st[112 + tok], kmax); }
    __syncthreads();
    if (tid < 16) { const unsigned lo = st[96 + tid], span = st[112 + tid] - lo; st[tid] = lo; st[16 + tid] = span; st[32 + tid] = span >= 1024u ? (unsigned)(22 - __clz((int)span)) : 0u; st[48 + tid] = 256u; }
    for (int round = 0; round < 8; ++round) {
#pragma unroll
        for (int i = 0; i < 8; ++i) *(LAS u32x4*)(F.lds + IX_HIST + tid * 16 + i * 8192) = (u32x4){0u, 0u, 0u, 0u};
        __syncthreads();
        const unsigned done = st[128];
        if (!((done >> tok) & 1u)) {
            const unsigned lo = st[tok], span = st[16 + tok], shift = st[32 + tok];
#pragma unroll
            for (int i = 0; i < 16; ++i) {
                int tile = wid + 8 * i; asm volatile("" : "+s"(tile));
                if (tile < ntile) {
#pragma unroll
                    for (int r = 0; r < 4; ++r) { const unsigned k = key[i][r]; if (k >= lo && k - lo <= span) atomicAdd((unsigned*)&hist[tok * 1024 + ((k - lo) >> shift)], 1u); }
                }
            }
        }
        __syncthreads();
#pragma unroll 1
        for (int tt = 0; tt < 2; ++tt) {
            const int tk = 2 * wid + tt;
            if (!((done >> tk) & 1u)) {
                const LAS u32x4* hp = (const LAS u32x4*)(hist + tk * 1024 + 16 * lane);
                const u32x4 c0 = hp[0], c1 = hp[1], c2 = hp[2], c3 = hp[3];
                const unsigned cnt[16] = {c0.x, c0.y, c0.z, c0.w, c1.x, c1.y, c1.z, c1.w, c2.x, c2.y, c2.z, c2.w, c3.x, c3.y, c3.z, c3.w};
                unsigned s = 0;
#pragma unroll
                for (int e = 0; e < 16; ++e) s += cnt[e];
                unsigned v = s;
#pragma unroll
                for (int o = 1; o < 64; o <<= 1) { const unsigned tmp = (unsigned)__shfl_down((int)v, o); if (lane + o < 64) v += tmp; }
                const unsigned above = v - s, need = st[48 + tk];
                if (above < need && need <= above + s) {
                    unsigned cum = above, bstar = 0, rr = 0, cb = 0; bool found = false;
#pragma unroll
                    for (int e = 15; e >= 0; --e) { const unsigned c = cnt[e]; if (!found && cum + c >= need) { found = true; bstar = 16u * lane + e; rr = need - cum; cb = c; } if (!found) cum += c; }
                    const unsigned lo = st[tk], shift = st[32 + tk];
                    const unsigned newlo = lo + (bstar << shift);
                    if (cb == rr) { st[64 + tk] = newlo; st[80 + tk] = 0u; atomicOr((unsigned*)&st[128], 1u << tk); }
                    else if (shift == 0u) { st[64 + tk] = newlo; st[80 + tk] = rr; atomicOr((unsigned*)&st[128], 1u << tk); }
                    else { st[tk] = newlo; st[16 + tk] = (1u << shift) - 1u; st[32 + tk] = shift > 10u ? shift - 10u : 0u; st[48 + tk] = rr; }
                }
            }
        }
        __syncthreads();
        if (st[128] == 0xffffu) break;
    }
    {
        const unsigned T = st[64 + tok], tr = st[80 + tok];
#pragma unroll
        for (int i = 0; i < 16; ++i) {
            int tile = wid + 8 * i; asm volatile("" : "+s"(tile));
            if (tile < ntile) {
                unsigned nib = 0u, tnib = 0u;
#pragma unroll
                for (int r = 0; r < 4; ++r) { const unsigned k = key[i][r]; const bool sel = tr ? (k > T) : (k >= T); nib |= sel ? (1u << r) : 0u; tnib |= (tr && k == T) ? (1u << r) : 0u; }
                const int s0 = tile * 16 + 4 * fq;
                if (nib) atomicOr((unsigned*)&omask[tok * 64 + (s0 >> 5)], nib << (s0 & 31));
                if (tnib) atomicOr((unsigned*)&tmask[tok * 64 + (s0 >> 5)], tnib << (s0 & 31));
            }
        }
    }
    __syncthreads();
#pragma unroll 1
    for (int tt = 0; tt < 2; ++tt) {
        const int tk = 2 * wid + tt; const unsigned tr = st[80 + tk];
        if (tr) {
            unsigned w = tmask[tk * 64 + lane]; const unsigned pc = __popc(w);
            unsigned incl = pc;
#pragma unroll
            for (int o = 1; o < 64; o <<= 1) { const unsigned tmp = (unsigned)__shfl_up((int)incl, o); if (lane >= o) incl += tmp; }
            const unsigned before = incl - pc;
            unsigned n = before >= tr ? 0u : min(tr - before, pc), kept = 0u;
            while (n) { const unsigned bit = w & (0u - w); kept |= bit; w ^= bit; --n; }
            if (kept) omask[tk * 64 + lane] |= kept;
        }
    }
    __syncthreads();
    for (int i = tid; i < 1024; i += NTHREADS) gmask[i] = omask[i];
    __syncthreads();
}
__device__ __forceinline__ void p2_norm_phase(Frame& F) {
    headnorm_pass(F, (h16*)(F.ws + WS_QA), 512, 512, F.qna, QSCALE);
    headnorm_pass(F, (h16*)(F.ws + WS_KVA), 256, 128, F.kna, 1.f);
    headnorm_pass(F, (h16*)(F.ws + WS_QB), 512, 512, F.qnb, QSCALE);
    headnorm_pass(F, (h16*)(F.ws + WS_KB), 512, 512, F.knb, 1.f);
    idx_prepass(F);
}
__device__ __forceinline__ void p3_index_phase(Frame& F) {
    for (int v = F.vcu; v < 256; v += F.G) {
        const int b = v >> 5, p = v & 31;
#pragma unroll 1
        for (int k = 0; k < 4; ++k) { const int g = (k == 0) ? p : (k == 1) ? 63 - p : (k == 2) ? 64 + p : 127 - p; idx_item(F, b, g); }
    }
}

constexpr int AT_K = 0, AT_KSZ = 64 * 144, AT_V = 2 * AT_KSZ, AT_VSZ = 64 * 192, AT_LUT = AT_V + 2 * AT_VSZ, AT_OST = AT_LUT + 320 * 4, AT_OSTSZ = 32 * 144;
static_assert(AT_OST + 8 * AT_OSTSZ <= RING_BYTES, "attention LDS");
__device__ __forceinline__ s16x4 vtr_read(const LAS unsigned char* p) { return __builtin_amdgcn_ds_read_tr16_b64_v4i16((LAS s16x4*)p); }

template <bool ISB>
__device__ __forceinline__ void attn_unit(Frame& F, int b, int h, int qb) {
    const int tid = F.tid, lane = F.lane, wid = F.wave, q = lane & 31, hi = lane >> 5;
    const int q0 = qb * 256, r0 = q0 + wid * 32, t = r0 + q;
    const size_t row = (size_t)b * SEQ + t;
    const h16* Qp; const h16* Kp; const h16* Vp; const h16* Zp; int kvpitch, ycol;
    if (ISB) { Qp = (const h16*)(F.ws + WS_QB) + h * 64; Kp = (const h16*)(F.ws + WS_KB) + h * 64; Vp = (const h16*)(F.ws + WS_VB) + h * 64; Zp = (const h16*)(F.ws + WS_ZB) + h * 64; kvpitch = 512; ycol = 512 + h * 64; }
    else     { Qp = (const h16*)(F.ws + WS_QA) + h * 64; Kp = (const h16*)(F.ws + WS_KVA) + (h >> 2) * 64; Vp = (const h16*)(F.ws + WS_KVA) + 128 + (h >> 2) * 64; Zp = (const h16*)(F.ws + WS_ZA) + h * 64; kvpitch = 256; ycol = h * 64; }
    const unsigned* mrow = (const unsigned*)(F.ws + WS_MASK) + row * 64;
    LAS float* lut = (LAS float*)(F.lds + AT_LUT);
    for (int i = tid; i < 320; i += NTHREADS) { const int dist = 223 - i; float v;
        if (ISB) v = dist < 0 ? 0.f : F.relb[t5_bucket(dist > 127 ? 127 : dist) * 16 + 8 + h] * LOG2E;
        else v = (dist >= 0 && dist < 128) ? F.relb[t5_bucket(dist) * 16 + h] * LOG2E : -INFINITY;
        lut[i] = v; }
    const float cfar = ISB ? F.relb[31 * 16 + 8 + h] * LOG2E : 0.f;
    h16x8 qr[4];
#pragma unroll
    for (int d0 = 0; d0 < 4; ++d0) qr[d0] = *(const h16x8*)(Qp + row * 512 + d0 * 16 + hi * 8);
    const int kt_lo = ISB ? 0 : (4 * qb - 2 < 0 ? 0 : 4 * qb - 2), kt_hi = 4 * qb + 3;
    const int srow = tid >> 3, sch = tid & 7;
    const h16* kg = Kp + ((size_t)b * SEQ + srow) * kvpitch + sch * 8; const h16* vg = Vp + ((size_t)b * SEQ + srow) * kvpitch + sch * 8;
    const int kst = srow * 144 + sch * 16, vst = srow * 192 + sch * 16;
    u32x4 kreg = *(const u32x4*)(kg + (size_t)kt_lo * 64 * kvpitch), vreg = *(const u32x4*)(vg + (size_t)kt_lo * 64 * kvpitch);
    u32x2 mw = {0u, 0u}, mwn = {0u, 0u};
    if (ISB) mw = *(const u32x2*)(mrow + 2 * kt_lo);
    *(LAS u32x4*)(F.lds + AT_K + kst) = kreg; *(LAS u32x4*)(F.lds + AT_V + vst) = vreg;
    __syncthreads();
    float m_run = -INFINITY, l_run = 0.f;
    f32x16 o[2];
#pragma unroll
    for (int r = 0; r < 16; ++r) { o[0][r] = 0.f; o[1][r] = 0.f; }
    const int kfo = q * 144 + hi * 16;
    const int vfo = (4 * hi + ((lane & 15) >> 2)) * 192 + ((lane >> 4) & 1) * 32 + (lane & 3) * 8;
    for (int kt = kt_lo; kt <= kt_hi; ++kt) {
        const int cur = (kt - kt_lo) & 1;
        if (kt < kt_hi) { kreg = *(const u32x4*)(kg + (size_t)(kt + 1) * 64 * kvpitch); vreg = *(const u32x4*)(vg + (size_t)(kt + 1) * 64 * kvpitch); if (ISB) mwn = *(const u32x2*)(mrow + 2 * (kt + 1)); }
        const int k0 = kt * 64;
        const bool active = ISB ? (k0 <= r0 + 31) : (k0 <= r0 + 31 && k0 + 63 >= r0 - 127);
        if (active) {
            const LAS unsigned char* kb = F.lds + AT_K + cur * AT_KSZ + kfo;
            const LAS unsigned char* vb = F.lds + AT_V + cur * AT_VSZ + vfo;
            f32x16 p0, p1;
#pragma unroll
            for (int r = 0; r < 16; ++r) { p0[r] = 0.f; p1[r] = 0.f; }
#pragma unroll
            for (int d0 = 0; d0 < 4; ++d0) {
                const h16x8 ka = *(const LAS h16x8*)(kb + d0 * 32), kc = *(const LAS h16x8*)(kb + 32 * 144 + d0 * 32);
                p0 = __builtin_amdgcn_mfma_f32_32x32x16_f16(ka, qr[d0], p0, 0, 0, 0);
                p1 = __builtin_amdgcn_mfma_f32_32x32x16_f16(kc, qr[d0], p1, 0, 0, 0);
            }
            if (ISB && (r0 - k0 - 63 >= 113)) {
#pragma unroll
                for (int r = 0; r < 16; ++r) { p0[r] += cfar; p1[r] += cfar; }
            } else {
                const LAS float* lp = lut + (223 - (t - k0 - 4 * hi));
#pragma unroll
                for (int r = 0; r < 16; ++r) { const int c = (r & 3) + 8 * (r >> 2); p0[r] += lp[c]; p1[r] += lp[32 + c]; }
            }
            if (ISB) {
                const unsigned mm0 = mw.x >> (4 * hi), mm1 = mw.y >> (4 * hi);
#pragma unroll
                for (int r = 0; r < 16; ++r) { const unsigned bit = 1u << ((r & 3) + 8 * (r >> 2)); if (!(mm0 & bit)) p0[r] = -INFINITY; if (!(mm1 & bit)) p1[r] = -INFINITY; }
            }
            float mx = fmaxf(p0[0], p1[0]);
#pragma unroll
            for (int r = 1; r < 16; ++r) mx = fmaxf(mx, fmaxf(p0[r], p1[r]));
            mx = fmaxf(mx, __shfl_xor(mx, 32));
            const float mnew = fmaxf(m_run, mx), muse = (mnew == -INFINITY) ? 0.f : mnew;
            const float alpha = __builtin_amdgcn_exp2f(m_run - muse);
            m_run = mnew;
            float sum = 0.f;
#pragma unroll
            for (int r = 0; r < 16; ++r) { p0[r] = __builtin_amdgcn_exp2f(p0[r] - muse); p1[r] = __builtin_amdgcn_exp2f(p1[r] - muse); sum += p0[r] + p1[r]; }
            l_run = l_run * alpha + sum;
#pragma unroll
            for (int r = 0; r < 16; ++r) { o[0][r] *= alpha; o[1][r] *= alpha; }
            u32x4 pk[4];
            pk[0] = (u32x4){pkh(p0[0], p0[1]), pkh(p0[2], p0[3]), pkh(p0[4], p0[5]), pkh(p0[6], p0[7])};
            pk[1] = (u32x4){pkh(p0[8], p0[9]), pkh(p0[10], p0[11]), pkh(p0[12], p0[13]), pkh(p0[14], p0[15])};
            pk[2] = (u32x4){pkh(p1[0], p1[1]), pkh(p1[2], p1[3]), pkh(p1[4], p1[5]), pkh(p1[6], p1[7])};
            pk[3] = (u32x4){pkh(p1[8], p1[9]), pkh(p1[10], p1[11]), pkh(p1[12], p1[13]), pkh(p1[14], p1[15])};
#pragma unroll
            for (int s = 0; s < 4; ++s)
#pragma unroll
                for (int d1 = 0; d1 < 2; ++d1) {
                    const s16x4 lo4 = vtr_read(vb + (16 * s) * 192 + d1 * 64), hi4 = vtr_read(vb + (16 * s + 8) * 192 + d1 * 64);
                    const h16x4 lf = __builtin_bit_cast(h16x4, lo4), hf = __builtin_bit_cast(h16x4, hi4);
                    const h16x8 vf = {lf[0], lf[1], lf[2], lf[3], hf[0], hf[1], hf[2], hf[3]};
                    o[d1] = __builtin_amdgcn_mfma_f32_32x32x16_f16(vf, __builtin_bit_cast(h16x8, pk[s]), o[d1], 0, 0, 0);
                }
        }
        if (kt < kt_hi) { *(LAS u32x4*)(F.lds + AT_K + (cur ^ 1) * AT_KSZ + kst) = kreg; *(LAS u32x4*)(F.lds + AT_V + (cur ^ 1) * AT_VSZ + vst) = vreg; mw = mwn; }
        __syncthreads();
    }
    l_run += __shfl_xor(l_run, 32);
    if (!ISB) l_run += __builtin_amdgcn_exp2f(F.sinks[h] * LOG2E - m_run);
    const float inv = 1.0f / l_run;
    LAS unsigned char* ost = F.lds + AT_OST + wid * AT_OSTSZ;
#pragma unroll
    for (int d1 = 0; d1 < 2; ++d1)
#pragma unroll
        for (int g4 = 0; g4 < 4; ++g4) { u32x2 w; w.x = pkh(o[d1][4 * g4] * inv, o[d1][4 * g4 + 1] * inv); w.y = pkh(o[d1][4 * g4 + 2] * inv, o[d1][4 * g4 + 3] * inv);
            *(LAS u32x2*)(ost + q * 144 + (32 * d1 + 8 * g4 + 4 * hi) * 2) = w; }
    LDS_WAIT(); asm volatile("" ::: "memory");
    h16* Yp = (h16*)(F.ws + WS_Y);
#pragma unroll
    for (int i = 0; i < 4; ++i) { const int rr = i * 8 + (lane >> 3), ch = lane & 7; const size_t grow = (size_t)b * SEQ + r0 + rr;
        const h16x8 ov = *(const LAS h16x8*)(ost + rr * 144 + ch * 16); const h16x8 zv = *(const h16x8*)(Zp + grow * 512 + ch * 8);
        float y[8];
#pragma unroll
        for (int e = 0; e < 8; ++e) { const float z = (float)zv[e]; y[e] = (float)ov[e] * z * sigmoidf_fast(z); }
        u32x4 w; w.x = pkh(y[0], y[1]); w.y = pkh(y[2], y[3]); w.z = pkh(y[4], y[5]); w.w = pkh(y[6], y[7]);
        *(u32x4*)(Yp + grow * 1024 + ycol + ch * 8) = w; }
    __syncthreads();
}
__device__ __forceinline__ void p4_attention_phase(Frame& F) {
    for (int v = F.vcu; v < 256; v += F.G) {
        const int bh = v >> 2, j = v & 3, b = bh >> 3, h = bh & 7;
        attn_unit<true>(F, b, h, 7 - j); attn_unit<true>(F, b, h, j);
        attn_unit<false>(F, b, h, 2 * j); attn_unit<false>(F, b, h, 2 * j + 1);
    }
}

struct Args { const float* in[12]; float* out; unsigned char* ws; int ph_lo, ph_hi; };
constexpr int N_PHASES = 7;
__global__ void __launch_bounds__(NTHREADS, 2) mk_fwd(Args args) {
    extern __shared__ __attribute__((aligned(16))) unsigned char lds_raw[];
    cg::grid_group grid = cg::this_grid();
    Frame F;
    F.lds = (LAS unsigned char*)lds_raw;
    F.tid = threadIdx.x; F.lane = F.tid & 63; F.wave = __builtin_amdgcn_readfirstlane(F.tid >> 6);
    F.G = gridDim.x; { const int bx = blockIdx.x; F.vcu = (F.G % 8 == 0) ? (bx % 8) * (F.G / 8) + bx / 8 : bx; }
    F.ws = args.ws;
    F.x = args.in[0]; F.norm_g = args.in[1]; F.w_in = args.in[2]; F.qna = args.in[3]; F.kna = args.in[4]; F.sinks = args.in[5];
    F.qnb = args.in[6]; F.knb = args.in[7]; F.relb = args.in[8]; F.wpa = args.in[9]; F.wpb = args.in[10]; F.wout = args.in[11]; F.out = args.out;
    const int lo = args.ph_lo, hi = args.ph_hi;
#ifdef ONLY_PH
#define IN(k) ((k) == ONLY_PH && lo <= (k) && (k) < hi)
#else
#define IN(k) (lo <= (k) && (k) < hi)
#endif
#define SEAM(k) do { if (IN(k) && IN((k) + 1)) grid.sync(); } while (0)
    if (IN(0)) { p0_prologue(F); }
    SEAM(0);
    if (IN(1)) {
        pg8::GemmIn g{(const h16*)(F.ws + WS_H2), (const h16*)(F.ws + WS_WIN), 2048, 1024};
        pg8::StaticOrder S; S.init(MROWS, 27 * 256, F.G, (int)blockIdx.x);
        pg8::EpiIn E{F.ws, (h16*)F.out};
        pg8::gemm_phase<pg8::EpiIn, pg8::StaticOrder, pg8::GemmIn, true, true>(F.lds, g, S, E);
    }
    SEAM(1);
    if (IN(2)) { p2_norm_phase(F); }
    SEAM(2);
    if (IN(3)) { p3_index_phase(F); }
    SEAM(3);
    if (IN(4)) { p4_attention_phase(F); }
    SEAM(4);
    if (IN(5)) {
        pg8::GemmPlain g{(const h16*)(F.ws + WS_Y), (const h16*)(F.ws + WS_WP), 1024, 1024};
        pg8::StaticOrder S; S.init(MROWS, DM, F.G, (int)blockIdx.x);
        pg8::EpiMerge E{(const h16*)F.out, (h16*)(F.ws + WS_MG)};
        pg8::gemm_phase<pg8::EpiMerge, pg8::StaticOrder, pg8::GemmPlain, true, true>(F.lds, g, S, E);
    }
    SEAM(5);
    if (IN(6)) {
        pg8::GemmPlain g{(const h16*)(F.ws + WS_MG), (const h16*)(F.ws + WS_WO), 1024, 1024};
        pg8::StaticOrder S; S.init(MROWS, DM, F.G, (int)blockIdx.x);
        pg8::EpiOut E{F.x, F.out};
        pg8::gemm_phase<pg8::EpiOut, pg8::StaticOrder, pg8::GemmPlain, true, true>(F.lds, g, S, E);
    }
#undef IN
#undef SEAM
}

#ifndef MK_N_LAUNCHES
#define MK_N_LAUNCHES 1
#endif
extern "C" void kernel_launch(void* const* d_in, const int* in_sizes, int n_in, void* d_out, int out_size, void* d_ws, size_t ws_size, hipStream_t stream) {
    static int grid = 0;
    if (grid == 0) {
        if (n_in != 12 || in_sizes[0] != MROWS * DM || out_size != MROWS * DM || ws_size < WS_END) { fprintf(stderr, "kernel_launch: unexpected problem (n_in %d, ws %zu)\n", n_in, ws_size); grid = -1; return; }
        int dev = 0, cus = 0, per_cu = 0;
        hipGetDevice(&dev); hipDeviceGetAttribute(&cus, hipDeviceAttributeMultiprocessorCount, dev);
        hipFuncSetAttribute((const void*)mk_fwd, hipFuncAttributeMaxDynamicSharedMemorySize, LDS_BYTES);
        hipOccupancyMaxActiveBlocksPerMultiprocessor(&per_cu, (const void*)mk_fwd, NTHREADS, LDS_BYTES);
        (void)hipGetLastError();
        if (per_cu < 1) { fprintf(stderr, "kernel_launch: occupancy query says %d blocks/CU\n", per_cu); per_cu = 1; }
        grid = cus;
        if (grid > 256) grid = 256;
    }
    if (grid < 0) return;
    Args a{};
    for (int i = 0; i < 12; ++i) a.in[i] = (const float*)d_in[i];
    a.out = (float*)d_out; a.ws = (unsigned char*)d_ws;
    if (MK_N_LAUNCHES == 1) {
        a.ph_lo = 0; a.ph_hi = N_PHASES;
        void* kargs[] = {&a};
        hipError_t e = hipLaunchCooperativeKernel((const void*)mk_fwd, dim3(grid), dim3(NTHREADS), kargs, LDS_BYTES, stream);
        if (e != hipSuccess) fprintf(stderr, "cooperative launch failed: %s (grid %d)\n", hipGetErrorString(e), grid);
    } else {
        for (int p = 0; p < N_PHASES; ++p) { a.ph_lo = p; a.ph_hi = p + 1; hipLaunchKernelGGL(mk_fwd, dim3(grid), dim3(NTHREADS), LDS_BYTES, stream, a); }
    }
}
```

```cpp
#include <hip/hip_runtime.h>
#include <hip/hip_cooperative_groups.h>
#include <cstdio>
#include <cstdint>
namespace cg = cooperative_groups;

#define LAS __attribute__((address_space(3)))
typedef _Float16 h16;
typedef _Float16 h16x2 __attribute__((ext_vector_type(2)));
typedef _Float16 h16x4 __attribute__((ext_vector_type(4)));
typedef _Float16 h16x8 __attribute__((ext_vector_type(8)));
typedef float f32x2 __attribute__((ext_vector_type(2)));
typedef float f32x4 __attribute__((ext_vector_type(4)));
typedef float f32x16 __attribute__((ext_vector_type(16)));
typedef unsigned u32x2 __attribute__((ext_vector_type(2)));
typedef unsigned u32x4 __attribute__((ext_vector_type(4)));
typedef short s16x4 __attribute__((ext_vector_type(4)));

__device__ __forceinline__ unsigned pkh(float lo, float hi) { const f32x2 v = {lo, hi}; const h16x2 h = __builtin_convertvector(v, h16x2); return __builtin_bit_cast(unsigned, h); }
__device__ __forceinline__ float sigmoidf_fast(float g) { g = fminf(fmaxf(g, -30.f), 30.f); return __builtin_amdgcn_rcpf(1.0f + __builtin_amdgcn_exp2f(-1.4426950408889634f * g)); }

constexpr int NBATCH = 8, SEQ = 2048, DM = 1024, MROWS = NBATCH * SEQ, INW = 5672;
constexpr int IDXP = 304;
constexpr float RMS_EPS = 1e-6f, LOG2E = 1.4426950408889634f, QSCALE = 0.125f * 1.4426950408889634f;
constexpr float HSCALE = 16.f, WSCALE = 64.f, INV_HW = 1.0f / (16.f * 64.f);
constexpr size_t MiB = 1u << 20;
constexpr size_t WS_H2 = 0;
constexpr size_t WS_Y = 0, WS_MG = 32 * MiB;
constexpr size_t WS_WIN = 64 * MiB;
constexpr size_t WS_WP = 77 * MiB, WS_WO = 79 * MiB;
constexpr size_t WS_QA = 81 * MiB, WS_KVA = 97 * MiB, WS_ZA = 105 * MiB, WS_QB = 121 * MiB, WS_KB = 137 * MiB, WS_VB = 153 * MiB, WS_ZB = 169 * MiB;
constexpr size_t WS_IDX = 185 * MiB, IDX_BYTES = (size_t)MROWS * IDXP * 4;
constexpr size_t WS_MASK = 242 * MiB;
constexpr size_t WS_CTL = 246 * MiB, CTL_BYTES = 16384;
constexpr size_t WS_END = 247 * MiB;
static_assert(WS_IDX + 3 * IDX_BYTES <= WS_MASK, "ws map");

namespace pg8 {
#define PG8_LAS __attribute__((address_space(3)))
constexpr int BM = 256, BK = 64, HALF = 128, HTB = HALF * BK * 2  , STAGE_BYTES = 8 * HTB, NXCD = 8, WGM = 8;

__host__ __device__ __forceinline__ int lds_byte(int r, int c) { const int st = (r >> 4) * 2 + (c >> 5), rr = r & 15, cc = c & 31, ob = rr * 64 + cc * 2; return st * 1024 + (ob ^ (((ob >> 9) & 1) << 5)); }
__host__ __device__ __forceinline__ void stage_rc(int b, int& R, int& C) { const int st = b / 1024, sb = b % 1024, swz = sb ^ (((sb >> 9) & 1) << 5); R = (st >> 1) * 16 + swz / 64; C = (st & 1) * 32 + (swz % 64) / 2; }
__host__ __device__ __forceinline__ int perm32(int rho) { const int n = rho >> 4, i = rho & 15; return 8 * (i >> 2) + 4 * n + (i & 3); }

struct Unit { int pm, pn; };

struct StaticOrder {
    int nM, nN, nwg, G, c;
    __host__ __device__ void init(int M, int N, int G_, int c_) { nM = M / BM; nN = N / BM; nwg = nM * nN; G = G_; c = c_; }
    __host__ __device__ bool next(int i, Unit& u) const {
        const long L = (long)i * G + c; if (L >= nwg) return false;
        int wgid = (int)L; { const int q = nwg / NXCD, r = nwg % NXCD, xcd = wgid % NXCD, off = wgid / NXCD; wgid = (xcd < r ? xcd * (q + 1) : r * (q + 1) + (xcd - r) * q) + off; }
        const int nig = WGM * nN, gid = wgid / nig, fm = gid * WGM, gsz = (nM - fm) < WGM ? (nM - fm) : WGM;
        u.pm = fm + ((wgid % nig) % gsz); u.pn = (wgid % nig) / gsz; return true;
    }
    __device__ __forceinline__ void a_ready(const Unit&) const {}
    __device__ __forceinline__ void done(const Unit&) const {}
};

struct GemmPlain { const h16* A; const h16* Bt; int lda, K;
    __device__ __forceinline__ const char* aptr(const Unit& u) const { return (const char*)(A + (size_t)u.pm * BM * lda); }
    __device__ __forceinline__ const char* bptr(const Unit& u) const { return (const char*)(Bt + (size_t)u.pn * BM * K); } };
struct GemmIn { const h16* H2; const h16* Wt; int lda, K;
    __device__ __forceinline__ const char* aptr(const Unit& u) const { return (const char*)(H2 + (size_t)u.pm * BM * lda + ((u.pn == 23 || u.pn == 24) ? 0 : 1024)); }
    __device__ __forceinline__ const char* bptr(const Unit& u) const { const int bt = u.pn < 23 ? u.pn : u.pn - 2; return (const char*)(Wt + (size_t)bt * BM * K); } };

struct EpiIn {
    static constexpr bool PERM = true, AFTER_DRAIN = false, MID = false;
    unsigned char* ws; h16* G;
    __device__ __forceinline__ void operator()(const f32x4 (&acc)[2][2][4][2], const Unit& u, int wr, int wc, int fr, int fq) const {
        const int pn = u.pn, row0 = u.pm * BM + wr * 64 + fr, cl = wc * 32 + 8 * fq;
        if (pn < 21) {
            h16* base; int ldc, colt;
            if (pn < 2)       { base = (h16*)(ws + WS_QA);  ldc = 512; colt = pn * 256; }
            else if (pn == 2) { base = (h16*)(ws + WS_KVA); ldc = 256; colt = 0; }
            else if (pn < 5)  { base = (h16*)(ws + WS_ZA);  ldc = 512; colt = (pn - 3) * 256; }
            else if (pn < 7)  { base = (h16*)(ws + WS_QB);  ldc = 512; colt = (pn - 5) * 256; }
            else if (pn < 9)  { base = (h16*)(ws + WS_KB);  ldc = 512; colt = (pn - 7) * 256; }
            else if (pn < 11) { base = (h16*)(ws + WS_VB);  ldc = 512; colt = (pn - 9) * 256; }
            else if (pn < 13) { base = (h16*)(ws + WS_ZB);  ldc = 512; colt = (pn - 11) * 256; }
            else              { base = G;                   ldc = 2048; colt = (pn - 13) * 256; }
#pragma unroll
            for (int ai = 0; ai < 2; ++ai)
#pragma unroll
                for (int m = 0; m < 4; ++m) { h16* rowp = base + (size_t)(row0 + ai * HALF + m * 16) * ldc + colt + cl;
#pragma unroll
                    for (int bj = 0; bj < 2; ++bj) { const f32x4 v0 = acc[ai][bj][m][0] * INV_HW, v1 = acc[ai][bj][m][1] * INV_HW;
                        u32x4 w; w.x = pkh(v0[0], v0[1]); w.y = pkh(v0[2], v0[3]); w.z = pkh(v1[0], v1[1]); w.w = pkh(v1[2], v1[3]);
                        *(u32x4*)(rowp + bj * HALF) = w; } }
        } else {
            const int term = (pn - 21) >> 1, colt = ((pn - 21) & 1) * 256 + cl;
            float* base = (float*)(ws + WS_IDX + (size_t)term * IDX_BYTES);
#pragma unroll
            for (int ai = 0; ai < 2; ++ai)
#pragma unroll
                for (int m = 0; m < 4; ++m) { float* rowp = base + (size_t)(row0 + ai * HALF + m * 16) * IDXP;
#pragma unroll
                    for (int bj = 0; bj < 2; ++bj)
#pragma unroll
                        for (int n = 0; n < 2; ++n) { const int c = colt + bj * HALF + 4 * n; if (c < IDXP) *(f32x4*)(rowp + c) = acc[ai][bj][m][n] * INV_HW; } }
        }
    }
};
struct EpiMerge {
    static constexpr bool PERM = true, AFTER_DRAIN = false, MID = true;
    const h16* G; h16* MG;
    __device__ __forceinline__ void mid(f32x4 (&acc)[2][2][4][2], const Unit& u, int wr, int wc, int fr, int fq) const {
        const int row0 = u.pm * BM + wr * 64 + fr, col0 = u.pn * BM + wc * 32 + 8 * fq;
#pragma unroll
        for (int ai = 0; ai < 2; ++ai)
#pragma unroll
            for (int m = 0; m < 4; ++m) { unsigned ro = (unsigned)(row0 + ai * HALF + m * 16); asm volatile("" : "+v"(ro)); const h16* gp = G + (size_t)ro * 2048 + col0;
#pragma unroll
                for (int bj = 0; bj < 2; ++bj) { const h16x8 ga = *(const h16x8*)(gp + bj * HALF), gb = *(const h16x8*)(gp + 1024 + bj * HALF);
#pragma unroll
                    for (int e = 0; e < 8; ++e) { const float a = fminf(fmaxf((float)ga[e], -30.f), 30.f), b = fminf(fmaxf((float)gb[e], -30.f), 30.f);
                        const float f = (1.0f + __builtin_amdgcn_exp2f(-LOG2E * b)) * __builtin_amdgcn_rcpf(1.0f + __builtin_amdgcn_exp2f(-LOG2E * a));
                        acc[ai][bj][m][e >> 2][e & 3] *= f; } }
                asm volatile("" ::: "memory"); }
    }
    __device__ __forceinline__ void operator()(const f32x4 (&acc)[2][2][4][2], const Unit& u, int wr, int wc, int fr, int fq) const {
        const int row0 = u.pm * BM + wr * 64 + fr, col0 = u.pn * BM + wc * 32 + 8 * fq;
#pragma unroll
        for (int ai = 0; ai < 2; ++ai)
#pragma unroll
            for (int m = 0; m < 4; ++m) { unsigned ro = (unsigned)(row0 + ai * HALF + m * 16); asm volatile("" : "+v"(ro)); const size_t r = (size_t)ro;
#pragma unroll
                for (int bj = 0; bj < 2; ++bj) { const h16x8 gb = *(const h16x8*)(G + r * 2048 + 1024 + col0 + bj * HALF);
                    float o[8];
#pragma unroll
                    for (int e = 0; e < 8; ++e) o[e] = acc[ai][bj][m][e >> 2][e & 3] * sigmoidf_fast((float)gb[e]);
                    u32x4 w; w.x = pkh(o[0], o[1]); w.y = pkh(o[2], o[3]); w.z = pkh(o[4], o[5]); w.w = pkh(o[6], o[7]);
                    *(u32x4*)(MG + r * 1024 + col0 + bj * HALF) = w; } }
    }
};
struct EpiOut {
    static constexpr bool PERM = true, AFTER_DRAIN = false, MID = false;
    const float* x; float* out;
    __device__ __forceinline__ void operator()(const f32x4 (&acc)[2][2][4][2], const Unit& u, int wr, int wc, int fr, int fq) const {
        const int row0 = u.pm * BM + wr * 64 + fr, col0 = u.pn * BM + wc * 32 + 8 * fq;
#pragma unroll
        for (int ai = 0; ai < 2; ++ai)
#pragma unroll
            for (int m = 0; m < 4; ++m) { const size_t off = (size_t)(row0 + ai * HALF + m * 16) * DM + col0;
#pragma unroll
                for (int bj = 0; bj < 2; ++bj)
#pragma unroll
                    for (int n = 0; n < 2; ++n) { const f32x4 xv = *(const f32x4*)(x + off + bj * HALF + 4 * n); *(f32x4*)(out + off + bj * HALF + 4 * n) = xv + acc[ai][bj][m][n]; }
                if (m & 1) asm volatile("" ::: "memory"); }
    }
};

template <class Epi, class Sched, class GemmT, bool ALIGN_EPI = false, bool SP2 = false>
__device__ __forceinline__ void gemm_phase(PG8_LAS unsigned char* lds, const GemmT g, const Sched& S, const Epi& E) {
    const int tid = threadIdx.x, wid = __builtin_amdgcn_readfirstlane(tid >> 6), lane = tid & 63, wr = wid >> 2, wc = wid & 3, fr = lane & 15, fq = lane >> 4;
    const int K = g.K, nt = K / BK;
    unsigned voffA[2], voffB[2];
#pragma unroll
    for (int i = 0; i < 2; ++i) { int R, C; stage_rc(tid * 16 + i * 8192, R, C); const int Rb = Epi::PERM ? ((R & ~31) + perm32(R & 31)) : R;
        voffA[i] = (unsigned)(R * g.lda + C) * 2u; voffB[i] = (unsigned)(Rb * K + C) * 2u; }
    const size_t kstep = (size_t)(BK * 2);
    const size_t hstepA = (size_t)HALF * g.lda * 2, hstepB = (size_t)HALF * K * 2;
    const unsigned ldsw = (unsigned)wid * 1024u;
    const int aoff = lds_byte(wr * 64 + fr, fq * 8), boff = lds_byte(wc * 32 + fr, fq * 8);
#define PG8_SA(b, h) (((b) * 2 + (h)) * HTB)
#define PG8_SB(b, h) ((4 + (b) * 2 + (h)) * HTB)
#define PG8_STAGE(bufoff, gbase, voff) do { _Pragma("unroll") for (int _i = 0; _i < 2; ++_i) \
        __builtin_amdgcn_global_load_lds((const unsigned*)((const char*)(gbase) + (voff)[_i]), (PG8_LAS unsigned*)(lds + (bufoff) + ldsw + _i * 8192), 16, 0, 0); } while (0)
#define PG8_LDA(dst, b, h) do { _Pragma("unroll") for (int m = 0; m < 4; ++m) _Pragma("unroll") for (int k = 0; k < 2; ++k) dst[m][k] = *(const PG8_LAS h16x8*)(lds + PG8_SA(b, h) + aoff + m * 2048 + k * 1024); } while (0)
#define PG8_LDB(dst, b, h) do { _Pragma("unroll") for (int n = 0; n < 2; ++n) _Pragma("unroll") for (int k = 0; k < 2; ++k) dst[n][k] = *(const PG8_LAS h16x8*)(lds + PG8_SB(b, h) + boff + n * 2048 + k * 1024); } while (0)
#define PG8_MMA(ai, bj, At, Bt) do { __builtin_amdgcn_s_setprio(1); _Pragma("unroll") for (int m = 0; m < 4; ++m) _Pragma("unroll") for (int n = 0; n < 2; ++n) _Pragma("unroll") for (int k = 0; k < 2; ++k) \
        acc[ai][bj][m][n] = __builtin_amdgcn_mfma_f32_16x16x32_f16(Bt[n][k], At[m][k], acc[ai][bj][m][n], 0, 0, 0); __builtin_amdgcn_s_setprio(0); } while (0)
#define PG8_WAIT_V(n) asm volatile("s_waitcnt vmcnt(" #n ")" ::: "memory")
#define PG8_WAIT_L(n) asm volatile("s_waitcnt lgkmcnt(" #n ")" ::: "memory")
#define PG8_BAR __builtin_amdgcn_s_barrier()
#define PG8_SCHED __builtin_amdgcn_sched_barrier(0)
    Unit cur, nxt; int ui = 0;
    if (!S.next(0, cur)) return;
    f32x4 acc[2][2][4][2];
#pragma unroll
    for (int a = 0; a < 2; ++a)
#pragma unroll
        for (int b = 0; b < 2; ++b)
#pragma unroll
            for (int m = 0; m < 4; ++m)
#pragma unroll
                for (int n = 0; n < 2; ++n) acc[a][b][m][n] = (f32x4){0.f, 0.f, 0.f, 0.f};
    h16x8 At[4][2], B0[2][2], B1[2][2];
    const char* cA = g.aptr(cur); const char* cB = g.bptr(cur);
    S.a_ready(cur);
    if constexpr (SP2) {
        PG8_STAGE(PG8_SB(0, 0), cB, voffB); PG8_STAGE(PG8_SB(0, 1), cB + hstepB, voffB); PG8_STAGE(PG8_SA(0, 0), cA, voffA); PG8_STAGE(PG8_SA(0, 1), cA + hstepA, voffA);
        if (wr == 1) PG8_BAR;
        PG8_WAIT_V(2); PG8_BAR;
        PG8_STAGE(PG8_SB(1, 0), cB + kstep, voffB); PG8_STAGE(PG8_SA(1, 0), cA + kstep, voffA); PG8_STAGE(PG8_SB(1, 1), cB + hstepB + kstep, voffB);
        PG8_WAIT_V(6); PG8_BAR;
    } else {
        PG8_STAGE(PG8_SB(0, 0), cB, voffB); PG8_STAGE(PG8_SA(0, 0), cA, voffA); PG8_STAGE(PG8_SB(0, 1), cB + hstepB, voffB); PG8_STAGE(PG8_SA(0, 1), cA + hstepA, voffA);
        if (wr == 1) PG8_BAR;
        PG8_WAIT_V(4); PG8_BAR;
        PG8_STAGE(PG8_SB(1, 0), cB + kstep, voffB); PG8_STAGE(PG8_SA(1, 0), cA + kstep, voffA); PG8_STAGE(PG8_SB(1, 1), cB + hstepB + kstep, voffB);
        PG8_WAIT_V(6); PG8_BAR;
    }
    for (;;) {
        const bool has_next = S.next(ui + 1, nxt);
        const char* nA = has_next ? g.aptr(nxt) : cA; const char* nB = has_next ? g.bptr(nxt) : cB;
        for (int t = 0; t < nt; t += 2) {
            const bool last = (t == nt - 2);
            const char* a1 = cA + (size_t)(t + 1) * kstep;
            const char* a2 = last ? nA : cA + (size_t)(t + 2) * kstep; const char* b2 = last ? nB : cB + (size_t)(t + 2) * kstep;
            const char* a3 = a2 + kstep; const char* b3 = b2 + kstep;
            if (last && has_next) S.a_ready(nxt);
            if constexpr (Epi::MID) { if (t == nt / 2) E.mid(acc, cur, wr, wc, fr, fq); }
            if constexpr (SP2) {
            PG8_LDB(B0, 0, 0); PG8_LDB(B1, 0, 1); PG8_SCHED; PG8_LDA(At, 0, 0); PG8_STAGE(PG8_SA(1, 1), a1 + hstepA, voffA);
            PG8_WAIT_V(8); PG8_WAIT_L(0); PG8_BAR; PG8_MMA(0, 0, At, B0); PG8_MMA(0, 1, At, B1); PG8_BAR; PG8_SCHED;
            PG8_LDA(At, 0, 1); PG8_STAGE(PG8_SB(0, 0), b2, voffB); PG8_STAGE(PG8_SB(0, 1), b2 + hstepB, voffB); PG8_STAGE(PG8_SA(0, 0), a2, voffA);
            PG8_WAIT_V(8); PG8_WAIT_L(0); PG8_BAR; PG8_MMA(1, 0, At, B0); PG8_MMA(1, 1, At, B1); PG8_BAR; PG8_SCHED;
            PG8_LDB(B0, 1, 0); PG8_LDB(B1, 1, 1); PG8_SCHED; PG8_LDA(At, 1, 0); PG8_STAGE(PG8_SA(0, 1), a2 + hstepA, voffA);
            PG8_WAIT_V(8); PG8_WAIT_L(0); PG8_BAR; PG8_MMA(0, 0, At, B0); PG8_MMA(0, 1, At, B1); PG8_BAR; PG8_SCHED;
            PG8_LDA(At, 1, 1); PG8_STAGE(PG8_SB(1, 0), b3, voffB); PG8_STAGE(PG8_SB(1, 1), b3 + hstepB, voffB); PG8_STAGE(PG8_SA(1, 0), a3, voffA);
            PG8_WAIT_V(8); PG8_WAIT_L(0); PG8_BAR; PG8_MMA(1, 0, At, B0); PG8_MMA(1, 1, At, B1); PG8_BAR; PG8_SCHED;
            } else {
            PG8_LDB(B0, 0, 0); PG8_SCHED; PG8_LDA(At, 0, 0); PG8_STAGE(PG8_SA(1, 1), a1 + hstepA, voffA);
            PG8_WAIT_L(8); PG8_BAR; PG8_WAIT_L(0); PG8_MMA(0, 0, At, B0); PG8_BAR; PG8_SCHED;
            PG8_LDB(B1, 0, 1); PG8_STAGE(PG8_SB(0, 0), b2, voffB);
            PG8_BAR; PG8_WAIT_L(0); PG8_MMA(0, 1, At, B1); PG8_BAR;
            PG8_LDA(At, 0, 1); PG8_STAGE(PG8_SA(0, 0), a2, voffA);
            PG8_BAR; PG8_WAIT_L(0); PG8_MMA(1, 0, At, B0); PG8_BAR; PG8_SCHED;
            PG8_STAGE(PG8_SB(0, 1), b2 + hstepB, voffB);
            PG8_WAIT_V(6); PG8_BAR; PG8_MMA(1, 1, At, B1); PG8_BAR;
            PG8_LDB(B0, 1, 0); PG8_SCHED; PG8_LDA(At, 1, 0); PG8_STAGE(PG8_SA(0, 1), a2 + hstepA, voffA);
            PG8_WAIT_L(8); PG8_BAR; PG8_WAIT_L(0); PG8_MMA(0, 0, At, B0); PG8_BAR; PG8_SCHED;
            PG8_LDB(B1, 1, 1); PG8_STAGE(PG8_SB(1, 0), b3, voffB);
            PG8_BAR; PG8_WAIT_L(0); PG8_MMA(0, 1, At, B1); PG8_BAR;
            PG8_LDA(At, 1, 1); PG8_STAGE(PG8_SA(1, 0), a3, voffA);
            PG8_BAR; PG8_WAIT_L(0); PG8_MMA(1, 0, At, B0); PG8_BAR; PG8_SCHED;
            PG8_STAGE(PG8_SB(1, 1), b3 + hstepB, voffB);
            PG8_WAIT_V(6); PG8_BAR; PG8_MMA(1, 1, At, B1); PG8_BAR;
            }
        }
        if constexpr (ALIGN_EPI) { if (wr == 0) PG8_BAR; }
        if constexpr (!Epi::AFTER_DRAIN) { E(acc, cur, wr, wc, fr, fq); S.done(cur); }
        if (!has_next) break;
#pragma unroll
        for (int a = 0; a < 2; ++a)
#pragma unroll
            for (int b = 0; b < 2; ++b)
#pragma unroll
                for (int m = 0; m < 4; ++m)
#pragma unroll
                    for (int n = 0; n < 2; ++n) acc[a][b][m][n] = (f32x4){0.f, 0.f, 0.f, 0.f};
        cur = nxt; cA = nA; cB = nB; ++ui;
        if constexpr (ALIGN_EPI) { if (wr == 1) PG8_BAR; }
    }
    PG8_WAIT_V(0);
    if constexpr (!ALIGN_EPI) { if (wr == 0) PG8_BAR; }
    PG8_BAR;
    if constexpr (Epi::AFTER_DRAIN) { E.fused(acc, cur, wr, wc, fr, fq, lds, wid, lane); S.done(cur); }
#undef PG8_SA
#undef PG8_SB
#undef PG8_STAGE
#undef PG8_LDA
#undef PG8_LDB
#undef PG8_MMA
#undef PG8_WAIT_V
#undef PG8_WAIT_L
#undef PG8_BAR
#undef PG8_SCHED
}
}

constexpr int NWAVES = 8, NTHREADS = 512;
constexpr int RING_BYTES = 131072, LDS_BYTES = 147456;
#define LDS_WAIT() asm volatile("s_waitcnt lgkmcnt(0)" ::: "memory")

#define XB_TMO      128
#define XB_XCNT(j)  (256  + 64 * (j))
#define XB_XSUB(j)  (1280 + 64 * (j))
#define XB_XGEN(j)  (2304 + 64 * (j))
#define XB_TOP      3328
#define XB_TOPGEN   3392
#define XCD_BAR_WORDS 3456
#define XB_SPIN_CAP (1u << 18)

__device__ __forceinline__ unsigned xb_ld(unsigned* p)              { return __hip_atomic_load(p, __ATOMIC_RELAXED, __HIP_MEMORY_SCOPE_AGENT); }
__device__ __forceinline__ unsigned xb_add(unsigned* p, unsigned v) { return __hip_atomic_fetch_add(p, v, __ATOMIC_RELAXED, __HIP_MEMORY_SCOPE_AGENT); }
__device__ __forceinline__ unsigned xb_xcc_id() { return (unsigned)__builtin_amdgcn_s_getreg((3 << 11) | 20) & 0xFu; }
#define XB_SPIN(cond, bar) do { unsigned _sp = 0; while (cond) { __builtin_amdgcn_s_sleep(1); \
    if ((++_sp & 255u) == 0u) { if (xb_ld(&(bar)[XB_TMO])) break; if (_sp > XB_SPIN_CAP) { atomicAdd(&(bar)[XB_TMO], 1u); break; } } } } while (0)

struct XcdBarrier {
    unsigned* bar; unsigned x;
    volatile LAS unsigned* st;
};

__device__ __forceinline__ XcdBarrier xcd_barrier_post(unsigned* bar, volatile LAS unsigned* st) {
    XcdBarrier b; b.bar = bar; b.x = xb_xcc_id(); b.st = st;
    if (threadIdx.x == 0) (void)xb_add(&bar[XB_XCNT(b.x)], 1u);
    return b;
}
__device__ __forceinline__ void xcd_barrier_complete(unsigned* bar, unsigned x, unsigned& nloc, unsigned& nx) {
    const unsigned G = gridDim.x * gridDim.y * gridDim.z;
    unsigned sum, cnt, mine, sp = 0u;
    for (;;) {
        sum = 0u; cnt = 0u; mine = 0u;
#pragma unroll
        for (unsigned j = 0; j < 16; ++j) { const unsigned c = xb_ld(&bar[XB_XCNT(j)]); sum += c; cnt += (c > 0u) ? 1u : 0u; mine = (j == x) ? c : mine; }
        if (sum == G) break;
        __builtin_amdgcn_s_sleep(1);
        if ((++sp & 255u) == 0u) { if (xb_ld(&bar[XB_TMO])) break; if (sp > XB_SPIN_CAP) { atomicAdd(&bar[XB_TMO], 1u); break; } }
    }
    nloc = mine > 0u ? mine : 1u; nx = cnt > 0u ? cnt : 1u;
}

__device__ __forceinline__ void xcd_barrier(const XcdBarrier& b) {
    asm volatile("s_waitcnt vmcnt(0)" ::: "memory");
    __syncthreads();
    if (threadIdx.x == 0) {
        unsigned* bar = b.bar;
        __builtin_amdgcn_s_waitcnt(0);
        unsigned nloc = b.st[0], nx = b.st[1];
        if (nloc == 0u) { xcd_barrier_complete(bar, b.x, nloc, nx); b.st[0] = nloc; b.st[1] = nx; }
        const unsigned old = xb_add(&bar[XB_XSUB(b.x)], 1u);
        const unsigned gen = old / nloc;
        if (old + 1u == (gen + 1u) * nloc) {
            __builtin_amdgcn_fence(__ATOMIC_RELEASE, "agent");
            asm volatile("s_waitcnt vmcnt(0)" ::: "memory");
            const unsigned og = xb_add(&bar[XB_TOP], 1u);
            const unsigned tg = og / nx;
            if (og + 1u == (tg + 1u) * nx) xb_add(&bar[XB_TOPGEN], 1u);
            else XB_SPIN(xb_ld(&bar[XB_TOPGEN]) == tg, bar);
            __builtin_amdgcn_fence(__ATOMIC_ACQUIRE, "agent");
            xb_add(&bar[XB_XGEN(b.x)], 1u);
            asm volatile("s_waitcnt vmcnt(0)" ::: "memory");
        } else {
            XB_SPIN(xb_ld(&bar[XB_XGEN(b.x)]) == gen, bar);
            __builtin_amdgcn_fence(__ATOMIC_ACQUIRE, "agent");
            asm volatile("s_waitcnt vmcnt(0)" ::: "memory");
        }
    }
    __syncthreads();
}

struct Frame {
    LAS unsigned char* lds;
    int tid, lane, wave, vcu, G;
    unsigned char* ws;
    const float *x, *norm_g, *w_in, *qna, *kna, *sinks, *qnb, *knb, *relb, *wpa, *wpb, *wout;
    float* out;
};

__device__ __forceinline__ float wave_sum(float v) {
#pragma unroll
    for (int o = 1; o < 64; o <<= 1) v += __shfl_xor(v, o);
    return v;
}
__device__ __forceinline__ int t5_bucket(int n) {
    if (n < 16) return n < 0 ? 0 : n;
    const int l = 16 + (int)(logf((float)n * 0.0625f) / logf(8.0f) * 16.0f);
    return l > 31 ? 31 : l;
}

__device__ __forceinline__ int win_src_col(int n) { return n < 3328 ? n : (n < 5376 ? n + 296 : (n < 5672 ? n - 2048 : -1)); }
template <bool INPROJ>
__device__ __forceinline__ void p0_transpose_item(const float* W, int srcN, int k0, int n0, h16* WT, int ldk, int kdst0, LAS float* scr, int lane, float scale) {
    const int n = n0 + (lane & 31); const int col = INPROJ ? win_src_col(n) : n;
#pragma unroll 8
    for (int i = 0; i < 32; ++i) { const int kk = 2 * i + (lane >> 5); scr[kk * 33 + (lane & 31)] = (col >= 0) ? W[(size_t)(k0 + kk) * srcN + col] * scale : 0.f; }
    LDS_WAIT(); asm volatile("" ::: "memory");
    const int c = lane & 7;
#pragma unroll
    for (int j = 0; j < 4; ++j) { const int nn = (lane >> 3) + 8 * j; const LAS float* s = scr + (8 * c) * 33 + nn;
        float v[8];
#pragma unroll
        for (int e = 0; e < 8; ++e) v[e] = s[e * 33];
        u32x4 o; o.x = pkh(v[0], v[1]); o.y = pkh(v[2], v[3]); o.z = pkh(v[4], v[5]); o.w = pkh(v[6], v[7]);
        *(u32x4*)(WT + (size_t)(n0 + nn) * ldk + kdst0 + k0 + 8 * c) = o;
        if (INPROJ && n0 >= 5376) {
            float r[8];
#pragma unroll
            for (int e = 0; e < 8; ++e) r[e] = v[e] - (float)(h16)v[e];
            u32x4 q; q.x = pkh(r[0], r[1]); q.y = pkh(r[2], r[3]); q.z = pkh(r[4], r[5]); q.w = pkh(r[6], r[7]);
            *(u32x4*)(WT + (size_t)(n0 + nn + 512) * ldk + kdst0 + k0 + 8 * c) = q;
        } }
    LDS_WAIT(); asm volatile("" ::: "memory");
}
__device__ __forceinline__ void p0_norm_row(const float* xrow, const float* g, h16* orow, int lane) {
    f32x4 v[4]; float s = 0.f;
#pragma unroll
    for (int j = 0; j < 4; ++j) { v[j] = *((const f32x4*)xrow + lane + 64 * j); s += (v[j].x * v[j].x + v[j].y * v[j].y) + (v[j].z * v[j].z + v[j].w * v[j].w); }
    const float r = rsqrtf(wave_sum(s) * (1.0f / DM) + RMS_EPS);
#pragma unroll
    for (int j = 0; j < 4; ++j) { const f32x4 gg = *((const f32x4*)g + lane + 64 * j); const f32x4 hv = v[j] * r * gg * HSCALE;
        const h16 h0 = (h16)hv.x, h1 = (h16)hv.y, h2 = (h16)hv.z, h3 = (h16)hv.w;
        u32x2 hi, lo; hi.x = pkh(hv.x, hv.y); hi.y = pkh(hv.z, hv.w);
        lo.x = pkh(hv.x - (float)h0, hv.y - (float)h1); lo.y = pkh(hv.z - (float)h2, hv.w - (float)h3);
        *((u32x2*)(orow + 1024) + lane + 64 * j) = hi; *((u32x2*)orow + lane + 64 * j) = lo; }
}
__device__ __forceinline__ void p0_prologue(Frame& F) {
    LAS float* scr = (LAS float*)(F.lds + F.wave * 16384);
    const int gw = F.vcu * NWAVES + F.wave, NGW = F.G * NWAVES;
    h16* Win = (h16*)(F.ws + WS_WIN); h16* Wp = (h16*)(F.ws + WS_WP); h16* Wo = (h16*)(F.ws + WS_WO);
    constexpr int I_IN = 16 * 184, I_P = 8 * 32, I_O = 16 * 32;
    constexpr int NITEMS = I_IN + 2 * I_P + I_O;
    for (int it = gw; it < NITEMS; it += NGW) {
        int r = it;
        if (r < I_IN) { p0_transpose_item<true>(F.w_in, INW, 64 * (r / 184), 32 * (r % 184), Win, 1024, 0, scr, F.lane, WSCALE); continue; } r -= I_IN;
        if (r < I_P) { p0_transpose_item<false>(F.wpa, DM, 64 * (r / 32), 32 * (r % 32), Wp, 1024, 0, scr, F.lane, 1.f); continue; } r -= I_P;
        if (r < I_P) { p0_transpose_item<false>(F.wpb, DM, 64 * (r / 32), 32 * (r % 32), Wp, 1024, 512, scr, F.lane, 1.f); continue; } r -= I_P;
        p0_transpose_item<false>(F.wout, DM, 64 * (r / 32), 32 * (r % 32), Wo, 1024, 0, scr, F.lane, 1.f);
    }
    h16* H2 = (h16*)(F.ws + WS_H2);
    for (int m = gw; m < MROWS; m += NGW) p0_norm_row(F.x + (size_t)m * DM, F.norm_g, H2 + (size_t)m * 2048, F.lane);
}

__device__ __forceinline__ void headnorm_pass(Frame& F, h16* buf, int pitch, int ncols, const float* gain, float scale) {
    const int cpr = ncols / 8;
    const size_t total = (size_t)MROWS * cpr;
    const size_t gl = (size_t)(F.vcu * NTHREADS + F.tid), NG = (size_t)F.G * NTHREADS;
    const int c8 = (int)(gl & 7);
    float gn[8];
#pragma unroll
    for (int e = 0; e < 8; ++e) gn[e] = gain[c8 * 8 + e] * scale;
    for (size_t ci = gl; ci < total; ci += NG) {
        const size_t row = ci / cpr; const int ch = (int)(ci % cpr);
        h16* p = buf + row * pitch + ch * 8;
        const h16x8 v = *(const h16x8*)p; float f[8]; float ss = 0.f;
#pragma unroll
        for (int e = 0; e < 8; ++e) { f[e] = (float)v[e]; ss += f[e] * f[e]; }
        ss += __shfl_xor(ss, 1); ss += __shfl_xor(ss, 2); ss += __shfl_xor(ss, 4);
        const float r = rsqrtf(ss * (1.0f / 64.0f) + RMS_EPS);
        u32x4 o; o.x = pkh(f[0] * r * gn[0], f[1] * r * gn[1]); o.y = pkh(f[2] * r * gn[2], f[3] * r * gn[3]); o.z = pkh(f[4] * r * gn[4], f[5] * r * gn[5]); o.w = pkh(f[6] * r * gn[6], f[7] * r * gn[7]);
        *(u32x4*)p = o;
    }
}

constexpr size_t WS_QH = 32 * MiB, WS_QL = 40 * MiB, WS_KH = 48 * MiB, WS_KL = 49 * MiB, WS_WI = 50 * MiB;
__device__ __forceinline__ void idx_prepass(Frame& F) {
    const float* I1 = (const float*)(F.ws + WS_IDX); const float* I2 = (const float*)(F.ws + WS_IDX + IDX_BYTES); const float* I3 = (const float*)(F.ws + WS_IDX + 2 * IDX_BYTES);
    const int gw = F.vcu * NWAVES + F.wave, NGW = F.G * NWAVES, l = F.lane;
    for (int m = gw; m < MROWS; m += NGW) {
        if (l < 37) {
            const size_t o = (size_t)m * IDXP + 8 * l;
            const f32x4 a0 = *(const f32x4*)(I1 + o), a1 = *(const f32x4*)(I1 + o + 4), b0 = *(const f32x4*)(I2 + o), b1 = *(const f32x4*)(I2 + o + 4), c0 = *(const f32x4*)(I3 + o), c1 = *(const f32x4*)(I3 + o + 4);
            const f32x4 s0 = (a0 + b0) + c0, s1 = (a1 + b1) + c1;
            if (l < 36) {
                float v[8] = {s0[0] * 16.f, s0[1] * 16.f, s0[2] * 16.f, s0[3] * 16.f, s1[0] * 16.f, s1[1] * 16.f, s1[2] * 16.f, s1[3] * 16.f}; float r[8];
#pragma unroll
                for (int e = 0; e < 8; ++e) r[e] = v[e] - (float)(h16)v[e];
                u32x4 hi, lo; hi.x = pkh(v[0], v[1]); hi.y = pkh(v[2], v[3]); hi.z = pkh(v[4], v[5]); hi.w = pkh(v[6], v[7]);
                lo.x = pkh(r[0], r[1]); lo.y = pkh(r[2], r[3]); lo.z = pkh(r[4], r[5]); lo.w = pkh(r[6], r[7]);
                if (l < 32) { *(u32x4*)((h16*)(F.ws + WS_QH) + (size_t)m * 256 + 8 * l) = hi; *(u32x4*)((h16*)(F.ws + WS_QL) + (size_t)m * 256 + 8 * l) = lo; }
                else { *(u32x4*)((h16*)(F.ws + WS_KH) + (size_t)m * 32 + 8 * (l - 32)) = hi; *(u32x4*)((h16*)(F.ws + WS_KL) + (size_t)m * 32 + 8 * (l - 32)) = lo; }
            } else { float* w = (float*)(F.ws + WS_WI) + (size_t)m * 8; *(f32x4*)w = s0; *(f32x4*)(w + 4) = s1; }
        }
    }
}
constexpr int IX_HIST = 0, IX_ST = 65536, IX_OMASK = 65536 + 1024, IX_TMASK = IX_OMASK + 4096;
__device__ __forceinline__ void idx_item(Frame& F, int b, int g) {
    const int tid = F.tid, lane = F.lane, wid = F.wave, tok = lane & 15, fq = lane >> 4;
    const int t0 = g * 16;
    unsigned* gmask = (unsigned*)(F.ws + WS_MASK) + (size_t)(b * SEQ + t0) * 64;
    if (g < 16) {
        for (int i = tid; i < 1024; i += NTHREADS) { const int tk = i >> 6, w = i & 63, t = t0 + tk, lo = w * 32;
            gmask[i] = (t >= lo + 31) ? 0xffffffffu : (t >= lo ? ((2u << (t - lo)) - 1u) : 0u); }
        return;
    }
    LAS unsigned* hist = (LAS unsigned*)(F.lds + IX_HIST);
    LAS unsigned* st = (LAS unsigned*)(F.lds + IX_ST);
    LAS unsigned* omask = (LAS unsigned*)(F.lds + IX_OMASK);
    LAS unsigned* tmask = (LAS unsigned*)(F.lds + IX_TMASK);
    const int ntile = g + 1;
    const size_t qrow = (size_t)(b * SEQ + t0 + tok);
    h16x8 qhi[8], qlo[8];
#pragma unroll
    for (int h = 0; h < 8; ++h) { qhi[h] = *(const h16x8*)((const h16*)(F.ws + WS_QH) + qrow * 256 + h * 32 + fq * 8); qlo[h] = *(const h16x8*)((const h16*)(F.ws + WS_QL) + qrow * 256 + h * 32 + fq * 8); }
    const f32x4 w0 = *(const f32x4*)((const float*)(F.ws + WS_WI) + qrow * 8), w1 = *(const f32x4*)((const float*)(F.ws + WS_WI) + qrow * 8 + 4);
    const float wv[8] = {w0[0], w0[1], w0[2], w0[3], w1[0], w1[1], w1[2], w1[3]};
    if (tid < 16) { st[96 + tid] = 0xffffffffu; st[112 + tid] = 0u; } if (tid == 0) st[128] = 0u;
    for (int i = tid; i < 2048; i += NTHREADS) omask[i] = 0u;
    unsigned key[16][4];
    unsigned kmin = 0xffffffffu, kmax = 0u;
    const h16* khb = (const h16*)(F.ws + WS_KH) + (size_t)(b * SEQ + tok) * 32 + fq * 8; const h16* klb = (const h16*)(F.ws + WS_KL) + (size_t)(b * SEQ + tok) * 32 + fq * 8;
#pragma unroll
    for (int i = 0; i < 16; ++i) {
        int tile = wid + 8 * i; asm volatile("" : "+s"(tile));
        if (tile < ntile) {
            unsigned toff = (unsigned)tile * (16u * 32u); asm volatile("" : "+v"(toff));
            const h16x8 khi = *(const h16x8*)(khb + toff), klo = *(const h16x8*)(klb + toff);
            f32x4 sc = {0.f, 0.f, 0.f, 0.f};
#pragma unroll
            for (int h = 0; h < 8; ++h) {
                f32x4 a = __builtin_amdgcn_mfma_f32_16x16x32_f16(khi, qhi[h], (f32x4){0.f, 0.f, 0.f, 0.f}, 0, 0, 0);
                a = __builtin_amdgcn_mfma_f32_16x16x32_f16(khi, qlo[h], a, 0, 0, 0);
                a = __builtin_amdgcn_mfma_f32_16x16x32_f16(klo, qhi[h], a, 0, 0, 0);
#pragma unroll
                for (int r = 0; r < 4; ++r) sc[r] = fmaf(wv[h], fmaxf(a[r], 0.f), sc[r]);
            }
#pragma unroll
            for (int r = 0; r < 4; ++r) { const int s = tile * 16 + 4 * fq + r; const unsigned u = __float_as_uint(sc[r] + 0.0f);
                const unsigned k = (u >> 31) ? ~u : (u | 0x80000000u); const bool valid = s <= t0 + tok;
                key[i][r] = valid ? k : 0u; if (valid) { kmin = min(kmin, k); kmax = max(kmax, k); } }
        } else {
#pragma unroll
            for (int r = 0; r < 4; ++r) key[i][r] = 0u;
        }
        asm volatile("" ::: "memory");
    }
    __syncthreads();
    kmin = min(kmin, (unsigned)__shfl_xor((int)kmin, 16)); kmin = min(kmin, (unsigned)__shfl_xor((int)kmin, 32));
    kmax = max(kmax, (unsigned)__shfl_xor((int)kmax, 16)); kmax = max(kmax, (unsigned)__shfl_xor((int)kmax, 32));
    if (fq == 0) { atomicMin((unsigned*)&st[96 + tok], kmin); atomicMax((unsigned*)&st[112 + tok], kmax); }
    __syncthreads();
    if (tid < 16) { const unsigned lo = st[96 + tid], span = st[112 + tid] - lo; st[tid] = lo; st[16 + tid] = span; st[32 + tid] = span >= 1024u ? (unsigned)(22 - __clz((int)span)) : 0u; st[48 + tid] = 256u; }
    for (int round = 0; round < 8; ++round) {
#pragma unroll
        for (int i = 0; i < 8; ++i) *(LAS u32x4*)(F.lds + IX_HIST + tid * 16 + i * 8192) = (u32x4){0u, 0u, 0u, 0u};
        __syncthreads();
        const unsigned done = st[128];
        if (!((done >> tok) & 1u)) {
            const unsigned lo = st[tok], span = st[16 + tok], shift = st[32 + tok];
#pragma unroll
            for (int i = 0; i < 16; ++i) {
                int tile = wid + 8 * i; asm volatile("" : "+s"(tile));
                if (tile < ntile) {
#pragma unroll
                    for (int r = 0; r < 4; ++r) { const unsigned k = key[i][r]; if (k >= lo && k - lo <= span) atomicAdd((unsigned*)&hist[tok * 1024 + ((k - lo) >> shift)], 1u); }
                }
            }
        }
        __syncthreads();
#pragma unroll 1
        for (int tt = 0; tt < 2; ++tt) {
            const int tk = 2 * wid + tt;
            if (!((done >> tk) & 1u)) {
                const LAS u32x4* hp = (const LAS u32x4*)(hist + tk * 1024 + 16 * lane);
                const u32x4 c0 = hp[0], c1 = hp[1], c2 = hp[2], c3 = hp[3];
                const unsigned cnt[16] = {c0.x, c0.y, c0.z, c0.w, c1.x, c1.y, c1.z, c1.w, c2.x, c2.y, c2.z, c2.w, c3.x, c3.y, c3.z, c3.w};
                unsigned s = 0;
#pragma unroll
                for (int e = 0; e < 16; ++e) s += cnt[e];
                unsigned v = s;
#pragma unroll
                for (int o = 1; o < 64; o <<= 1) { const unsigned tmp = (unsigned)__shfl_down((int)v, o); if (lane + o < 64) v += tmp; }
                const unsigned above = v - s, need = st[48 + tk];
                if (above < need && need <= above + s) {
                    unsigned cum = above, bstar = 0, rr = 0, cb = 0; bool found = false;
#pragma unroll
                    for (int e = 15; e >= 0; --e) { const unsigned c = cnt[e]; if (!found && cum + c >= need) { found = true; bstar = 16u * lane + e; rr = need - cum; cb = c; } if (!found) cum += c; }
                    const unsigned lo = st[tk], shift = st[32 + tk];
                    const unsigned newlo = lo + (bstar << shift);
                    if (cb == rr) { st[64 + tk] = newlo; st[80 + tk] = 0u; atomicOr((unsigned*)&st[128], 1u << tk); }
                    else if (shift == 0u) { st[64 + tk] = newlo; st[80 + tk] = rr; atomicOr((unsigned*)&st[128], 1u << tk); }
                    else { st[tk] = newlo; st[16 + tk] = (1u << shift) - 1u; st[32 + tk] = shift > 10u ? shift - 10u : 0u; st[48 + tk] = rr; }
                }
            }
        }
        __syncthreads();
        if (st[128] == 0xffffu) break;
    }
    {
        const unsigned T = st[64 + tok], tr = st[80 + tok];
#pragma unroll
        for (int i = 0; i < 16; ++i) {
            int tile = wid + 8 * i; asm volatile("" : "+s"(tile));
            if (tile < ntile) {
                unsigned nib = 0u, tnib = 0u;
#pragma unroll
                for (int r = 0; r < 4; ++r) { const unsigned k = key[i][r]; const bool sel = tr ? (k > T) : (k >= T); nib |= sel ? (1u << r) : 0u; tnib |= (tr && k == T) ? (1u << r) : 0u; }
                const int s0 = tile * 16 + 4 * fq;
                if (nib) atomicOr((unsigned*)&omask[tok * 64 + (s0 >> 5)], nib << (s0 & 31));
                if (tnib) atomicOr((unsigned*)&tmask[tok * 64 + (s0 >> 5)], tnib << (s0 & 31));
            }
        }
    }
    __syncthreads();
#pragma unroll 1
    for (int tt = 0; tt < 2; ++tt) {
        const int tk = 2 * wid + tt; const unsigned tr = st[80 + tk];
        if (tr) {
            unsigned w = tmask[tk * 64 + lane]; const unsigned pc = __popc(w);
            unsigned incl = pc;
#pragma unroll
            for (int o = 1; o < 64; o <<= 1) { const unsigned tmp = (unsigned)__shfl_up((int)incl, o); if (lane >= o) incl += tmp; }
            const unsigned before = incl - pc;
            unsigned n = before >= tr ? 0u : min(tr - before, pc), kept = 0u;
            while (n) { const unsigned bit = w & (0u - w); kept |= bit; w ^= bit; --n; }
            if (kept) omask[tk * 64 + lane] |= kept;
        }
    }
    __syncthreads();
    for (int i = tid; i < 1024; i += NTHREADS) gmask[i] = omask[i];
    __syncthreads();
}
__device__ __forceinline__ void p2_norm_phase(Frame& F) {
    headnorm_pass(F, (h16*)(F.ws + WS_QA), 512, 512, F.qna, QSCALE);
    headnorm_pass(F, (h16*)(F.ws + WS_KVA), 256, 128, F.kna, 1.f);
    headnorm_pass(F, (h16*)(F.ws + WS_QB), 512, 512, F.qnb, QSCALE);
    headnorm_pass(F, (h16*)(F.ws + WS_KB), 512, 512, F.knb, 1.f);
    idx_prepass(F);
}
__device__ __forceinline__ void p3_index_phase(Frame& F) {
    for (int v = F.vcu; v < 256; v += F.G) {
        const int b = v >> 5, p = v & 31;
#pragma unroll 1
        for (int k = 0; k < 4; ++k) { const int g = (k == 0) ? p : (k == 1) ? 63 - p : (k == 2) ? 64 + p : 127 - p; idx_item(F, b, g); }
    }
}

constexpr int AT_K = 0, AT_KSZ = 64 * 144, AT_V = 2 * AT_KSZ, AT_VSZ = 64 * 192, AT_LUT = AT_V + 2 * AT_VSZ, AT_OST = AT_LUT + 320 * 4, AT_OSTSZ = 32 * 144;
static_assert(AT_OST + 8 * AT_OSTSZ <= RING_BYTES, "attention LDS");
__device__ __forceinline__ s16x4 vtr_read(const LAS unsigned char* p) { return __builtin_amdgcn_ds_read_tr16_b64_v4i16((LAS s16x4*)p); }

template <bool ISB>
__device__ __forceinline__ void attn_unit(Frame& F, int b, int h, int qb) {
    const int tid = F.tid, lane = F.lane, wid = F.wave, q = lane & 31, hi = lane >> 5;
    const int q0 = qb * 256, r0 = q0 + wid * 32, t = r0 + q;
    const size_t row = (size_t)b * SEQ + t;
    const h16* Qp; const h16* Kp; const h16* Vp; const h16* Zp; int kvpitch, ycol;
    if (ISB) { Qp = (const h16*)(F.ws + WS_QB) + h * 64; Kp = (const h16*)(F.ws + WS_KB) + h * 64; Vp = (const h16*)(F.ws + WS_VB) + h * 64; Zp = (const h16*)(F.ws + WS_ZB) + h * 64; kvpitch = 512; ycol = 512 + h * 64; }
    else     { Qp = (const h16*)(F.ws + WS_QA) + h * 64; Kp = (const h16*)(F.ws + WS_KVA) + (h >> 2) * 64; Vp = (const h16*)(F.ws + WS_KVA) + 128 + (h >> 2) * 64; Zp = (const h16*)(F.ws + WS_ZA) + h * 64; kvpitch = 256; ycol = h * 64; }
    const unsigned* mrow = (const unsigned*)(F.ws + WS_MASK) + row * 64;
    LAS float* lut = (LAS float*)(F.lds + AT_LUT);
    for (int i = tid; i < 320; i += NTHREADS) { const int dist = 223 - i; float v;
        if (ISB) v = dist < 0 ? 0.f : F.relb[t5_bucket(dist > 127 ? 127 : dist) * 16 + 8 + h] * LOG2E;
        else v = (dist >= 0 && dist < 128) ? F.relb[t5_bucket(dist) * 16 + h] * LOG2E : -INFINITY;
        lut[i] = v; }
    const float cfar = ISB ? F.relb[31 * 16 + 8 + h] * LOG2E : 0.f;
    h16x8 qr[4];
#pragma unroll
    for (int d0 = 0; d0 < 4; ++d0) qr[d0] = *(const h16x8*)(Qp + row * 512 + d0 * 16 + hi * 8);
    const int kt_lo = ISB ? 0 : (4 * qb - 2 < 0 ? 0 : 4 * qb - 2), kt_hi = 4 * qb + 3;
    const int srow = tid >> 3, sch = tid & 7;
    const h16* kg = Kp + ((size_t)b * SEQ + srow) * kvpitch + sch * 8; const h16* vg = Vp + ((size_t)b * SEQ + srow) * kvpitch + sch * 8;
    const int kst = srow * 144 + sch * 16, vst = srow * 192 + sch * 16;
    u32x4 kreg = *(const u32x4*)(kg + (size_t)kt_lo * 64 * kvpitch), vreg = *(const u32x4*)(vg + (size_t)kt_lo * 64 * kvpitch);
    u32x2 mw = {0u, 0u}, mwn = {0u, 0u};
    if (ISB) mw = *(const u32x2*)(mrow + 2 * kt_lo);
    *(LAS u32x4*)(F.lds + AT_K + kst) = kreg; *(LAS u32x4*)(F.lds + AT_V + vst) = vreg;
    __syncthreads();
    float m_run = -INFINITY, l_run = 0.f;
    f32x16 o[2];
#pragma unroll
    for (int r = 0; r < 16; ++r) { o[0][r] = 0.f; o[1][r] = 0.f; }
    const int kfo = q * 144 + hi * 16;
    const int vfo = (4 * hi + ((lane & 15) >> 2)) * 192 + ((lane >> 4) & 1) * 32 + (lane & 3) * 8;
    for (int kt = kt_lo; kt <= kt_hi; ++kt) {
        const int cur = (kt - kt_lo) & 1;
        if (kt < kt_hi) { kreg = *(const u32x4*)(kg + (size_t)(kt + 1) * 64 * kvpitch); vreg = *(const u32x4*)(vg + (size_t)(kt + 1) * 64 * kvpitch); if (ISB) mwn = *(const u32x2*)(mrow + 2 * (kt + 1)); }
        const int k0 = kt * 64;
        const bool active = ISB ? (k0 <= r0 + 31) : (k0 <= r0 + 31 && k0 + 63 >= r0 - 127);
        if (active) {
            const LAS unsigned char* kb = F.lds + AT_K + cur * AT_KSZ + kfo;
            const LAS unsigned char* vb = F.lds + AT_V + cur * AT_VSZ + vfo;
            f32x16 p0, p1;
#pragma unroll
            for (int r = 0; r < 16; ++r) { p0[r] = 0.f; p1[r] = 0.f; }
#pragma unroll
            for (int d0 = 0; d0 < 4; ++d0) {
                const h16x8 ka = *(const LAS h16x8*)(kb + d0 * 32), kc = *(const LAS h16x8*)(kb + 32 * 144 + d0 * 32);
                p0 = __builtin_amdgcn_mfma_f32_32x32x16_f16(ka, qr[d0], p0, 0, 0, 0);
                p1 = __builtin_amdgcn_mfma_f32_32x32x16_f16(kc, qr[d0], p1, 0, 0, 0);
            }
            if (ISB && (r0 - k0 - 63 >= 113)) {
#pragma unroll
                for (int r = 0; r < 16; ++r) { p0[r] += cfar; p1[r] += cfar; }
            } else {
                const LAS float* lp = lut + (223 - (t - k0 - 4 * hi));
#pragma unroll
                for (int r = 0; r < 16; ++r) { const int c = (r & 3) + 8 * (r >> 2); p0[r] += lp[c]; p1[r] += lp[32 + c]; }
            }
            if (ISB) {
                const unsigned mm0 = mw.x >> (4 * hi), mm1 = mw.y >> (4 * hi);
#pragma unroll
                for (int r = 0; r < 16; ++r) { const unsigned bit = 1u << ((r & 3) + 8 * (r >> 2)); if (!(mm0 & bit)) p0[r] = -INFINITY; if (!(mm1 & bit)) p1[r] = -INFINITY; }
            }
            float mx = fmaxf(p0[0], p1[0]);
#pragma unroll
            for (int r = 1; r < 16; ++r) mx = fmaxf(mx, fmaxf(p0[r], p1[r]));
            mx = fmaxf(mx, __shfl_xor(mx, 32));
            const float mnew = fmaxf(m_run, mx), muse = (mnew == -INFINITY) ? 0.f : mnew;
            const float alpha = __builtin_amdgcn_exp2f(m_run - muse);
            m_run = mnew;
            float sum = 0.f;
#pragma unroll
            for (int r = 0; r < 16; ++r) { p0[r] = __builtin_amdgcn_exp2f(p0[r] - muse); p1[r] = __builtin_amdgcn_exp2f(p1[r] - muse); sum += p0[r] + p1[r]; }
            l_run = l_run * alpha + sum;
#pragma unroll
            for (int r = 0; r < 16; ++r) { o[0][r] *= alpha; o[1][r] *= alpha; }
            u32x4 pk[4];
            pk[0] = (u32x4){pkh(p0[0], p0[1]), pkh(p0[2], p0[3]), pkh(p0[4], p0[5]), pkh(p0[6], p0[7])};
            pk[1] = (u32x4){pkh(p0[8], p0[9]), pkh(p0[10], p0[11]), pkh(p0[12], p0[13]), pkh(p0[14], p0[15])};
            pk[2] = (u32x4){pkh(p1[0], p1[1]), pkh(p1[2], p1[3]), pkh(p1[4], p1[5]), pkh(p1[6], p1[7])};
            pk[3] = (u32x4){pkh(p1[8], p1[9]), pkh(p1[10], p1[11]), pkh(p1[12], p1[13]), pkh(p1[14], p1[15])};
#pragma unroll
            for (int s = 0; s < 4; ++s)
#pragma unroll
                for (int d1 = 0; d1 < 2; ++d1) {
                    const s16x4 lo4 = vtr_read(vb + (16 * s) * 192 + d1 * 64), hi4 = vtr_read(vb + (16 * s + 8) * 192 + d1 * 64);
                    const h16x4 lf = __builtin_bit_cast(h16x4, lo4), hf = __builtin_bit_cast(h16x4, hi4);
                    const h16x8 vf = {lf[0], lf[1], lf[2], lf[3], hf[0], hf[1], hf[2], hf[3]};
                    o[d1] = __builtin_amdgcn_mfma_f32_32x32x16_f16(vf, __builtin_bit_cast(h16x8, pk[s]), o[d1], 0, 0, 0);
                }
        }
        if (kt < kt_hi) { *(LAS u32x4*)(F.lds + AT_K + (cur ^ 1) * AT_KSZ + kst) = kreg; *(LAS u32x4*)(F.lds + AT_V + (cur ^ 1) * AT_VSZ + vst) = vreg; mw = mwn; }
        __syncthreads();
    }
    l_run += __shfl_xor(l_run, 32);
    if (!ISB) l_run += __builtin_amdgcn_exp2f(F.sinks[h] * LOG2E - m_run);
    const float inv = 1.0f / l_run;
    LAS unsigned char* ost = F.lds + AT_OST + wid * AT_OSTSZ;
#pragma unroll
    for (int d1 = 0; d1 < 2; ++d1)
#pragma unroll
        for (int g4 = 0; g4 < 4; ++g4) { u32x2 w; w.x = pkh(o[d1][4 * g4] * inv, o[d1][4 * g4 + 1] * inv); w.y = pkh(o[d1][4 * g4 + 2] * inv, o[d1][4 * g4 + 3] * inv);
            *(LAS u32x2*)(ost + q * 144 + (32 * d1 + 8 * g4 + 4 * hi) * 2) = w; }
    LDS_WAIT(); asm volatile("" ::: "memory");
    h16* Yp = (h16*)(F.ws + WS_Y);
#pragma unroll
    for (int i = 0; i < 4; ++i) { const int rr = i * 8 + (lane >> 3), ch = lane & 7; const size_t grow = (size_t)b * SEQ + r0 + rr;
        const h16x8 ov = *(const LAS h16x8*)(ost + rr * 144 + ch * 16); const h16x8 zv = *(const h16x8*)(Zp + grow * 512 + ch * 8);
        float y[8];
#pragma unroll
        for (int e = 0; e < 8; ++e) { const float z = (float)zv[e]; y[e] = (float)ov[e] * z * sigmoidf_fast(z); }
        u32x4 w; w.x = pkh(y[0], y[1]); w.y = pkh(y[2], y[3]); w.z = pkh(y[4], y[5]); w.w = pkh(y[6], y[7]);
        *(u32x4*)(Yp + grow * 1024 + ycol + ch * 8) = w; }
    __syncthreads();
}
__device__ __forceinline__ void p4_attention_phase(Frame& F) {
    for (int v = F.vcu; v < 256; v += F.G) {
        const int bh = v >> 2, j = v & 3, b = bh >> 3, h = bh & 7;
        attn_unit<true>(F, b, h, 7 - j); attn_unit<true>(F, b, h, j);
        attn_unit<false>(F, b, h, 2 * j); attn_unit<false>(F, b, h, 2 * j + 1);
    }
}

struct Args { const float* in[12]; float* out; unsigned char* ws; int ph_lo, ph_hi; };
constexpr int N_PHASES = 7;
__global__ void __launch_bounds__(NTHREADS, 2) mk_fwd(Args args) {
    extern __shared__ __attribute__((aligned(16))) unsigned char lds_raw[];
    cg::grid_group grid = cg::this_grid();
    Frame F;
    F.lds = (LAS unsigned char*)lds_raw;
    F.tid = threadIdx.x; F.lane = F.tid & 63; F.wave = __builtin_amdgcn_readfirstlane(F.tid >> 6);
    F.G = gridDim.x; { const int bx = blockIdx.x; F.vcu = (F.G % 8 == 0) ? (bx % 8) * (F.G / 8) + bx / 8 : bx; }
    F.ws = args.ws;
    F.x = args.in[0]; F.norm_g = args.in[1]; F.w_in = args.in[2]; F.qna = args.in[3]; F.kna = args.in[4]; F.sinks = args.in[5];
    F.qnb = args.in[6]; F.knb = args.in[7]; F.relb = args.in[8]; F.wpa = args.in[9]; F.wpb = args.in[10]; F.wout = args.in[11]; F.out = args.out;
    const int lo = args.ph_lo, hi = args.ph_hi;
    if (lo < 0) grid.sync();
    if (F.tid < 64) ((LAS unsigned*)(F.lds + RING_BYTES))[F.tid] = 0u;
    __syncthreads();
    XcdBarrier bar = xcd_barrier_post((unsigned*)(F.ws + WS_CTL), (volatile LAS unsigned*)(F.lds + RING_BYTES) + 8);
#ifdef ONLY_PH
#define IN(k) ((k) == ONLY_PH && lo <= (k) && (k) < hi)
#else
#define IN(k) (lo <= (k) && (k) < hi)
#endif
#ifdef PROBE_SYNC2
#define SEAM(k) do { if (IN(k) && IN((k) + 1)) { xcd_barrier(bar); xcd_barrier(bar); } } while (0)
#else
#define SEAM(k) do { if (IN(k) && IN((k) + 1)) xcd_barrier(bar); } while (0)
#endif
    if (IN(0)) { p0_prologue(F); }
    SEAM(0);
    if (IN(1)) {
        pg8::GemmIn g{(const h16*)(F.ws + WS_H2), (const h16*)(F.ws + WS_WIN), 2048, 1024};
        pg8::StaticOrder S; S.init(MROWS, 27 * 256, F.G, (int)blockIdx.x);
        pg8::EpiIn E{F.ws, (h16*)F.out};
        pg8::gemm_phase<pg8::EpiIn, pg8::StaticOrder, pg8::GemmIn, true, true>(F.lds, g, S, E);
    }
    SEAM(1);
    if (IN(2)) { p2_norm_phase(F); }
    SEAM(2);
    if (IN(3)) { p3_index_phase(F); }
    SEAM(3);
    if (IN(4)) { p4_attention_phase(F); }
    SEAM(4);
    if (IN(5)) {
        pg8::GemmPlain g{(const h16*)(F.ws + WS_Y), (const h16*)(F.ws + WS_WP), 1024, 1024};
        pg8::StaticOrder S; S.init(MROWS, DM, F.G, (int)blockIdx.x);
        pg8::EpiMerge E{(const h16*)F.out, (h16*)(F.ws + WS_MG)};
        pg8::gemm_phase<pg8::EpiMerge, pg8::StaticOrder, pg8::GemmPlain, true, true>(F.lds, g, S, E);
    }
    SEAM(5);
    if (IN(6)) {
        pg8::GemmPlain g{(const h16*)(F.ws + WS_MG), (const h16*)(F.ws + WS_WO), 1024, 1024};
        pg8::StaticOrder S; S.init(MROWS, DM, F.G, (int)blockIdx.x);
        pg8::EpiOut E{F.x, F.out};
        pg8::gemm_phase<pg8::EpiOut, pg8::StaticOrder, pg8::GemmPlain, true, true>(F.lds, g, S, E);
    }
#undef IN
#undef SEAM
}

extern "C" void kernel_launch(void* const* d_in, const int* in_sizes, int n_in, void* d_out, int out_size, void* d_ws, size_t ws_size, hipStream_t stream) {
    static int grid = 0;
    if (grid == 0) {
        if (n_in != 12 || in_sizes[0] != MROWS * DM || out_size != MROWS * DM || ws_size < WS_END) { fprintf(stderr, "kernel_launch: unexpected problem (n_in %d, ws %zu)\n", n_in, ws_size); grid = -1; return; }
        int dev = 0, cus = 0, per_cu = 0;
        hipGetDevice(&dev); hipDeviceGetAttribute(&cus, hipDeviceAttributeMultiprocessorCount, dev);
        hipFuncSetAttribute((const void*)mk_fwd, hipFuncAttributeMaxDynamicSharedMemorySize, LDS_BYTES);
        hipOccupancyMaxActiveBlocksPerMultiprocessor(&per_cu, (const void*)mk_fwd, NTHREADS, LDS_BYTES);
        (void)hipGetLastError();
        if (per_cu < 1) { fprintf(stderr, "kernel_launch: occupancy query says %d blocks/CU\n", per_cu); per_cu = 1; }
        grid = cus;
        if (grid > 256) grid = 256;
    }
    if (grid < 0) return;
    (void)hipMemsetAsync((char*)d_ws + WS_CTL, 0, CTL_BYTES, stream);
    Args a{};
    for (int i = 0; i < 12; ++i) a.in[i] = (const float*)d_in[i];
    a.out = (float*)d_out; a.ws = (unsigned char*)d_ws;
#ifdef PROBE_PH
    {
        void* kargs[] = {&a};
        a.ph_lo = 0; a.ph_hi = PROBE_PH + 1;
        (void)hipLaunchCooperativeKernel((const void*)mk_fwd, dim3(grid), dim3(NTHREADS), kargs, LDS_BYTES, stream);
        (void)hipMemsetAsync((char*)d_ws + WS_CTL, 0, CTL_BYTES, stream);
#ifdef PROBE_SPLIT_ONLY
        a.ph_lo = PROBE_PH + 1; a.ph_hi = N_PHASES;
#else
        a.ph_lo = PROBE_PH; a.ph_hi = N_PHASES;
#endif
        (void)hipLaunchCooperativeKernel((const void*)mk_fwd, dim3(grid), dim3(NTHREADS), kargs, LDS_BYTES, stream);
    }
#else
    {
        a.ph_lo = 0; a.ph_hi = N_PHASES;
        void* kargs[] = {&a};
        hipError_t e = hipLaunchCooperativeKernel((const void*)mk_fwd, dim3(grid), dim3(NTHREADS), kargs, LDS_BYTES, stream);
        if (e != hipSuccess) fprintf(stderr, "cooperative launch failed: %s (grid %d)\n", hipGetErrorString(e), grid);
    }
#endif
}
```

```cpp
#include <hip/hip_runtime.h>
#include <hip/hip_cooperative_groups.h>
#include <cstdio>
#include <cstdint>
namespace cg = cooperative_groups;

#define LAS __attribute__((address_space(3)))
typedef _Float16 h16;
typedef _Float16 h16x2 __attribute__((ext_vector_type(2)));
typedef _Float16 h16x4 __attribute__((ext_vector_type(4)));
typedef _Float16 h16x8 __attribute__((ext_vector_type(8)));
typedef float f32x2 __attribute__((ext_vector_type(2)));
typedef float f32x4 __attribute__((ext_vector_type(4)));
typedef float f32x16 __attribute__((ext_vector_type(16)));
typedef unsigned u32x2 __attribute__((ext_vector_type(2)));
typedef unsigned u32x4 __attribute__((ext_vector_type(4)));
typedef short s16x4 __attribute__((ext_vector_type(4)));

__device__ __forceinline__ unsigned pkh(float lo, float hi) { const f32x2 v = {lo, hi}; const h16x2 h = __builtin_convertvector(v, h16x2); return __builtin_bit_cast(unsigned, h); }
__device__ __forceinline__ float sigmoidf_fast(float g) { g = fminf(fmaxf(g, -30.f), 30.f); return __builtin_amdgcn_rcpf(1.0f + __builtin_amdgcn_exp2f(-1.4426950408889634f * g)); }

constexpr int NBATCH = 8, SEQ = 2048, DM = 1024, MROWS = NBATCH * SEQ, INW = 5672;
constexpr int IDXP = 304;
constexpr float RMS_EPS = 1e-6f, LOG2E = 1.4426950408889634f, QSCALE = 0.125f * 1.4426950408889634f;
constexpr float HSCALE = 16.f, WSCALE = 64.f, INV_HW = 1.0f / (16.f * 64.f);
constexpr size_t MiB = 1u << 20;
constexpr size_t WS_H2 = 0;
constexpr size_t WS_Y = 0, WS_MG = 32 * MiB;
constexpr size_t WS_WIN = 64 * MiB;
constexpr size_t WS_WP = 77 * MiB, WS_WO = 79 * MiB;
constexpr size_t WS_QA = 81 * MiB, WS_KVA = 97 * MiB, WS_ZA = 105 * MiB, WS_QB = 121 * MiB, WS_KB = 137 * MiB, WS_VB = 153 * MiB, WS_ZB = 169 * MiB;
constexpr size_t WS_IDX = 185 * MiB, IDX_BYTES = (size_t)MROWS * IDXP * 4;
constexpr size_t WS_MASK = 242 * MiB;
constexpr size_t WS_CTL = 246 * MiB, CTL_BYTES = 16384;
constexpr size_t WS_END = 247 * MiB;
static_assert(WS_IDX + 3 * IDX_BYTES <= WS_MASK, "ws map");

namespace pg8 {
#define PG8_LAS __attribute__((address_space(3)))
constexpr int BM = 256, BK = 64, HALF = 128, HTB = HALF * BK * 2  , STAGE_BYTES = 8 * HTB, NXCD = 8, WGM = 8;

__host__ __device__ __forceinline__ int lds_byte(int r, int c) { const int st = (r >> 4) * 2 + (c >> 5), rr = r & 15, cc = c & 31, ob = rr * 64 + cc * 2; return st * 1024 + (ob ^ (((ob >> 9) & 1) << 5)); }
__host__ __device__ __forceinline__ void stage_rc(int b, int& R, int& C) { const int st = b / 1024, sb = b % 1024, swz = sb ^ (((sb >> 9) & 1) << 5); R = (st >> 1) * 16 + swz / 64; C = (st & 1) * 32 + (swz % 64) / 2; }
__host__ __device__ __forceinline__ int perm32(int rho) { const int n = rho >> 4, i = rho & 15; return 8 * (i >> 2) + 4 * n + (i & 3); }

struct Unit { int pm, pn; };

struct StaticOrder {
    int nM, nN, nwg, G, c;
    __host__ __device__ void init(int M, int N, int G_, int c_) { nM = M / BM; nN = N / BM; nwg = nM * nN; G = G_; c = c_; }
    __host__ __device__ bool next(int i, Unit& u) const {
        const long L = (long)i * G + c; if (L >= nwg) return false;
        int wgid = (int)L; { const int q = nwg / NXCD, r = nwg % NXCD, xcd = wgid % NXCD, off = wgid / NXCD; wgid = (xcd < r ? xcd * (q + 1) : r * (q + 1) + (xcd - r) * q) + off; }
        const int nig = WGM * nN, gid = wgid / nig, fm = gid * WGM, gsz = (nM - fm) < WGM ? (nM - fm) : WGM;
        u.pm = fm + ((wgid % nig) % gsz); u.pn = (wgid % nig) / gsz; return true;
    }
    __device__ __forceinline__ void a_ready(const Unit&) const {}
    __device__ __forceinline__ void done(const Unit&) const {}
};

struct GemmPlain { const h16* A; const h16* Bt; int lda, K;
    __device__ __forceinline__ const char* aptr(const Unit& u) const { return (const char*)(A + (size_t)u.pm * BM * lda); }
    __device__ __forceinline__ const char* bptr(const Unit& u) const { return (const char*)(Bt + (size_t)u.pn * BM * K); } };
struct GemmIn { const h16* H2; const h16* Wt; int lda, K;
    __device__ __forceinline__ const char* aptr(const Unit& u) const { return (const char*)(H2 + (size_t)u.pm * BM * lda + ((u.pn == 23 || u.pn == 24) ? 0 : 1024)); }
    __device__ __forceinline__ const char* bptr(const Unit& u) const { const int bt = u.pn < 23 ? u.pn : u.pn - 2; return (const char*)(Wt + (size_t)bt * BM * K); } };

struct EpiIn {
    static constexpr bool PERM = true, AFTER_DRAIN = false, MID = false;
    unsigned char* ws; h16* G;
    __device__ __forceinline__ void operator()(const f32x4 (&acc)[2][2][4][2], const Unit& u, int wr, int wc, int fr, int fq) const {
        const int pn = u.pn, row0 = u.pm * BM + wr * 64 + fr, cl = wc * 32 + 8 * fq;
        if (pn < 21) {
            h16* base; int ldc, colt;
            if (pn < 2)       { base = (h16*)(ws + WS_QA);  ldc = 512; colt = pn * 256; }
            else if (pn == 2) { base = (h16*)(ws + WS_KVA); ldc = 256; colt = 0; }
            else if (pn < 5)  { base = (h16*)(ws + WS_ZA);  ldc = 512; colt = (pn - 3) * 256; }
            else if (pn < 7)  { base = (h16*)(ws + WS_QB);  ldc = 512; colt = (pn - 5) * 256; }
            else if (pn < 9)  { base = (h16*)(ws + WS_KB);  ldc = 512; colt = (pn - 7) * 256; }
            else if (pn < 11) { base = (h16*)(ws + WS_VB);  ldc = 512; colt = (pn - 9) * 256; }
            else if (pn < 13) { base = (h16*)(ws + WS_ZB);  ldc = 512; colt = (pn - 11) * 256; }
            else              { base = G;                   ldc = 2048; colt = (pn - 13) * 256; }
#pragma unroll
            for (int ai = 0; ai < 2; ++ai)
#pragma unroll
                for (int m = 0; m < 4; ++m) { h16* rowp = base + (size_t)(row0 + ai * HALF + m * 16) * ldc + colt + cl;
#pragma unroll
                    for (int bj = 0; bj < 2; ++bj) { const f32x4 v0 = acc[ai][bj][m][0] * INV_HW, v1 = acc[ai][bj][m][1] * INV_HW;
                        u32x4 w; w.x = pkh(v0[0], v0[1]); w.y = pkh(v0[2], v0[3]); w.z = pkh(v1[0], v1[1]); w.w = pkh(v1[2], v1[3]);
                        *(u32x4*)(rowp + bj * HALF) = w; } }
        } else {
            const int term = (pn - 21) >> 1, colt = ((pn - 21) & 1) * 256 + cl;
            float* base = (float*)(ws + WS_IDX + (size_t)term * IDX_BYTES);
#pragma unroll
            for (int ai = 0; ai < 2; ++ai)
#pragma unroll
                for (int m = 0; m < 4; ++m) { float* rowp = base + (size_t)(row0 + ai * HALF + m * 16) * IDXP;
#pragma unroll
                    for (int bj = 0; bj < 2; ++bj)
#pragma unroll
                        for (int n = 0; n < 2; ++n) { const int c = colt + bj * HALF + 4 * n; if (c < IDXP) *(f32x4*)(rowp + c) = acc[ai][bj][m][n] * INV_HW; } }
        }
    }
};
struct EpiMerge {
    static constexpr bool PERM = true, AFTER_DRAIN = false, MID = true;
    const h16* G; h16* MG;
    __device__ __forceinline__ void mid(f32x4 (&acc)[2][2][4][2], const Unit& u, int wr, int wc, int fr, int fq) const {
        const int row0 = u.pm * BM + wr * 64 + fr, col0 = u.pn * BM + wc * 32 + 8 * fq;
#pragma unroll
        for (int ai = 0; ai < 2; ++ai)
#pragma unroll
            for (int m = 0; m < 4; ++m) { unsigned ro = (unsigned)(row0 + ai * HALF + m * 16); asm volatile("" : "+v"(ro)); const h16* gp = G + (size_t)ro * 2048 + col0;
#pragma unroll
                for (int bj = 0; bj < 2; ++bj) { const h16x8 ga = *(const h16x8*)(gp + bj * HALF), gb = *(const h16x8*)(gp + 1024 + bj * HALF);
#pragma unroll
                    for (int e = 0; e < 8; ++e) { const float a = fminf(fmaxf((float)ga[e], -30.f), 30.f), b = fminf(fmaxf((float)gb[e], -30.f), 30.f);
                        const float f = (1.0f + __builtin_amdgcn_exp2f(-LOG2E * b)) * __builtin_amdgcn_rcpf(1.0f + __builtin_amdgcn_exp2f(-LOG2E * a));
                        acc[ai][bj][m][e >> 2][e & 3] *= f; } }
                asm volatile("" ::: "memory"); }
    }
    __device__ __forceinline__ void operator()(const f32x4 (&acc)[2][2][4][2], const Unit& u, int wr, int wc, int fr, int fq) const {
        const int row0 = u.pm * BM + wr * 64 + fr, col0 = u.pn * BM + wc * 32 + 8 * fq;
#pragma unroll
        for (int ai = 0; ai < 2; ++ai)
#pragma unroll
            for (int m = 0; m < 4; ++m) { unsigned ro = (unsigned)(row0 + ai * HALF + m * 16); asm volatile("" : "+v"(ro)); const size_t r = (size_t)ro;
#pragma unroll
                for (int bj = 0; bj < 2; ++bj) { const h16x8 gb = *(const h16x8*)(G + r * 2048 + 1024 + col0 + bj * HALF);
                    float o[8];
#pragma unroll
                    for (int e = 0; e < 8; ++e) o[e] = acc[ai][bj][m][e >> 2][e & 3] * sigmoidf_fast((float)gb[e]);
                    u32x4 w; w.x = pkh(o[0], o[1]); w.y = pkh(o[2], o[3]); w.z = pkh(o[4], o[5]); w.w = pkh(o[6], o[7]);
                    *(u32x4*)(MG + r * 1024 + col0 + bj * HALF) = w; } }
    }
};
struct EpiOut {
    static constexpr bool PERM = true, AFTER_DRAIN = false, MID = false;
    const float* x; float* out;
    __device__ __forceinline__ void operator()(const f32x4 (&acc)[2][2][4][2], const Unit& u, int wr, int wc, int fr, int fq) const {
        const int row0 = u.pm * BM + wr * 64 + fr, col0 = u.pn * BM + wc * 32 + 8 * fq;
#pragma unroll
        for (int ai = 0; ai < 2; ++ai)
#pragma unroll
            for (int m = 0; m < 4; ++m) { const size_t off = (size_t)(row0 + ai * HALF + m * 16) * DM + col0;
#pragma unroll
                for (int bj = 0; bj < 2; ++bj)
#pragma unroll
                    for (int n = 0; n < 2; ++n) { const f32x4 xv = *(const f32x4*)(x + off + bj * HALF + 4 * n); *(f32x4*)(out + off + bj * HALF + 4 * n) = xv + acc[ai][bj][m][n]; }
                if (m & 1) asm volatile("" ::: "memory"); }
    }
};

template <class Epi, class Sched, class GemmT, bool ALIGN_EPI = false, bool SP2 = false>
__device__ __forceinline__ void gemm_phase(PG8_LAS unsigned char* lds, const GemmT g, const Sched& S, const Epi& E) {
    const int tid = threadIdx.x, wid = __builtin_amdgcn_readfirstlane(tid >> 6), lane = tid & 63, wr = wid >> 2, wc = wid & 3, fr = lane & 15, fq = lane >> 4;
    const int K = g.K, nt = K / BK;
    unsigned voffA[2], voffB[2];
#pragma unroll
    for (int i = 0; i < 2; ++i) { int R, C; stage_rc(tid * 16 + i * 8192, R, C); const int Rb = Epi::PERM ? ((R & ~31) + perm32(R & 31)) : R;
        voffA[i] = (unsigned)(R * g.lda + C) * 2u; voffB[i] = (unsigned)(Rb * K + C) * 2u; }
    const size_t kstep = (size_t)(BK * 2);
    const size_t hstepA = (size_t)HALF * g.lda * 2, hstepB = (size_t)HALF * K * 2;
    const unsigned ldsw = (unsigned)wid * 1024u;
    const int aoff = lds_byte(wr * 64 + fr, fq * 8), boff = lds_byte(wc * 32 + fr, fq * 8);
#define PG8_SA(b, h) (((b) * 2 + (h)) * HTB)
#define PG8_SB(b, h) ((4 + (b) * 2 + (h)) * HTB)
#define PG8_STAGE(bufoff, gbase, voff) do { _Pragma("unroll") for (int _i = 0; _i < 2; ++_i) \
        __builtin_amdgcn_global_load_lds((const unsigned*)((const char*)(gbase) + (voff)[_i]), (PG8_LAS unsigned*)(lds + (bufoff) + ldsw + _i * 8192), 16, 0, 0); } while (0)
#define PG8_LDA(dst, b, h) do { _Pragma("unroll") for (int m = 0; m < 4; ++m) _Pragma("unroll") for (int k = 0; k < 2; ++k) dst[m][k] = *(const PG8_LAS h16x8*)(lds + PG8_SA(b, h) + aoff + m * 2048 + k * 1024); } while (0)
#define PG8_LDB(dst, b, h) do { _Pragma("unroll") for (int n = 0; n < 2; ++n) _Pragma("unroll") for (int k = 0; k < 2; ++k) dst[n][k] = *(const PG8_LAS h16x8*)(lds + PG8_SB(b, h) + boff + n * 2048 + k * 1024); } while (0)
#define PG8_MMA(ai, bj, At, Bt) do { __builtin_amdgcn_s_setprio(1); _Pragma("unroll") for (int m = 0; m < 4; ++m) _Pragma("unroll") for (int n = 0; n < 2; ++n) _Pragma("unroll") for (int k = 0; k < 2; ++k) \
        acc[ai][bj][m][n] = __builtin_amdgcn_mfma_f32_16x16x32_f16(Bt[n][k], At[m][k], acc[ai][bj][m][n], 0, 0, 0); __builtin_amdgcn_s_setprio(0); } while (0)
#define PG8_WAIT_V(n) asm volatile("s_waitcnt vmcnt(" #n ")" ::: "memory")
#define PG8_WAIT_L(n) asm volatile("s_waitcnt lgkmcnt(" #n ")" ::: "memory")
#define PG8_BAR __builtin_amdgcn_s_barrier()
#define PG8_SCHED __builtin_amdgcn_sched_barrier(0)
    Unit cur, nxt; int ui = 0;
    if (!S.next(0, cur)) return;
    f32x4 acc[2][2][4][2];
#pragma unroll
    for (int a = 0; a < 2; ++a)
#pragma unroll
        for (int b = 0; b < 2; ++b)
#pragma unroll
            for (int m = 0; m < 4; ++m)
#pragma unroll
                for (int n = 0; n < 2; ++n) acc[a][b][m][n] = (f32x4){0.f, 0.f, 0.f, 0.f};
    h16x8 At[4][2], B0[2][2], B1[2][2];
    const char* cA = g.aptr(cur); const char* cB = g.bptr(cur);
    S.a_ready(cur);
    if constexpr (SP2) {
        PG8_STAGE(PG8_SB(0, 0), cB, voffB); PG8_STAGE(PG8_SB(0, 1), cB + hstepB, voffB); PG8_STAGE(PG8_SA(0, 0), cA, voffA); PG8_STAGE(PG8_SA(0, 1), cA + hstepA, voffA);
        if (wr == 1) PG8_BAR;
        PG8_WAIT_V(2); PG8_BAR;
        PG8_STAGE(PG8_SB(1, 0), cB + kstep, voffB); PG8_STAGE(PG8_SA(1, 0), cA + kstep, voffA); PG8_STAGE(PG8_SB(1, 1), cB + hstepB + kstep, voffB);
        PG8_WAIT_V(6); PG8_BAR;
    } else {
        PG8_STAGE(PG8_SB(0, 0), cB, voffB); PG8_STAGE(PG8_SA(0, 0), cA, voffA); PG8_STAGE(PG8_SB(0, 1), cB + hstepB, voffB); PG8_STAGE(PG8_SA(0, 1), cA + hstepA, voffA);
        if (wr == 1) PG8_BAR;
        PG8_WAIT_V(4); PG8_BAR;
        PG8_STAGE(PG8_SB(1, 0), cB + kstep, voffB); PG8_STAGE(PG8_SA(1, 0), cA + kstep, voffA); PG8_STAGE(PG8_SB(1, 1), cB + hstepB + kstep, voffB);
        PG8_WAIT_V(6); PG8_BAR;
    }
    for (;;) {
        const bool has_next = S.next(ui + 1, nxt);
        const char* nA = has_next ? g.aptr(nxt) : cA; const char* nB = has_next ? g.bptr(nxt) : cB;
        for (int t = 0; t < nt; t += 2) {
            const bool last = (t == nt - 2);
            const char* a1 = cA + (size_t)(t + 1) * kstep;
            const char* a2 = last ? nA : cA + (size_t)(t + 2) * kstep; const char* b2 = last ? nB : cB + (size_t)(t + 2) * kstep;
            const char* a3 = a2 + kstep; const char* b3 = b2 + kstep;
            if (last && has_next) S.a_ready(nxt);
            if constexpr (Epi::MID) { if (t == nt / 2) E.mid(acc, cur, wr, wc, fr, fq); }
            if constexpr (SP2) {
            PG8_LDB(B0, 0, 0); PG8_LDB(B1, 0, 1); PG8_SCHED; PG8_LDA(At, 0, 0); PG8_STAGE(PG8_SA(1, 1), a1 + hstepA, voffA);
            PG8_WAIT_V(8); PG8_WAIT_L(0); PG8_BAR; PG8_MMA(0, 0, At, B0); PG8_MMA(0, 1, At, B1); PG8_BAR; PG8_SCHED;
            PG8_LDA(At, 0, 1); PG8_STAGE(PG8_SB(0, 0), b2, voffB); PG8_STAGE(PG8_SB(0, 1), b2 + hstepB, voffB); PG8_STAGE(PG8_SA(0, 0), a2, voffA);
            PG8_WAIT_V(8); PG8_WAIT_L(0); PG8_BAR; PG8_MMA(1, 0, At, B0); PG8_MMA(1, 1, At, B1); PG8_BAR; PG8_SCHED;
            PG8_LDB(B0, 1, 0); PG8_LDB(B1, 1, 1); PG8_SCHED; PG8_LDA(At, 1, 0); PG8_STAGE(PG8_SA(0, 1), a2 + hstepA, voffA);
            PG8_WAIT_V(8); PG8_WAIT_L(0); PG8_BAR; PG8_MMA(0, 0, At, B0); PG8_MMA(0, 1, At, B1); PG8_BAR; PG8_SCHED;
            PG8_LDA(At, 1, 1); PG8_STAGE(PG8_SB(1, 0), b3, voffB); PG8_STAGE(PG8_SB(1, 1), b3 + hstepB, voffB); PG8_STAGE(PG8_SA(1, 0), a3, voffA);
            PG8_WAIT_V(8); PG8_WAIT_L(0); PG8_BAR; PG8_MMA(1, 0, At, B0); PG8_MMA(1, 1, At, B1); PG8_BAR; PG8_SCHED;
            } else {
            PG8_LDB(B0, 0, 0); PG8_SCHED; PG8_LDA(At, 0, 0); PG8_STAGE(PG8_SA(1, 1), a1 + hstepA, voffA);
            PG8_WAIT_L(8); PG8_BAR; PG8_WAIT_L(0); PG8_MMA(0, 0, At, B0); PG8_BAR; PG8_SCHED;
            PG8_LDB(B1, 0, 1); PG8_STAGE(PG8_SB(0, 0), b2, voffB);
            PG8_BAR; PG8_WAIT_L(0); PG8_MMA(0, 1, At, B1); PG8_BAR;
            PG8_LDA(At, 0, 1); PG8_STAGE(PG8_SA(0, 0), a2, voffA);
            PG8_BAR; PG8_WAIT_L(0); PG8_MMA(1, 0, At, B0); PG8_BAR; PG8_SCHED;
            PG8_STAGE(PG8_SB(0, 1), b2 + hstepB, voffB);
            PG8_WAIT_V(6); PG8_BAR; PG8_MMA(1, 1, At, B1); PG8_BAR;
            PG8_LDB(B0, 1, 0); PG8_SCHED; PG8_LDA(At, 1, 0); PG8_STAGE(PG8_SA(0, 1), a2 + hstepA, voffA);
            PG8_WAIT_L(8); PG8_BAR; PG8_WAIT_L(0); PG8_MMA(0, 0, At, B0); PG8_BAR; PG8_SCHED;
            PG8_LDB(B1, 1, 1); PG8_STAGE(PG8_SB(1, 0), b3, voffB);
            PG8_BAR; PG8_WAIT_L(0); PG8_MMA(0, 1, At, B1); PG8_BAR;
            PG8_LDA(At, 1, 1); PG8_STAGE(PG8_SA(1, 0), a3, voffA);
            PG8_BAR; PG8_WAIT_L(0); PG8_MMA(1, 0, At, B0); PG8_BAR; PG8_SCHED;
            PG8_STAGE(PG8_SB(1, 1), b3 + hstepB, voffB);
            PG8_WAIT_V(6); PG8_BAR; PG8_MMA(1, 1, At, B1); PG8_BAR;
            }
        }
        if constexpr (ALIGN_EPI) { if (wr == 0) PG8_BAR; }
        if constexpr (!Epi::AFTER_DRAIN) { E(acc, cur, wr, wc, fr, fq); S.done(cur); }
        if (!has_next) break;
#pragma unroll
        for (int a = 0; a < 2; ++a)
#pragma unroll
            for (int b = 0; b < 2; ++b)
#pragma unroll
                for (int m = 0; m < 4; ++m)
#pragma unroll
                    for (int n = 0; n < 2; ++n) acc[a][b][m][n] = (f32x4){0.f, 0.f, 0.f, 0.f};
        cur = nxt; cA = nA; cB = nB; ++ui;
        if constexpr (ALIGN_EPI) { if (wr == 1) PG8_BAR; }
    }
    PG8_WAIT_V(0);
    if constexpr (!ALIGN_EPI) { if (wr == 0) PG8_BAR; }
    PG8_BAR;
    if constexpr (Epi::AFTER_DRAIN) { E.fused(acc, cur, wr, wc, fr, fq, lds, wid, lane); S.done(cur); }
#undef PG8_SA
#undef PG8_SB
#undef PG8_STAGE
#undef PG8_LDA
#undef PG8_LDB
#undef PG8_MMA
#undef PG8_WAIT_V
#undef PG8_WAIT_L
#undef PG8_BAR
#undef PG8_SCHED
}
}

constexpr int NWAVES = 8, NTHREADS = 512;
constexpr int RING_BYTES = 131072, LDS_BYTES = 147456;
#define LDS_WAIT() asm volatile("s_waitcnt lgkmcnt(0)" ::: "memory")

#define XB_TMO      128
#define XB_XCNT(j)  (256  + 64 * (j))
#define XB_XSUB(j)  (1280 + 64 * (j))
#define XB_XGEN(j)  (2304 + 64 * (j))
#define XB_TOP      3328
#define XB_TOPGEN   3392
#define XCD_BAR_WORDS 3456
#define XB_SPIN_CAP (1u << 18)

__device__ __forceinline__ unsigned xb_ld(unsigned* p)              { return __hip_atomic_load(p, __ATOMIC_RELAXED, __HIP_MEMORY_SCOPE_AGENT); }
__device__ __forceinline__ unsigned xb_add(unsigned* p, unsigned v) { return __hip_atomic_fetch_add(p, v, __ATOMIC_RELAXED, __HIP_MEMORY_SCOPE_AGENT); }
__device__ __forceinline__ unsigned xb_xcc_id() { return (unsigned)__builtin_amdgcn_s_getreg((3 << 11) | 20) & 0xFu; }
#define XB_SPIN(cond, bar) do { unsigned _sp = 0; while (cond) { __builtin_amdgcn_s_sleep(1); \
    if ((++_sp & 255u) == 0u) { if (xb_ld(&(bar)[XB_TMO])) break; if (_sp > XB_SPIN_CAP) { atomicAdd(&(bar)[XB_TMO], 1u); break; } } } } while (0)

struct XcdBarrier {
    unsigned* bar; unsigned x;
    volatile LAS unsigned* st;
};

__device__ __forceinline__ XcdBarrier xcd_barrier_post(unsigned* bar, volatile LAS unsigned* st) {
    XcdBarrier b; b.bar = bar; b.x = xb_xcc_id(); b.st = st;
    if (threadIdx.x == 0) (void)xb_add(&bar[XB_XCNT(b.x)], 1u);
    return b;
}
__device__ __forceinline__ void xcd_barrier_complete(unsigned* bar, unsigned x, unsigned& nloc, unsigned& nx) {
    const unsigned G = gridDim.x * gridDim.y * gridDim.z;
    unsigned sum, cnt, mine, sp = 0u;
    for (;;) {
        sum = 0u; cnt = 0u; mine = 0u;
#pragma unroll
        for (unsigned j = 0; j < 16; ++j) { const unsigned c = xb_ld(&bar[XB_XCNT(j)]); sum += c; cnt += (c > 0u) ? 1u : 0u; mine = (j == x) ? c : mine; }
        if (sum == G) break;
        __builtin_amdgcn_s_sleep(1);
        if ((++sp & 255u) == 0u) { if (xb_ld(&bar[XB_TMO])) break; if (sp > XB_SPIN_CAP) { atomicAdd(&bar[XB_TMO], 1u); break; } }
    }
    nloc = mine > 0u ? mine : 1u; nx = cnt > 0u ? cnt : 1u;
}

__device__ __forceinline__ void xcd_barrier(const XcdBarrier& b) {
    asm volatile("s_waitcnt vmcnt(0)" ::: "memory");
    __syncthreads();
    if (threadIdx.x == 0) {
        unsigned* bar = b.bar;
        __builtin_amdgcn_s_waitcnt(0);
        unsigned nloc = b.st[0], nx = b.st[1];
        if (nloc == 0u) { xcd_barrier_complete(bar, b.x, nloc, nx); b.st[0] = nloc; b.st[1] = nx; }
        const unsigned old = xb_add(&bar[XB_XSUB(b.x)], 1u);
        const unsigned gen = old / nloc;
        if (old + 1u == (gen + 1u) * nloc) {
            __builtin_amdgcn_fence(__ATOMIC_RELEASE, "agent");
            asm volatile("s_waitcnt vmcnt(0)" ::: "memory");
            const unsigned og = xb_add(&bar[XB_TOP], 1u);
            const unsigned tg = og / nx;
            if (og + 1u == (tg + 1u) * nx) xb_add(&bar[XB_TOPGEN], 1u);
            else XB_SPIN(xb_ld(&bar[XB_TOPGEN]) == tg, bar);
            __builtin_amdgcn_fence(__ATOMIC_ACQUIRE, "agent");
            xb_add(&bar[XB_XGEN(b.x)], 1u);
            asm volatile("s_waitcnt vmcnt(0)" ::: "memory");
        } else {
            XB_SPIN(xb_ld(&bar[XB_XGEN(b.x)]) == gen, bar);
            __builtin_amdgcn_fence(__ATOMIC_ACQUIRE, "agent");
            asm volatile("s_waitcnt vmcnt(0)" ::: "memory");
        }
    }
    __syncthreads();
}

struct Frame {
    LAS unsigned char* lds;
    int tid, lane, wave, vcu, G;
    unsigned char* ws;
    const float *x, *norm_g, *w_in, *qna, *kna, *sinks, *qnb, *knb, *relb, *wpa, *wpb, *wout;
    float* out;
};

__device__ __forceinline__ float wave_sum(float v) {
#pragma unroll
    for (int o = 1; o < 64; o <<= 1) v += __shfl_xor(v, o);
    return v;
}
__device__ __forceinline__ int t5_bucket(int n) {
    if (n < 16) return n < 0 ? 0 : n;
    const int l = 16 + (int)(logf((float)n * 0.0625f) / logf(8.0f) * 16.0f);
    return l > 31 ? 31 : l;
}

__device__ __forceinline__ int win_src_col(int n) { return n < 3328 ? n : (n < 5376 ? n + 296 : (n < 5672 ? n - 2048 : -1)); }
template <bool INPROJ>
__device__ __forceinline__ void p0_transpose_item(const float* W, int srcN, int k0, int n0, h16* WT, int ldk, int kdst0, LAS float* scr, int lane, float scale) {
    const int n = n0 + (lane & 31); const int col = INPROJ ? win_src_col(n) : n;
#pragma unroll 8
    for (int i = 0; i < 32; ++i) { const int kk = 2 * i + (lane >> 5); scr[kk * 33 + (lane & 31)] = (col >= 0) ? W[(size_t)(k0 + kk) * srcN + col] * scale : 0.f; }
    LDS_WAIT(); asm volatile("" ::: "memory");
    const int c = lane & 7;
#pragma unroll
    for (int j = 0; j < 4; ++j) { const int nn = (lane >> 3) + 8 * j; const LAS float* s = scr + (8 * c) * 33 + nn;
        float v[8];
#pragma unroll
        for (int e = 0; e < 8; ++e) v[e] = s[e * 33];
        u32x4 o; o.x = pkh(v[0], v[1]); o.y = pkh(v[2], v[3]); o.z = pkh(v[4], v[5]); o.w = pkh(v[6], v[7]);
        *(u32x4*)(WT + (size_t)(n0 + nn) * ldk + kdst0 + k0 + 8 * c) = o;
        if (INPROJ && n0 >= 5376) {
            float r[8];
#pragma unroll
            for (int e = 0; e < 8; ++e) r[e] = v[e] - (float)(h16)v[e];
            u32x4 q; q.x = pkh(r[0], r[1]); q.y = pkh(r[2], r[3]); q.z = pkh(r[4], r[5]); q.w = pkh(r[6], r[7]);
            *(u32x4*)(WT + (size_t)(n0 + nn + 512) * ldk + kdst0 + k0 + 8 * c) = q;
        } }
    LDS_WAIT(); asm volatile("" ::: "memory");
}
__device__ __forceinline__ void p0_norm_row(const float* xrow, const float* g, h16* orow, int lane) {
    f32x4 v[4]; float s = 0.f;
#pragma unroll
    for (int j = 0; j < 4; ++j) { v[j] = *((const f32x4*)xrow + lane + 64 * j); s += (v[j].x * v[j].x + v[j].y * v[j].y) + (v[j].z * v[j].z + v[j].w * v[j].w); }
    const float r = rsqrtf(wave_sum(s) * (1.0f / DM) + RMS_EPS);
#pragma unroll
    for (int j = 0; j < 4; ++j) { const f32x4 gg = *((const f32x4*)g + lane + 64 * j); const f32x4 hv = v[j] * r * gg * HSCALE;
        const h16 h0 = (h16)hv.x, h1 = (h16)hv.y, h2 = (h16)hv.z, h3 = (h16)hv.w;
        u32x2 hi, lo; hi.x = pkh(hv.x, hv.y); hi.y = pkh(hv.z, hv.w);
        lo.x = pkh(hv.x - (float)h0, hv.y - (float)h1); lo.y = pkh(hv.z - (float)h2, hv.w - (float)h3);
        *((u32x2*)(orow + 1024) + lane + 64 * j) = hi; *((u32x2*)orow + lane + 64 * j) = lo; }
}
__device__ __forceinline__ void p0_prologue(Frame& F) {
    LAS float* scr = (LAS float*)(F.lds + F.wave * 16384);
    const int gw = F.vcu * NWAVES + F.wave, NGW = F.G * NWAVES;
    h16* Win = (h16*)(F.ws + WS_WIN); h16* Wp = (h16*)(F.ws + WS_WP); h16* Wo = (h16*)(F.ws + WS_WO);
    constexpr int I_IN = 16 * 184, I_P = 8 * 32, I_O = 16 * 32;
    constexpr int NITEMS = I_IN + 2 * I_P + I_O;
    for (int it = gw; it < NITEMS; it += NGW) {
        int r = it;
        if (r < I_IN) { p0_transpose_item<true>(F.w_in, INW, 64 * (r / 184), 32 * (r % 184), Win, 1024, 0, scr, F.lane, WSCALE); continue; } r -= I_IN;
        if (r < I_P) { p0_transpose_item<false>(F.wpa, DM, 64 * (r / 32), 32 * (r % 32), Wp, 1024, 0, scr, F.lane, 1.f); continue; } r -= I_P;
        if (r < I_P) { p0_transpose_item<false>(F.wpb, DM, 64 * (r / 32), 32 * (r % 32), Wp, 1024, 512, scr, F.lane, 1.f); continue; } r -= I_P;
        p0_transpose_item<false>(F.wout, DM, 64 * (r / 32), 32 * (r % 32), Wo, 1024, 0, scr, F.lane, 1.f);
    }
    h16* H2 = (h16*)(F.ws + WS_H2);
    for (int m = gw; m < MROWS; m += NGW) p0_norm_row(F.x + (size_t)m * DM, F.norm_g, H2 + (size_t)m * 2048, F.lane);
}

__device__ __forceinline__ void headnorm_pass(Frame& F, h16* buf, int pitch, int ncols, const float* gain, float scale) {
    const int cpr = ncols / 8;
    const size_t total = (size_t)MROWS * cpr;
    const size_t gl = (size_t)(F.vcu * NTHREADS + F.tid), NG = (size_t)F.G * NTHREADS;
    const int c8 = (int)(gl & 7);
    float gn[8];
#pragma unroll
    for (int e = 0; e < 8; ++e) gn[e] = gain[c8 * 8 + e] * scale;
    for (size_t ci = gl; ci < total; ci += NG) {
        const size_t row = ci / cpr; const int ch = (int)(ci % cpr);
        h16* p = buf + row * pitch + ch * 8;
        const h16x8 v = *(const h16x8*)p; float f[8]; float ss = 0.f;
#pragma unroll
        for (int e = 0; e < 8; ++e) { f[e] = (float)v[e]; ss += f[e] * f[e]; }
        ss += __shfl_xor(ss, 1); ss += __shfl_xor(ss, 2); ss += __shfl_xor(ss, 4);
        const float r = rsqrtf(ss * (1.0f / 64.0f) + RMS_EPS);
        u32x4 o; o.x = pkh(f[0] * r * gn[0], f[1] * r * gn[1]); o.y = pkh(f[2] * r * gn[2], f[3] * r * gn[3]); o.z = pkh(f[4] * r * gn[4], f[5] * r * gn[5]); o.w = pkh(f[6] * r * gn[6], f[7] * r * gn[7]);
        *(u32x4*)p = o;
    }
}

constexpr size_t WS_QH = 32 * MiB, WS_QL = 40 * MiB, WS_KH = 48 * MiB, WS_KL = 49 * MiB, WS_WI = 50 * MiB;
__device__ __forceinline__ void idx_prepass(Frame& F) {
    const float* I1 = (const float*)(F.ws + WS_IDX); const float* I2 = (const float*)(F.ws + WS_IDX + IDX_BYTES); const float* I3 = (const float*)(F.ws + WS_IDX + 2 * IDX_BYTES);
    const int gw = F.vcu * NWAVES + F.wave, NGW = F.G * NWAVES, l = F.lane;
    for (int m = gw; m < MROWS; m += NGW) {
        if (l < 37) {
            const size_t o = (size_t)m * IDXP + 8 * l;
            const f32x4 a0 = *(const f32x4*)(I1 + o), a1 = *(const f32x4*)(I1 + o + 4), b0 = *(const f32x4*)(I2 + o), b1 = *(const f32x4*)(I2 + o + 4), c0 = *(const f32x4*)(I3 + o), c1 = *(const f32x4*)(I3 + o + 4);
            const f32x4 s0 = (a0 + b0) + c0, s1 = (a1 + b1) + c1;
            if (l < 36) {
                float v[8] = {s0[0] * 16.f, s0[1] * 16.f, s0[2] * 16.f, s0[3] * 16.f, s1[0] * 16.f, s1[1] * 16.f, s1[2] * 16.f, s1[3] * 16.f}; float r[8];
#pragma unroll
                for (int e = 0; e < 8; ++e) r[e] = v[e] - (float)(h16)v[e];
                u32x4 hi, lo; hi.x = pkh(v[0], v[1]); hi.y = pkh(v[2], v[3]); hi.z = pkh(v[4], v[5]); hi.w = pkh(v[6], v[7]);
                lo.x = pkh(r[0], r[1]); lo.y = pkh(r[2], r[3]); lo.z = pkh(r[4], r[5]); lo.w = pkh(r[6], r[7]);
                if (l < 32) { *(u32x4*)((h16*)(F.ws + WS_QH) + (size_t)m * 256 + 8 * l) = hi; *(u32x4*)((h16*)(F.ws + WS_QL) + (size_t)m * 256 + 8 * l) = lo; }
                else { *(u32x4*)((h16*)(F.ws + WS_KH) + (size_t)m * 32 + 8 * (l - 32)) = hi; *(u32x4*)((h16*)(F.ws + WS_KL) + (size_t)m * 32 + 8 * (l - 32)) = lo; }
            } else { float* w = (float*)(F.ws + WS_WI) + (size_t)m * 8; *(f32x4*)w = s0; *(f32x4*)(w + 4) = s1; }
        }
    }
}
constexpr int HROW = 1028;
constexpr int IX_HIST = 0, IX_ST = 66560, IX_OMASK = IX_ST + 1024, IX_TMASK = IX_OMASK + 4096;
__device__ __forceinline__ void idx_item(Frame& F, int b, int g) {
    const int tid = F.tid, lane = F.lane, wid = F.wave, tok = lane & 15, fq = lane >> 4;
    const int t0 = g * 16;
    unsigned* gmask = (unsigned*)(F.ws + WS_MASK) + (size_t)(b * SEQ + t0) * 64;
    if (g < 16) {
        for (int i = tid; i < 1024; i += NTHREADS) { const int tk = i >> 6, w = i & 63, t = t0 + tk, lo = w * 32;
            gmask[i] = (t >= lo + 31) ? 0xffffffffu : (t >= lo ? ((2u << (t - lo)) - 1u) : 0u); }
        return;
    }
    LAS unsigned* hist = (LAS unsigned*)(F.lds + IX_HIST);
    LAS unsigned* st = (LAS unsigned*)(F.lds + IX_ST);
    LAS unsigned* omask = (LAS unsigned*)(F.lds + IX_OMASK);
    LAS unsigned* tmask = (LAS unsigned*)(F.lds + IX_TMASK);
    const int ntile = g + 1;
    const size_t qrow = (size_t)(b * SEQ + t0 + tok);
    h16x8 qhi[8], qlo[8];
#pragma unroll
    for (int h = 0; h < 8; ++h) { qhi[h] = *(const h16x8*)((const h16*)(F.ws + WS_QH) + qrow * 256 + h * 32 + fq * 8); qlo[h] = *(const h16x8*)((const h16*)(F.ws + WS_QL) + qrow * 256 + h * 32 + fq * 8); }
    const f32x4 w0 = *(const f32x4*)((const float*)(F.ws + WS_WI) + qrow * 8), w1 = *(const f32x4*)((const float*)(F.ws + WS_WI) + qrow * 8 + 4);
    const float wv[8] = {w0[0], w0[1], w0[2], w0[3], w1[0], w1[1], w1[2], w1[3]};
    if (tid < 16) { st[96 + tid] = 0xffffffffu; st[112 + tid] = 0u; } if (tid == 0) st[128] = 0u;
    for (int i = tid; i < 2048; i += NTHREADS) omask[i] = 0u;
    unsigned key[16][4];
    unsigned kmin = 0xffffffffu, kmax = 0u;
    h16x8 khn = {}, kln = {};
    const h16* khb = (const h16*)(F.ws + WS_KH) + (size_t)(b * SEQ + tok) * 32 + fq * 8; const h16* klb = (const h16*)(F.ws + WS_KL) + (size_t)(b * SEQ + tok) * 32 + fq * 8;
    if (wid < ntile) { khn = *(const h16x8*)(khb + wid * 512); kln = *(const h16x8*)(klb + wid * 512); }
#pragma unroll
    for (int i = 0; i < 16; ++i) {
        int tile = wid + 8 * i; asm volatile("" : "+s"(tile));
        if (tile < ntile) {
            const h16x8 khi = khn, klo = kln;
            if (tile + 8 < ntile) { unsigned toff = (unsigned)(tile + 8) * (16u * 32u); asm volatile("" : "+v"(toff));
                khn = *(const h16x8*)(khb + toff); kln = *(const h16x8*)(klb + toff); }
            f32x4 sc = {0.f, 0.f, 0.f, 0.f};
#pragma unroll
            for (int h = 0; h < 8; ++h) {
                f32x4 a = __builtin_amdgcn_mfma_f32_16x16x32_f16(khi, qhi[h], (f32x4){0.f, 0.f, 0.f, 0.f}, 0, 0, 0);
                a = __builtin_amdgcn_mfma_f32_16x16x32_f16(khi, qlo[h], a, 0, 0, 0);
                a = __builtin_amdgcn_mfma_f32_16x16x32_f16(klo, qhi[h], a, 0, 0, 0);
#pragma unroll
                for (int r = 0; r < 4; ++r) sc[r] = fmaf(wv[h], fmaxf(a[r], 0.f), sc[r]);
            }
#pragma unroll
            for (int r = 0; r < 4; ++r) { const int s = tile * 16 + 4 * fq + r; const unsigned u = __float_as_uint(sc[r] + 0.0f);
                const unsigned k = (u >> 31) ? ~u : (u | 0x80000000u); const bool valid = s <= t0 + tok;
                key[i][r] = valid ? k : 0u; if (valid) { kmin = min(kmin, k); kmax = max(kmax, k); } }
        } else {
#pragma unroll
            for (int r = 0; r < 4; ++r) key[i][r] = 0u;
        }
    }
    __syncthreads();
    kmin = min(kmin, (unsigned)__shfl_xor((int)kmin, 16)); kmin = min(kmin, (unsigned)__shfl_xor((int)kmin, 32));
    kmax = max(kmax, (unsigned)__shfl_xor((int)kmax, 16)); kmax = max(kmax, (unsigned)__shfl_xor((int)kmax, 32));
    if (fq == 0) { atomicMin((unsigned*)&st[96 + tok], kmin); atomicMax((unsigned*)&st[112 + tok], kmax); }
    __syncthreads();
    if (tid < 16) { const unsigned lo = st[96 + tid], span = st[112 + tid] - lo; st[tid] = lo; st[16 + tid] = span; st[32 + tid] = span >= 1024u ? (unsigned)(22 - __clz((int)span)) : 0u; st[48 + tid] = 256u; }
    for (int round = 0; round < 8; ++round) {
#pragma unroll
        for (int i = 0; i < 9; ++i) { const int o = tid * 16 + i * 8192; if (o < 16 * HROW * 4) *(LAS u32x4*)(F.lds + IX_HIST + o) = (u32x4){0u, 0u, 0u, 0u}; }
        __syncthreads();
        const unsigned done = st[128];
        if (!((done >> tok) & 1u)) {
            const unsigned lo = st[tok], span = st[16 + tok], shift = st[32 + tok];
#pragma unroll
            for (int i = 0; i < 16; ++i) {
                int tile = wid + 8 * i; asm volatile("" : "+s"(tile));
                if (tile < ntile) {
#pragma unroll
                    for (int r = 0; r < 4; ++r) { const unsigned k = key[i][r]; if (k >= lo && k - lo <= span) atomicAdd((unsigned*)&hist[tok * HROW + ((k - lo) >> shift)], 1u); }
                }
            }
        }
        __syncthreads();
#pragma unroll 1
        for (int tt = 0; tt < 2; ++tt) {
            const int tk = 2 * wid + tt;
            if (!((done >> tk) & 1u)) {
                const LAS u32x4* hp = (const LAS u32x4*)(hist + tk * HROW + 16 * lane);
                const u32x4 c0 = hp[0], c1 = hp[1], c2 = hp[2], c3 = hp[3];
                const unsigned cnt[16] = {c0.x, c0.y, c0.z, c0.w, c1.x, c1.y, c1.z, c1.w, c2.x, c2.y, c2.z, c2.w, c3.x, c3.y, c3.z, c3.w};
                unsigned s = 0;
#pragma unroll
                for (int e = 0; e < 16; ++e) s += cnt[e];
                unsigned v = s;
#pragma unroll
                for (int o = 1; o < 64; o <<= 1) { const unsigned tmp = (unsigned)__shfl_down((int)v, o); if (lane + o < 64) v += tmp; }
                const unsigned above = v - s, need = st[48 + tk];
                if (above < need && need <= above + s) {
                    unsigned cum = above, bstar = 0, rr = 0, cb = 0; bool found = false;
#pragma unroll
                    for (int e = 15; e >= 0; --e) { const unsigned c = cnt[e]; if (!found && cum + c >= need) { found = true; bstar = 16u * lane + e; rr = need - cum; cb = c; } if (!found) cum += c; }
                    const unsigned lo = st[tk], shift = st[32 + tk];
                    const unsigned newlo = lo + (bstar << shift);
                    if (cb == rr) { st[64 + tk] = newlo; st[80 + tk] = 0u; atomicOr((unsigned*)&st[128], 1u << tk); }
                    else if (shift == 0u) { st[64 + tk] = newlo; st[80 + tk] = rr; atomicOr((unsigned*)&st[128], 1u << tk); }
                    else { st[tk] = newlo; st[16 + tk] = (1u << shift) - 1u; st[32 + tk] = shift > 10u ? shift - 10u : 0u; st[48 + tk] = rr; }
                }
            }
        }
        __syncthreads();
        if (st[128] == 0xffffu) break;
    }
    {
        const unsigned T = st[64 + tok], tr = st[80 + tok];
#pragma unroll
        for (int i = 0; i < 16; ++i) {
            int tile = wid + 8 * i; asm volatile("" : "+s"(tile));
            if (tile < ntile) {
                unsigned nib = 0u, tnib = 0u;
#pragma unroll
                for (int r = 0; r < 4; ++r) { const unsigned k = key[i][r]; const bool sel = tr ? (k > T) : (k >= T); nib |= sel ? (1u << r) : 0u; tnib |= (tr && k == T) ? (1u << r) : 0u; }
                const int s0 = tile * 16 + 4 * fq;
                if (nib) atomicOr((unsigned*)&omask[tok * 64 + (s0 >> 5)], nib << (s0 & 31));
                if (tnib) atomicOr((unsigned*)&tmask[tok * 64 + (s0 >> 5)], tnib << (s0 & 31));
            }
        }
    }
    __syncthreads();
#pragma unroll 1
    for (int tt = 0; tt < 2; ++tt) {
        const int tk = 2 * wid + tt; const unsigned tr = st[80 + tk];
        if (tr) {
            unsigned w = tmask[tk * 64 + lane]; const unsigned pc = __popc(w);
            unsigned incl = pc;
#pragma unroll
            for (int o = 1; o < 64; o <<= 1) { const unsigned tmp = (unsigned)__shfl_up((int)incl, o); if (lane >= o) incl += tmp; }
            const unsigned before = incl - pc;
            unsigned n = before >= tr ? 0u : min(tr - before, pc), kept = 0u;
            while (n) { const unsigned bit = w & (0u - w); kept |= bit; w ^= bit; --n; }
            if (kept) omask[tk * 64 + lane] |= kept;
        }
    }
    __syncthreads();
    for (int i = tid; i < 1024; i += NTHREADS) gmask[i] = omask[i];
    __syncthreads();
}
__device__ __forceinline__ void p2_norm_phase(Frame& F) { idx_prepass(F); }
__device__ __forceinline__ void p3_index_phase(Frame& F) {
    for (int v = F.vcu; v < 256; v += F.G) {
        const int b = v >> 5, p = v & 31;
#pragma unroll 1
        for (int k = 0; k < 4; ++k) { const int g = (k == 0) ? p : (k == 1) ? 63 - p : (k == 2) ? 64 + p : 127 - p; idx_item(F, b, g); }
    }
}

constexpr int AT_K = 0, AT_KSZ = 64 * 144, AT_V = 2 * AT_KSZ, AT_VSZ = 64 * 192, AT_LUT = AT_V + 2 * AT_VSZ, AT_OST = AT_LUT + 320 * 4, AT_OSTSZ = 32 * 144;
static_assert(AT_OST + 8 * AT_OSTSZ <= RING_BYTES, "attention LDS");
__device__ __forceinline__ s16x4 vtr_read(const LAS unsigned char* p) { return __builtin_amdgcn_ds_read_tr16_b64_v4i16((LAS s16x4*)p); }

template <bool ISB>
__device__ __forceinline__ void attn_unit(Frame& F, int b, int h, int qb) {
    const int tid = F.tid, lane = F.lane, wid = F.wave, q = lane & 31, hi = lane >> 5;
    const int q0 = qb * 256, r0 = q0 + wid * 32, t = r0 + q;
    const size_t row = (size_t)b * SEQ + t;
    const h16* Qp; const h16* Kp; const h16* Vp; const h16* Zp; int kvpitch, ycol;
    if (ISB) { Qp = (const h16*)(F.ws + WS_QB) + h * 64; Kp = (const h16*)(F.ws + WS_KB) + h * 64; Vp = (const h16*)(F.ws + WS_VB) + h * 64; Zp = (const h16*)(F.ws + WS_ZB) + h * 64; kvpitch = 512; ycol = 512 + h * 64; }
    else     { Qp = (const h16*)(F.ws + WS_QA) + h * 64; Kp = (const h16*)(F.ws + WS_KVA) + (h >> 2) * 64; Vp = (const h16*)(F.ws + WS_KVA) + 128 + (h >> 2) * 64; Zp = (const h16*)(F.ws + WS_ZA) + h * 64; kvpitch = 256; ycol = h * 64; }
    const unsigned* mrow = (const unsigned*)(F.ws + WS_MASK) + row * 64;
    LAS float* lut = (LAS float*)(F.lds + AT_LUT);
    for (int i = tid; i < 320; i += NTHREADS) { const int dist = 223 - i; float v;
        if (ISB) v = dist < 0 ? 0.f : F.relb[t5_bucket(dist > 127 ? 127 : dist) * 16 + 8 + h] * LOG2E;
        else v = (dist >= 0 && dist < 128) ? F.relb[t5_bucket(dist) * 16 + h] * LOG2E : -INFINITY;
        lut[i] = v; }
    const float cfar = ISB ? F.relb[31 * 16 + 8 + h] * LOG2E : 0.f;
    h16x8 qr[4];
    {   const float* qg = ISB ? F.qnb : F.qna; float ss = 0.f;
#pragma unroll
        for (int d0 = 0; d0 < 4; ++d0) { qr[d0] = *(const h16x8*)(Qp + row * 512 + d0 * 16 + hi * 8);
#pragma unroll
            for (int e = 0; e < 8; ++e) { const float f = (float)qr[d0][e]; ss += f * f; } }
        ss += __shfl_xor(ss, 32);
        const float rq = rsqrtf(ss * (1.0f / 64.0f) + RMS_EPS) * QSCALE;
#pragma unroll
        for (int d0 = 0; d0 < 4; ++d0) { const f32x4 g0 = *(const f32x4*)(qg + d0 * 16 + hi * 8), g1 = *(const f32x4*)(qg + d0 * 16 + hi * 8 + 4);
            u32x4 w; w.x = pkh((float)qr[d0][0] * rq * g0[0], (float)qr[d0][1] * rq * g0[1]); w.y = pkh((float)qr[d0][2] * rq * g0[2], (float)qr[d0][3] * rq * g0[3]);
            w.z = pkh((float)qr[d0][4] * rq * g1[0], (float)qr[d0][5] * rq * g1[1]); w.w = pkh((float)qr[d0][6] * rq * g1[2], (float)qr[d0][7] * rq * g1[3]);
            qr[d0] = __builtin_bit_cast(h16x8, w); } }
    float kgn[8];
    {   const float* kgp = (ISB ? F.knb : F.kna) + (tid & 7) * 8; const f32x4 g0 = *(const f32x4*)kgp, g1 = *(const f32x4*)(kgp + 4);
        kgn[0] = g0[0]; kgn[1] = g0[1]; kgn[2] = g0[2]; kgn[3] = g0[3]; kgn[4] = g1[0]; kgn[5] = g1[1]; kgn[6] = g1[2]; kgn[7] = g1[3]; }
#define KNORM(KR) do { const h16x8 kv_ = __builtin_bit_cast(h16x8, KR); float f_[8]; float ss_ = 0.f; \
        _Pragma("unroll") for (int e = 0; e < 8; ++e) { f_[e] = (float)kv_[e]; ss_ += f_[e] * f_[e]; } \
        ss_ += __shfl_xor(ss_, 1); ss_ += __shfl_xor(ss_, 2); ss_ += __shfl_xor(ss_, 4); \
        const float rk_ = rsqrtf(ss_ * (1.0f / 64.0f) + RMS_EPS); \
        KR.x = pkh(f_[0] * rk_ * kgn[0], f_[1] * rk_ * kgn[1]); KR.y = pkh(f_[2] * rk_ * kgn[2], f_[3] * rk_ * kgn[3]); \
        KR.z = pkh(f_[4] * rk_ * kgn[4], f_[5] * rk_ * kgn[5]); KR.w = pkh(f_[6] * rk_ * kgn[6], f_[7] * rk_ * kgn[7]); } while (0)
    const int kt_lo = ISB ? 0 : (4 * qb - 2 < 0 ? 0 : 4 * qb - 2), kt_hi = 4 * qb + 3;
    const int srow = tid >> 3, sch = tid & 7;
    const h16* kg = Kp + ((size_t)b * SEQ + srow) * kvpitch + sch * 8; const h16* vg = Vp + ((size_t)b * SEQ + srow) * kvpitch + sch * 8;
    const int kst = srow * 144 + sch * 16, vst = srow * 192 + sch * 16;
    u32x4 kreg = *(const u32x4*)(kg + (size_t)kt_lo * 64 * kvpitch), vreg = *(const u32x4*)(vg + (size_t)kt_lo * 64 * kvpitch);
    u32x2 mw = {0u, 0u}, mwn = {0u, 0u};
    if (ISB) mw = *(const u32x2*)(mrow + 2 * kt_lo);
    KNORM(kreg);
    *(LAS u32x4*)(F.lds + AT_K + kst) = kreg; *(LAS u32x4*)(F.lds + AT_V + vst) = vreg;
    __syncthreads();
    float m_run = -INFINITY, l_run = 0.f;
    f32x16 o[2];
#pragma unroll
    for (int r = 0; r < 16; ++r) { o[0][r] = 0.f; o[1][r] = 0.f; }
    const int kfo = q * 144 + hi * 16;
    const int vfo = (4 * hi + ((lane & 15) >> 2)) * 192 + ((lane >> 4) & 1) * 32 + (lane & 3) * 8;
    for (int kt = kt_lo; kt <= kt_hi; ++kt) {
        const int cur = (kt - kt_lo) & 1;
        if (kt < kt_hi) { kreg = *(const u32x4*)(kg + (size_t)(kt + 1) * 64 * kvpitch); vreg = *(const u32x4*)(vg + (size_t)(kt + 1) * 64 * kvpitch); if (ISB) mwn = *(const u32x2*)(mrow + 2 * (kt + 1)); }
        const int k0 = kt * 64;
        const bool active = ISB ? (k0 <= r0 + 31) : (k0 <= r0 + 31 && k0 + 63 >= r0 - 127);
        if (active) {
            const LAS unsigned char* kb = F.lds + AT_K + cur * AT_KSZ + kfo;
            const LAS unsigned char* vb = F.lds + AT_V + cur * AT_VSZ + vfo;
            f32x16 p0, p1;
#pragma unroll
            for (int r = 0; r < 16; ++r) { p0[r] = 0.f; p1[r] = 0.f; }
#pragma unroll
            for (int d0 = 0; d0 < 4; ++d0) {
                const h16x8 ka = *(const LAS h16x8*)(kb + d0 * 32), kc = *(const LAS h16x8*)(kb + 32 * 144 + d0 * 32);
                p0 = __builtin_amdgcn_mfma_f32_32x32x16_f16(ka, qr[d0], p0, 0, 0, 0);
                p1 = __builtin_amdgcn_mfma_f32_32x32x16_f16(kc, qr[d0], p1, 0, 0, 0);
            }
            if (ISB && (r0 - k0 - 63 >= 113)) {
#pragma unroll
                for (int r = 0; r < 16; ++r) { p0[r] += cfar; p1[r] += cfar; }
            } else {
                const LAS float* lp = lut + (223 - (t - k0 - 4 * hi));
#pragma unroll
                for (int r = 0; r < 16; ++r) { const int c = (r & 3) + 8 * (r >> 2); p0[r] += lp[c]; p1[r] += lp[32 + c]; }
            }
            if (ISB) {
                const unsigned mm0 = mw.x >> (4 * hi), mm1 = mw.y >> (4 * hi);
#pragma unroll
                for (int r = 0; r < 16; ++r) { const unsigned bit = 1u << ((r & 3) + 8 * (r >> 2)); if (!(mm0 & bit)) p0[r] = -INFINITY; if (!(mm1 & bit)) p1[r] = -INFINITY; }
            }
            float mx = fmaxf(p0[0], p1[0]);
#pragma unroll
            for (int r = 1; r < 16; ++r) mx = fmaxf(mx, fmaxf(p0[r], p1[r]));
            mx = fmaxf(mx, __shfl_xor(mx, 32));
            const float mnew = fmaxf(m_run, mx), muse = (mnew == -INFINITY) ? 0.f : mnew;
            const float alpha = __builtin_amdgcn_exp2f(m_run - muse);
            m_run = mnew;
            float sum = 0.f;
#pragma unroll
            for (int r = 0; r < 16; ++r) { p0[r] = __builtin_amdgcn_exp2f(p0[r] - muse); p1[r] = __builtin_amdgcn_exp2f(p1[r] - muse); sum += p0[r] + p1[r]; }
            l_run = l_run * alpha + sum;
#pragma unroll
            for (int r = 0; r < 16; ++r) { o[0][r] *= alpha; o[1][r] *= alpha; }
            u32x4 pk[4];
            pk[0] = (u32x4){pkh(p0[0], p0[1]), pkh(p0[2], p0[3]), pkh(p0[4], p0[5]), pkh(p0[6], p0[7])};
            pk[1] = (u32x4){pkh(p0[8], p0[9]), pkh(p0[10], p0[11]), pkh(p0[12], p0[13]), pkh(p0[14], p0[15])};
            pk[2] = (u32x4){pkh(p1[0], p1[1]), pkh(p1[2], p1[3]), pkh(p1[4], p1[5]), pkh(p1[6], p1[7])};
            pk[3] = (u32x4){pkh(p1[8], p1[9]), pkh(p1[10], p1[11]), pkh(p1[12], p1[13]), pkh(p1[14], p1[15])};
#pragma unroll
            for (int s = 0; s < 4; ++s)
#pragma unroll
                for (int d1 = 0; d1 < 2; ++d1) {
                    const s16x4 lo4 = vtr_read(vb + (16 * s) * 192 + d1 * 64), hi4 = vtr_read(vb + (16 * s + 8) * 192 + d1 * 64);
                    const h16x4 lf = __builtin_bit_cast(h16x4, lo4), hf = __builtin_bit_cast(h16x4, hi4);
                    const h16x8 vf = {lf[0], lf[1], lf[2], lf[3], hf[0], hf[1], hf[2], hf[3]};
                    o[d1] = __builtin_amdgcn_mfma_f32_32x32x16_f16(vf, __builtin_bit_cast(h16x8, pk[s]), o[d1], 0, 0, 0);
                }
        }
        if (kt < kt_hi) { KNORM(kreg); *(LAS u32x4*)(F.lds + AT_K + (cur ^ 1) * AT_KSZ + kst) = kreg; *(LAS u32x4*)(F.lds + AT_V + (cur ^ 1) * AT_VSZ + vst) = vreg; mw = mwn; }
        __syncthreads();
    }
    l_run += __shfl_xor(l_run, 32);
    if (!ISB) l_run += __builtin_amdgcn_exp2f(F.sinks[h] * LOG2E - m_run);
    const float inv = 1.0f / l_run;
    LAS unsigned char* ost = F.lds + AT_OST + wid * AT_OSTSZ;
#pragma unroll
    for (int d1 = 0; d1 < 2; ++d1)
#pragma unroll
        for (int g4 = 0; g4 < 4; ++g4) { u32x2 w; w.x = pkh(o[d1][4 * g4] * inv, o[d1][4 * g4 + 1] * inv); w.y = pkh(o[d1][4 * g4 + 2] * inv, o[d1][4 * g4 + 3] * inv);
            *(LAS u32x2*)(ost + q * 144 + (32 * d1 + 8 * g4 + 4 * hi) * 2) = w; }
    LDS_WAIT(); asm volatile("" ::: "memory");
    h16* Yp = (h16*)(F.ws + WS_Y);
#pragma unroll
    for (int i = 0; i < 4; ++i) { const int rr = i * 8 + (lane >> 3), ch = lane & 7; const size_t grow = (size_t)b * SEQ + r0 + rr;
        const h16x8 ov = *(const LAS h16x8*)(ost + rr * 144 + ch * 16); const h16x8 zv = *(const h16x8*)(Zp + grow * 512 + ch * 8);
        float y[8];
#pragma unroll
        for (int e = 0; e < 8; ++e) { const float z = (float)zv[e]; y[e] = (float)ov[e] * z * sigmoidf_fast(z); }
        u32x4 w; w.x = pkh(y[0], y[1]); w.y = pkh(y[2], y[3]); w.z = pkh(y[4], y[5]); w.w = pkh(y[6], y[7]);
        *(u32x4*)(Yp + grow * 1024 + ycol + ch * 8) = w; }
    __syncthreads();
#undef KNORM
}
__device__ __forceinline__ void p4_attention_phase(Frame& F) {
    for (int v = F.vcu; v < 256; v += F.G) {
        const int bh = v >> 2, j = v & 3, b = bh >> 3, h = bh & 7;
        attn_unit<true>(F, b, h, 7 - j); attn_unit<true>(F, b, h, j);
        attn_unit<false>(F, b, h, 2 * j); attn_unit<false>(F, b, h, 2 * j + 1);
    }
}

struct Args { const float* in[12]; float* out; unsigned char* ws; int ph_lo, ph_hi; };
constexpr int N_PHASES = 7;
__global__ void __launch_bounds__(NTHREADS, 2) mk_fwd(Args args) {
    extern __shared__ __attribute__((aligned(16))) unsigned char lds_raw[];
    cg::grid_group grid = cg::this_grid();
    Frame F;
    F.lds = (LAS unsigned char*)lds_raw;
    F.tid = threadIdx.x; F.lane = F.tid & 63; F.wave = __builtin_amdgcn_readfirstlane(F.tid >> 6);
    F.G = gridDim.x; { const int bx = blockIdx.x; F.vcu = (F.G % 8 == 0) ? (bx % 8) * (F.G / 8) + bx / 8 : bx; }
    F.ws = args.ws;
    F.x = args.in[0]; F.norm_g = args.in[1]; F.w_in = args.in[2]; F.qna = args.in[3]; F.kna = args.in[4]; F.sinks = args.in[5];
    F.qnb = args.in[6]; F.knb = args.in[7]; F.relb = args.in[8]; F.wpa = args.in[9]; F.wpb = args.in[10]; F.wout = args.in[11]; F.out = args.out;
    const int lo = args.ph_lo, hi = args.ph_hi;
    if (lo < 0) grid.sync();
    if (F.tid < 64) ((LAS unsigned*)(F.lds + RING_BYTES))[F.tid] = 0u;
    __syncthreads();
    XcdBarrier bar = xcd_barrier_post((unsigned*)(F.ws + WS_CTL), (volatile LAS unsigned*)(F.lds + RING_BYTES) + 8);
#ifdef ONLY_PH
#define IN(k) ((k) == ONLY_PH && lo <= (k) && (k) < hi)
#else
#define IN(k) (lo <= (k) && (k) < hi)
#endif
#ifdef PROBE_SYNC2
#define SEAM(k) do { if (IN(k) && IN((k) + 1)) { xcd_barrier(bar); xcd_barrier(bar); } } while (0)
#else
#define SEAM(k) do { if (IN(k) && IN((k) + 1)) xcd_barrier(bar); } while (0)
#endif
    if (IN(0)) { p0_prologue(F); }
    SEAM(0);
    if (IN(1)) {
        pg8::GemmIn g{(const h16*)(F.ws + WS_H2), (const h16*)(F.ws + WS_WIN), 2048, 1024};
        pg8::StaticOrder S; S.init(MROWS, 27 * 256, F.G, (int)blockIdx.x);
        pg8::EpiIn E{F.ws, (h16*)F.out};
        pg8::gemm_phase<pg8::EpiIn, pg8::StaticOrder, pg8::GemmIn, true, true>(F.lds, g, S, E);
    }
    SEAM(1);
    if (IN(2)) { p2_norm_phase(F); }
    SEAM(2);
    if (IN(3)) { p3_index_phase(F); }
    SEAM(3);
    if (IN(4)) { p4_attention_phase(F); }
    SEAM(4);
    if (IN(5)) {
        pg8::GemmPlain g{(const h16*)(F.ws + WS_Y), (const h16*)(F.ws + WS_WP), 1024, 1024};
        pg8::StaticOrder S; S.init(MROWS, DM, F.G, (int)blockIdx.x);
        pg8::EpiMerge E{(const h16*)F.out, (h16*)(F.ws + WS_MG)};
        pg8::gemm_phase<pg8::EpiMerge, pg8::StaticOrder, pg8::GemmPlain, true, true>(F.lds, g, S, E);
    }
    SEAM(5);
    if (IN(6)) {
        pg8::GemmPlain g{(const h16*)(F.ws + WS_MG), (const h16*)(F.ws + WS_WO), 1024, 1024};
        pg8::StaticOrder S; S.init(MROWS, DM, F.G, (int)blockIdx.x);
        pg8::EpiOut E{F.x, F.out};
        pg8::gemm_phase<pg8::EpiOut, pg8::StaticOrder, pg8::GemmPlain, true, true>(F.lds, g, S, E);
    }
#undef IN
#undef SEAM
}

extern "C" void kernel_launch(void* const* d_in, const int* in_sizes, int n_in, void* d_out, int out_size, void* d_ws, size_t ws_size, hipStream_t stream) {
    static int grid = 0;
    if (grid == 0) {
        if (n_in != 12 || in_sizes[0] != MROWS * DM || out_size != MROWS * DM || ws_size < WS_END) { fprintf(stderr, "kernel_launch: unexpected problem (n_in %d, ws %zu)\n", n_in, ws_size); grid = -1; return; }
        int dev = 0, cus = 0, per_cu = 0;
        hipGetDevice(&dev); hipDeviceGetAttribute(&cus, hipDeviceAttributeMultiprocessorCount, dev);
        hipFuncSetAttribute((const void*)mk_fwd, hipFuncAttributeMaxDynamicSharedMemorySize, LDS_BYTES);
        hipOccupancyMaxActiveBlocksPerMultiprocessor(&per_cu, (const void*)mk_fwd, NTHREADS, LDS_BYTES);
        (void)hipGetLastError();
        if (per_cu < 1) { fprintf(stderr, "kernel_launch: occupancy query says %d blocks/CU\n", per_cu); per_cu = 1; }
        grid = cus;
        if (grid > 256) grid = 256;
    }
    if (grid < 0) return;
    (void)hipMemsetAsync((char*)d_ws + WS_CTL, 0, CTL_BYTES, stream);
    Args a{};
    for (int i = 0; i < 12; ++i) a.in[i] = (const float*)d_in[i];
    a.out = (float*)d_out; a.ws = (unsigned char*)d_ws;
#ifdef PROBE_PH
    {
        void* kargs[] = {&a};
        a.ph_lo = 0; a.ph_hi = PROBE_PH + 1;
        (void)hipLaunchCooperativeKernel((const void*)mk_fwd, dim3(grid), dim3(NTHREADS), kargs, LDS_BYTES, stream);
        (void)hipMemsetAsync((char*)d_ws + WS_CTL, 0, CTL_BYTES, stream);
#ifdef PROBE_SPLIT_ONLY
        a.ph_lo = PROBE_PH + 1; a.ph_hi = N_PHASES;
#else
        a.ph_lo = PROBE_PH; a.ph_hi = N_PHASES;
#endif
        (void)hipLaunchCooperativeKernel((const void*)mk_fwd, dim3(grid), dim3(NTHREADS), kargs, LDS_BYTES, stream);
    }
#else
    {
        a.ph_lo = 0; a.ph_hi = N_PHASES;
        void* kargs[] = {&a};
        hipError_t e = hipLaunchCooperativeKernel((const void*)mk_fwd, dim3(grid), dim3(NTHREADS), kargs, LDS_BYTES, stream);
        if (e != hipSuccess) fprintf(stderr, "cooperative launch failed: %s (grid %d)\n", hipGetErrorString(e), grid);
    }
#endif
}
```

```cpp
#include <hip/hip_runtime.h>
#include <hip/hip_cooperative_groups.h>
#include <cstdio>
#include <cstdint>
namespace cg = cooperative_groups;

#define LAS __attribute__((address_space(3)))
typedef _Float16 h16;
typedef _Float16 h16x2 __attribute__((ext_vector_type(2)));
typedef _Float16 h16x4 __attribute__((ext_vector_type(4)));
typedef _Float16 h16x8 __attribute__((ext_vector_type(8)));
typedef float f32x2 __attribute__((ext_vector_type(2)));
typedef float f32x4 __attribute__((ext_vector_type(4)));
typedef float f32x16 __attribute__((ext_vector_type(16)));
typedef unsigned u32x2 __attribute__((ext_vector_type(2)));
typedef unsigned u32x4 __attribute__((ext_vector_type(4)));
typedef short s16x4 __attribute__((ext_vector_type(4)));

__device__ __forceinline__ unsigned pkh(float lo, float hi) { const f32x2 v = {lo, hi}; const h16x2 h = __builtin_convertvector(v, h16x2); return __builtin_bit_cast(unsigned, h); }
__device__ __forceinline__ float sigmoidf_fast(float g) { g = fminf(fmaxf(g, -30.f), 30.f); return __builtin_amdgcn_rcpf(1.0f + __builtin_amdgcn_exp2f(-1.4426950408889634f * g)); }

constexpr int NBATCH = 8, SEQ = 2048, DM = 1024, MROWS = NBATCH * SEQ, INW = 5672;
constexpr float RMS_EPS = 1e-6f, LOG2E = 1.4426950408889634f, QSCALE = 0.125f * 1.4426950408889634f;
constexpr float HSCALE = 16.f, WSCALE = 64.f, INV_HW = 1.0f / (16.f * 64.f);
constexpr size_t MiB = 1u << 20;
constexpr size_t WS_H = 0;
constexpr size_t WS_Y = 0, WS_MG = 32 * MiB;
constexpr size_t WS_QH = 32 * MiB, WS_QL = 40 * MiB, WS_KH = 48 * MiB, WS_KL = 49 * MiB, WS_WI = 50 * MiB;
constexpr size_t WS_WIN = 64 * MiB;
constexpr size_t WS_WP = 77 * MiB, WS_WO = 79 * MiB;
constexpr size_t WS_QA = 81 * MiB, WS_KVA = 97 * MiB, WS_ZA = 105 * MiB, WS_QB = 121 * MiB, WS_KB = 137 * MiB, WS_VB = 153 * MiB, WS_ZB = 169 * MiB;
constexpr size_t WS_MASK = 185 * MiB;
constexpr size_t WS_CTL = 190 * MiB, CTL_BYTES = 16384;
constexpr size_t WS_END = 191 * MiB;

namespace pg8 {
#define PG8_LAS __attribute__((address_space(3)))
constexpr int BM = 256, BK = 64, HALF = 128, HTB = HALF * BK * 2  , STAGE_BYTES = 8 * HTB, NXCD = 8, WGM = 8;

__host__ __device__ __forceinline__ int lds_byte(int r, int c) { const int st = (r >> 4) * 2 + (c >> 5), rr = r & 15, cc = c & 31, ob = rr * 64 + cc * 2; return st * 1024 + (ob ^ (((ob >> 9) & 1) << 5)); }
__host__ __device__ __forceinline__ void stage_rc(int b, int& R, int& C) { const int st = b / 1024, sb = b % 1024, swz = sb ^ (((sb >> 9) & 1) << 5); R = (st >> 1) * 16 + swz / 64; C = (st & 1) * 32 + (swz % 64) / 2; }
__host__ __device__ __forceinline__ int perm32(int rho) { const int n = rho >> 4, i = rho & 15; return 8 * (i >> 2) + 4 * n + (i & 3); }

struct Unit { int pm, pn; };

struct StaticOrder {
    int nM, nN, nwg, G, c;
    __host__ __device__ void init(int M, int N, int G_, int c_) { nM = M / BM; nN = N / BM; nwg = nM * nN; G = G_; c = c_; }
    __host__ __device__ bool next(int i, Unit& u) const {
        const long L = (long)i * G + c; if (L >= nwg) return false;
        int wgid = (int)L; { const int q = nwg / NXCD, r = nwg % NXCD, xcd = wgid % NXCD, off = wgid / NXCD; wgid = (xcd < r ? xcd * (q + 1) : r * (q + 1) + (xcd - r) * q) + off; }
        const int nig = WGM * nN, gid = wgid / nig, fm = gid * WGM, gsz = (nM - fm) < WGM ? (nM - fm) : WGM;
        u.pm = fm + ((wgid % nig) % gsz); u.pn = (wgid % nig) / gsz; return true;
    }
    __device__ __forceinline__ void a_ready(const Unit&) const {}
    __device__ __forceinline__ void done(const Unit&) const {}
};

struct GemmPlain { const h16* A; const h16* Bt; int lda, K;
    __device__ __forceinline__ const char* aptr(const Unit& u) const { return (const char*)(A + (size_t)u.pm * BM * lda); }
    __device__ __forceinline__ const char* bptr(const Unit& u) const { return (const char*)(Bt + (size_t)u.pn * BM * K); } };
struct EpiIn {
    static constexpr bool PERM = true, AFTER_DRAIN = false, MID = false;
    unsigned char* ws; h16* G;
    __device__ __forceinline__ void operator()(const f32x4 (&acc)[2][2][4][2], const Unit& u, int wr, int wc, int fr, int fq) const {
        const int pn = u.pn, row0 = u.pm * BM + wr * 64 + fr, cl = wc * 32 + 8 * fq;
        if (pn < 21) {
            h16* base; int ldc, colt;
            if (pn < 2)       { base = (h16*)(ws + WS_QA);  ldc = 512; colt = pn * 256; }
            else if (pn == 2) { base = (h16*)(ws + WS_KVA); ldc = 256; colt = 0; }
            else if (pn < 5)  { base = (h16*)(ws + WS_ZA);  ldc = 512; colt = (pn - 3) * 256; }
            else if (pn < 7)  { base = (h16*)(ws + WS_QB);  ldc = 512; colt = (pn - 5) * 256; }
            else if (pn < 9)  { base = (h16*)(ws + WS_KB);  ldc = 512; colt = (pn - 7) * 256; }
            else if (pn < 11) { base = (h16*)(ws + WS_VB);  ldc = 512; colt = (pn - 9) * 256; }
            else if (pn < 13) { base = (h16*)(ws + WS_ZB);  ldc = 512; colt = (pn - 11) * 256; }
            else              { base = G;                   ldc = 2048; colt = (pn - 13) * 256; }
#pragma unroll
            for (int ai = 0; ai < 2; ++ai)
#pragma unroll
                for (int m = 0; m < 4; ++m) { h16* rowp = base + (size_t)(row0 + ai * HALF + m * 16) * ldc + colt + cl;
#pragma unroll
                    for (int bj = 0; bj < 2; ++bj) { const f32x4 v0 = acc[ai][bj][m][0] * INV_HW, v1 = acc[ai][bj][m][1] * INV_HW;
                        u32x4 w; w.x = pkh(v0[0], v0[1]); w.y = pkh(v0[2], v0[3]); w.z = pkh(v1[0], v1[1]); w.w = pkh(v1[2], v1[3]);
                        *(u32x4*)(rowp + bj * HALF) = w; } }
        } else {
            const int colt = (pn - 21) * 256 + cl;
#pragma unroll
            for (int ai = 0; ai < 2; ++ai)
#pragma unroll
                for (int m = 0; m < 4; ++m) { const size_t r = (size_t)(row0 + ai * HALF + m * 16);
#pragma unroll
                    for (int bj = 0; bj < 2; ++bj) { const int j = colt + bj * HALF; const f32x4 v0 = acc[ai][bj][m][0] * INV_HW, v1 = acc[ai][bj][m][1] * INV_HW;
                        if (j < 288) {
                            const float v[8] = {v0[0] * 16.f, v0[1] * 16.f, v0[2] * 16.f, v0[3] * 16.f, v1[0] * 16.f, v1[1] * 16.f, v1[2] * 16.f, v1[3] * 16.f}; float d[8];
#pragma unroll
                            for (int e = 0; e < 8; ++e) d[e] = v[e] - (float)(h16)v[e];
                            u32x4 hi, lo; hi.x = pkh(v[0], v[1]); hi.y = pkh(v[2], v[3]); hi.z = pkh(v[4], v[5]); hi.w = pkh(v[6], v[7]);
                            lo.x = pkh(d[0], d[1]); lo.y = pkh(d[2], d[3]); lo.z = pkh(d[4], d[5]); lo.w = pkh(d[6], d[7]);
                            if (j < 256) { *(u32x4*)((h16*)(ws + WS_QH) + r * 256 + j) = hi; *(u32x4*)((h16*)(ws + WS_QL) + r * 256 + j) = lo; }
                            else { *(u32x4*)((h16*)(ws + WS_KH) + r * 32 + (j - 256)) = hi; *(u32x4*)((h16*)(ws + WS_KL) + r * 32 + (j - 256)) = lo; }
                        } else if (j < 296) { float* w = (float*)(ws + WS_WI) + r * 8; *(f32x4*)w = v0; *(f32x4*)(w + 4) = v1; }
                    } }
        }
    }
};
struct EpiMerge {
    static constexpr bool PERM = true, AFTER_DRAIN = false, MID = true;
    const h16* G; h16* MG;
    __device__ __forceinline__ void mid(f32x4 (&acc)[2][2][4][2], const Unit& u, int wr, int wc, int fr, int fq) const {
        const int row0 = u.pm * BM + wr * 64 + fr, col0 = u.pn * BM + wc * 32 + 8 * fq;
#pragma unroll
        for (int ai = 0; ai < 2; ++ai)
#pragma unroll
            for (int m = 0; m < 4; ++m) { unsigned ro = (unsigned)(row0 + ai * HALF + m * 16); asm volatile("" : "+v"(ro)); const h16* gp = G + (size_t)ro * 2048 + col0;
#pragma unroll
                for (int bj = 0; bj < 2; ++bj) { const h16x8 ga = *(const h16x8*)(gp + bj * HALF), gb = *(const h16x8*)(gp + 1024 + bj * HALF);
#pragma unroll
                    for (int e = 0; e < 8; ++e) { const float a = fminf(fmaxf((float)ga[e], -30.f), 30.f), b = fminf(fmaxf((float)gb[e], -30.f), 30.f);
                        const float f = (1.0f + __builtin_amdgcn_exp2f(-LOG2E * b)) * __builtin_amdgcn_rcpf(1.0f + __builtin_amdgcn_exp2f(-LOG2E * a));
                        acc[ai][bj][m][e >> 2][e & 3] *= f; } }
                asm volatile("" ::: "memory"); }
    }
    __device__ __forceinline__ void operator()(const f32x4 (&acc)[2][2][4][2], const Unit& u, int wr, int wc, int fr, int fq) const {
        const int row0 = u.pm * BM + wr * 64 + fr, col0 = u.pn * BM + wc * 32 + 8 * fq;
#pragma unroll
        for (int ai = 0; ai < 2; ++ai)
#pragma unroll
            for (int m = 0; m < 4; ++m) { unsigned ro = (unsigned)(row0 + ai * HALF + m * 16); asm volatile("" : "+v"(ro)); const size_t r = (size_t)ro;
#pragma unroll
                for (int bj = 0; bj < 2; ++bj) { const h16x8 gb = *(const h16x8*)(G + r * 2048 + 1024 + col0 + bj * HALF);
                    float o[8];
#pragma unroll
                    for (int e = 0; e < 8; ++e) o[e] = acc[ai][bj][m][e >> 2][e & 3] * sigmoidf_fast((float)gb[e]);
                    u32x4 w; w.x = pkh(o[0], o[1]); w.y = pkh(o[2], o[3]); w.z = pkh(o[4], o[5]); w.w = pkh(o[6], o[7]);
                    *(u32x4*)(MG + r * 1024 + col0 + bj * HALF) = w; } }
    }
};
struct EpiOut {
    static constexpr bool PERM = true, AFTER_DRAIN = false, MID = false;
    const float* x; float* out;
    __device__ __forceinline__ void operator()(const f32x4 (&acc)[2][2][4][2], const Unit& u, int wr, int wc, int fr, int fq) const {
        const int row0 = u.pm * BM + wr * 64 + fr, col0 = u.pn * BM + wc * 32 + 8 * fq;
#pragma unroll
        for (int ai = 0; ai < 2; ++ai)
#pragma unroll
            for (int m = 0; m < 4; ++m) { const size_t off = (size_t)(row0 + ai * HALF + m * 16) * DM + col0;
#pragma unroll
                for (int bj = 0; bj < 2; ++bj)
#pragma unroll
                    for (int n = 0; n < 2; ++n) { const f32x4 xv = *(const f32x4*)(x + off + bj * HALF + 4 * n); *(f32x4*)(out + off + bj * HALF + 4 * n) = xv + acc[ai][bj][m][n]; }
                if (m & 1) asm volatile("" ::: "memory"); }
    }
};

template <class Epi, class Sched, class GemmT, bool ALIGN_EPI = false, bool SP2 = false>
__device__ __forceinline__ void gemm_phase(PG8_LAS unsigned char* lds, const GemmT g, const Sched& S, const Epi& E) {
    const int tid = threadIdx.x, wid = __builtin_amdgcn_readfirstlane(tid >> 6), lane = tid & 63, wr = wid >> 2, wc = wid & 3, fr = lane & 15, fq = lane >> 4;
    const int K = g.K, nt = K / BK;
    unsigned voffA[2], voffB[2];
#pragma unroll
    for (int i = 0; i < 2; ++i) { int R, C; stage_rc(tid * 16 + i * 8192, R, C); const int Rb = Epi::PERM ? ((R & ~31) + perm32(R & 31)) : R;
        voffA[i] = (unsigned)(R * g.lda + C) * 2u; voffB[i] = (unsigned)(Rb * K + C) * 2u; }
    const size_t kstep = (size_t)(BK * 2);
    const size_t hstepA = (size_t)HALF * g.lda * 2, hstepB = (size_t)HALF * K * 2;
    const unsigned ldsw = (unsigned)wid * 1024u;
    const int aoff = lds_byte(wr * 64 + fr, fq * 8), boff = lds_byte(wc * 32 + fr, fq * 8);
#define PG8_SA(b, h) (((b) * 2 + (h)) * HTB)
#define PG8_SB(b, h) ((4 + (b) * 2 + (h)) * HTB)
#define PG8_STAGE(bufoff, gbase, voff) do { _Pragma("unroll") for (int _i = 0; _i < 2; ++_i) \
        __builtin_amdgcn_global_load_lds((const unsigned*)((const char*)(gbase) + (voff)[_i]), (PG8_LAS unsigned*)(lds + (bufoff) + ldsw + _i * 8192), 16, 0, 0); } while (0)
#define PG8_LDA(dst, b, h) do { _Pragma("unroll") for (int m = 0; m < 4; ++m) _Pragma("unroll") for (int k = 0; k < 2; ++k) dst[m][k] = *(const PG8_LAS h16x8*)(lds + PG8_SA(b, h) + aoff + m * 2048 + k * 1024); } while (0)
#define PG8_LDB(dst, b, h) do { _Pragma("unroll") for (int n = 0; n < 2; ++n) _Pragma("unroll") for (int k = 0; k < 2; ++k) dst[n][k] = *(const PG8_LAS h16x8*)(lds + PG8_SB(b, h) + boff + n * 2048 + k * 1024); } while (0)
#define PG8_MMA(ai, bj, At, Bt) do { __builtin_amdgcn_s_setprio(1); _Pragma("unroll") for (int m = 0; m < 4; ++m) _Pragma("unroll") for (int n = 0; n < 2; ++n) _Pragma("unroll") for (int k = 0; k < 2; ++k) \
        acc[ai][bj][m][n] = __builtin_amdgcn_mfma_f32_16x16x32_f16(Bt[n][k], At[m][k], acc[ai][bj][m][n], 0, 0, 0); __builtin_amdgcn_s_setprio(0); } while (0)
#define PG8_WAIT_V(n) asm volatile("s_waitcnt vmcnt(" #n ")" ::: "memory")
#define PG8_WAIT_L(n) asm volatile("s_waitcnt lgkmcnt(" #n ")" ::: "memory")
#define PG8_BAR __builtin_amdgcn_s_barrier()
#define PG8_SCHED __builtin_amdgcn_sched_barrier(0)
    Unit cur, nxt; int ui = 0;
    if (!S.next(0, cur)) return;
    f32x4 acc[2][2][4][2];
#pragma unroll
    for (int a = 0; a < 2; ++a)
#pragma unroll
        for (int b = 0; b < 2; ++b)
#pragma unroll
            for (int m = 0; m < 4; ++m)
#pragma unroll
                for (int n = 0; n < 2; ++n) acc[a][b][m][n] = (f32x4){0.f, 0.f, 0.f, 0.f};
    h16x8 At[4][2], B0[2][2], B1[2][2];
    const char* cA = g.aptr(cur); const char* cB = g.bptr(cur);
    S.a_ready(cur);
    if constexpr (SP2) {
        PG8_STAGE(PG8_SB(0, 0), cB, voffB); PG8_STAGE(PG8_SB(0, 1), cB + hstepB, voffB); PG8_STAGE(PG8_SA(0, 0), cA, voffA); PG8_STAGE(PG8_SA(0, 1), cA + hstepA, voffA);
        if (wr == 1) PG8_BAR;
        PG8_WAIT_V(2); PG8_BAR;
        PG8_STAGE(PG8_SB(1, 0), cB + kstep, voffB); PG8_STAGE(PG8_SA(1, 0), cA + kstep, voffA); PG8_STAGE(PG8_SB(1, 1), cB + hstepB + kstep, voffB);
        PG8_WAIT_V(6); PG8_BAR;
    } else {
        PG8_STAGE(PG8_SB(0, 0), cB, voffB); PG8_STAGE(PG8_SA(0, 0), cA, voffA); PG8_STAGE(PG8_SB(0, 1), cB + hstepB, voffB); PG8_STAGE(PG8_SA(0, 1), cA + hstepA, voffA);
        if (wr == 1) PG8_BAR;
        PG8_WAIT_V(4); PG8_BAR;
        PG8_STAGE(PG8_SB(1, 0), cB + kstep, voffB); PG8_STAGE(PG8_SA(1, 0), cA + kstep, voffA); PG8_STAGE(PG8_SB(1, 1), cB + hstepB + kstep, voffB);
        PG8_WAIT_V(6); PG8_BAR;
    }
    for (;;) {
        const bool has_next = S.next(ui + 1, nxt);
        const char* nA = has_next ? g.aptr(nxt) : cA; const char* nB = has_next ? g.bptr(nxt) : cB;
        for (int t = 0; t < nt; t += 2) {
            const bool last = (t == nt - 2);
            const char* a1 = cA + (size_t)(t + 1) * kstep;
            const char* a2 = last ? nA : cA + (size_t)(t + 2) * kstep; const char* b2 = last ? nB : cB + (size_t)(t + 2) * kstep;
            const char* a3 = a2 + kstep; const char* b3 = b2 + kstep;
            if (last && has_next) S.a_ready(nxt);
            if constexpr (Epi::MID) { if (t == nt / 2) E.mid(acc, cur, wr, wc, fr, fq); }
            if constexpr (SP2) {
            PG8_LDB(B0, 0, 0); PG8_LDB(B1, 0, 1); PG8_SCHED; PG8_LDA(At, 0, 0); PG8_STAGE(PG8_SA(1, 1), a1 + hstepA, voffA);
            PG8_WAIT_V(8); PG8_WAIT_L(0); PG8_BAR; PG8_MMA(0, 0, At, B0); PG8_MMA(0, 1, At, B1); PG8_BAR; PG8_SCHED;
            PG8_LDA(At, 0, 1); PG8_STAGE(PG8_SB(0, 0), b2, voffB); PG8_STAGE(PG8_SB(0, 1), b2 + hstepB, voffB); PG8_STAGE(PG8_SA(0, 0), a2, voffA);
            PG8_WAIT_V(8); PG8_WAIT_L(0); PG8_BAR; PG8_MMA(1, 0, At, B0); PG8_MMA(1, 1, At, B1); PG8_BAR; PG8_SCHED;
            PG8_LDB(B0, 1, 0); PG8_LDB(B1, 1, 1); PG8_SCHED; PG8_LDA(At, 1, 0); PG8_STAGE(PG8_SA(0, 1), a2 + hstepA, voffA);
            PG8_WAIT_V(8); PG8_WAIT_L(0); PG8_BAR; PG8_MMA(0, 0, At, B0); PG8_MMA(0, 1, At, B1); PG8_BAR; PG8_SCHED;
            PG8_LDA(At, 1, 1); PG8_STAGE(PG8_SB(1, 0), b3, voffB); PG8_STAGE(PG8_SB(1, 1), b3 + hstepB, voffB); PG8_STAGE(PG8_SA(1, 0), a3, voffA);
            PG8_WAIT_V(8); PG8_WAIT_L(0); PG8_BAR; PG8_MMA(1, 0, At, B0); PG8_MMA(1, 1, At, B1); PG8_BAR; PG8_SCHED;
            } else {
            PG8_LDB(B0, 0, 0); PG8_SCHED; PG8_LDA(At, 0, 0); PG8_STAGE(PG8_SA(1, 1), a1 + hstepA, voffA);
            PG8_WAIT_L(8); PG8_BAR; PG8_WAIT_L(0); PG8_MMA(0, 0, At, B0); PG8_BAR; PG8_SCHED;
            PG8_LDB(B1, 0, 1); PG8_STAGE(PG8_SB(0, 0), b2, voffB);
            PG8_BAR; PG8_WAIT_L(0); PG8_MMA(0, 1, At, B1); PG8_BAR;
            PG8_LDA(At, 0, 1); PG8_STAGE(PG8_SA(0, 0), a2, voffA);
            PG8_BAR; PG8_WAIT_L(0); PG8_MMA(1, 0, At, B0); PG8_BAR; PG8_SCHED;
            PG8_STAGE(PG8_SB(0, 1), b2 + hstepB, voffB);
            PG8_WAIT_V(6); PG8_BAR; PG8_MMA(1, 1, At, B1); PG8_BAR;
            PG8_LDB(B0, 1, 0); PG8_SCHED; PG8_LDA(At, 1, 0); PG8_STAGE(PG8_SA(0, 1), a2 + hstepA, voffA);
            PG8_WAIT_L(8); PG8_BAR; PG8_WAIT_L(0); PG8_MMA(0, 0, At, B0); PG8_BAR; PG8_SCHED;
            PG8_LDB(B1, 1, 1); PG8_STAGE(PG8_SB(1, 0), b3, voffB);
            PG8_BAR; PG8_WAIT_L(0); PG8_MMA(0, 1, At, B1); PG8_BAR;
            PG8_LDA(At, 1, 1); PG8_STAGE(PG8_SA(1, 0), a3, voffA);
            PG8_BAR; PG8_WAIT_L(0); PG8_MMA(1, 0, At, B0); PG8_BAR; PG8_SCHED;
            PG8_STAGE(PG8_SB(1, 1), b3 + hstepB, voffB);
            PG8_WAIT_V(6); PG8_BAR; PG8_MMA(1, 1, At, B1); PG8_BAR;
            }
        }
        if constexpr (ALIGN_EPI) { if (wr == 0) PG8_BAR; }
        if constexpr (!Epi::AFTER_DRAIN) { E(acc, cur, wr, wc, fr, fq); S.done(cur); }
        if (!has_next) break;
#pragma unroll
        for (int a = 0; a < 2; ++a)
#pragma unroll
            for (int b = 0; b < 2; ++b)
#pragma unroll
                for (int m = 0; m < 4; ++m)
#pragma unroll
                    for (int n = 0; n < 2; ++n) acc[a][b][m][n] = (f32x4){0.f, 0.f, 0.f, 0.f};
        cur = nxt; cA = nA; cB = nB; ++ui;
        if constexpr (ALIGN_EPI) { if (wr == 1) PG8_BAR; }
    }
    PG8_WAIT_V(0);
    if constexpr (!ALIGN_EPI) { if (wr == 0) PG8_BAR; }
    PG8_BAR;
    if constexpr (Epi::AFTER_DRAIN) { E.fused(acc, cur, wr, wc, fr, fq, lds, wid, lane); S.done(cur); }
#undef PG8_SA
#undef PG8_SB
#undef PG8_STAGE
#undef PG8_LDA
#undef PG8_LDB
#undef PG8_MMA
#undef PG8_WAIT_V
#undef PG8_WAIT_L
#undef PG8_BAR
#undef PG8_SCHED
}
}

constexpr int NWAVES = 8, NTHREADS = 512;
constexpr int RING_BYTES = 131072, LDS_BYTES = 147456;
#define LDS_WAIT() asm volatile("s_waitcnt lgkmcnt(0)" ::: "memory")

#define XB_TMO      128
#define XB_XCNT(j)  (256  + 64 * (j))
#define XB_XSUB(j)  (1280 + 64 * (j))
#define XB_XGEN(j)  (2304 + 64 * (j))
#define XB_TOP      3328
#define XB_TOPGEN   3392
#define XCD_BAR_WORDS 3456
#define XB_SPIN_CAP (1u << 18)

__device__ __forceinline__ unsigned xb_ld(unsigned* p)              { return __hip_atomic_load(p, __ATOMIC_RELAXED, __HIP_MEMORY_SCOPE_AGENT); }
__device__ __forceinline__ unsigned xb_add(unsigned* p, unsigned v) { return __hip_atomic_fetch_add(p, v, __ATOMIC_RELAXED, __HIP_MEMORY_SCOPE_AGENT); }
__device__ __forceinline__ unsigned xb_xcc_id() { return (unsigned)__builtin_amdgcn_s_getreg((3 << 11) | 20) & 0xFu; }
#define XB_SPIN(cond, bar) do { unsigned _sp = 0; while (cond) { __builtin_amdgcn_s_sleep(1); \
    if ((++_sp & 255u) == 0u) { if (xb_ld(&(bar)[XB_TMO])) break; if (_sp > XB_SPIN_CAP) { atomicAdd(&(bar)[XB_TMO], 1u); break; } } } } while (0)

struct XcdBarrier {
    unsigned* bar; unsigned x;
    volatile LAS unsigned* st;
};

__device__ __forceinline__ XcdBarrier xcd_barrier_post(unsigned* bar, volatile LAS unsigned* st) {
    XcdBarrier b; b.bar = bar; b.x = xb_xcc_id(); b.st = st;
    if (threadIdx.x == 0) (void)xb_add(&bar[XB_XCNT(b.x)], 1u);
    return b;
}
__device__ __forceinline__ void xcd_barrier_complete(unsigned* bar, unsigned x, unsigned& nloc, unsigned& nx) {
    const unsigned G = gridDim.x * gridDim.y * gridDim.z;
    unsigned sum, cnt, mine, sp = 0u;
    for (;;) {
        sum = 0u; cnt = 0u; mine = 0u;
#pragma unroll
        for (unsigned j = 0; j < 16; ++j) { const unsigned c = xb_ld(&bar[XB_XCNT(j)]); sum += c; cnt += (c > 0u) ? 1u : 0u; mine = (j == x) ? c : mine; }
        if (sum == G) break;
        __builtin_amdgcn_s_sleep(1);
        if ((++sp & 255u) == 0u) { if (xb_ld(&bar[XB_TMO])) break; if (sp > XB_SPIN_CAP) { atomicAdd(&bar[XB_TMO], 1u); break; } }
    }
    nloc = mine > 0u ? mine : 1u; nx = cnt > 0u ? cnt : 1u;
}

__device__ __forceinline__ void xcd_barrier(const XcdBarrier& b) {
    asm volatile("s_waitcnt vmcnt(0)" ::: "memory");
    __syncthreads();
    if (threadIdx.x == 0) {
        unsigned* bar = b.bar;
        __builtin_amdgcn_s_waitcnt(0);
        unsigned nloc = b.st[0], nx = b.st[1];
        if (nloc == 0u) { xcd_barrier_complete(bar, b.x, nloc, nx); b.st[0] = nloc; b.st[1] = nx; }
        const unsigned old = xb_add(&bar[XB_XSUB(b.x)], 1u);
        const unsigned gen = old / nloc;
        if (old + 1u == (gen + 1u) * nloc) {
            __builtin_amdgcn_fence(__ATOMIC_RELEASE, "agent");
            asm volatile("s_waitcnt vmcnt(0)" ::: "memory");
            const unsigned og = xb_add(&bar[XB_TOP], 1u);
            const unsigned tg = og / nx;
            if (og + 1u == (tg + 1u) * nx) xb_add(&bar[XB_TOPGEN], 1u);
            else XB_SPIN(xb_ld(&bar[XB_TOPGEN]) == tg, bar);
            __builtin_amdgcn_fence(__ATOMIC_ACQUIRE, "agent");
            xb_add(&bar[XB_XGEN(b.x)], 1u);
            asm volatile("s_waitcnt vmcnt(0)" ::: "memory");
        } else {
            XB_SPIN(xb_ld(&bar[XB_XGEN(b.x)]) == gen, bar);
            __builtin_amdgcn_fence(__ATOMIC_ACQUIRE, "agent");
            asm volatile("s_waitcnt vmcnt(0)" ::: "memory");
        }
    }
    __syncthreads();
}

struct Frame {
    LAS unsigned char* lds;
    int tid, lane, wave, vcu, G;
    unsigned char* ws;
    const float *x, *norm_g, *w_in, *qna, *kna, *sinks, *qnb, *knb, *relb, *wpa, *wpb, *wout;
    float* out;
};

__device__ __forceinline__ float wave_sum(float v) {
#pragma unroll
    for (int o = 1; o < 64; o <<= 1) v += __shfl_xor(v, o);
    return v;
}
__device__ __forceinline__ int t5_bucket(int n) {
    if (n < 16) return n < 0 ? 0 : n;
    const int l = 16 + (int)(logf((float)n * 0.0625f) / logf(8.0f) * 16.0f);
    return l > 31 ? 31 : l;
}

__device__ __forceinline__ int win_src_col(int n) { return n < 3328 ? n : (n < 5376 ? n + 296 : (n < 5672 ? n - 2048 : -1)); }
template <bool INPROJ>
__device__ __forceinline__ void p0_transpose_item(const float* W, int srcN, int k0, int n0, h16* WT, int ldk, int kdst0, LAS float* scr, int lane, float scale) {
    const int n = n0 + (lane & 31); const int col = INPROJ ? win_src_col(n) : n;
#pragma unroll 8
    for (int i = 0; i < 32; ++i) { const int kk = 2 * i + (lane >> 5); scr[kk * 33 + (lane & 31)] = (col >= 0) ? W[(size_t)(k0 + kk) * srcN + col] * scale : 0.f; }
    LDS_WAIT(); asm volatile("" ::: "memory");
    const int c = lane & 7;
#pragma unroll
    for (int j = 0; j < 4; ++j) { const int nn = (lane >> 3) + 8 * j; const LAS float* s = scr + (8 * c) * 33 + nn;
        float v[8];
#pragma unroll
        for (int e = 0; e < 8; ++e) v[e] = s[e * 33];
        u32x4 o; o.x = pkh(v[0], v[1]); o.y = pkh(v[2], v[3]); o.z = pkh(v[4], v[5]); o.w = pkh(v[6], v[7]);
        *(u32x4*)(WT + (size_t)(n0 + nn) * ldk + kdst0 + k0 + 8 * c) = o;
    }
    LDS_WAIT(); asm volatile("" ::: "memory");
}
__device__ __forceinline__ void p0_norm_row(const float* xrow, const float* g, h16* orow, int lane) {
    f32x4 v[4]; float s = 0.f;
#pragma unroll
    for (int j = 0; j < 4; ++j) { v[j] = *((const f32x4*)xrow + lane + 64 * j); s += (v[j].x * v[j].x + v[j].y * v[j].y) + (v[j].z * v[j].z + v[j].w * v[j].w); }
    const float r = rsqrtf(wave_sum(s) * (1.0f / DM) + RMS_EPS);
#pragma unroll
    for (int j = 0; j < 4; ++j) { const f32x4 gg = *((const f32x4*)g + lane + 64 * j); const f32x4 hv = v[j] * r * gg * HSCALE;
        u32x2 hi; hi.x = pkh(hv.x, hv.y); hi.y = pkh(hv.z, hv.w);
        *((u32x2*)orow + lane + 64 * j) = hi; }
}
__device__ __forceinline__ void p0_prologue(Frame& F) {
    LAS float* scr = (LAS float*)(F.lds + F.wave * 16384);
    const int gw = F.vcu * NWAVES + F.wave, NGW = F.G * NWAVES;
    h16* Win = (h16*)(F.ws + WS_WIN); h16* Wp = (h16*)(F.ws + WS_WP); h16* Wo = (h16*)(F.ws + WS_WO);
    constexpr int I_IN = 16 * 184, I_P = 8 * 32, I_O = 16 * 32;
    constexpr int NITEMS = I_IN + 2 * I_P + I_O;
    for (int it = gw; it < NITEMS; it += NGW) {
        int r = it;
        if (r < I_IN) { p0_transpose_item<true>(F.w_in, INW, 64 * (r / 184), 32 * (r % 184), Win, 1024, 0, scr, F.lane, WSCALE); continue; } r -= I_IN;
        if (r < I_P) { p0_transpose_item<false>(F.wpa, DM, 64 * (r / 32), 32 * (r % 32), Wp, 1024, 0, scr, F.lane, 1.f); continue; } r -= I_P;
        if (r < I_P) { p0_transpose_item<false>(F.wpb, DM, 64 * (r / 32), 32 * (r % 32), Wp, 1024, 512, scr, F.lane, 1.f); continue; } r -= I_P;
        p0_transpose_item<false>(F.wout, DM, 64 * (r / 32), 32 * (r % 32), Wo, 1024, 0, scr, F.lane, 1.f);
    }
    h16* Hb = (h16*)(F.ws + WS_H);
    for (int m = gw; m < MROWS; m += NGW) p0_norm_row(F.x + (size_t)m * DM, F.norm_g, Hb + (size_t)m * 1024, F.lane);
}

constexpr int HROW = 1028;
constexpr int IX_HIST = 0, IX_ST = 66560, IX_OMASK = IX_ST + 1024, IX_TMASK = IX_OMASK + 4096;
__device__ __forceinline__ void idx_item(Frame& F, int b, int g) {
    const int tid = F.tid, lane = F.lane, wid = F.wave, tok = lane & 15, fq = lane >> 4;
    const int t0 = g * 16;
    unsigned* gmask = (unsigned*)(F.ws + WS_MASK) + (size_t)(b * SEQ + t0) * 64;
    if (g < 16) {
        for (int i = tid; i < 1024; i += NTHREADS) { const int tk = i >> 6, w = i & 63, t = t0 + tk, lo = w * 32;
            gmask[i] = (t >= lo + 31) ? 0xffffffffu : (t >= lo ? ((2u << (t - lo)) - 1u) : 0u); }
        return;
    }
    LAS unsigned* hist = (LAS unsigned*)(F.lds + IX_HIST);
    LAS unsigned* st = (LAS unsigned*)(F.lds + IX_ST);
    LAS unsigned* omask = (LAS unsigned*)(F.lds + IX_OMASK);
    LAS unsigned* tmask = (LAS unsigned*)(F.lds + IX_TMASK);
    const int ntile = g + 1;
    const size_t qrow = (size_t)(b * SEQ + t0 + tok);
    h16x8 qhi[8], qlo[8];
#pragma unroll
    for (int h = 0; h < 8; ++h) { qhi[h] = *(const h16x8*)((const h16*)(F.ws + WS_QH) + qrow * 256 + h * 32 + fq * 8); qlo[h] = *(const h16x8*)((const h16*)(F.ws + WS_QL) + qrow * 256 + h * 32 + fq * 8); }
    const f32x4 w0 = *(const f32x4*)((const float*)(F.ws + WS_WI) + qrow * 8), w1 = *(const f32x4*)((const float*)(F.ws + WS_WI) + qrow * 8 + 4);
    const float wv[8] = {w0[0], w0[1], w0[2], w0[3], w1[0], w1[1], w1[2], w1[3]};
    if (tid < 16) { st[96 + tid] = 0xffffffffu; st[112 + tid] = 0u; } if (tid == 0) st[128] = 0u;
    for (int i = tid; i < 2048; i += NTHREADS) omask[i] = 0u;
    unsigned key[16][4];
    unsigned kmin = 0xffffffffu, kmax = 0u;
    h16x8 khn = {}, kln = {};
    const h16* khb = (const h16*)(F.ws + WS_KH) + (size_t)(b * SEQ + tok) * 32 + fq * 8; const h16* klb = (const h16*)(F.ws + WS_KL) + (size_t)(b * SEQ + tok) * 32 + fq * 8;
#ifdef DUP_MFMA
#pragma unroll 1
    for (int rep_ = 0; rep_ < 2; ++rep_) {
#endif
    if (wid < ntile) { khn = *(const h16x8*)(khb + wid * 512); kln = *(const h16x8*)(klb + wid * 512); }
#pragma unroll
    for (int i = 0; i < 16; ++i) {
        int tile = wid + 8 * i; asm volatile("" : "+s"(tile));
        if (tile < ntile) {
            const h16x8 khi = khn, klo = kln;
            if (tile + 8 < ntile) { unsigned toff = (unsigned)(tile + 8) * (16u * 32u); asm volatile("" : "+v"(toff));
                khn = *(const h16x8*)(khb + toff); kln = *(const h16x8*)(klb + toff); }
            f32x4 sc = {0.f, 0.f, 0.f, 0.f};
#pragma unroll
            for (int h = 0; h < 8; ++h) {
                f32x4 a = __builtin_amdgcn_mfma_f32_16x16x32_f16(khi, qhi[h], (f32x4){0.f, 0.f, 0.f, 0.f}, 0, 0, 0);
                a = __builtin_amdgcn_mfma_f32_16x16x32_f16(khi, qlo[h], a, 0, 0, 0);
                a = __builtin_amdgcn_mfma_f32_16x16x32_f16(klo, qhi[h], a, 0, 0, 0);
#pragma unroll
                for (int r = 0; r < 4; ++r) sc[r] = fmaf(wv[h], fmaxf(a[r], 0.f), sc[r]);
            }
#pragma unroll
            for (int r = 0; r < 4; ++r) { const int s = tile * 16 + 4 * fq + r; const unsigned u = __float_as_uint(sc[r] + 0.0f);
                const unsigned k = (u >> 31) ? ~u : (u | 0x80000000u); const bool valid = s <= t0 + tok;
                key[i][r] = valid ? k : 0u; if (valid) { kmin = min(kmin, k); kmax = max(kmax, k); } }
        } else {
#pragma unroll
            for (int r = 0; r < 4; ++r) key[i][r] = 0u;
        }
    }
#ifdef DUP_MFMA
    }
#endif
#ifdef DUP_SEL
#pragma unroll 1
    for (int rep_ = 0; rep_ < 2; ++rep_) {
    __syncthreads();
    if (tid < 16) { st[96 + tid] = 0xffffffffu; st[112 + tid] = 0u; } if (tid == 0) st[128] = 0u;
#endif
    __syncthreads();
    kmin = min(kmin, (unsigned)__shfl_xor((int)kmin, 16)); kmin = min(kmin, (unsigned)__shfl_xor((int)kmin, 32));
    kmax = max(kmax, (unsigned)__shfl_xor((int)kmax, 16)); kmax = max(kmax, (unsigned)__shfl_xor((int)kmax, 32));
    if (fq == 0) { atomicMin((unsigned*)&st[96 + tok], kmin); atomicMax((unsigned*)&st[112 + tok], kmax); }
    __syncthreads();
    if (tid < 16) { const unsigned lo = st[96 + tid], span = st[112 + tid] - lo; st[tid] = lo; st[16 + tid] = span; st[32 + tid] = span >= 1024u ? (unsigned)(22 - __clz((int)span)) : 0u; st[48 + tid] = 256u; }
    for (int round = 0; round < 8; ++round) {
#pragma unroll
        for (int i = 0; i < 9; ++i) { const int o = tid * 16 + i * 8192; if (o < 16 * HROW * 4) *(LAS u32x4*)(F.lds + IX_HIST + o) = (u32x4){0u, 0u, 0u, 0u}; }
        __syncthreads();
        const unsigned done = st[128];
        if (!((done >> tok) & 1u)) {
            unsigned lo = st[tok], span = st[16 + tok], shift = st[32 + tok];
            asm volatile("s_waitcnt lgkmcnt(0)" : "+v"(lo), "+v"(span), "+v"(shift));
#pragma unroll
            for (int i = 0; i < 16; ++i) {
                int tile = wid + 8 * i; asm volatile("" : "+s"(tile));
                if (tile < ntile) {
#pragma unroll
                    for (int r = 0; r < 4; ++r) { const unsigned k = key[i][r]; if (k >= lo && k - lo <= span) atomicAdd((unsigned*)&hist[tok * HROW + ((k - lo) >> shift)], 1u); }
                }
            }
        }
#ifdef DUP_HIST
        if (!((done >> tok) & 1u)) {
            unsigned lo = st[tok], span = st[16 + tok], shift = st[32 + tok];
            asm volatile("s_waitcnt lgkmcnt(0)" : "+v"(lo), "+v"(span), "+v"(shift));
            LAS unsigned* dummy = (LAS unsigned*)(F.lds + 77824);
#pragma unroll
            for (int i = 0; i < 16; ++i) {
                int tile = wid + 8 * i; asm volatile("" : "+s"(tile));
                if (tile < ntile) {
#pragma unroll
                    for (int r = 0; r < 4; ++r) { const unsigned k = key[i][r]; if (k >= lo && k - lo <= span) atomicAdd((unsigned*)&dummy[tok * 516 + (((k - lo) >> shift) & 511u)], 1u); }
                }
            }
        }
#endif
        __syncthreads();
#pragma unroll 1
        for (int tt = 0; tt < 2; ++tt) {
            const int tk = 2 * wid + tt;
            if (!((done >> tk) & 1u)) {
                const LAS u32x4* hp = (const LAS u32x4*)(hist + tk * HROW + 16 * lane);
                const u32x4 c0 = hp[0], c1 = hp[1], c2 = hp[2], c3 = hp[3];
                const unsigned cnt[16] = {c0.x, c0.y, c0.z, c0.w, c1.x, c1.y, c1.z, c1.w, c2.x, c2.y, c2.z, c2.w, c3.x, c3.y, c3.z, c3.w};
                unsigned s = 0;
#pragma unroll
                for (int e = 0; e < 16; ++e) s += cnt[e];
                unsigned v = s;
#pragma unroll
                for (int o = 1; o < 64; o <<= 1) { const unsigned tmp = (unsigned)__shfl_down((int)v, o); if (lane + o < 64) v += tmp; }
                const unsigned above = v - s, need = st[48 + tk];
                if (above < need && need <= above + s) {
                    unsigned cum = above, bstar = 0, rr = 0, cb = 0; bool found = false;
#pragma unroll
                    for (int e = 15; e >= 0; --e) { const unsigned c = cnt[e]; if (!found && cum + c >= need) { found = true; bstar = 16u * lane + e; rr = need - cum; cb = c; } if (!found) cum += c; }
                    const unsigned lo = st[tk], shift = st[32 + tk];
                    const unsigned newlo = lo + (bstar << shift);
                    if (cb == rr) { st[64 + tk] = newlo; st[80 + tk] = 0u; atomicOr((unsigned*)&st[128], 1u << tk); }
                    else if (shift == 0u) { st[64 + tk] = newlo; st[80 + tk] = rr; atomicOr((unsigned*)&st[128], 1u << tk); }
                    else { st[tk] = newlo; st[16 + tk] = (1u << shift) - 1u; st[32 + tk] = shift > 10u ? shift - 10u : 0u; st[48 + tk] = rr; }
                }
            }
        }
        __syncthreads();
        if (st[128] == 0xffffu) break;
    }
#ifdef DUP_SEL
    }
#endif
    {
        unsigned T = st[64 + tok], tr = st[80 + tok];
        asm volatile("s_waitcnt lgkmcnt(0)" : "+v"(T), "+v"(tr));
#pragma unroll
        for (int i = 0; i < 16; ++i) {
            int tile = wid + 8 * i; asm volatile("" : "+s"(tile));
            if (tile < ntile) {
                unsigned nib = 0u, tnib = 0u;
#pragma unroll
                for (int r = 0; r < 4; ++r) { const unsigned k = key[i][r]; const bool sel = tr ? (k > T) : (k >= T); nib |= sel ? (1u << r) : 0u; tnib |= (tr && k == T) ? (1u << r) : 0u; }
                const int s0 = tile * 16 + 4 * fq;
                if (nib) atomicOr((unsigned*)&omask[tok * 64 + (s0 >> 5)], nib << (s0 & 31));
                if (tnib) atomicOr((unsigned*)&tmask[tok * 64 + (s0 >> 5)], tnib << (s0 & 31));
            }
        }
    }
    __syncthreads();
#pragma unroll 1
    for (int tt = 0; tt < 2; ++tt) {
        const int tk = 2 * wid + tt; const unsigned tr = st[80 + tk];
        if (tr) {
            unsigned w = tmask[tk * 64 + lane]; const unsigned pc = __popc(w);
            unsigned incl = pc;
#pragma unroll
            for (int o = 1; o < 64; o <<= 1) { const unsigned tmp = (unsigned)__shfl_up((int)incl, o); if (lane >= o) incl += tmp; }
            const unsigned before = incl - pc;
            unsigned n = before >= tr ? 0u : min(tr - before, pc), kept = 0u;
            while (n) { const unsigned bit = w & (0u - w); kept |= bit; w ^= bit; --n; }
            if (kept) omask[tk * 64 + lane] |= kept;
        }
    }
    __syncthreads();
    for (int i = tid; i < 1024; i += NTHREADS) gmask[i] = omask[i];
    __syncthreads();
}
__device__ __forceinline__ void p2_index_phase(Frame& F) {
    for (int v = F.vcu; v < 256; v += F.G) {
        const int b = v >> 5, p = v & 31;
#pragma unroll 1
        for (int k = 0; k < 4; ++k) { const int g = (k == 0) ? p : (k == 1) ? 63 - p : (k == 2) ? 64 + p : 127 - p; idx_item(F, b, g); }
    }
}

constexpr int AT_K = 0, AT_KSZ = 64 * 144, AT_V = 2 * AT_KSZ, AT_VSZ = 64 * 192, AT_LUT = AT_V + 2 * AT_VSZ, AT_OST = AT_LUT + 320 * 4, AT_OSTSZ = 32 * 144;
static_assert(AT_OST + 8 * AT_OSTSZ <= RING_BYTES, "attention LDS");
__device__ __forceinline__ s16x4 vtr_read(const LAS unsigned char* p) { return __builtin_amdgcn_ds_read_tr16_b64_v4i16((LAS s16x4*)p); }

template <bool ISB>
__device__ __forceinline__ void attn_unit(Frame& F, int b, int h, int qb) {
    const int tid = F.tid, lane = F.lane, wid = F.wave, q = lane & 31, hi = lane >> 5;
    const int q0 = qb * 256, r0 = q0 + wid * 32, t = r0 + q;
    const size_t row = (size_t)b * SEQ + t;
    const h16* Qp; const h16* Kp; const h16* Vp; const h16* Zp; int kvpitch, ycol;
    if (ISB) { Qp = (const h16*)(F.ws + WS_QB) + h * 64; Kp = (const h16*)(F.ws + WS_KB) + h * 64; Vp = (const h16*)(F.ws + WS_VB) + h * 64; Zp = (const h16*)(F.ws + WS_ZB) + h * 64; kvpitch = 512; ycol = 512 + h * 64; }
    else     { Qp = (const h16*)(F.ws + WS_QA) + h * 64; Kp = (const h16*)(F.ws + WS_KVA) + (h >> 2) * 64; Vp = (const h16*)(F.ws + WS_KVA) + 128 + (h >> 2) * 64; Zp = (const h16*)(F.ws + WS_ZA) + h * 64; kvpitch = 256; ycol = h * 64; }
    const unsigned* mrow = (const unsigned*)(F.ws + WS_MASK) + row * 64;
    LAS float* lut = (LAS float*)(F.lds + AT_LUT);
    for (int i = tid; i < 320; i += NTHREADS) { const int dist = 223 - i; float v;
        if (ISB) v = dist < 0 ? 0.f : F.relb[t5_bucket(dist > 127 ? 127 : dist) * 16 + 8 + h] * LOG2E;
        else v = (dist >= 0 && dist < 128) ? F.relb[t5_bucket(dist) * 16 + h] * LOG2E : -INFINITY;
        lut[i] = v; }
    const float cfar = ISB ? F.relb[31 * 16 + 8 + h] * LOG2E : 0.f;
    h16x8 qr[4];
    {   const float* qg = ISB ? F.qnb : F.qna; float ss = 0.f;
#pragma unroll
        for (int d0 = 0; d0 < 4; ++d0) { qr[d0] = *(const h16x8*)(Qp + row * 512 + d0 * 16 + hi * 8);
#pragma unroll
            for (int e = 0; e < 8; ++e) { const float f = (float)qr[d0][e]; ss += f * f; } }
        ss += __shfl_xor(ss, 32);
        const float rq = rsqrtf(ss * (1.0f / 64.0f) + RMS_EPS) * QSCALE;
#pragma unroll
        for (int d0 = 0; d0 < 4; ++d0) { const f32x4 g0 = *(const f32x4*)(qg + d0 * 16 + hi * 8), g1 = *(const f32x4*)(qg + d0 * 16 + hi * 8 + 4);
            u32x4 w; w.x = pkh((float)qr[d0][0] * rq * g0[0], (float)qr[d0][1] * rq * g0[1]); w.y = pkh((float)qr[d0][2] * rq * g0[2], (float)qr[d0][3] * rq * g0[3]);
            w.z = pkh((float)qr[d0][4] * rq * g1[0], (float)qr[d0][5] * rq * g1[1]); w.w = pkh((float)qr[d0][6] * rq * g1[2], (float)qr[d0][7] * rq * g1[3]);
            qr[d0] = __builtin_bit_cast(h16x8, w); } }
    float kgn[8];
    {   const float* kgp = (ISB ? F.knb : F.kna) + (tid & 7) * 8; const f32x4 g0 = *(const f32x4*)kgp, g1 = *(const f32x4*)(kgp + 4);
        kgn[0] = g0[0]; kgn[1] = g0[1]; kgn[2] = g0[2]; kgn[3] = g0[3]; kgn[4] = g1[0]; kgn[5] = g1[1]; kgn[6] = g1[2]; kgn[7] = g1[3]; }
#define KNORM(KR) do { const h16x8 kv_ = __builtin_bit_cast(h16x8, KR); float f_[8]; float ss_ = 0.f; \
        _Pragma("unroll") for (int e = 0; e < 8; ++e) { f_[e] = (float)kv_[e]; ss_ += f_[e] * f_[e]; } \
        ss_ += __shfl_xor(ss_, 1); ss_ += __shfl_xor(ss_, 2); ss_ += __shfl_xor(ss_, 4); \
        const float rk_ = rsqrtf(ss_ * (1.0f / 64.0f) + RMS_EPS); \
        KR.x = pkh(f_[0] * rk_ * kgn[0], f_[1] * rk_ * kgn[1]); KR.y = pkh(f_[2] * rk_ * kgn[2], f_[3] * rk_ * kgn[3]); \
        KR.z = pkh(f_[4] * rk_ * kgn[4], f_[5] * rk_ * kgn[5]); KR.w = pkh(f_[6] * rk_ * kgn[6], f_[7] * rk_ * kgn[7]); } while (0)
    const int kt_lo = ISB ? 0 : (4 * qb - 2 < 0 ? 0 : 4 * qb - 2), kt_hi = 4 * qb + 3;
    const int srow = tid >> 3, sch = tid & 7;
    const h16* kg = Kp + ((size_t)b * SEQ + srow) * kvpitch + sch * 8; const h16* vg = Vp + ((size_t)b * SEQ + srow) * kvpitch + sch * 8;
    const int kst = srow * 144 + sch * 16, vst = srow * 192 + sch * 16;
    u32x4 kreg = *(const u32x4*)(kg + (size_t)kt_lo * 64 * kvpitch), vreg = *(const u32x4*)(vg + (size_t)kt_lo * 64 * kvpitch);
    u32x2 mw = {0u, 0u}, mwn = {0u, 0u};
    if (ISB) mw = *(const u32x2*)(mrow + 2 * kt_lo);
    KNORM(kreg);
    *(LAS u32x4*)(F.lds + AT_K + kst) = kreg; *(LAS u32x4*)(F.lds + AT_V + vst) = vreg;
    __syncthreads();
    float m_run = -INFINITY, l_run = 0.f;
    f32x16 o[2];
#pragma unroll
    for (int r = 0; r < 16; ++r) { o[0][r] = 0.f; o[1][r] = 0.f; }
    const int kfo = q * 144 + hi * 16;
    const int vfo = (4 * hi + ((lane & 15) >> 2)) * 192 + ((lane >> 4) & 1) * 32 + (lane & 3) * 8;
    for (int kt = kt_lo; kt <= kt_hi; ++kt) {
        const int cur = (kt - kt_lo) & 1;
        if (kt < kt_hi) { kreg = *(const u32x4*)(kg + (size_t)(kt + 1) * 64 * kvpitch); vreg = *(const u32x4*)(vg + (size_t)(kt + 1) * 64 * kvpitch); if (ISB) mwn = *(const u32x2*)(mrow + 2 * (kt + 1)); }
        const int k0 = kt * 64;
        const bool active = ISB ? (k0 <= r0 + 31) : (k0 <= r0 + 31 && k0 + 63 >= r0 - 127);
        if (active) {
            const LAS unsigned char* kb = F.lds + AT_K + cur * AT_KSZ + kfo;
            const LAS unsigned char* vb = F.lds + AT_V + cur * AT_VSZ + vfo;
            f32x16 p0, p1;
#pragma unroll
            for (int r = 0; r < 16; ++r) { p0[r] = 0.f; p1[r] = 0.f; }
#pragma unroll
            for (int d0 = 0; d0 < 4; ++d0) {
                const h16x8 ka = *(const LAS h16x8*)(kb + d0 * 32), kc = *(const LAS h16x8*)(kb + 32 * 144 + d0 * 32);
                p0 = __builtin_amdgcn_mfma_f32_32x32x16_f16(ka, qr[d0], p0, 0, 0, 0);
                p1 = __builtin_amdgcn_mfma_f32_32x32x16_f16(kc, qr[d0], p1, 0, 0, 0);
            }
            if (ISB && (r0 - k0 - 63 >= 113)) {
#pragma unroll
                for (int r = 0; r < 16; ++r) { p0[r] += cfar; p1[r] += cfar; }
            } else {
                const LAS float* lp = lut + (223 - (t - k0 - 4 * hi));
#pragma unroll
                for (int r = 0; r < 16; ++r) { const int c = (r & 3) + 8 * (r >> 2); p0[r] += lp[c]; p1[r] += lp[32 + c]; }
            }
            if (ISB) {
                const unsigned mm0 = mw.x >> (4 * hi), mm1 = mw.y >> (4 * hi);
#pragma unroll
                for (int r = 0; r < 16; ++r) { const unsigned bit = 1u << ((r & 3) + 8 * (r >> 2)); if (!(mm0 & bit)) p0[r] = -INFINITY; if (!(mm1 & bit)) p1[r] = -INFINITY; }
            }
            float mx = fmaxf(p0[0], p1[0]);
#pragma unroll
            for (int r = 1; r < 16; ++r) mx = fmaxf(mx, fmaxf(p0[r], p1[r]));
            mx = fmaxf(mx, __shfl_xor(mx, 32));
            const float mnew = fmaxf(m_run, mx), muse = (mnew == -INFINITY) ? 0.f : mnew;
            const float alpha = __builtin_amdgcn_exp2f(m_run - muse);
            m_run = mnew;
            float sum = 0.f;
#pragma unroll
            for (int r = 0; r < 16; ++r) { p0[r] = __builtin_amdgcn_exp2f(p0[r] - muse); p1[r] = __builtin_amdgcn_exp2f(p1[r] - muse); sum += p0[r] + p1[r]; }
            l_run = l_run * alpha + sum;
#pragma unroll
            for (int r = 0; r < 16; ++r) { o[0][r] *= alpha; o[1][r] *= alpha; }
            u32x4 pk[4];
            pk[0] = (u32x4){pkh(p0[0], p0[1]), pkh(p0[2], p0[3]), pkh(p0[4], p0[5]), pkh(p0[6], p0[7])};
            pk[1] = (u32x4){pkh(p0[8], p0[9]), pkh(p0[10], p0[11]), pkh(p0[12], p0[13]), pkh(p0[14], p0[15])};
            pk[2] = (u32x4){pkh(p1[0], p1[1]), pkh(p1[2], p1[3]), pkh(p1[4], p1[5]), pkh(p1[6], p1[7])};
            pk[3] = (u32x4){pkh(p1[8], p1[9]), pkh(p1[10], p1[11]), pkh(p1[12], p1[13]), pkh(p1[14], p1[15])};
#pragma unroll
            for (int s = 0; s < 4; ++s)
#pragma unroll
                for (int d1 = 0; d1 < 2; ++d1) {
                    const s16x4 lo4 = vtr_read(vb + (16 * s) * 192 + d1 * 64), hi4 = vtr_read(vb + (16 * s + 8) * 192 + d1 * 64);
                    const h16x4 lf = __builtin_bit_cast(h16x4, lo4), hf = __builtin_bit_cast(h16x4, hi4);
                    const h16x8 vf = {lf[0], lf[1], lf[2], lf[3], hf[0], hf[1], hf[2], hf[3]};
                    o[d1] = __builtin_amdgcn_mfma_f32_32x32x16_f16(vf, __builtin_bit_cast(h16x8, pk[s]), o[d1], 0, 0, 0);
                }
        }
        if (kt < kt_hi) { KNORM(kreg); *(LAS u32x4*)(F.lds + AT_K + (cur ^ 1) * AT_KSZ + kst) = kreg; *(LAS u32x4*)(F.lds + AT_V + (cur ^ 1) * AT_VSZ + vst) = vreg; mw = mwn; }
        __syncthreads();
    }
    l_run += __shfl_xor(l_run, 32);
    if (!ISB) l_run += __builtin_amdgcn_exp2f(F.sinks[h] * LOG2E - m_run);
    const float inv = 1.0f / l_run;
    LAS unsigned char* ost = F.lds + AT_OST + wid * AT_OSTSZ;
#pragma unroll
    for (int d1 = 0; d1 < 2; ++d1)
#pragma unroll
        for (int g4 = 0; g4 < 4; ++g4) { u32x2 w; w.x = pkh(o[d1][4 * g4] * inv, o[d1][4 * g4 + 1] * inv); w.y = pkh(o[d1][4 * g4 + 2] * inv, o[d1][4 * g4 + 3] * inv);
            *(LAS u32x2*)(ost + q * 144 + (32 * d1 + 8 * g4 + 4 * hi) * 2) = w; }
    LDS_WAIT(); asm volatile("" ::: "memory");
    h16* Yp = (h16*)(F.ws + WS_Y);
#pragma unroll
    for (int i = 0; i < 4; ++i) { const int rr = i * 8 + (lane >> 3), ch = lane & 7; const size_t grow = (size_t)b * SEQ + r0 + rr;
        const h16x8 ov = *(const LAS h16x8*)(ost + rr * 144 + ch * 16); const h16x8 zv = *(const h16x8*)(Zp + grow * 512 + ch * 8);
        float y[8];
#pragma unroll
        for (int e = 0; e < 8; ++e) { const float z = (float)zv[e]; y[e] = (float)ov[e] * z * sigmoidf_fast(z); }
        u32x4 w; w.x = pkh(y[0], y[1]); w.y = pkh(y[2], y[3]); w.z = pkh(y[4], y[5]); w.w = pkh(y[6], y[7]);
        *(u32x4*)(Yp + grow * 1024 + ycol + ch * 8) = w; }
    __syncthreads();
#undef KNORM
}
__device__ __forceinline__ void p3_attention_phase(Frame& F) {
    for (int v = F.vcu; v < 256; v += F.G) {
        const int bh = v >> 2, j = v & 3, b = bh >> 3, h = bh & 7;
        attn_unit<true>(F, b, h, 7 - j); attn_unit<true>(F, b, h, j);
        attn_unit<false>(F, b, h, 2 * j); attn_unit<false>(F, b, h, 2 * j + 1);
    }
}

struct Args { const float* in[12]; float* out; unsigned char* ws; int ph_lo, ph_hi; };
constexpr int N_PHASES = 6;
__global__ void __launch_bounds__(NTHREADS, 2) mk_fwd(Args args) {
    extern __shared__ __attribute__((aligned(16))) unsigned char lds_raw[];
    cg::grid_group grid = cg::this_grid();
    Frame F;
    F.lds = (LAS unsigned char*)lds_raw;
    F.tid = threadIdx.x; F.lane = F.tid & 63; F.wave = __builtin_amdgcn_readfirstlane(F.tid >> 6);
    F.G = gridDim.x; { const int bx = blockIdx.x; F.vcu = (F.G % 8 == 0) ? (bx % 8) * (F.G / 8) + bx / 8 : bx; }
    F.ws = args.ws;
    F.x = args.in[0]; F.norm_g = args.in[1]; F.w_in = args.in[2]; F.qna = args.in[3]; F.kna = args.in[4]; F.sinks = args.in[5];
    F.qnb = args.in[6]; F.knb = args.in[7]; F.relb = args.in[8]; F.wpa = args.in[9]; F.wpb = args.in[10]; F.wout = args.in[11]; F.out = args.out;
    const int lo = args.ph_lo, hi = args.ph_hi;
    if (lo < 0) grid.sync();
    if (F.tid < 64) ((LAS unsigned*)(F.lds + RING_BYTES))[F.tid] = 0u;
    __syncthreads();
    XcdBarrier bar = xcd_barrier_post((unsigned*)(F.ws + WS_CTL), (volatile LAS unsigned*)(F.lds + RING_BYTES) + 8);
#ifdef ONLY_PH
#define IN(k) ((k) == ONLY_PH && lo <= (k) && (k) < hi)
#else
#define IN(k) (lo <= (k) && (k) < hi)
#endif
#ifdef PROBE_SYNC2
#define SEAM(k) do { if (IN(k) && IN((k) + 1)) { xcd_barrier(bar); xcd_barrier(bar); } } while (0)
#else
#define SEAM(k) do { if (IN(k) && IN((k) + 1)) xcd_barrier(bar); } while (0)
#endif
    if (IN(0)) { p0_prologue(F); }
    SEAM(0);
    if (IN(1)) {
        pg8::GemmPlain g{(const h16*)(F.ws + WS_H), (const h16*)(F.ws + WS_WIN), 1024, 1024};
        pg8::StaticOrder S; S.init(MROWS, 23 * 256, F.G, (int)blockIdx.x);
        pg8::EpiIn E{F.ws, (h16*)F.out};
        pg8::gemm_phase<pg8::EpiIn, pg8::StaticOrder, pg8::GemmPlain, true, true>(F.lds, g, S, E);
    }
    SEAM(1);
    if (IN(2)) { p2_index_phase(F); }
    SEAM(2);
    if (IN(3)) { p3_attention_phase(F); }
    SEAM(3);
    if (IN(4)) {
        pg8::GemmPlain g{(const h16*)(F.ws + WS_Y), (const h16*)(F.ws + WS_WP), 1024, 1024};
        pg8::StaticOrder S; S.init(MROWS, DM, F.G, (int)blockIdx.x);
        pg8::EpiMerge E{(const h16*)F.out, (h16*)(F.ws + WS_MG)};
        pg8::gemm_phase<pg8::EpiMerge, pg8::StaticOrder, pg8::GemmPlain, true, true>(F.lds, g, S, E);
    }
    SEAM(4);
    if (IN(5)) {
        pg8::GemmPlain g{(const h16*)(F.ws + WS_MG), (const h16*)(F.ws + WS_WO), 1024, 1024};
        pg8::StaticOrder S; S.init(MROWS, DM, F.G, (int)blockIdx.x);
        pg8::EpiOut E{F.x, F.out};
        pg8::gemm_phase<pg8::EpiOut, pg8::StaticOrder, pg8::GemmPlain, true, true>(F.lds, g, S, E);
    }
#undef IN
#undef SEAM
}

extern "C" void kernel_launch(void* const* d_in, const int* in_sizes, int n_in, void* d_out, int out_size, void* d_ws, size_t ws_size, hipStream_t stream) {
    static int grid = 0;
    if (grid == 0) {
        if (n_in != 12 || in_sizes[0] != MROWS * DM || out_size != MROWS * DM || ws_size < WS_END) { fprintf(stderr, "kernel_launch: unexpected problem (n_in %d, ws %zu)\n", n_in, ws_size); grid = -1; return; }
        int dev = 0, cus = 0, per_cu = 0;
        hipGetDevice(&dev); hipDeviceGetAttribute(&cus, hipDeviceAttributeMultiprocessorCount, dev);
        hipFuncSetAttribute((const void*)mk_fwd, hipFuncAttributeMaxDynamicSharedMemorySize, LDS_BYTES);
        hipOccupancyMaxActiveBlocksPerMultiprocessor(&per_cu, (const void*)mk_fwd, NTHREADS, LDS_BYTES);
        (void)hipGetLastError();
        if (per_cu < 1) { fprintf(stderr, "kernel_launch: occupancy query says %d blocks/CU\n", per_cu); per_cu = 1; }
        grid = cus;
        if (grid > 256) grid = 256;
    }
    if (grid < 0) return;
    (void)hipMemsetAsync((char*)d_ws + WS_CTL, 0, CTL_BYTES, stream);
    Args a{};
    for (int i = 0; i < 12; ++i) a.in[i] = (const float*)d_in[i];
    a.out = (float*)d_out; a.ws = (unsigned char*)d_ws;
#ifdef PROBE_PH
    {
        void* kargs[] = {&a};
        a.ph_lo = 0; a.ph_hi = PROBE_PH + 1;
        (void)hipLaunchCooperativeKernel((const void*)mk_fwd, dim3(grid), dim3(NTHREADS), kargs, LDS_BYTES, stream);
        (void)hipMemsetAsync((char*)d_ws + WS_CTL, 0, CTL_BYTES, stream);
#ifdef PROBE_SPLIT_ONLY
        a.ph_lo = PROBE_PH + 1; a.ph_hi = N_PHASES;
#else
        a.ph_lo = PROBE_PH; a.ph_hi = N_PHASES;
#endif
        (void)hipLaunchCooperativeKernel((const void*)mk_fwd, dim3(grid), dim3(NTHREADS), kargs, LDS_BYTES, stream);
    }
#else
    {
        a.ph_lo = 0; a.ph_hi = N_PHASES;
        void* kargs[] = {&a};
        hipError_t e = hipLaunchCooperativeKernel((const void*)mk_fwd, dim3(grid), dim3(NTHREADS), kargs, LDS_BYTES, stream);
        if (e != hipSuccess) fprintf(stderr, "cooperative launch failed: %s (grid %d)\n", hipGetErrorString(e), grid);
    }
#endif
}
```

```cpp
#include <hip/hip_runtime.h>
#include <hip/hip_cooperative_groups.h>
#include <cstdio>
#include <cstdint>
namespace cg = cooperative_groups;
#ifdef PROF_SEG
#ifndef PROF_MULT
#define PROF_MULT 4
#endif
#ifndef PROF_BLK
#define PROF_BLK 100
#endif
#ifndef PROF_WAVE
#define PROF_WAVE 3
#endif
#endif

#define LAS __attribute__((address_space(3)))
typedef _Float16 h16;
typedef _Float16 h16x2 __attribute__((ext_vector_type(2)));
typedef _Float16 h16x4 __attribute__((ext_vector_type(4)));
typedef _Float16 h16x8 __attribute__((ext_vector_type(8)));
typedef float f32x2 __attribute__((ext_vector_type(2)));
typedef float f32x4 __attribute__((ext_vector_type(4)));
typedef float f32x16 __attribute__((ext_vector_type(16)));
typedef unsigned u32x2 __attribute__((ext_vector_type(2)));
typedef unsigned u32x4 __attribute__((ext_vector_type(4)));
typedef short s16x4 __attribute__((ext_vector_type(4)));

__device__ __forceinline__ unsigned pkh(float lo, float hi) { const f32x2 v = {lo, hi}; const h16x2 h = __builtin_convertvector(v, h16x2); return __builtin_bit_cast(unsigned, h); }
__device__ __forceinline__ float sigmoidf_fast(float g) { g = fminf(fmaxf(g, -30.f), 30.f); return __builtin_amdgcn_rcpf(1.0f + __builtin_amdgcn_exp2f(-1.4426950408889634f * g)); }

constexpr int NBATCH = 8, SEQ = 2048, DM = 1024, MROWS = NBATCH * SEQ, INW = 5672;
constexpr float RMS_EPS = 1e-6f, LOG2E = 1.4426950408889634f, QSCALE = 0.125f * 1.4426950408889634f;
constexpr float HSCALE = 16.f, WSCALE = 64.f, INV_HW = 1.0f / (16.f * 64.f);
constexpr size_t MiB = 1u << 20;
constexpr size_t WS_H = 0;
constexpr size_t WS_Y = 0, WS_MG = 32 * MiB;
constexpr size_t WS_QH = 32 * MiB, WS_QL = 40 * MiB, WS_KH = 48 * MiB, WS_KL = 49 * MiB, WS_WI = 50 * MiB;
constexpr size_t WS_WIN = 64 * MiB;
constexpr size_t WS_WP = 77 * MiB, WS_WO = 79 * MiB;
constexpr size_t WS_QA = 81 * MiB, WS_KVA = 97 * MiB, WS_ZA = 105 * MiB, WS_QB = 121 * MiB, WS_KB = 137 * MiB, WS_VB = 153 * MiB, WS_ZB = 169 * MiB;
constexpr size_t WS_MASK = 185 * MiB;
constexpr size_t WS_CTL = 190 * MiB, CTL_BYTES = 16384;
constexpr size_t WS_END = 191 * MiB;

namespace pg8 {
#define PG8_LAS __attribute__((address_space(3)))
constexpr int BM = 256, BK = 64, HALF = 128, HTB = HALF * BK * 2  , STAGE_BYTES = 8 * HTB, NXCD = 8, WGM = 8;

__host__ __device__ __forceinline__ int lds_byte(int r, int c) { const int st = (r >> 4) * 2 + (c >> 5), rr = r & 15, cc = c & 31, ob = rr * 64 + cc * 2; return st * 1024 + (ob ^ (((ob >> 9) & 1) << 5)); }
__host__ __device__ __forceinline__ void stage_rc(int b, int& R, int& C) { const int st = b / 1024, sb = b % 1024, swz = sb ^ (((sb >> 9) & 1) << 5); R = (st >> 1) * 16 + swz / 64; C = (st & 1) * 32 + (swz % 64) / 2; }
__host__ __device__ __forceinline__ int perm32(int rho) { const int n = rho >> 4, i = rho & 15; return 8 * (i >> 2) + 4 * n + (i & 3); }

struct Unit { int pm, pn; };

struct StaticOrder {
    int nM, nN, nwg, G, c;
    __host__ __device__ void init(int M, int N, int G_, int c_) { nM = M / BM; nN = N / BM; nwg = nM * nN; G = G_; c = c_; }
    __host__ __device__ bool next(int i, Unit& u) const {
        const long L = (long)i * G + c; if (L >= nwg) return false;
        int wgid = (int)L; { const int q = nwg / NXCD, r = nwg % NXCD, xcd = wgid % NXCD, off = wgid / NXCD; wgid = (xcd < r ? xcd * (q + 1) : r * (q + 1) + (xcd - r) * q) + off; }
        const int nig = WGM * nN, gid = wgid / nig, fm = gid * WGM, gsz = (nM - fm) < WGM ? (nM - fm) : WGM;
        u.pm = fm + ((wgid % nig) % gsz); u.pn = (wgid % nig) / gsz; return true;
    }
    __device__ __forceinline__ void a_ready(const Unit&) const {}
    __device__ __forceinline__ void done(const Unit&) const {}
};

struct GemmPlain { const h16* A; const h16* Bt; int lda, K;
    __device__ __forceinline__ const char* aptr(const Unit& u) const { return (const char*)(A + (size_t)u.pm * BM * lda); }
    __device__ __forceinline__ const char* bptr(const Unit& u) const { return (const char*)(Bt + (size_t)u.pn * BM * K); } };
struct EpiIn {
    static constexpr bool PERM = true, AFTER_DRAIN = false, MID = false;
    unsigned char* ws; h16* G;
    __device__ __forceinline__ void operator()(const f32x4 (&acc)[2][2][4][2], const Unit& u, int wr, int wc, int fr, int fq) const {
        const int pn = u.pn, row0 = u.pm * BM + wr * 64 + fr, cl = wc * 32 + 8 * fq;
        if (pn < 21) {
            h16* base; int ldc, colt;
            if (pn < 2)       { base = (h16*)(ws + WS_QA);  ldc = 512; colt = pn * 256; }
            else if (pn == 2) { base = (h16*)(ws + WS_KVA); ldc = 256; colt = 0; }
            else if (pn < 5)  { base = (h16*)(ws + WS_ZA);  ldc = 512; colt = (pn - 3) * 256; }
            else if (pn < 7)  { base = (h16*)(ws + WS_QB);  ldc = 512; colt = (pn - 5) * 256; }
            else if (pn < 9)  { base = (h16*)(ws + WS_KB);  ldc = 512; colt = (pn - 7) * 256; }
            else if (pn < 11) { base = (h16*)(ws + WS_VB);  ldc = 512; colt = (pn - 9) * 256; }
            else if (pn < 13) { base = (h16*)(ws + WS_ZB);  ldc = 512; colt = (pn - 11) * 256; }
            else              { base = G;                   ldc = 2048; colt = (pn - 13) * 256; }
#pragma unroll
            for (int ai = 0; ai < 2; ++ai)
#pragma unroll
                for (int m = 0; m < 4; ++m) { h16* rowp = base + (size_t)(row0 + ai * HALF + m * 16) * ldc + colt + cl;
#pragma unroll
                    for (int bj = 0; bj < 2; ++bj) { const f32x4 v0 = acc[ai][bj][m][0] * INV_HW, v1 = acc[ai][bj][m][1] * INV_HW;
                        u32x4 w; w.x = pkh(v0[0], v0[1]); w.y = pkh(v0[2], v0[3]); w.z = pkh(v1[0], v1[1]); w.w = pkh(v1[2], v1[3]);
                        *(u32x4*)(rowp + bj * HALF) = w; } }
        } else {
            const int colt = (pn - 21) * 256 + cl;
#pragma unroll
            for (int ai = 0; ai < 2; ++ai)
#pragma unroll
                for (int m = 0; m < 4; ++m) { const size_t r = (size_t)(row0 + ai * HALF + m * 16);
#pragma unroll
                    for (int bj = 0; bj < 2; ++bj) { const int j = colt + bj * HALF; const f32x4 v0 = acc[ai][bj][m][0] * INV_HW, v1 = acc[ai][bj][m][1] * INV_HW;
                        if (j < 288) {
                            const float v[8] = {v0[0] * 16.f, v0[1] * 16.f, v0[2] * 16.f, v0[3] * 16.f, v1[0] * 16.f, v1[1] * 16.f, v1[2] * 16.f, v1[3] * 16.f}; float d[8];
#pragma unroll
                            for (int e = 0; e < 8; ++e) d[e] = v[e] - (float)(h16)v[e];
                            u32x4 hi, lo; hi.x = pkh(v[0], v[1]); hi.y = pkh(v[2], v[3]); hi.z = pkh(v[4], v[5]); hi.w = pkh(v[6], v[7]);
                            lo.x = pkh(d[0], d[1]); lo.y = pkh(d[2], d[3]); lo.z = pkh(d[4], d[5]); lo.w = pkh(d[6], d[7]);
                            if (j < 256) { *(u32x4*)((h16*)(ws + WS_QH) + r * 256 + j) = hi; *(u32x4*)((h16*)(ws + WS_QL) + r * 256 + j) = lo; }
                            else { *(u32x4*)((h16*)(ws + WS_KH) + r * 32 + (j - 256)) = hi; *(u32x4*)((h16*)(ws + WS_KL) + r * 32 + (j - 256)) = lo; }
                        } else if (j < 296) { float* w = (float*)(ws + WS_WI) + r * 8; *(f32x4*)w = v0; *(f32x4*)(w + 4) = v1; }
                    } }
        }
    }
};
struct EpiMerge {
    static constexpr bool PERM = true, AFTER_DRAIN = false, MID = true;
    const h16* G; h16* MG;
    __device__ __forceinline__ void mid(f32x4 (&acc)[2][2][4][2], const Unit& u, int wr, int wc, int fr, int fq) const {
        const int row0 = u.pm * BM + wr * 64 + fr, col0 = u.pn * BM + wc * 32 + 8 * fq;
#pragma unroll
        for (int ai = 0; ai < 2; ++ai)
#pragma unroll
            for (int m = 0; m < 4; ++m) { unsigned ro = (unsigned)(row0 + ai * HALF + m * 16); asm volatile("" : "+v"(ro)); const h16* gp = G + (size_t)ro * 2048 + col0;
#pragma unroll
                for (int bj = 0; bj < 2; ++bj) { const h16x8 ga = *(const h16x8*)(gp + bj * HALF), gb = *(const h16x8*)(gp + 1024 + bj * HALF);
#pragma unroll
                    for (int e = 0; e < 8; ++e) { const float a = fminf(fmaxf((float)ga[e], -30.f), 30.f), b = fminf(fmaxf((float)gb[e], -30.f), 30.f);
                        const float f = (1.0f + __builtin_amdgcn_exp2f(-LOG2E * b)) * __builtin_amdgcn_rcpf(1.0f + __builtin_amdgcn_exp2f(-LOG2E * a));
                        acc[ai][bj][m][e >> 2][e & 3] *= f; } }
                asm volatile("" ::: "memory"); }
    }
    __device__ __forceinline__ void operator()(const f32x4 (&acc)[2][2][4][2], const Unit& u, int wr, int wc, int fr, int fq) const {
        const int row0 = u.pm * BM + wr * 64 + fr, col0 = u.pn * BM + wc * 32 + 8 * fq;
#pragma unroll
        for (int ai = 0; ai < 2; ++ai)
#pragma unroll
            for (int m = 0; m < 4; ++m) { unsigned ro = (unsigned)(row0 + ai * HALF + m * 16); asm volatile("" : "+v"(ro)); const size_t r = (size_t)ro;
#pragma unroll
                for (int bj = 0; bj < 2; ++bj) { const h16x8 gb = *(const h16x8*)(G + r * 2048 + 1024 + col0 + bj * HALF);
                    float o[8];
#pragma unroll
                    for (int e = 0; e < 8; ++e) o[e] = acc[ai][bj][m][e >> 2][e & 3] * sigmoidf_fast((float)gb[e]);
                    u32x4 w; w.x = pkh(o[0], o[1]); w.y = pkh(o[2], o[3]); w.z = pkh(o[4], o[5]); w.w = pkh(o[6], o[7]);
                    *(u32x4*)(MG + r * 1024 + col0 + bj * HALF) = w; } }
    }
};
struct EpiOut {
    static constexpr bool PERM = true, AFTER_DRAIN = false, MID = false;
    const float* x; float* out;
    __device__ __forceinline__ void operator()(const f32x4 (&acc)[2][2][4][2], const Unit& u, int wr, int wc, int fr, int fq) const {
        const int row0 = u.pm * BM + wr * 64 + fr, col0 = u.pn * BM + wc * 32 + 8 * fq;
#pragma unroll
        for (int ai = 0; ai < 2; ++ai)
#pragma unroll
            for (int m = 0; m < 4; ++m) { const size_t off = (size_t)(row0 + ai * HALF + m * 16) * DM + col0;
#pragma unroll
                for (int bj = 0; bj < 2; ++bj)
#pragma unroll
                    for (int n = 0; n < 2; ++n) { const f32x4 xv = *(const f32x4*)(x + off + bj * HALF + 4 * n); *(f32x4*)(out + off + bj * HALF + 4 * n) = xv + acc[ai][bj][m][n]; }
                if (m & 1) asm volatile("" ::: "memory"); }
    }
};

template <class Epi, class Sched, class GemmT, bool ALIGN_EPI = false, bool SP2 = false>
__device__ __forceinline__ void gemm_phase(PG8_LAS unsigned char* lds, const GemmT g, const Sched& S, const Epi& E) {
    const int tid = threadIdx.x, wid = __builtin_amdgcn_readfirstlane(tid >> 6), lane = tid & 63, wr = wid >> 2, wc = wid & 3, fr = lane & 15, fq = lane >> 4;
    const int K = g.K, nt = K / BK;
    unsigned voffA[2], voffB[2];
#pragma unroll
    for (int i = 0; i < 2; ++i) { int R, C; stage_rc(tid * 16 + i * 8192, R, C); const int Rb = Epi::PERM ? ((R & ~31) + perm32(R & 31)) : R;
        voffA[i] = (unsigned)(R * g.lda + C) * 2u; voffB[i] = (unsigned)(Rb * K + C) * 2u; }
    const size_t kstep = (size_t)(BK * 2);
    const size_t hstepA = (size_t)HALF * g.lda * 2, hstepB = (size_t)HALF * K * 2;
    const unsigned ldsw = (unsigned)wid * 1024u;
    const int aoff = lds_byte(wr * 64 + fr, fq * 8), boff = lds_byte(wc * 32 + fr, fq * 8);
#define PG8_SA(b, h) (((b) * 2 + (h)) * HTB)
#define PG8_SB(b, h) ((4 + (b) * 2 + (h)) * HTB)
#define PG8_STAGE(bufoff, gbase, voff) do { _Pragma("unroll") for (int _i = 0; _i < 2; ++_i) \
        __builtin_amdgcn_global_load_lds((const unsigned*)((const char*)(gbase) + (voff)[_i]), (PG8_LAS unsigned*)(lds + (bufoff) + ldsw + _i * 8192), 16, 0, 0); } while (0)
#define PG8_LDA(dst, b, h) do { _Pragma("unroll") for (int m = 0; m < 4; ++m) _Pragma("unroll") for (int k = 0; k < 2; ++k) dst[m][k] = *(const PG8_LAS h16x8*)(lds + PG8_SA(b, h) + aoff + m * 2048 + k * 1024); } while (0)
#define PG8_LDB(dst, b, h) do { _Pragma("unroll") for (int n = 0; n < 2; ++n) _Pragma("unroll") for (int k = 0; k < 2; ++k) dst[n][k] = *(const PG8_LAS h16x8*)(lds + PG8_SB(b, h) + boff + n * 2048 + k * 1024); } while (0)
#define PG8_MMA(ai, bj, At, Bt) do { __builtin_amdgcn_s_setprio(1); _Pragma("unroll") for (int m = 0; m < 4; ++m) _Pragma("unroll") for (int n = 0; n < 2; ++n) _Pragma("unroll") for (int k = 0; k < 2; ++k) \
        acc[ai][bj][m][n] = __builtin_amdgcn_mfma_f32_16x16x32_f16(Bt[n][k], At[m][k], acc[ai][bj][m][n], 0, 0, 0); __builtin_amdgcn_s_setprio(0); } while (0)
#define PG8_WAIT_V(n) asm volatile("s_waitcnt vmcnt(" #n ")" ::: "memory")
#define PG8_WAIT_L(n) asm volatile("s_waitcnt lgkmcnt(" #n ")" ::: "memory")
#define PG8_BAR __builtin_amdgcn_s_barrier()
#define PG8_SCHED __builtin_amdgcn_sched_barrier(0)
    Unit cur, nxt; int ui = 0;
    if (!S.next(0, cur)) return;
    f32x4 acc[2][2][4][2];
#pragma unroll
    for (int a = 0; a < 2; ++a)
#pragma unroll
        for (int b = 0; b < 2; ++b)
#pragma unroll
            for (int m = 0; m < 4; ++m)
#pragma unroll
                for (int n = 0; n < 2; ++n) acc[a][b][m][n] = (f32x4){0.f, 0.f, 0.f, 0.f};
    h16x8 At[4][2], B0[2][2], B1[2][2];
    const char* cA = g.aptr(cur); const char* cB = g.bptr(cur);
    S.a_ready(cur);
    if constexpr (SP2) {
        PG8_STAGE(PG8_SB(0, 0), cB, voffB); PG8_STAGE(PG8_SB(0, 1), cB + hstepB, voffB); PG8_STAGE(PG8_SA(0, 0), cA, voffA); PG8_STAGE(PG8_SA(0, 1), cA + hstepA, voffA);
        if (wr == 1) PG8_BAR;
        PG8_WAIT_V(2); PG8_BAR;
        PG8_STAGE(PG8_SB(1, 0), cB + kstep, voffB); PG8_STAGE(PG8_SA(1, 0), cA + kstep, voffA); PG8_STAGE(PG8_SB(1, 1), cB + hstepB + kstep, voffB);
        PG8_WAIT_V(6); PG8_BAR;
    } else {
        PG8_STAGE(PG8_SB(0, 0), cB, voffB); PG8_STAGE(PG8_SA(0, 0), cA, voffA); PG8_STAGE(PG8_SB(0, 1), cB + hstepB, voffB); PG8_STAGE(PG8_SA(0, 1), cA + hstepA, voffA);
        if (wr == 1) PG8_BAR;
        PG8_WAIT_V(4); PG8_BAR;
        PG8_STAGE(PG8_SB(1, 0), cB + kstep, voffB); PG8_STAGE(PG8_SA(1, 0), cA + kstep, voffA); PG8_STAGE(PG8_SB(1, 1), cB + hstepB + kstep, voffB);
        PG8_WAIT_V(6); PG8_BAR;
    }
    for (;;) {
        const bool has_next = S.next(ui + 1, nxt);
        const char* nA = has_next ? g.aptr(nxt) : cA; const char* nB = has_next ? g.bptr(nxt) : cB;
        for (int t = 0; t < nt; t += 2) {
            const bool last = (t == nt - 2);
            const char* a1 = cA + (size_t)(t + 1) * kstep;
            const char* a2 = last ? nA : cA + (size_t)(t + 2) * kstep; const char* b2 = last ? nB : cB + (size_t)(t + 2) * kstep;
            const char* a3 = a2 + kstep; const char* b3 = b2 + kstep;
            if (last && has_next) S.a_ready(nxt);
            if constexpr (Epi::MID) { if (t == nt / 2) E.mid(acc, cur, wr, wc, fr, fq); }
            if constexpr (SP2) {
            PG8_LDB(B0, 0, 0); PG8_LDB(B1, 0, 1); PG8_SCHED; PG8_LDA(At, 0, 0); PG8_STAGE(PG8_SA(1, 1), a1 + hstepA, voffA);
            PG8_WAIT_V(8); PG8_WAIT_L(0); PG8_BAR; PG8_MMA(0, 0, At, B0); PG8_MMA(0, 1, At, B1); PG8_BAR; PG8_SCHED;
            PG8_LDA(At, 0, 1); PG8_STAGE(PG8_SB(0, 0), b2, voffB); PG8_STAGE(PG8_SB(0, 1), b2 + hstepB, voffB); PG8_STAGE(PG8_SA(0, 0), a2, voffA);
            PG8_WAIT_V(8); PG8_WAIT_L(0); PG8_BAR; PG8_MMA(1, 0, At, B0); PG8_MMA(1, 1, At, B1); PG8_BAR; PG8_SCHED;
            PG8_LDB(B0, 1, 0); PG8_LDB(B1, 1, 1); PG8_SCHED; PG8_LDA(At, 1, 0); PG8_STAGE(PG8_SA(0, 1), a2 + hstepA, voffA);
            PG8_WAIT_V(8); PG8_WAIT_L(0); PG8_BAR; PG8_MMA(0, 0, At, B0); PG8_MMA(0, 1, At, B1); PG8_BAR; PG8_SCHED;
            PG8_LDA(At, 1, 1); PG8_STAGE(PG8_SB(1, 0), b3, voffB); PG8_STAGE(PG8_SB(1, 1), b3 + hstepB, voffB); PG8_STAGE(PG8_SA(1, 0), a3, voffA);
            PG8_WAIT_V(8); PG8_WAIT_L(0); PG8_BAR; PG8_MMA(1, 0, At, B0); PG8_MMA(1, 1, At, B1); PG8_BAR; PG8_SCHED;
            } else {
            PG8_LDB(B0, 0, 0); PG8_SCHED; PG8_LDA(At, 0, 0); PG8_STAGE(PG8_SA(1, 1), a1 + hstepA, voffA);
            PG8_WAIT_L(8); PG8_BAR; PG8_WAIT_L(0); PG8_MMA(0, 0, At, B0); PG8_BAR; PG8_SCHED;
            PG8_LDB(B1, 0, 1); PG8_STAGE(PG8_SB(0, 0), b2, voffB);
            PG8_BAR; PG8_WAIT_L(0); PG8_MMA(0, 1, At, B1); PG8_BAR;
            PG8_LDA(At, 0, 1); PG8_STAGE(PG8_SA(0, 0), a2, voffA);
            PG8_BAR; PG8_WAIT_L(0); PG8_MMA(1, 0, At, B0); PG8_BAR; PG8_SCHED;
            PG8_STAGE(PG8_SB(0, 1), b2 + hstepB, voffB);
            PG8_WAIT_V(6); PG8_BAR; PG8_MMA(1, 1, At, B1); PG8_BAR;
            PG8_LDB(B0, 1, 0); PG8_SCHED; PG8_LDA(At, 1, 0); PG8_STAGE(PG8_SA(0, 1), a2 + hstepA, voffA);
            PG8_WAIT_L(8); PG8_BAR; PG8_WAIT_L(0); PG8_MMA(0, 0, At, B0); PG8_BAR; PG8_SCHED;
            PG8_LDB(B1, 1, 1); PG8_STAGE(PG8_SB(1, 0), b3, voffB);
            PG8_BAR; PG8_WAIT_L(0); PG8_MMA(0, 1, At, B1); PG8_BAR;
            PG8_LDA(At, 1, 1); PG8_STAGE(PG8_SA(1, 0), a3, voffA);
            PG8_BAR; PG8_WAIT_L(0); PG8_MMA(1, 0, At, B0); PG8_BAR; PG8_SCHED;
            PG8_STAGE(PG8_SB(1, 1), b3 + hstepB, voffB);
            PG8_WAIT_V(6); PG8_BAR; PG8_MMA(1, 1, At, B1); PG8_BAR;
            }
        }
        if constexpr (ALIGN_EPI) { if (wr == 0) PG8_BAR; }
        if constexpr (!Epi::AFTER_DRAIN) { E(acc, cur, wr, wc, fr, fq); S.done(cur); }
        if (!has_next) break;
#pragma unroll
        for (int a = 0; a < 2; ++a)
#pragma unroll
            for (int b = 0; b < 2; ++b)
#pragma unroll
                for (int m = 0; m < 4; ++m)
#pragma unroll
                    for (int n = 0; n < 2; ++n) acc[a][b][m][n] = (f32x4){0.f, 0.f, 0.f, 0.f};
        cur = nxt; cA = nA; cB = nB; ++ui;
        if constexpr (ALIGN_EPI) { if (wr == 1) PG8_BAR; }
    }
    PG8_WAIT_V(0);
    if constexpr (!ALIGN_EPI) { if (wr == 0) PG8_BAR; }
    PG8_BAR;
    if constexpr (Epi::AFTER_DRAIN) { E.fused(acc, cur, wr, wc, fr, fq, lds, wid, lane); S.done(cur); }
#undef PG8_SA
#undef PG8_SB
#undef PG8_STAGE
#undef PG8_LDA
#undef PG8_LDB
#undef PG8_MMA
#undef PG8_WAIT_V
#undef PG8_WAIT_L
#undef PG8_BAR
#undef PG8_SCHED
}
}

constexpr int NWAVES = 8, NTHREADS = 512;
constexpr int RING_BYTES = 131072, LDSCTL_OFF = 159744, LDS_BYTES = 163840;
#define LDS_WAIT() asm volatile("s_waitcnt lgkmcnt(0)" ::: "memory")
#ifdef PROF_SEG
#define TSTART(id) unsigned long long t0_##id = 0; if ((id) == PROF_SEG) { asm volatile("s_waitcnt vmcnt(0) lgkmcnt(0)" ::: "memory"); t0_##id = __builtin_amdgcn_s_memrealtime(); }
#define TSTOP(id) if ((id) == PROF_SEG) { asm volatile("s_waitcnt vmcnt(0) lgkmcnt(0)" ::: "memory"); F.prof += __builtin_amdgcn_s_memrealtime() - t0_##id; }
#else
#define TSTART(id)
#define TSTOP(id)
#endif

#define XB_TMO      128
#define XB_XCNT(j)  (256  + 64 * (j))
#define XB_XSUB(j)  (1280 + 64 * (j))
#define XB_XGEN(j)  (2304 + 64 * (j))
#define XB_TOP      3328
#define XB_TOPGEN   3392
#define XCD_BAR_WORDS 3456
#define XB_SPIN_CAP (1u << 18)

__device__ __forceinline__ unsigned xb_ld(unsigned* p)              { return __hip_atomic_load(p, __ATOMIC_RELAXED, __HIP_MEMORY_SCOPE_AGENT); }
__device__ __forceinline__ unsigned xb_add(unsigned* p, unsigned v) { return __hip_atomic_fetch_add(p, v, __ATOMIC_RELAXED, __HIP_MEMORY_SCOPE_AGENT); }
__device__ __forceinline__ unsigned xb_xcc_id() { return (unsigned)__builtin_amdgcn_s_getreg((3 << 11) | 20) & 0xFu; }
#define XB_SPIN(cond, bar) do { unsigned _sp = 0; while (cond) { __builtin_amdgcn_s_sleep(1); \
    if ((++_sp & 255u) == 0u) { if (xb_ld(&(bar)[XB_TMO])) break; if (_sp > XB_SPIN_CAP) { atomicAdd(&(bar)[XB_TMO], 1u); break; } } } } while (0)

struct XcdBarrier {
    unsigned* bar; unsigned x;
    volatile LAS unsigned* st;
};

__device__ __forceinline__ XcdBarrier xcd_barrier_post(unsigned* bar, volatile LAS unsigned* st) {
    XcdBarrier b; b.bar = bar; b.x = xb_xcc_id(); b.st = st;
    if (threadIdx.x == 0) (void)xb_add(&bar[XB_XCNT(b.x)], 1u);
    return b;
}
__device__ __forceinline__ void xcd_barrier_complete(unsigned* bar, unsigned x, unsigned& nloc, unsigned& nx) {
    const unsigned G = gridDim.x * gridDim.y * gridDim.z;
    unsigned sum, cnt, mine, sp = 0u;
    for (;;) {
        sum = 0u; cnt = 0u; mine = 0u;
#pragma unroll
        for (unsigned j = 0; j < 16; ++j) { const unsigned c = xb_ld(&bar[XB_XCNT(j)]); sum += c; cnt += (c > 0u) ? 1u : 0u; mine = (j == x) ? c : mine; }
        if (sum == G) break;
        __builtin_amdgcn_s_sleep(1);
        if ((++sp & 255u) == 0u) { if (xb_ld(&bar[XB_TMO])) break; if (sp > XB_SPIN_CAP) { atomicAdd(&bar[XB_TMO], 1u); break; } }
    }
    nloc = mine > 0u ? mine : 1u; nx = cnt > 0u ? cnt : 1u;
}

__device__ __forceinline__ void xcd_barrier(const XcdBarrier& b) {
    asm volatile("s_waitcnt vmcnt(0)" ::: "memory");
    __syncthreads();
    if (threadIdx.x == 0) {
        unsigned* bar = b.bar;
        __builtin_amdgcn_s_waitcnt(0);
        unsigned nloc = b.st[0], nx = b.st[1];
        if (nloc == 0u) { xcd_barrier_complete(bar, b.x, nloc, nx); b.st[0] = nloc; b.st[1] = nx; }
        const unsigned old = xb_add(&bar[XB_XSUB(b.x)], 1u);
        const unsigned gen = old / nloc;
        if (old + 1u == (gen + 1u) * nloc) {
            __builtin_amdgcn_fence(__ATOMIC_RELEASE, "agent");
            asm volatile("s_waitcnt vmcnt(0)" ::: "memory");
            const unsigned og = xb_add(&bar[XB_TOP], 1u);
            const unsigned tg = og / nx;
            if (og + 1u == (tg + 1u) * nx) xb_add(&bar[XB_TOPGEN], 1u);
            else XB_SPIN(xb_ld(&bar[XB_TOPGEN]) == tg, bar);
            __builtin_amdgcn_fence(__ATOMIC_ACQUIRE, "agent");
            xb_add(&bar[XB_XGEN(b.x)], 1u);
            asm volatile("s_waitcnt vmcnt(0)" ::: "memory");
        } else {
            XB_SPIN(xb_ld(&bar[XB_XGEN(b.x)]) == gen, bar);
            __builtin_amdgcn_fence(__ATOMIC_ACQUIRE, "agent");
            asm volatile("s_waitcnt vmcnt(0)" ::: "memory");
        }
    }
    __syncthreads();
}

struct Frame {
    LAS unsigned char* lds;
    int tid, lane, wave, vcu, G;
    unsigned char* ws;
    const float *x, *norm_g, *w_in, *qna, *kna, *sinks, *qnb, *knb, *relb, *wpa, *wpb, *wout;
    float* out;
    unsigned long long prof;
};

__device__ __forceinline__ float wave_sum(float v) {
#pragma unroll
    for (int o = 1; o < 64; o <<= 1) v += __shfl_xor(v, o);
    return v;
}
__device__ __forceinline__ int t5_bucket(int n) {
    if (n < 16) return n < 0 ? 0 : n;
    const int l = 16 + (int)(logf((float)n * 0.0625f) / logf(8.0f) * 16.0f);
    return l > 31 ? 31 : l;
}

__device__ __forceinline__ int win_src_col(int n) { return n < 3328 ? n : (n < 5376 ? n + 296 : (n < 5672 ? n - 2048 : -1)); }
template <bool INPROJ>
__device__ __forceinline__ void p0_transpose_item(const float* W, int srcN, int k0, int n0, h16* WT, int ldk, int kdst0, LAS float* scr, int lane, float scale) {
    const int n = n0 + (lane & 31); const int col = INPROJ ? win_src_col(n) : n;
    float wv_[32];
#pragma unroll
    for (int i = 0; i < 32; ++i) { const int kk = 2 * i + (lane >> 5); wv_[i] = (col >= 0) ? W[(size_t)(k0 + kk) * srcN + col] : 0.f; }
#pragma unroll
    for (int i = 0; i < 32; ++i) { const int kk = 2 * i + (lane >> 5); scr[kk * 33 + (lane & 31)] = wv_[i] * scale; }
    LDS_WAIT(); asm volatile("" ::: "memory");
    const int c = lane & 7;
#pragma unroll
    for (int j = 0; j < 4; ++j) { const int nn = (lane >> 3) + 8 * j; const LAS float* s = scr + (8 * c) * 33 + nn;
        float v[8];
#pragma unroll
        for (int e = 0; e < 8; ++e) v[e] = s[e * 33];
        u32x4 o; o.x = pkh(v[0], v[1]); o.y = pkh(v[2], v[3]); o.z = pkh(v[4], v[5]); o.w = pkh(v[6], v[7]);
        *(u32x4*)(WT + (size_t)(n0 + nn) * ldk + kdst0 + k0 + 8 * c) = o;
    }
    LDS_WAIT(); asm volatile("" ::: "memory");
}
__device__ __forceinline__ void p0_norm_rows4(const float* x, const float* g, h16* H, int m0, int mstride, int lane) {
    f32x4 v[4][4];
#pragma unroll
    for (int r = 0; r < 4; ++r)
#pragma unroll
        for (int j = 0; j < 4; ++j) v[r][j] = __builtin_nontemporal_load((const f32x4*)(x + (size_t)(m0 + r * mstride) * DM) + lane + 64 * j);
    f32x4 gg[4];
#pragma unroll
    for (int j = 0; j < 4; ++j) gg[j] = *((const f32x4*)g + lane + 64 * j) * HSCALE;
#pragma unroll
    for (int r = 0; r < 4; ++r) {
        float s = 0.f;
#pragma unroll
        for (int j = 0; j < 4; ++j) s += (v[r][j].x * v[r][j].x + v[r][j].y * v[r][j].y) + (v[r][j].z * v[r][j].z + v[r][j].w * v[r][j].w);
        const float rs = rsqrtf(wave_sum(s) * (1.0f / DM) + RMS_EPS);
#pragma unroll
        for (int j = 0; j < 4; ++j) { const f32x4 hv = v[r][j] * rs * gg[j]; u32x2 hi; hi.x = pkh(hv.x, hv.y); hi.y = pkh(hv.z, hv.w);
            *((u32x2*)(H + (size_t)(m0 + r * mstride) * 1024) + lane + 64 * j) = hi; }
    }
}
__device__ __forceinline__ void p0_prologue(Frame& F) {
    LAS float* scr = (LAS float*)(F.lds + F.wave * 16384);
    const int gw = F.vcu * NWAVES + F.wave, NGW = F.G * NWAVES;
    h16* Win = (h16*)(F.ws + WS_WIN); h16* Wp = (h16*)(F.ws + WS_WP); h16* Wo = (h16*)(F.ws + WS_WO);
    constexpr int I_IN = 16 * 184, I_P = 8 * 32, I_O = 16 * 32;
    constexpr int NITEMS = I_IN + 2 * I_P + I_O;
    for (int it = gw; it < NITEMS; it += NGW) {
        int r = it;
        if (r < I_IN) { p0_transpose_item<true>(F.w_in, INW, 64 * (r / 184), 32 * (r % 184), Win, 1024, 0, scr, F.lane, WSCALE); continue; } r -= I_IN;
        if (r < I_P) { p0_transpose_item<false>(F.wpa, DM, 64 * (r / 32), 32 * (r % 32), Wp, 1024, 0, scr, F.lane, 1.f); continue; } r -= I_P;
        if (r < I_P) { p0_transpose_item<false>(F.wpb, DM, 64 * (r / 32), 32 * (r % 32), Wp, 1024, 512, scr, F.lane, 1.f); continue; } r -= I_P;
        p0_transpose_item<false>(F.wout, DM, 64 * (r / 32), 32 * (r % 32), Wo, 1024, 0, scr, F.lane, 1.f);
    }
    h16* Hb = (h16*)(F.ws + WS_H);
    for (int m = gw; m + 3 * NGW < MROWS; m += 4 * NGW) p0_norm_rows4(F.x, F.norm_g, Hb, m, NGW, F.lane);
    if (MROWS % (4 * NGW) != 0) for (int m = gw + (MROWS / (4 * NGW)) * 4 * NGW; m < MROWS; m += NGW) p0_norm_rows4(F.x, F.norm_g, Hb, m, 0, F.lane);
}

constexpr int NBIN = 512, ICAP = 32;
constexpr int IW_VALS = 0, IW_HIST = 16384, IW_LIST = IW_HIST + 2 * (NBIN / 2) * 4, IW_LMASK = IW_LIST + 2 * ICAP * 8, IW_BYTES = IW_LMASK + 512;
static_assert(8 * IW_BYTES <= LDSCTL_OFF, "indexer LDS");
__device__ __forceinline__ int idx_bin(float v, float smin, float scale) { const int b = (int)((v - smin) * scale); return b > NBIN - 1 ? NBIN - 1 : b; }
__device__ __forceinline__ float swz16(float x) { return __int_as_float(__builtin_amdgcn_ds_swizzle(__float_as_int(x), 0x401F)); }
__device__ __forceinline__ float half_min(float v) { v = fminf(v, __shfl_xor(v, 1)); v = fminf(v, __shfl_xor(v, 2)); v = fminf(v, __shfl_xor(v, 4)); v = fminf(v, __shfl_xor(v, 8)); return fminf(v, __shfl_xor(v, 16)); }
__device__ __forceinline__ float half_max(float v) { v = fmaxf(v, __shfl_xor(v, 1)); v = fmaxf(v, __shfl_xor(v, 2)); v = fmaxf(v, __shfl_xor(v, 4)); v = fmaxf(v, __shfl_xor(v, 8)); return fmaxf(v, __shfl_xor(v, 16)); }
__device__ __forceinline__ unsigned lowest_bits(unsigned w, unsigned n) { unsigned kept = 0u; while (n && w) { const unsigned bit = w & (0u - w); kept |= bit; w ^= bit; --n; } return kept; }
__device__ __forceinline__ void idx_pair(Frame& F, int b, int u) {
    const int lane = F.lane, k16 = lane & 15, fq = lane >> 4, th = fq >> 1, par = fq & 1;
    const int ta = 2 * u, t = ta + th;
    unsigned* gm = (unsigned*)(F.ws + WS_MASK) + (size_t)(b * SEQ + ta) * 64;
    if (ta < 256) {
        const int lo = lane * 32;
        gm[lane] = (ta >= lo + 31) ? 0xffffffffu : (ta >= lo ? ((2u << (ta - lo)) - 1u) : 0u);
        gm[64 + lane] = (ta + 1 >= lo + 31) ? 0xffffffffu : (ta + 1 >= lo ? ((2u << (ta + 1 - lo)) - 1u) : 0u);
        return;
    }
    LAS unsigned char* wl = F.lds + F.wave * IW_BYTES;
    LAS float* vals = (LAS float*)(wl + IW_VALS) + th * 2048 + 16 * par + k16;
    LAS unsigned* hist = (LAS unsigned*)(wl + IW_HIST) + th * (NBIN / 2);
    LAS u32x2* clist = (LAS u32x2*)(wl + IW_LIST) + th * ICAP;
    LAS unsigned* lmask = (LAS unsigned*)(wl + IW_LMASK);
    lmask[lane] = 0u; lmask[64 + lane] = 0u;
    TSTART(20)
    TSTART(21)
    const size_t qrow = (size_t)(b * SEQ + ta + (k16 >> 3));
    const h16x8 qh = *(const h16x8*)((const h16*)(F.ws + WS_QH) + qrow * 256 + (k16 & 7) * 32 + fq * 8), ql = *(const h16x8*)((const h16*)(F.ws + WS_QL) + qrow * 256 + (k16 & 7) * 32 + fq * 8);
    const f32x4 wv = *(const f32x4*)((const float*)(F.ws + WS_WI) + (size_t)(b * SEQ + t) * 8 + 4 * par);
    const int nstep = (ta + 1) / 32 + 1;
    const h16* kph = (const h16*)(F.ws + WS_KH) + (size_t)(b * SEQ + k16) * 32 + fq * 8; const h16* kpl = (const h16*)(F.ws + WS_KL) + (size_t)(b * SEQ + k16) * 32 + fq * 8;
    h16x8 kb[4][4];
#define IDX_LOAD(slot, step) do { const int st_ = (step) < 64 ? (step) : 63; const h16* ph_ = kph + (size_t)st_ * 1024; const h16* pl_ = kpl + (size_t)st_ * 1024; \
        kb[slot][0] = *(const h16x8*)ph_; kb[slot][1] = *(const h16x8*)pl_; kb[slot][2] = *(const h16x8*)(ph_ + 512); kb[slot][3] = *(const h16x8*)(pl_ + 512); } while (0)
    IDX_LOAD(0, 0); IDX_LOAD(1, 1); IDX_LOAD(2, 2); IDX_LOAD(3, 3);
    float vmin = INFINITY, vmax = -INFINITY;
    const int myk = 16 * par + k16;
#define IDX_STEP(slot, step) do { \
        f32x4 a0 = __builtin_amdgcn_mfma_f32_16x16x32_f16(qh, kb[slot][0], (f32x4){0.f, 0.f, 0.f, 0.f}, 0, 0, 0), a1 = __builtin_amdgcn_mfma_f32_16x16x32_f16(qh, kb[slot][2], (f32x4){0.f, 0.f, 0.f, 0.f}, 0, 0, 0); \
        a0 = __builtin_amdgcn_mfma_f32_16x16x32_f16(ql, kb[slot][0], a0, 0, 0, 0); a1 = __builtin_amdgcn_mfma_f32_16x16x32_f16(ql, kb[slot][2], a1, 0, 0, 0); \
        a0 = __builtin_amdgcn_mfma_f32_16x16x32_f16(qh, kb[slot][1], a0, 0, 0, 0); a1 = __builtin_amdgcn_mfma_f32_16x16x32_f16(qh, kb[slot][3], a1, 0, 0, 0); \
        IDX_LOAD(slot, (step) + 4); \
        float s0 = wv[0] * fmaxf(a0[0], 0.f), s1 = wv[0] * fmaxf(a1[0], 0.f); \
        _Pragma("unroll") for (int r = 1; r < 4; ++r) { s0 = fmaf(wv[r], fmaxf(a0[r], 0.f), s0); s1 = fmaf(wv[r], fmaxf(a1[r], 0.f), s1); } \
        const float recv = swz16(par ? s0 : s1); \
        const float mine = (par ? s1 : s0) + recv + 0.0f; \
        const bool valid = (32 * (step) + myk) <= t; \
        vals[32 * (step)] = valid ? mine : __builtin_nanf(""); \
        if (valid) { vmin = fminf(vmin, mine); vmax = fmaxf(vmax, mine); } } while (0)
#pragma unroll 1
    for (int i = 0; i < nstep; i += 8) { IDX_STEP(0, i); IDX_STEP(1, i + 1); IDX_STEP(2, i + 2); IDX_STEP(3, i + 3); IDX_STEP(0, i + 4); IDX_STEP(1, i + 5); IDX_STEP(2, i + 6); IDX_STEP(3, i + 7); }
#undef IDX_STEP
#undef IDX_LOAD
    TSTOP(21)
    TSTART(22)
    float lo = half_min(vmin), hi = half_max(vmax);
    unsigned need = 256u, wa = 0u, wb = 0u; bool done = false;
#pragma unroll 1
    for (int level = 0; level < 64; ++level) {
        if (__ballot(!done) == 0ull) break;
        const bool tie = !done && !(hi > lo);
        const float scale = (hi > lo) ? ((float)NBIN - 0.5f) / (hi - lo) : 0.f;
        unsigned bst = 0u, rr = 0u, cb = 0u;
        TSTART(23)
        if (__ballot(!done && !tie) != 0ull) {
            *(LAS u32x4*)(wl + IW_HIST + lane * 16) = (u32x4){0u, 0u, 0u, 0u}; *(LAS u32x4*)(wl + IW_HIST + 1024 + lane * 16) = (u32x4){0u, 0u, 0u, 0u};
            asm volatile("s_waitcnt lgkmcnt(0)" ::: "memory");
            if (!done && !tie) {
#pragma unroll 4
                for (int i = 0; i < nstep; ++i) { const float v = vals[32 * i]; if (v >= lo && v <= hi) { const int bn = idx_bin(v, lo, scale); atomicAdd((unsigned*)&hist[bn >> 1], (bn & 1) ? 65536u : 1u); } }
            }
            asm volatile("s_waitcnt lgkmcnt(0)" ::: "memory");
#pragma unroll 1
            for (int tt = 0; tt < 2; ++tt) {
                const unsigned need_t = (unsigned)__builtin_amdgcn_readlane((int)need, 32 * tt); const bool skip_t = __builtin_amdgcn_readlane((int)(done || tie), 32 * tt) != 0;
                if (!skip_t) {
                    const u32x4 cw = *(const LAS u32x4*)(wl + IW_HIST + tt * 1024 + lane * 16);
                    const unsigned cnt[8] = {cw.x & 0xffffu, cw.x >> 16, cw.y & 0xffffu, cw.y >> 16, cw.z & 0xffffu, cw.z >> 16, cw.w & 0xffffu, cw.w >> 16};
                    unsigned s = 0;
#pragma unroll
                    for (int e = 0; e < 8; ++e) s += cnt[e];
                    unsigned v = s;
#pragma unroll
                    for (int o = 1; o < 64; o <<= 1) { const unsigned tmp = (unsigned)__shfl_down((int)v, o); if (lane + o < 64) v += tmp; }
                    const unsigned above = v - s; const bool crit = above < need_t && need_t <= above + s;
                    unsigned cum = above, b_ = 0, r_ = 0, c_ = 0; bool found = false;
#pragma unroll
                    for (int e = 7; e >= 0; --e) { const unsigned cc = cnt[e]; if (!found && cum + cc >= need_t) { found = true; b_ = 8u * lane + e; r_ = need_t - cum; c_ = cc; } if (!found) cum += cc; }
                    const unsigned long long cm = __ballot(crit); const int cl = cm ? (int)__builtin_ctzll(cm) : 0;
                    const unsigned bq = (unsigned)__builtin_amdgcn_readlane((int)b_, cl), rq = (unsigned)__builtin_amdgcn_readlane((int)r_, cl), cq = (unsigned)__builtin_amdgcn_readlane((int)c_, cl);
                    if (th == tt) { bst = bq; rr = rq; cb = cq; }
                }
            }
        }
        TSTOP(23)
        TSTART(24)
        const bool takeall = (cb == rr);
        const bool uselist = !takeall && cb <= (unsigned)ICAP;
        const int bsel = takeall ? (int)bst : (int)bst + 1;
        float nlo = INFINITY, nhi = -INFINITY; unsigned cnt_a = 0u, cnt_b = 0u, tie_a = 0u, tie_b = 0u;
        const unsigned need_a = (unsigned)__builtin_amdgcn_readlane((int)need, 0), need_b = (unsigned)__builtin_amdgcn_readlane((int)need, 32);
        const bool tie_any = __ballot(tie) != 0ull;
#pragma unroll 2
        for (int i = 0; i < nstep; ++i) {
            const float v = vals[32 * i]; const bool act = !done && v >= lo && v <= hi;
            const int bn = idx_bin(v, lo, scale);
            const bool sel = act && !tie && bn >= bsel, mem = act && !tie && !takeall && bn == (int)bst;
            unsigned long long sm = __ballot(sel);
            if (tie_any) {
                const unsigned long long tm = __ballot(act && tie);
                const unsigned ka = lowest_bits((unsigned)tm, need_a - tie_a), kb = lowest_bits((unsigned)(tm >> 32), need_b - tie_b);
                tie_a += __popc(ka); tie_b += __popc(kb); sm |= (unsigned long long)ka | ((unsigned long long)kb << 32);
            }
            if (sm) { if (lane == i) { wa |= (unsigned)sm; wb |= (unsigned)(sm >> 32); } }
            const unsigned long long mm = __ballot(mem);
            if (mm) {
                if (mem) { nlo = fminf(nlo, v); nhi = fmaxf(nhi, v);
                    if (uselist) { const unsigned slot = th ? cnt_b + __builtin_amdgcn_mbcnt_hi((unsigned)(mm >> 32), 0u) : cnt_a + __builtin_amdgcn_mbcnt_lo((unsigned)mm, 0u);
                        if (slot < (unsigned)ICAP) clist[slot] = (u32x2){__float_as_uint(v), (unsigned)(32 * i + myk)}; } }
                cnt_a += __popc((unsigned)mm); cnt_b += __popc((unsigned)(mm >> 32));
            }
        }
        asm volatile("s_waitcnt lgkmcnt(0)" ::: "memory");
        TSTOP(24)
        if (!done) {
            if (tie || takeall) done = true;
            else if (uselist) {
                const int j = lane & 31; const u32x2 me = clist[j]; const float vj = __uint_as_float(me.x); unsigned rank = 0u;
                for (unsigned i2 = 0; i2 < cb; ++i2) { const u32x2 o = clist[i2]; const float vi = __uint_as_float(o.x); rank += (vi > vj || (vi == vj && o.y < me.y)) ? 1u : 0u; }
                if ((unsigned)j < cb && rank < rr) atomicOr((unsigned*)&lmask[th * 64 + (me.y >> 5)], 1u << (me.y & 31));
                done = true;
            } else { lo = half_min(nlo); hi = half_max(nhi); need = rr; }
        }
    }
    asm volatile("s_waitcnt lgkmcnt(0)" ::: "memory");
    gm[lane] = wa | lmask[lane]; gm[64 + lane] = wb | lmask[64 + lane];
    TSTOP(22)
    TSTOP(20)
}
__device__ __forceinline__ void p2_index_phase(Frame& F) {
    for (int gw = F.vcu * NWAVES + F.wave; gw < 2048; gw += F.G * NWAVES) {
        const int b = gw >> 8, r = gw & 255;
#pragma unroll 1
        for (int k = 0; k < 4; ++k) { const int u = (k == 0) ? 1023 - r : (k == 1) ? 512 + r : (k == 2) ? 511 - r : r; idx_pair(F, b, u); }
    }
}

constexpr int AT_K = 0, AT_KSZ = 64 * 144, AT_V = 2 * AT_KSZ, AT_VSZ = 64 * 192, AT_LUT = AT_V + 2 * AT_VSZ, AT_OST = AT_LUT + 320 * 4, AT_OSTSZ = 32 * 144, AT_MTAB = AT_OST + 8 * AT_OSTSZ;
static_assert(AT_MTAB + 128 <= RING_BYTES, "attention LDS");
typedef _Float16 h16x2v __attribute__((ext_vector_type(2)));
__device__ __forceinline__ s16x4 vtr_read(const LAS unsigned char* p) { return __builtin_amdgcn_ds_read_tr16_b64_v4i16((LAS s16x4*)p); }

template <bool ISB>
__device__ __forceinline__ void attn_unit(Frame& F, int b, int h, int qb) {
    const int tid = F.tid, lane = F.lane, wid = F.wave, q = lane & 31, hi = lane >> 5;
    const int q0 = qb * 256, r0 = q0 + wid * 32, t = r0 + q;
    const size_t row = (size_t)b * SEQ + t;
    const h16* Qp; const h16* Kp; const h16* Vp; const h16* Zp; int kvpitch, ycol;
    if (ISB) { Qp = (const h16*)(F.ws + WS_QB) + h * 64; Kp = (const h16*)(F.ws + WS_KB) + h * 64; Vp = (const h16*)(F.ws + WS_VB) + h * 64; Zp = (const h16*)(F.ws + WS_ZB) + h * 64; kvpitch = 512; ycol = 512 + h * 64; }
    else     { Qp = (const h16*)(F.ws + WS_QA) + h * 64; Kp = (const h16*)(F.ws + WS_KVA) + (h >> 2) * 64; Vp = (const h16*)(F.ws + WS_KVA) + 128 + (h >> 2) * 64; Zp = (const h16*)(F.ws + WS_ZA) + h * 64; kvpitch = 256; ycol = h * 64; }
    const unsigned* mrow = (const unsigned*)(F.ws + WS_MASK) + row * 64;
    LAS float* lut = (LAS float*)(F.lds + AT_LUT);
    for (int i = tid; i < 320; i += NTHREADS) { const int dist = 223 - i; float v;
        if (ISB) v = dist < 0 ? 0.f : (F.relb[t5_bucket(dist > 127 ? 127 : dist) * 16 + 8 + h] - F.relb[31 * 16 + 8 + h]) * LOG2E;
        else v = (dist >= 0 && dist < 128) ? F.relb[t5_bucket(dist) * 16 + h] * LOG2E : -INFINITY;
        lut[i] = v; }
    if (tid < 16) { u32x2 e; e.x = ((tid & 1) ? 0xffffu : 0u) | ((tid & 2) ? 0xffff0000u : 0u); e.y = ((tid & 4) ? 0xffffu : 0u) | ((tid & 8) ? 0xffff0000u : 0u); *(LAS u32x2*)(F.lds + AT_MTAB + tid * 8) = e; }
    h16x8 qr[4];
    {   const float* qg = ISB ? F.qnb : F.qna; float ss = 0.f;
#pragma unroll
        for (int d0 = 0; d0 < 4; ++d0) { qr[d0] = *(const h16x8*)(Qp + row * 512 + d0 * 16 + hi * 8);
#pragma unroll
            for (int e = 0; e < 8; ++e) { const float f = (float)qr[d0][e]; ss += f * f; } }
        ss += __shfl_xor(ss, 32);
        const float rq = rsqrtf(ss * (1.0f / 64.0f) + RMS_EPS) * QSCALE;
#pragma unroll
        for (int d0 = 0; d0 < 4; ++d0) { const f32x4 g0 = *(const f32x4*)(qg + d0 * 16 + hi * 8), g1 = *(const f32x4*)(qg + d0 * 16 + hi * 8 + 4);
            u32x4 w; w.x = pkh((float)qr[d0][0] * rq * g0[0], (float)qr[d0][1] * rq * g0[1]); w.y = pkh((float)qr[d0][2] * rq * g0[2], (float)qr[d0][3] * rq * g0[3]);
            w.z = pkh((float)qr[d0][4] * rq * g1[0], (float)qr[d0][5] * rq * g1[1]); w.w = pkh((float)qr[d0][6] * rq * g1[2], (float)qr[d0][7] * rq * g1[3]);
            qr[d0] = __builtin_bit_cast(h16x8, w); } }
    float kgn[8];
    {   const float* kgp = (ISB ? F.knb : F.kna) + (tid & 7) * 8; const f32x4 g0 = *(const f32x4*)kgp, g1 = *(const f32x4*)(kgp + 4);
        kgn[0] = g0[0]; kgn[1] = g0[1]; kgn[2] = g0[2]; kgn[3] = g0[3]; kgn[4] = g1[0]; kgn[5] = g1[1]; kgn[6] = g1[2]; kgn[7] = g1[3]; }
#define KNORM(KR) do { const h16x8 kv_ = __builtin_bit_cast(h16x8, KR); float f_[8]; float ss_ = 0.f; \
        _Pragma("unroll") for (int e = 0; e < 8; ++e) { f_[e] = (float)kv_[e]; ss_ += f_[e] * f_[e]; } \
        ss_ += __shfl_xor(ss_, 1); ss_ += __shfl_xor(ss_, 2); ss_ += __shfl_xor(ss_, 4); \
        const float rk_ = rsqrtf(ss_ * (1.0f / 64.0f) + RMS_EPS); \
        KR.x = pkh(f_[0] * rk_ * kgn[0], f_[1] * rk_ * kgn[1]); KR.y = pkh(f_[2] * rk_ * kgn[2], f_[3] * rk_ * kgn[3]); \
        KR.z = pkh(f_[4] * rk_ * kgn[4], f_[5] * rk_ * kgn[5]); KR.w = pkh(f_[6] * rk_ * kgn[6], f_[7] * rk_ * kgn[7]); } while (0)
    const int kt_lo = ISB ? 0 : (4 * qb - 2 < 0 ? 0 : 4 * qb - 2), kt_hi = 4 * qb + 3;
    const int srow = tid >> 3, sch = tid & 7;
    const h16* kg = Kp + ((size_t)b * SEQ + srow) * kvpitch + sch * 8; const h16* vg = Vp + ((size_t)b * SEQ + srow) * kvpitch + sch * 8;
    const int kst = srow * 144 + sch * 16, vst = srow * 192 + sch * 16;
    u32x4 kreg = *(const u32x4*)(kg + (size_t)kt_lo * 64 * kvpitch), vreg = *(const u32x4*)(vg + (size_t)kt_lo * 64 * kvpitch);
    u32x2 mw = {0u, 0u}, mwn = {0u, 0u};
    if (ISB) mw = *(const u32x2*)(mrow + 2 * kt_lo);
    KNORM(kreg);
    *(LAS u32x4*)(F.lds + AT_K + kst) = kreg; *(LAS u32x4*)(F.lds + AT_V + vst) = vreg;
    __syncthreads();
    float m_run = -INFINITY, l_run = 0.f;
    f32x16 o[2];
#pragma unroll
    for (int r = 0; r < 16; ++r) { o[0][r] = 0.f; o[1][r] = 0.f; }
    const int kfo = q * 144 + hi * 16;
    const int vfo = (4 * hi + ((lane & 15) >> 2)) * 192 + ((lane >> 4) & 1) * 32 + (lane & 3) * 8;
    for (int kt = kt_lo; kt <= kt_hi; ++kt) {
        const int cur = (kt - kt_lo) & 1;
        if (kt < kt_hi) { kreg = *(const u32x4*)(kg + (size_t)(kt + 1) * 64 * kvpitch); vreg = *(const u32x4*)(vg + (size_t)(kt + 1) * 64 * kvpitch); if (ISB) mwn = *(const u32x2*)(mrow + 2 * (kt + 1)); }
        const int k0 = kt * 64;
        const bool active = ISB ? (k0 <= r0 + 31) : (k0 <= r0 + 31 && k0 + 63 >= r0 - 127);
        TSTART(31)
        if (active) {
            const LAS unsigned char* kb = F.lds + AT_K + cur * AT_KSZ + kfo;
            const LAS unsigned char* vb = F.lds + AT_V + cur * AT_VSZ + vfo;
            f32x16 p0, p1;
#pragma unroll
            for (int r = 0; r < 16; ++r) { p0[r] = 0.f; p1[r] = 0.f; }
#pragma unroll
            for (int d0 = 0; d0 < 4; ++d0) {
                const h16x8 ka = *(const LAS h16x8*)(kb + d0 * 32), kc = *(const LAS h16x8*)(kb + 32 * 144 + d0 * 32);
                p0 = __builtin_amdgcn_mfma_f32_32x32x16_f16(ka, qr[d0], p0, 0, 0, 0);
                p1 = __builtin_amdgcn_mfma_f32_32x32x16_f16(kc, qr[d0], p1, 0, 0, 0);
            }
            if (!ISB || (r0 - k0 - 63 < 113)) {
                const LAS float* lp = lut + (223 - (t - k0 - 4 * hi));
#pragma unroll
                for (int r = 0; r < 16; ++r) { const int c = (r & 3) + 8 * (r >> 2); p0[r] += lp[c]; p1[r] += lp[32 + c]; }
            }
            h16x2v s2[16];
#pragma unroll
            for (int j = 0; j < 8; ++j) { s2[j] = __builtin_convertvector((f32x2){p0[2 * j], p0[2 * j + 1]}, h16x2v); s2[8 + j] = __builtin_convertvector((f32x2){p1[2 * j], p1[2 * j + 1]}, h16x2v); }
            h16x2v m2 = __builtin_elementwise_max(s2[0], s2[1]);
#pragma unroll
            for (int j = 2; j < 16; ++j) m2 = __builtin_elementwise_max(m2, s2[j]);
            float mx = fmaxf((float)m2.x, (float)m2.y);
            mx = fmaxf(mx, __shfl_xor(mx, 32));
            const float mnew = fmaxf(m_run, mx), muse = (mnew == -INFINITY) ? 0.f : mnew;
            if (__any(mnew > m_run)) {
                const float alpha = __builtin_amdgcn_exp2f(m_run - muse);
                l_run *= alpha;
#pragma unroll
                for (int r = 0; r < 16; ++r) { o[0][r] *= alpha; o[1][r] *= alpha; }
            }
            m_run = mnew;
            const h16 nm = (h16)(-muse); const h16x2v nm2 = {nm, nm};
#pragma unroll
            for (int j = 0; j < 16; ++j) { const h16x2v a = s2[j] + nm2; s2[j].x = __builtin_exp2f16(a.x); s2[j].y = __builtin_exp2f16(a.y); }
            if (ISB) {
                const unsigned mm0 = mw.x >> (4 * hi), mm1 = mw.y >> (4 * hi);
#pragma unroll
                for (int g4 = 0; g4 < 4; ++g4) {
                    const u32x2 e0 = *(const LAS u32x2*)(F.lds + AT_MTAB + ((mm0 >> (8 * g4)) & 15u) * 8), e1 = *(const LAS u32x2*)(F.lds + AT_MTAB + ((mm1 >> (8 * g4)) & 15u) * 8);
                    s2[2 * g4] = __builtin_bit_cast(h16x2v, __builtin_bit_cast(unsigned, s2[2 * g4]) & e0.x); s2[2 * g4 + 1] = __builtin_bit_cast(h16x2v, __builtin_bit_cast(unsigned, s2[2 * g4 + 1]) & e0.y);
                    s2[8 + 2 * g4] = __builtin_bit_cast(h16x2v, __builtin_bit_cast(unsigned, s2[8 + 2 * g4]) & e1.x); s2[8 + 2 * g4 + 1] = __builtin_bit_cast(h16x2v, __builtin_bit_cast(unsigned, s2[8 + 2 * g4 + 1]) & e1.y);
                }
            }
            {   h16x2v a0 = s2[0] + s2[1], a1 = s2[2] + s2[3], a2 = s2[4] + s2[5], a3 = s2[6] + s2[7], a4 = s2[8] + s2[9], a5 = s2[10] + s2[11], a6 = s2[12] + s2[13], a7 = s2[14] + s2[15];
                a0 = a0 + a1; a2 = a2 + a3; a4 = a4 + a5; a6 = a6 + a7;
                l_run += (((float)a0.x + (float)a0.y) + ((float)a2.x + (float)a2.y)) + (((float)a4.x + (float)a4.y) + ((float)a6.x + (float)a6.y)); }
            u32x4 pk[4];
#pragma unroll
            for (int s = 0; s < 4; ++s) pk[s] = (u32x4){__builtin_bit_cast(unsigned, s2[4 * s]), __builtin_bit_cast(unsigned, s2[4 * s + 1]), __builtin_bit_cast(unsigned, s2[4 * s + 2]), __builtin_bit_cast(unsigned, s2[4 * s + 3])};
#pragma unroll
            for (int s = 0; s < 4; ++s)
#pragma unroll
                for (int d1 = 0; d1 < 2; ++d1) {
                    const s16x4 lo4 = vtr_read(vb + (16 * s) * 192 + d1 * 64), hi4 = vtr_read(vb + (16 * s + 8) * 192 + d1 * 64);
                    const h16x4 lf = __builtin_bit_cast(h16x4, lo4), hf = __builtin_bit_cast(h16x4, hi4);
                    const h16x8 vf = {lf[0], lf[1], lf[2], lf[3], hf[0], hf[1], hf[2], hf[3]};
                    o[d1] = __builtin_amdgcn_mfma_f32_32x32x16_f16(vf, __builtin_bit_cast(h16x8, pk[s]), o[d1], 0, 0, 0);
                }
        }
        TSTOP(31)
        TSTART(32)
        if (kt < kt_hi) { KNORM(kreg); *(LAS u32x4*)(F.lds + AT_K + (cur ^ 1) * AT_KSZ + kst) = kreg; *(LAS u32x4*)(F.lds + AT_V + (cur ^ 1) * AT_VSZ + vst) = vreg; mw = mwn; }
        TSTOP(32)
        TSTART(33)
        __syncthreads();
        TSTOP(33)
    }
    TSTART(34)
    l_run += __shfl_xor(l_run, 32);
    if (!ISB) l_run += __builtin_amdgcn_exp2f(F.sinks[h] * LOG2E - m_run);
    const float inv = 1.0f / l_run;
    LAS unsigned char* ost = F.lds + AT_OST + wid * AT_OSTSZ;
#pragma unroll
    for (int d1 = 0; d1 < 2; ++d1)
#pragma unroll
        for (int g4 = 0; g4 < 4; ++g4) { u32x2 w; w.x = pkh(o[d1][4 * g4] * inv, o[d1][4 * g4 + 1] * inv); w.y = pkh(o[d1][4 * g4 + 2] * inv, o[d1][4 * g4 + 3] * inv);
            *(LAS u32x2*)(ost + q * 144 + (32 * d1 + 8 * g4 + 4 * hi) * 2) = w; }
    LDS_WAIT(); asm volatile("" ::: "memory");
    h16* Yp = (h16*)(F.ws + WS_Y);
#pragma unroll
    for (int i = 0; i < 4; ++i) { const int rr = i * 8 + (lane >> 3), ch = lane & 7; const size_t grow = (size_t)b * SEQ + r0 + rr;
        const h16x8 ov = *(const LAS h16x8*)(ost + rr * 144 + ch * 16); const h16x8 zv = *(const h16x8*)(Zp + grow * 512 + ch * 8);
        float y[8];
#pragma unroll
        for (int e = 0; e < 8; ++e) { const float z = (float)zv[e]; y[e] = (float)ov[e] * z * sigmoidf_fast(z); }
        u32x4 w; w.x = pkh(y[0], y[1]); w.y = pkh(y[2], y[3]); w.z = pkh(y[4], y[5]); w.w = pkh(y[6], y[7]);
        *(u32x4*)(Yp + grow * 1024 + ycol + ch * 8) = w; }
    __syncthreads();
    TSTOP(34)
#undef KNORM
}
__device__ __forceinline__ void p3_attention_phase(Frame& F) {
    for (int v = F.vcu; v < 256; v += F.G) {
        const int bh = v >> 2, j = v & 3, b = bh >> 3, h = bh & 7;
        attn_unit<true>(F, b, h, 7 - j); attn_unit<true>(F, b, h, j);
        attn_unit<false>(F, b, h, 2 * j); attn_unit<false>(F, b, h, 2 * j + 1);
    }
}

struct Args { const float* in[12]; float* out; unsigned char* ws; int ph_lo, ph_hi; };
constexpr int N_PHASES = 6;
__global__ void __launch_bounds__(NTHREADS, 2) mk_fwd(Args args) {
    extern __shared__ __attribute__((aligned(16))) unsigned char lds_raw[];
    cg::grid_group grid = cg::this_grid();
    Frame F;
    F.lds = (LAS unsigned char*)lds_raw;
    F.tid = threadIdx.x; F.lane = F.tid & 63; F.wave = __builtin_amdgcn_readfirstlane(F.tid >> 6);
    F.G = gridDim.x; { const int bx = blockIdx.x; F.vcu = (F.G % 8 == 0) ? (bx % 8) * (F.G / 8) + bx / 8 : bx; }
    F.ws = args.ws; F.prof = 0ull;
    F.x = args.in[0]; F.norm_g = args.in[1]; F.w_in = args.in[2]; F.qna = args.in[3]; F.kna = args.in[4]; F.sinks = args.in[5];
    F.qnb = args.in[6]; F.knb = args.in[7]; F.relb = args.in[8]; F.wpa = args.in[9]; F.wpb = args.in[10]; F.wout = args.in[11]; F.out = args.out;
    const int lo = args.ph_lo, hi = args.ph_hi;
    if (lo < 0) grid.sync();
    if (F.tid < 64) ((LAS unsigned*)(F.lds + LDSCTL_OFF))[F.tid] = 0u;
    __syncthreads();
    XcdBarrier bar = xcd_barrier_post((unsigned*)(F.ws + WS_CTL), (volatile LAS unsigned*)(F.lds + LDSCTL_OFF) + 8);
#ifdef ONLY_PH
#define IN(k) ((k) == ONLY_PH && lo <= (k) && (k) < hi)
#else
#define IN(k) (lo <= (k) && (k) < hi)
#endif
#ifdef PROBE_SYNC2
#define SEAM(k) do { if (IN(k) && IN((k) + 1)) { xcd_barrier(bar); xcd_barrier(bar); } } while (0)
#else
#define SEAM(k) do { if (IN(k) && IN((k) + 1)) xcd_barrier(bar); } while (0)
#endif
    { TSTART(1) if (IN(0)) { p0_prologue(F); }
    SEAM(0); TSTOP(1) }
    TSTART(2)
    if (IN(1)) {
        pg8::GemmPlain g{(const h16*)(F.ws + WS_H), (const h16*)(F.ws + WS_WIN), 1024, 1024};
        pg8::StaticOrder S; S.init(MROWS, 23 * 256, F.G, (int)blockIdx.x);
        pg8::EpiIn E{F.ws, (h16*)F.out};
        pg8::gemm_phase<pg8::EpiIn, pg8::StaticOrder, pg8::GemmPlain, true, true>(F.lds, g, S, E);
    }
    SEAM(1);
    TSTOP(2)
    { TSTART(3) if (IN(2)) { p2_index_phase(F); }
    SEAM(2); TSTOP(3) }
    { TSTART(4) if (IN(3)) { p3_attention_phase(F); }
    SEAM(3); TSTOP(4) }
    TSTART(5)
    if (IN(4)) {
        pg8::GemmPlain g{(const h16*)(F.ws + WS_Y), (const h16*)(F.ws + WS_WP), 1024, 1024};
        pg8::StaticOrder S; S.init(MROWS, DM, F.G, (int)blockIdx.x);
        pg8::EpiMerge E{(const h16*)F.out, (h16*)(F.ws + WS_MG)};
        pg8::gemm_phase<pg8::EpiMerge, pg8::StaticOrder, pg8::GemmPlain, true, true>(F.lds, g, S, E);
    }
    SEAM(4);
    TSTOP(5)
    TSTART(6)
    if (IN(5)) {
        pg8::GemmPlain g{(const h16*)(F.ws + WS_MG), (const h16*)(F.ws + WS_WO), 1024, 1024};
        pg8::StaticOrder S; S.init(MROWS, DM, F.G, (int)blockIdx.x);
        pg8::EpiOut E{F.x, F.out};
        pg8::gemm_phase<pg8::EpiOut, pg8::StaticOrder, pg8::GemmPlain, true, true>(F.lds, g, S, E);
    }
    TSTOP(6)
#undef IN
#undef SEAM
#ifdef PROF_SEG
    if (blockIdx.x == PROF_BLK && F.wave == PROF_WAVE && hi == N_PHASES) { const unsigned long long t1 = __builtin_amdgcn_s_memrealtime() + F.prof * PROF_MULT; while (__builtin_amdgcn_s_memrealtime() < t1) __builtin_amdgcn_s_sleep(8); }
#endif
}

extern "C" void kernel_launch(void* const* d_in, const int* in_sizes, int n_in, void* d_out, int out_size, void* d_ws, size_t ws_size, hipStream_t stream) {
    static int grid = 0;
    if (grid == 0) {
        if (n_in != 12 || in_sizes[0] != MROWS * DM || out_size != MROWS * DM || ws_size < WS_END) { fprintf(stderr, "kernel_launch: unexpected problem (n_in %d, ws %zu)\n", n_in, ws_size); grid = -1; return; }
        int dev = 0, cus = 0, per_cu = 0;
        hipGetDevice(&dev); hipDeviceGetAttribute(&cus, hipDeviceAttributeMultiprocessorCount, dev);
        hipFuncSetAttribute((const void*)mk_fwd, hipFuncAttributeMaxDynamicSharedMemorySize, LDS_BYTES);
        hipOccupancyMaxActiveBlocksPerMultiprocessor(&per_cu, (const void*)mk_fwd, NTHREADS, LDS_BYTES);
        (void)hipGetLastError();
        if (per_cu < 1) { fprintf(stderr, "kernel_launch: occupancy query says %d blocks/CU\n", per_cu); per_cu = 1; }
        grid = cus;
        if (grid > 256) grid = 256;
    }
    if (grid < 0) return;
    (void)hipMemsetAsync((char*)d_ws + WS_CTL, 0, CTL_BYTES, stream);
    Args a{};
    for (int i = 0; i < 12; ++i) a.in[i] = (const float*)d_in[i];
    a.out = (float*)d_out; a.ws = (unsigned char*)d_ws;
#ifdef PROBE_PH
    {
        void* kargs[] = {&a};
        a.ph_lo = 0; a.ph_hi = PROBE_PH + 1;
        (void)hipLaunchCooperativeKernel((const void*)mk_fwd, dim3(grid), dim3(NTHREADS), kargs, LDS_BYTES, stream);
        (void)hipMemsetAsync((char*)d_ws + WS_CTL, 0, CTL_BYTES, stream);
#ifdef PROBE_SPLIT_ONLY
        a.ph_lo = PROBE_PH + 1; a.ph_hi = N_PHASES;
#else
        a.ph_lo = PROBE_PH; a.ph_hi = N_PHASES;
#endif
        (void)hipLaunchCooperativeKernel((const void*)mk_fwd, dim3(grid), dim3(NTHREADS), kargs, LDS_BYTES, stream);
    }
#else
    {
        a.ph_lo = 0; a.ph_hi = N_PHASES;
        void* kargs[] = {&a};
        hipError_t e = hipLaunchCooperativeKernel((const void*)mk_fwd, dim3(grid), dim3(NTHREADS), kargs, LDS_BYTES, stream);
        if (e != hipSuccess) fprintf(stderr, "cooperative launch failed: %s (grid %d)\n", hipGetErrorString(e), grid);
    }
#endif
}
```

```cpp
#include <hip/hip_runtime.h>
#include <hip/hip_cooperative_groups.h>
#include <cstdio>
#include <cstdint>
namespace cg = cooperative_groups;
#ifdef PROF_SEG
#ifndef PROF_MULT
#define PROF_MULT 4
#endif
#ifndef PROF_BLK
#define PROF_BLK 100
#endif
#ifndef PROF_WAVE
#define PROF_WAVE 3
#endif
#endif

#define LAS __attribute__((address_space(3)))
typedef _Float16 h16;
typedef _Float16 h16x2 __attribute__((ext_vector_type(2)));
typedef _Float16 h16x4 __attribute__((ext_vector_type(4)));
typedef _Float16 h16x8 __attribute__((ext_vector_type(8)));
typedef float f32x2 __attribute__((ext_vector_type(2)));
typedef float f32x4 __attribute__((ext_vector_type(4)));
typedef float f32x16 __attribute__((ext_vector_type(16)));
typedef unsigned u32x2 __attribute__((ext_vector_type(2)));
typedef unsigned u32x4 __attribute__((ext_vector_type(4)));
typedef short s16x4 __attribute__((ext_vector_type(4)));

__device__ __forceinline__ unsigned pkh(float lo, float hi) { const f32x2 v = {lo, hi}; const h16x2 h = __builtin_convertvector(v, h16x2); return __builtin_bit_cast(unsigned, h); }
__device__ __forceinline__ float sigmoidf_fast(float g) { g = fminf(fmaxf(g, -30.f), 30.f); return __builtin_amdgcn_rcpf(1.0f + __builtin_amdgcn_exp2f(-1.4426950408889634f * g)); }

constexpr int NBATCH = 8, SEQ = 2048, DM = 1024, MROWS = NBATCH * SEQ, INW = 5672;
constexpr float RMS_EPS = 1e-6f, LOG2E = 1.4426950408889634f, QSCALE = 0.125f * 1.4426950408889634f;
constexpr float HSCALE = 16.f, WSCALE = 64.f, INV_HW = 1.0f / (16.f * 64.f);
constexpr size_t MiB = 1u << 20;
constexpr size_t WS_H = 0;
constexpr size_t WS_Y = 0, WS_MG = 32 * MiB;
constexpr size_t WS_QH = 32 * MiB, WS_QL = 40 * MiB, WS_KH = 48 * MiB, WS_KL = 49 * MiB, WS_WI = 50 * MiB;
constexpr size_t WS_WIN = 64 * MiB;
constexpr size_t WS_WP = 77 * MiB, WS_WO = 79 * MiB;
constexpr size_t WS_QA = 81 * MiB, WS_KVA = 97 * MiB, WS_ZA = 105 * MiB, WS_QB = 121 * MiB, WS_KB = 137 * MiB, WS_VB = 153 * MiB, WS_ZB = 169 * MiB;
constexpr size_t WS_MASK = 185 * MiB;
constexpr size_t WS_CTL = 190 * MiB, CTL_BYTES = 16384;
constexpr size_t WS_END = 191 * MiB;

namespace pg8 {
#define PG8_LAS __attribute__((address_space(3)))
constexpr int BM = 256, BK = 64, HALF = 128, HTB = HALF * BK * 2  , STAGE_BYTES = 8 * HTB, NXCD = 8, WGM = 8;

__host__ __device__ __forceinline__ int lds_byte(int r, int c) { const int st = (r >> 4) * 2 + (c >> 5), rr = r & 15, cc = c & 31, ob = rr * 64 + cc * 2; return st * 1024 + (ob ^ (((ob >> 9) & 1) << 5)); }
__host__ __device__ __forceinline__ void stage_rc(int b, int& R, int& C) { const int st = b / 1024, sb = b % 1024, swz = sb ^ (((sb >> 9) & 1) << 5); R = (st >> 1) * 16 + swz / 64; C = (st & 1) * 32 + (swz % 64) / 2; }
__host__ __device__ __forceinline__ int perm32(int rho) { const int n = rho >> 4, i = rho & 15; return 8 * (i >> 2) + 4 * n + (i & 3); }

struct Unit { int pm, pn; };

struct StaticOrder {
    int nM, nN, nwg, G, c;
    __host__ __device__ void init(int M, int N, int G_, int c_) { nM = M / BM; nN = N / BM; nwg = nM * nN; G = G_; c = c_; }
    __host__ __device__ bool next(int i, Unit& u) const {
        const long L = (long)i * G + c; if (L >= nwg) return false;
        int wgid = (int)L; { const int q = nwg / NXCD, r = nwg % NXCD, xcd = wgid % NXCD, off = wgid / NXCD; wgid = (xcd < r ? xcd * (q + 1) : r * (q + 1) + (xcd - r) * q) + off; }
        const int nig = WGM * nN, gid = wgid / nig, fm = gid * WGM, gsz = (nM - fm) < WGM ? (nM - fm) : WGM;
        u.pm = fm + ((wgid % nig) % gsz); u.pn = (wgid % nig) / gsz; return true;
    }
    __device__ __forceinline__ void a_ready(const Unit&) const {}
    __device__ __forceinline__ void done(const Unit&) const {}
};

struct GemmPlain { const h16* A; const h16* Bt; int lda, K;
    __device__ __forceinline__ const char* aptr(const Unit& u) const { return (const char*)(A + (size_t)u.pm * BM * lda); }
    __device__ __forceinline__ const char* bptr(const Unit& u) const { return (const char*)(Bt + (size_t)u.pn * BM * K); } };
struct EpiIn {
    static constexpr bool PERM = true, AFTER_DRAIN = false, MID = false;
    unsigned char* ws; h16* G;
    __device__ __forceinline__ void operator()(const f32x4 (&acc)[2][2][4][2], const Unit& u, int wr, int wc, int fr, int fq) const {
        const int pn = u.pn, row0 = u.pm * BM + wr * 64 + fr, cl = wc * 32 + 8 * fq;
        if (pn < 21) {
            h16* base; int ldc, colt;
            if (pn < 2)       { base = (h16*)(ws + WS_QA);  ldc = 512; colt = pn * 256; }
            else if (pn == 2) { base = (h16*)(ws + WS_KVA); ldc = 256; colt = 0; }
            else if (pn < 5)  { base = (h16*)(ws + WS_ZA);  ldc = 512; colt = (pn - 3) * 256; }
            else if (pn < 7)  { base = (h16*)(ws + WS_QB);  ldc = 512; colt = (pn - 5) * 256; }
            else if (pn < 9)  { base = (h16*)(ws + WS_KB);  ldc = 512; colt = (pn - 7) * 256; }
            else if (pn < 11) { base = (h16*)(ws + WS_VB);  ldc = 512; colt = (pn - 9) * 256; }
            else if (pn < 13) { base = (h16*)(ws + WS_ZB);  ldc = 512; colt = (pn - 11) * 256; }
            else              { base = G;                   ldc = 2048; colt = (pn - 13) * 256; }
#pragma unroll
            for (int ai = 0; ai < 2; ++ai)
#pragma unroll
                for (int m = 0; m < 4; ++m) { h16* rowp = base + (size_t)(row0 + ai * HALF + m * 16) * ldc + colt + cl;
#pragma unroll
                    for (int bj = 0; bj < 2; ++bj) { const f32x4 v0 = acc[ai][bj][m][0] * INV_HW, v1 = acc[ai][bj][m][1] * INV_HW;
                        u32x4 w; w.x = pkh(v0[0], v0[1]); w.y = pkh(v0[2], v0[3]); w.z = pkh(v1[0], v1[1]); w.w = pkh(v1[2], v1[3]);
                        *(u32x4*)(rowp + bj * HALF) = w; } }
        } else {
            const int colt = (pn - 21) * 256 + cl;
#pragma unroll
            for (int ai = 0; ai < 2; ++ai)
#pragma unroll
                for (int m = 0; m < 4; ++m) { const size_t r = (size_t)(row0 + ai * HALF + m * 16);
#pragma unroll
                    for (int bj = 0; bj < 2; ++bj) { const int j = colt + bj * HALF; const f32x4 v0 = acc[ai][bj][m][0] * INV_HW, v1 = acc[ai][bj][m][1] * INV_HW;
                        if (j < 288) {
                            u32x4 hi; hi.x = pkh(v0[0] * 16.f, v0[1] * 16.f); hi.y = pkh(v0[2] * 16.f, v0[3] * 16.f); hi.z = pkh(v1[0] * 16.f, v1[1] * 16.f); hi.w = pkh(v1[2] * 16.f, v1[3] * 16.f);
                            if (j < 256) *(u32x4*)((h16*)(ws + WS_QH) + r * 256 + j) = hi; else *(u32x4*)((h16*)(ws + WS_KH) + r * 32 + (j - 256)) = hi;
                        } else if (j < 296) { float* w = (float*)(ws + WS_WI) + r * 8; *(f32x4*)w = v0; *(f32x4*)(w + 4) = v1; }
                    } }
        }
    }
};
struct EpiMerge {
    static constexpr bool PERM = true, AFTER_DRAIN = false, MID = true;
    const h16* G; h16* MG;
    __device__ __forceinline__ void mid(f32x4 (&acc)[2][2][4][2], const Unit& u, int wr, int wc, int fr, int fq) const {
        const int row0 = u.pm * BM + wr * 64 + fr, col0 = u.pn * BM + wc * 32 + 8 * fq;
#pragma unroll
        for (int ai = 0; ai < 2; ++ai)
#pragma unroll
            for (int m = 0; m < 4; ++m) { unsigned ro = (unsigned)(row0 + ai * HALF + m * 16); asm volatile("" : "+v"(ro)); const h16* gp = G + (size_t)ro * 2048 + col0;
#pragma unroll
                for (int bj = 0; bj < 2; ++bj) { const h16x8 ga = *(const h16x8*)(gp + bj * HALF), gb = *(const h16x8*)(gp + 1024 + bj * HALF);
#pragma unroll
                    for (int e = 0; e < 8; ++e) { const float a = fminf(fmaxf((float)ga[e], -30.f), 30.f), b = fminf(fmaxf((float)gb[e], -30.f), 30.f);
                        const float f = (1.0f + __builtin_amdgcn_exp2f(-LOG2E * b)) * __builtin_amdgcn_rcpf(1.0f + __builtin_amdgcn_exp2f(-LOG2E * a));
                        acc[ai][bj][m][e >> 2][e & 3] *= f; } }
                asm volatile("" ::: "memory"); }
    }
    __device__ __forceinline__ void operator()(const f32x4 (&acc)[2][2][4][2], const Unit& u, int wr, int wc, int fr, int fq) const {
        const int row0 = u.pm * BM + wr * 64 + fr, col0 = u.pn * BM + wc * 32 + 8 * fq;
#pragma unroll
        for (int ai = 0; ai < 2; ++ai)
#pragma unroll
            for (int m = 0; m < 4; ++m) { unsigned ro = (unsigned)(row0 + ai * HALF + m * 16); asm volatile("" : "+v"(ro)); const size_t r = (size_t)ro;
#pragma unroll
                for (int bj = 0; bj < 2; ++bj) { const h16x8 gb = *(const h16x8*)(G + r * 2048 + 1024 + col0 + bj * HALF);
                    float o[8];
#pragma unroll
                    for (int e = 0; e < 8; ++e) o[e] = acc[ai][bj][m][e >> 2][e & 3] * sigmoidf_fast((float)gb[e]);
                    u32x4 w; w.x = pkh(o[0], o[1]); w.y = pkh(o[2], o[3]); w.z = pkh(o[4], o[5]); w.w = pkh(o[6], o[7]);
                    *(u32x4*)(MG + r * 1024 + col0 + bj * HALF) = w; } }
    }
};
struct EpiOut {
    static constexpr bool PERM = true, AFTER_DRAIN = false, MID = false;
    const float* x; float* out;
    __device__ __forceinline__ void operator()(const f32x4 (&acc)[2][2][4][2], const Unit& u, int wr, int wc, int fr, int fq) const {
        const int row0 = u.pm * BM + wr * 64 + fr, col0 = u.pn * BM + wc * 32 + 8 * fq;
#pragma unroll
        for (int ai = 0; ai < 2; ++ai)
#pragma unroll
            for (int m = 0; m < 4; ++m) { const size_t off = (size_t)(row0 + ai * HALF + m * 16) * DM + col0;
#pragma unroll
                for (int bj = 0; bj < 2; ++bj)
#pragma unroll
                    for (int n = 0; n < 2; ++n) { const f32x4 xv = *(const f32x4*)(x + off + bj * HALF + 4 * n); *(f32x4*)(out + off + bj * HALF + 4 * n) = xv + acc[ai][bj][m][n]; }
                if (m & 1) asm volatile("" ::: "memory"); }
    }
};

template <class Epi, class Sched, class GemmT, bool ALIGN_EPI = false, bool SP2 = false>
__device__ __forceinline__ void gemm_phase(PG8_LAS unsigned char* lds, const GemmT g, const Sched& S, const Epi& E) {
    const int tid = threadIdx.x, wid = __builtin_amdgcn_readfirstlane(tid >> 6), lane = tid & 63, wr = wid >> 2, wc = wid & 3, fr = lane & 15, fq = lane >> 4;
    const int K = g.K, nt = K / BK;
    unsigned voffA[2], voffB[2];
#pragma unroll
    for (int i = 0; i < 2; ++i) { int R, C; stage_rc(tid * 16 + i * 8192, R, C); const int Rb = Epi::PERM ? ((R & ~31) + perm32(R & 31)) : R;
        voffA[i] = (unsigned)(R * g.lda + C) * 2u; voffB[i] = (unsigned)(Rb * K + C) * 2u; }
    const size_t kstep = (size_t)(BK * 2);
    const size_t hstepA = (size_t)HALF * g.lda * 2, hstepB = (size_t)HALF * K * 2;
    const unsigned ldsw = (unsigned)wid * 1024u;
    const int aoff = lds_byte(wr * 64 + fr, fq * 8), boff = lds_byte(wc * 32 + fr, fq * 8);
#define PG8_SA(b, h) (((b) * 2 + (h)) * HTB)
#define PG8_SB(b, h) ((4 + (b) * 2 + (h)) * HTB)
#define PG8_STAGE(bufoff, gbase, voff) do { _Pragma("unroll") for (int _i = 0; _i < 2; ++_i) \
        __builtin_amdgcn_global_load_lds((const unsigned*)((const char*)(gbase) + (voff)[_i]), (PG8_LAS unsigned*)(lds + (bufoff) + ldsw + _i * 8192), 16, 0, 0); } while (0)
#define PG8_LDA(dst, b, h) do { _Pragma("unroll") for (int m = 0; m < 4; ++m) _Pragma("unroll") for (int k = 0; k < 2; ++k) dst[m][k] = *(const PG8_LAS h16x8*)(lds + PG8_SA(b, h) + aoff + m * 2048 + k * 1024); } while (0)
#define PG8_LDB(dst, b, h) do { _Pragma("unroll") for (int n = 0; n < 2; ++n) _Pragma("unroll") for (int k = 0; k < 2; ++k) dst[n][k] = *(const PG8_LAS h16x8*)(lds + PG8_SB(b, h) + boff + n * 2048 + k * 1024); } while (0)
#define PG8_MMA(ai, bj, At, Bt) do { __builtin_amdgcn_s_setprio(1); _Pragma("unroll") for (int m = 0; m < 4; ++m) _Pragma("unroll") for (int n = 0; n < 2; ++n) _Pragma("unroll") for (int k = 0; k < 2; ++k) \
        acc[ai][bj][m][n] = __builtin_amdgcn_mfma_f32_16x16x32_f16(Bt[n][k], At[m][k], acc[ai][bj][m][n], 0, 0, 0); __builtin_amdgcn_s_setprio(0); } while (0)
#define PG8_WAIT_V(n) asm volatile("s_waitcnt vmcnt(" #n ")" ::: "memory")
#define PG8_WAIT_L(n) asm volatile("s_waitcnt lgkmcnt(" #n ")" ::: "memory")
#define PG8_BAR __builtin_amdgcn_s_barrier()
#define PG8_SCHED __builtin_amdgcn_sched_barrier(0)
    Unit cur, nxt; int ui = 0;
    if (!S.next(0, cur)) return;
    f32x4 acc[2][2][4][2];
#pragma unroll
    for (int a = 0; a < 2; ++a)
#pragma unroll
        for (int b = 0; b < 2; ++b)
#pragma unroll
            for (int m = 0; m < 4; ++m)
#pragma unroll
                for (int n = 0; n < 2; ++n) acc[a][b][m][n] = (f32x4){0.f, 0.f, 0.f, 0.f};
    h16x8 At[4][2], B0[2][2], B1[2][2];
    const char* cA = g.aptr(cur); const char* cB = g.bptr(cur);
    S.a_ready(cur);
    if constexpr (SP2) {
        PG8_STAGE(PG8_SB(0, 0), cB, voffB); PG8_STAGE(PG8_SB(0, 1), cB + hstepB, voffB); PG8_STAGE(PG8_SA(0, 0), cA, voffA); PG8_STAGE(PG8_SA(0, 1), cA + hstepA, voffA);
        if (wr == 1) PG8_BAR;
        PG8_WAIT_V(2); PG8_BAR;
        PG8_STAGE(PG8_SB(1, 0), cB + kstep, voffB); PG8_STAGE(PG8_SA(1, 0), cA + kstep, voffA); PG8_STAGE(PG8_SB(1, 1), cB + hstepB + kstep, voffB);
        PG8_WAIT_V(6); PG8_BAR;
    } else {
        PG8_STAGE(PG8_SB(0, 0), cB, voffB); PG8_STAGE(PG8_SA(0, 0), cA, voffA); PG8_STAGE(PG8_SB(0, 1), cB + hstepB, voffB); PG8_STAGE(PG8_SA(0, 1), cA + hstepA, voffA);
        if (wr == 1) PG8_BAR;
        PG8_WAIT_V(4); PG8_BAR;
        PG8_STAGE(PG8_SB(1, 0), cB + kstep, voffB); PG8_STAGE(PG8_SA(1, 0), cA + kstep, voffA); PG8_STAGE(PG8_SB(1, 1), cB + hstepB + kstep, voffB);
        PG8_WAIT_V(6); PG8_BAR;
    }
    for (;;) {
        const bool has_next = S.next(ui + 1, nxt);
        const char* nA = has_next ? g.aptr(nxt) : cA; const char* nB = has_next ? g.bptr(nxt) : cB;
        for (int t = 0; t < nt; t += 2) {
            const bool last = (t == nt - 2);
            const char* a1 = cA + (size_t)(t + 1) * kstep;
            const char* a2 = last ? nA : cA + (size_t)(t + 2) * kstep; const char* b2 = last ? nB : cB + (size_t)(t + 2) * kstep;
            const char* a3 = a2 + kstep; const char* b3 = b2 + kstep;
            if (last && has_next) S.a_ready(nxt);
            if constexpr (Epi::MID) { if (t == nt / 2) E.mid(acc, cur, wr, wc, fr, fq); }
            if constexpr (SP2) {
            PG8_LDB(B0, 0, 0); PG8_LDB(B1, 0, 1); PG8_SCHED; PG8_LDA(At, 0, 0); PG8_STAGE(PG8_SA(1, 1), a1 + hstepA, voffA);
            PG8_WAIT_V(8); PG8_WAIT_L(0); PG8_BAR; PG8_MMA(0, 0, At, B0); PG8_MMA(0, 1, At, B1); PG8_BAR; PG8_SCHED;
            PG8_LDA(At, 0, 1); PG8_STAGE(PG8_SB(0, 0), b2, voffB); PG8_STAGE(PG8_SB(0, 1), b2 + hstepB, voffB); PG8_STAGE(PG8_SA(0, 0), a2, voffA);
            PG8_WAIT_V(8); PG8_WAIT_L(0); PG8_BAR; PG8_MMA(1, 0, At, B0); PG8_MMA(1, 1, At, B1); PG8_BAR; PG8_SCHED;
            PG8_LDB(B0, 1, 0); PG8_LDB(B1, 1, 1); PG8_SCHED; PG8_LDA(At, 1, 0); PG8_STAGE(PG8_SA(0, 1), a2 + hstepA, voffA);
            PG8_WAIT_V(8); PG8_WAIT_L(0); PG8_BAR; PG8_MMA(0, 0, At, B0); PG8_MMA(0, 1, At, B1); PG8_BAR; PG8_SCHED;
            PG8_LDA(At, 1, 1); PG8_STAGE(PG8_SB(1, 0), b3, voffB); PG8_STAGE(PG8_SB(1, 1), b3 + hstepB, voffB); PG8_STAGE(PG8_SA(1, 0), a3, voffA);
            PG8_WAIT_V(8); PG8_WAIT_L(0); PG8_BAR; PG8_MMA(1, 0, At, B0); PG8_MMA(1, 1, At, B1); PG8_BAR; PG8_SCHED;
            } else {
            PG8_LDB(B0, 0, 0); PG8_SCHED; PG8_LDA(At, 0, 0); PG8_STAGE(PG8_SA(1, 1), a1 + hstepA, voffA);
            PG8_WAIT_L(8); PG8_BAR; PG8_WAIT_L(0); PG8_MMA(0, 0, At, B0); PG8_BAR; PG8_SCHED;
            PG8_LDB(B1, 0, 1); PG8_STAGE(PG8_SB(0, 0), b2, voffB);
            PG8_BAR; PG8_WAIT_L(0); PG8_MMA(0, 1, At, B1); PG8_BAR;
            PG8_LDA(At, 0, 1); PG8_STAGE(PG8_SA(0, 0), a2, voffA);
            PG8_BAR; PG8_WAIT_L(0); PG8_MMA(1, 0, At, B0); PG8_BAR; PG8_SCHED;
            PG8_STAGE(PG8_SB(0, 1), b2 + hstepB, voffB);
            PG8_WAIT_V(6); PG8_BAR; PG8_MMA(1, 1, At, B1); PG8_BAR;
            PG8_LDB(B0, 1, 0); PG8_SCHED; PG8_LDA(At, 1, 0); PG8_STAGE(PG8_SA(0, 1), a2 + hstepA, voffA);
            PG8_WAIT_L(8); PG8_BAR; PG8_WAIT_L(0); PG8_MMA(0, 0, At, B0); PG8_BAR; PG8_SCHED;
            PG8_LDB(B1, 1, 1); PG8_STAGE(PG8_SB(1, 0), b3, voffB);
            PG8_BAR; PG8_WAIT_L(0); PG8_MMA(0, 1, At, B1); PG8_BAR;
            PG8_LDA(At, 1, 1); PG8_STAGE(PG8_SA(1, 0), a3, voffA);
            PG8_BAR; PG8_WAIT_L(0); PG8_MMA(1, 0, At, B0); PG8_BAR; PG8_SCHED;
            PG8_STAGE(PG8_SB(1, 1), b3 + hstepB, voffB);
            PG8_WAIT_V(6); PG8_BAR; PG8_MMA(1, 1, At, B1); PG8_BAR;
            }
        }
        if constexpr (ALIGN_EPI) { if (wr == 0) PG8_BAR; }
        if constexpr (!Epi::AFTER_DRAIN) { E(acc, cur, wr, wc, fr, fq); S.done(cur); }
        if (!has_next) break;
#pragma unroll
        for (int a = 0; a < 2; ++a)
#pragma unroll
            for (int b = 0; b < 2; ++b)
#pragma unroll
                for (int m = 0; m < 4; ++m)
#pragma unroll
                    for (int n = 0; n < 2; ++n) acc[a][b][m][n] = (f32x4){0.f, 0.f, 0.f, 0.f};
        cur = nxt; cA = nA; cB = nB; ++ui;
        if constexpr (ALIGN_EPI) { if (wr == 1) PG8_BAR; }
    }
    PG8_WAIT_V(0);
    if constexpr (!ALIGN_EPI) { if (wr == 0) PG8_BAR; }
    PG8_BAR;
    if constexpr (Epi::AFTER_DRAIN) { E.fused(acc, cur, wr, wc, fr, fq, lds, wid, lane); S.done(cur); }
#undef PG8_SA
#undef PG8_SB
#undef PG8_STAGE
#undef PG8_LDA
#undef PG8_LDB
#undef PG8_MMA
#undef PG8_WAIT_V
#undef PG8_WAIT_L
#undef PG8_BAR
#undef PG8_SCHED
}
}

constexpr int NWAVES = 8, NTHREADS = 512;
constexpr int RING_BYTES = 131072, LDSCTL_OFF = 159744, LDS_BYTES = 163840;
#define LDS_WAIT() asm volatile("s_waitcnt lgkmcnt(0)" ::: "memory")
#ifdef PROF_SEG
#define TSTART(id) unsigned long long t0_##id = 0; if ((id) == PROF_SEG) { asm volatile("s_waitcnt vmcnt(0) lgkmcnt(0)" ::: "memory"); t0_##id = __builtin_amdgcn_s_memrealtime(); }
#define TSTOP(id) if ((id) == PROF_SEG) { asm volatile("s_waitcnt vmcnt(0) lgkmcnt(0)" ::: "memory"); F.prof += __builtin_amdgcn_s_memrealtime() - t0_##id; }
#else
#define TSTART(id)
#define TSTOP(id)
#endif

#define XB_TMO      128
#define XB_XCNT(j)  (256  + 64 * (j))
#define XB_XSUB(j)  (1280 + 64 * (j))
#define XB_XGEN(j)  (2304 + 64 * (j))
#define XB_TOP      3328
#define XB_TOPGEN   3392
#define XCD_BAR_WORDS 3456
#define XB_SPIN_CAP (1u << 18)

__device__ __forceinline__ unsigned xb_ld(unsigned* p)              { return __hip_atomic_load(p, __ATOMIC_RELAXED, __HIP_MEMORY_SCOPE_AGENT); }
__device__ __forceinline__ unsigned xb_add(unsigned* p, unsigned v) { return __hip_atomic_fetch_add(p, v, __ATOMIC_RELAXED, __HIP_MEMORY_SCOPE_AGENT); }
__device__ __forceinline__ unsigned xb_xcc_id() { return (unsigned)__builtin_amdgcn_s_getreg((3 << 11) | 20) & 0xFu; }
#define XB_SPIN(cond, bar) do { unsigned _sp = 0; while (cond) { __builtin_amdgcn_s_sleep(1); \
    if ((++_sp & 255u) == 0u) { if (xb_ld(&(bar)[XB_TMO])) break; if (_sp > XB_SPIN_CAP) { atomicAdd(&(bar)[XB_TMO], 1u); break; } } } } while (0)

struct XcdBarrier {
    unsigned* bar; unsigned x;
    volatile LAS unsigned* st;
};

__device__ __forceinline__ XcdBarrier xcd_barrier_post(unsigned* bar, volatile LAS unsigned* st) {
    XcdBarrier b; b.bar = bar; b.x = xb_xcc_id(); b.st = st;
    if (threadIdx.x == 0) (void)xb_add(&bar[XB_XCNT(b.x)], 1u);
    return b;
}
__device__ __forceinline__ void xcd_barrier_complete(unsigned* bar, unsigned x, unsigned& nloc, unsigned& nx) {
    const unsigned G = gridDim.x * gridDim.y * gridDim.z;
    unsigned sum, cnt, mine, sp = 0u;
    for (;;) {
        sum = 0u; cnt = 0u; mine = 0u;
#pragma unroll
        for (unsigned j = 0; j < 16; ++j) { const unsigned c = xb_ld(&bar[XB_XCNT(j)]); sum += c; cnt += (c > 0u) ? 1u : 0u; mine = (j == x) ? c : mine; }
        if (sum == G) break;
        __builtin_amdgcn_s_sleep(1);
        if ((++sp & 255u) == 0u) { if (xb_ld(&bar[XB_TMO])) break; if (sp > XB_SPIN_CAP) { atomicAdd(&bar[XB_TMO], 1u); break; } }
    }
    nloc = mine > 0u ? mine : 1u; nx = cnt > 0u ? cnt : 1u;
}

__device__ __forceinline__ void xcd_barrier(const XcdBarrier& b) {
    asm volatile("s_waitcnt vmcnt(0)" ::: "memory");
    __syncthreads();
    if (threadIdx.x == 0) {
        unsigned* bar = b.bar;
        __builtin_amdgcn_s_waitcnt(0);
        unsigned nloc = b.st[0], nx = b.st[1];
        if (nloc == 0u) { xcd_barrier_complete(bar, b.x, nloc, nx); b.st[0] = nloc; b.st[1] = nx; }
        const unsigned old = xb_add(&bar[XB_XSUB(b.x)], 1u);
        const unsigned gen = old / nloc;
        if (old + 1u == (gen + 1u) * nloc) {
            __builtin_amdgcn_fence(__ATOMIC_RELEASE, "agent");
            asm volatile("s_waitcnt vmcnt(0)" ::: "memory");
            const unsigned og = xb_add(&bar[XB_TOP], 1u);
            const unsigned tg = og / nx;
            if (og + 1u == (tg + 1u) * nx) xb_add(&bar[XB_TOPGEN], 1u);
            else XB_SPIN(xb_ld(&bar[XB_TOPGEN]) == tg, bar);
            __builtin_amdgcn_fence(__ATOMIC_ACQUIRE, "agent");
            xb_add(&bar[XB_XGEN(b.x)], 1u);
            asm volatile("s_waitcnt vmcnt(0)" ::: "memory");
        } else {
            XB_SPIN(xb_ld(&bar[XB_XGEN(b.x)]) == gen, bar);
            __builtin_amdgcn_fence(__ATOMIC_ACQUIRE, "agent");
            asm volatile("s_waitcnt vmcnt(0)" ::: "memory");
        }
    }
    __syncthreads();
}

struct Frame {
    LAS unsigned char* lds;
    int tid, lane, wave, vcu, G;
    unsigned char* ws;
    const float *x, *norm_g, *w_in, *qna, *kna, *sinks, *qnb, *knb, *relb, *wpa, *wpb, *wout;
    float* out;
    unsigned long long prof;
};

__device__ __forceinline__ float wave_sum(float v) {
#pragma unroll
    for (int o = 1; o < 64; o <<= 1) v += __shfl_xor(v, o);
    return v;
}
__device__ __forceinline__ int t5_bucket(int n) {
    if (n < 16) return n < 0 ? 0 : n;
    const int l = 16 + (int)(logf((float)n * 0.0625f) / logf(8.0f) * 16.0f);
    return l > 31 ? 31 : l;
}

__device__ __forceinline__ int win_src_col(int n) { return n < 3328 ? n : (n < 5376 ? n + 296 : (n < 5672 ? n - 2048 : -1)); }
template <bool INPROJ>
__device__ __forceinline__ void p0_transpose_item(const float* W, int srcN, int k0, int n0, h16* WT, int ldk, int kdst0, LAS float* scr, int lane, float scale) {
    const int n = n0 + (lane & 31); const int col = INPROJ ? win_src_col(n) : n;
    float wv_[32];
#pragma unroll
    for (int i = 0; i < 32; ++i) { const int kk = 2 * i + (lane >> 5); wv_[i] = (col >= 0) ? W[(size_t)(k0 + kk) * srcN + col] : 0.f; }
#pragma unroll
    for (int i = 0; i < 32; ++i) { const int kk = 2 * i + (lane >> 5); scr[kk * 33 + (lane & 31)] = wv_[i] * scale; }
    LDS_WAIT(); asm volatile("" ::: "memory");
    const int c = lane & 7;
#pragma unroll
    for (int j = 0; j < 4; ++j) { const int nn = (lane >> 3) + 8 * j; const LAS float* s = scr + (8 * c) * 33 + nn;
        float v[8];
#pragma unroll
        for (int e = 0; e < 8; ++e) v[e] = s[e * 33];
        u32x4 o; o.x = pkh(v[0], v[1]); o.y = pkh(v[2], v[3]); o.z = pkh(v[4], v[5]); o.w = pkh(v[6], v[7]);
        *(u32x4*)(WT + (size_t)(n0 + nn) * ldk + kdst0 + k0 + 8 * c) = o;
    }
    LDS_WAIT(); asm volatile("" ::: "memory");
}
__device__ __forceinline__ void p0_norm_rows4(const float* x, const float* g, h16* H, int m0, int mstride, int lane) {
    f32x4 v[4][4];
#pragma unroll
    for (int r = 0; r < 4; ++r)
#pragma unroll
        for (int j = 0; j < 4; ++j) v[r][j] = __builtin_nontemporal_load((const f32x4*)(x + (size_t)(m0 + r * mstride) * DM) + lane + 64 * j);
    f32x4 gg[4];
#pragma unroll
    for (int j = 0; j < 4; ++j) gg[j] = *((const f32x4*)g + lane + 64 * j) * HSCALE;
#pragma unroll
    for (int r = 0; r < 4; ++r) {
        float s = 0.f;
#pragma unroll
        for (int j = 0; j < 4; ++j) s += (v[r][j].x * v[r][j].x + v[r][j].y * v[r][j].y) + (v[r][j].z * v[r][j].z + v[r][j].w * v[r][j].w);
        const float rs = rsqrtf(wave_sum(s) * (1.0f / DM) + RMS_EPS);
#pragma unroll
        for (int j = 0; j < 4; ++j) { const f32x4 hv = v[r][j] * rs * gg[j]; u32x2 hi; hi.x = pkh(hv.x, hv.y); hi.y = pkh(hv.z, hv.w);
            *((u32x2*)(H + (size_t)(m0 + r * mstride) * 1024) + lane + 64 * j) = hi; }
    }
}
__device__ __forceinline__ void p0_prologue(Frame& F) {
    LAS float* scr = (LAS float*)(F.lds + F.wave * 16384);
    const int gw = F.vcu * NWAVES + F.wave, NGW = F.G * NWAVES;
    h16* Win = (h16*)(F.ws + WS_WIN); h16* Wp = (h16*)(F.ws + WS_WP); h16* Wo = (h16*)(F.ws + WS_WO);
    constexpr int I_IN = 16 * 184, I_P = 8 * 32, I_O = 16 * 32;
    constexpr int NITEMS = I_IN + 2 * I_P + I_O;
    for (int it = gw; it < NITEMS; it += NGW) {
        int r = it;
        if (r < I_IN) { p0_transpose_item<true>(F.w_in, INW, 64 * (r / 184), 32 * (r % 184), Win, 1024, 0, scr, F.lane, WSCALE); continue; } r -= I_IN;
        if (r < I_P) { p0_transpose_item<false>(F.wpa, DM, 64 * (r / 32), 32 * (r % 32), Wp, 1024, 0, scr, F.lane, 1.f); continue; } r -= I_P;
        if (r < I_P) { p0_transpose_item<false>(F.wpb, DM, 64 * (r / 32), 32 * (r % 32), Wp, 1024, 512, scr, F.lane, 1.f); continue; } r -= I_P;
        p0_transpose_item<false>(F.wout, DM, 64 * (r / 32), 32 * (r % 32), Wo, 1024, 0, scr, F.lane, 1.f);
    }
    h16* Hb = (h16*)(F.ws + WS_H);
    for (int m = gw; m + 3 * NGW < MROWS; m += 4 * NGW) p0_norm_rows4(F.x, F.norm_g, Hb, m, NGW, F.lane);
    if (MROWS % (4 * NGW) != 0) for (int m = gw + (MROWS / (4 * NGW)) * 4 * NGW; m < MROWS; m += NGW) p0_norm_rows4(F.x, F.norm_g, Hb, m, 0, F.lane);
}

constexpr int NBIN = 512, ICAP = 32;
constexpr int IW_VALS = 0, IW_HIST = 16384, IW_LIST = IW_HIST + 2 * (NBIN / 2) * 4, IW_LMASK = IW_LIST + 2 * ICAP * 8, IW_BYTES = IW_LMASK + 512;
static_assert(8 * IW_BYTES <= LDSCTL_OFF, "indexer LDS");
__device__ __forceinline__ int idx_bin(float v, float smin, float scale) { const int b = (int)((v - smin) * scale); return b > NBIN - 1 ? NBIN - 1 : b; }
__device__ __forceinline__ float swz16(float x) { return __int_as_float(__builtin_amdgcn_ds_swizzle(__float_as_int(x), 0x401F)); }
__device__ __forceinline__ float half_min(float v) { v = fminf(v, __shfl_xor(v, 1)); v = fminf(v, __shfl_xor(v, 2)); v = fminf(v, __shfl_xor(v, 4)); v = fminf(v, __shfl_xor(v, 8)); return fminf(v, __shfl_xor(v, 16)); }
__device__ __forceinline__ float half_max(float v) { v = fmaxf(v, __shfl_xor(v, 1)); v = fmaxf(v, __shfl_xor(v, 2)); v = fmaxf(v, __shfl_xor(v, 4)); v = fmaxf(v, __shfl_xor(v, 8)); return fmaxf(v, __shfl_xor(v, 16)); }
__device__ __forceinline__ unsigned lowest_bits(unsigned w, unsigned n) { unsigned kept = 0u; while (n && w) { const unsigned bit = w & (0u - w); kept |= bit; w ^= bit; --n; } return kept; }
__device__ __forceinline__ void idx_pair(Frame& F, int b, int u) {
    const int lane = F.lane, k16 = lane & 15, fq = lane >> 4, th = fq >> 1, par = fq & 1;
    const int ta = 2 * u, t = ta + th;
    unsigned* gm = (unsigned*)(F.ws + WS_MASK) + (size_t)(b * SEQ + ta) * 64;
    if (ta < 256) {
        const int lo = lane * 32;
        gm[lane] = (ta >= lo + 31) ? 0xffffffffu : (ta >= lo ? ((2u << (ta - lo)) - 1u) : 0u);
        gm[64 + lane] = (ta + 1 >= lo + 31) ? 0xffffffffu : (ta + 1 >= lo ? ((2u << (ta + 1 - lo)) - 1u) : 0u);
        return;
    }
    LAS unsigned char* wl = F.lds + F.wave * IW_BYTES;
    LAS float* vals = (LAS float*)(wl + IW_VALS) + th * 2048 + 16 * par + k16;
    LAS unsigned* hist = (LAS unsigned*)(wl + IW_HIST) + th * (NBIN / 2);
    LAS u32x2* clist = (LAS u32x2*)(wl + IW_LIST) + th * ICAP;
    LAS unsigned* lmask = (LAS unsigned*)(wl + IW_LMASK);
    lmask[lane] = 0u; lmask[64 + lane] = 0u;
    TSTART(20)
    TSTART(21)
    const size_t qrow = (size_t)(b * SEQ + ta + (k16 >> 3));
    const h16x8 qh = *(const h16x8*)((const h16*)(F.ws + WS_QH) + qrow * 256 + (k16 & 7) * 32 + fq * 8);
    const f32x4 wv = *(const f32x4*)((const float*)(F.ws + WS_WI) + (size_t)(b * SEQ + t) * 8 + 4 * par);
    const int nstep = (ta + 1) / 32 + 1;
    const h16* kph = (const h16*)(F.ws + WS_KH) + (size_t)(b * SEQ + k16) * 32 + fq * 8;
    h16x8 kb[4][4];
#define IDX_LOAD(slot, step) do { const int st_ = (step) < 64 ? (step) : 63; const h16* ph_ = kph + (size_t)st_ * 1024; \
        kb[slot][0] = *(const h16x8*)ph_; kb[slot][2] = *(const h16x8*)(ph_ + 512); } while (0)
    IDX_LOAD(0, 0); IDX_LOAD(1, 1); IDX_LOAD(2, 2); IDX_LOAD(3, 3);
    float vmin = INFINITY, vmax = -INFINITY;
    const int myk = 16 * par + k16;
#define IDX_STEP(slot, step) do { \
        f32x4 a0 = __builtin_amdgcn_mfma_f32_16x16x32_f16(qh, kb[slot][0], (f32x4){0.f, 0.f, 0.f, 0.f}, 0, 0, 0), a1 = __builtin_amdgcn_mfma_f32_16x16x32_f16(qh, kb[slot][2], (f32x4){0.f, 0.f, 0.f, 0.f}, 0, 0, 0); \
        IDX_LOAD(slot, (step) + 4); \
        float s0 = wv[0] * fmaxf(a0[0], 0.f), s1 = wv[0] * fmaxf(a1[0], 0.f); \
        _Pragma("unroll") for (int r = 1; r < 4; ++r) { s0 = fmaf(wv[r], fmaxf(a0[r], 0.f), s0); s1 = fmaf(wv[r], fmaxf(a1[r], 0.f), s1); } \
        const float recv = swz16(par ? s0 : s1); \
        const float mine = (par ? s1 : s0) + recv + 0.0f; \
        const bool valid = (32 * (step) + myk) <= t; \
        vals[32 * (step)] = valid ? mine : __builtin_nanf(""); \
        if (valid) { vmin = fminf(vmin, mine); vmax = fmaxf(vmax, mine); } } while (0)
#pragma unroll 1
    for (int i = 0; i < nstep; i += 8) { IDX_STEP(0, i); IDX_STEP(1, i + 1); IDX_STEP(2, i + 2); IDX_STEP(3, i + 3); IDX_STEP(0, i + 4); IDX_STEP(1, i + 5); IDX_STEP(2, i + 6); IDX_STEP(3, i + 7); }
#undef IDX_STEP
#undef IDX_LOAD
    TSTOP(21)
    TSTART(22)
    float lo = half_min(vmin), hi = half_max(vmax);
    unsigned need = 256u, wa = 0u, wb = 0u; bool done = false;
#pragma unroll 1
    for (int level = 0; level < 64; ++level) {
        if (__ballot(!done) == 0ull) break;
        const bool tie = !done && !(hi > lo);
        const float scale = (hi > lo) ? ((float)NBIN - 0.5f) / (hi - lo) : 0.f;
        unsigned bst = 0u, rr = 0u, cb = 0u;
        TSTART(23)
        if (__ballot(!done && !tie) != 0ull) {
            *(LAS u32x4*)(wl + IW_HIST + lane * 16) = (u32x4){0u, 0u, 0u, 0u}; *(LAS u32x4*)(wl + IW_HIST + 1024 + lane * 16) = (u32x4){0u, 0u, 0u, 0u};
            asm volatile("s_waitcnt lgkmcnt(0)" ::: "memory");
            if (!done && !tie) {
#pragma unroll 4
                for (int i = 0; i < nstep; ++i) { const float v = vals[32 * i]; if (v >= lo && v <= hi) { const int bn = idx_bin(v, lo, scale); atomicAdd((unsigned*)&hist[bn >> 1], (bn & 1) ? 65536u : 1u); } }
            }
            asm volatile("s_waitcnt lgkmcnt(0)" ::: "memory");
#pragma unroll 1
            for (int tt = 0; tt < 2; ++tt) {
                const unsigned need_t = (unsigned)__builtin_amdgcn_readlane((int)need, 32 * tt); const bool skip_t = __builtin_amdgcn_readlane((int)(done || tie), 32 * tt) != 0;
                if (!skip_t) {
                    const u32x4 cw = *(const LAS u32x4*)(wl + IW_HIST + tt * 1024 + lane * 16);
                    const unsigned cnt[8] = {cw.x & 0xffffu, cw.x >> 16, cw.y & 0xffffu, cw.y >> 16, cw.z & 0xffffu, cw.z >> 16, cw.w & 0xffffu, cw.w >> 16};
                    unsigned s = 0;
#pragma unroll
                    for (int e = 0; e < 8; ++e) s += cnt[e];
                    unsigned v = s;
#pragma unroll
                    for (int o = 1; o < 64; o <<= 1) { const unsigned tmp = (unsigned)__shfl_down((int)v, o); if (lane + o < 64) v += tmp; }
                    const unsigned above = v - s; const bool crit = above < need_t && need_t <= above + s;
                    unsigned cum = above, b_ = 0, r_ = 0, c_ = 0; bool found = false;
#pragma unroll
                    for (int e = 7; e >= 0; --e) { const unsigned cc = cnt[e]; if (!found && cum + cc >= need_t) { found = true; b_ = 8u * lane + e; r_ = need_t - cum; c_ = cc; } if (!found) cum += cc; }
                    const unsigned long long cm = __ballot(crit); const int cl = cm ? (int)__builtin_ctzll(cm) : 0;
                    const unsigned bq = (unsigned)__builtin_amdgcn_readlane((int)b_, cl), rq = (unsigned)__builtin_amdgcn_readlane((int)r_, cl), cq = (unsigned)__builtin_amdgcn_readlane((int)c_, cl);
                    if (th == tt) { bst = bq; rr = rq; cb = cq; }
                }
            }
        }
        TSTOP(23)
        TSTART(24)
        const bool takeall = (cb == rr);
        const bool uselist = !takeall && cb <= (unsigned)ICAP;
        const int bsel = takeall ? (int)bst : (int)bst + 1;
        float nlo = INFINITY, nhi = -INFINITY; unsigned cnt_a = 0u, cnt_b = 0u, tie_a = 0u, tie_b = 0u;
        const unsigned need_a = (unsigned)__builtin_amdgcn_readlane((int)need, 0), need_b = (unsigned)__builtin_amdgcn_readlane((int)need, 32);
        const bool tie_any = __ballot(tie) != 0ull;
#pragma unroll 2
        for (int i = 0; i < nstep; ++i) {
            const float v = vals[32 * i]; const bool act = !done && v >= lo && v <= hi;
            const int bn = idx_bin(v, lo, scale);
            const bool sel = act && !tie && bn >= bsel, mem = act && !tie && !takeall && bn == (int)bst;
            unsigned long long sm = __ballot(sel);
            if (tie_any) {
                const unsigned long long tm = __ballot(act && tie);
                const unsigned ka = lowest_bits((unsigned)tm, need_a - tie_a), kb = lowest_bits((unsigned)(tm >> 32), need_b - tie_b);
                tie_a += __popc(ka); tie_b += __popc(kb); sm |= (unsigned long long)ka | ((unsigned long long)kb << 32);
            }
            if (sm) { if (lane == i) { wa |= (unsigned)sm; wb |= (unsigned)(sm >> 32); } }
            const unsigned long long mm = __ballot(mem);
            if (mm) {
                if (mem) { nlo = fminf(nlo, v); nhi = fmaxf(nhi, v);
                    if (uselist) { const unsigned slot = th ? cnt_b + __builtin_amdgcn_mbcnt_hi((unsigned)(mm >> 32), 0u) : cnt_a + __builtin_amdgcn_mbcnt_lo((unsigned)mm, 0u);
                        if (slot < (unsigned)ICAP) clist[slot] = (u32x2){__float_as_uint(v), (unsigned)(32 * i + myk)}; } }
                cnt_a += __popc((unsigned)mm); cnt_b += __popc((unsigned)(mm >> 32));
            }
        }
        asm volatile("s_waitcnt lgkmcnt(0)" ::: "memory");
        TSTOP(24)
        if (!done) {
            if (tie || takeall) done = true;
            else if (uselist) {
                const int j = lane & 31; const u32x2 me = clist[j]; const float vj = __uint_as_float(me.x); unsigned rank = 0u;
                for (unsigned i2 = 0; i2 < cb; ++i2) { const u32x2 o = clist[i2]; const float vi = __uint_as_float(o.x); rank += (vi > vj || (vi == vj && o.y < me.y)) ? 1u : 0u; }
                if ((unsigned)j < cb && rank < rr) atomicOr((unsigned*)&lmask[th * 64 + (me.y >> 5)], 1u << (me.y & 31));
                done = true;
            } else { lo = half_min(nlo); hi = half_max(nhi); need = rr; }
        }
    }
    asm volatile("s_waitcnt lgkmcnt(0)" ::: "memory");
    gm[lane] = wa | lmask[lane]; gm[64 + lane] = wb | lmask[64 + lane];
    TSTOP(22)
    TSTOP(20)
}
__device__ __forceinline__ void p2_index_phase(Frame& F) {
    for (int gw = F.vcu * NWAVES + F.wave; gw < 2048; gw += F.G * NWAVES) {
        const int b = gw >> 8, r = gw & 255;
#pragma unroll 1
        for (int k = 0; k < 4; ++k) { const int u = (k == 0) ? 1023 - r : (k == 1) ? 512 + r : (k == 2) ? 511 - r : r; idx_pair(F, b, u); }
    }
}

constexpr int AT_K = 0, AT_KSZ = 64 * 144, AT_V = 2 * AT_KSZ, AT_VSZ = 64 * 192, AT_LUT = AT_V + 2 * AT_VSZ, AT_OST = AT_LUT + 320 * 4, AT_OSTSZ = 32 * 144, AT_MTAB = AT_OST + 8 * AT_OSTSZ;
static_assert(AT_MTAB + 128 <= RING_BYTES, "attention LDS");
typedef _Float16 h16x2v __attribute__((ext_vector_type(2)));
__device__ __forceinline__ s16x4 vtr_read(const LAS unsigned char* p) { return __builtin_amdgcn_ds_read_tr16_b64_v4i16((LAS s16x4*)p); }

template <bool ISB>
__device__ __forceinline__ void attn_unit(Frame& F, int b, int h, int qb) {
    const int tid = F.tid, lane = F.lane, wid = F.wave, q = lane & 31, hi = lane >> 5;
    const int q0 = qb * 256, r0 = q0 + wid * 32, t = r0 + q;
    const size_t row = (size_t)b * SEQ + t;
    const h16* Qp; const h16* Kp; const h16* Vp; const h16* Zp; int kvpitch, ycol;
    if (ISB) { Qp = (const h16*)(F.ws + WS_QB) + h * 64; Kp = (const h16*)(F.ws + WS_KB) + h * 64; Vp = (const h16*)(F.ws + WS_VB) + h * 64; Zp = (const h16*)(F.ws + WS_ZB) + h * 64; kvpitch = 512; ycol = 512 + h * 64; }
    else     { Qp = (const h16*)(F.ws + WS_QA) + h * 64; Kp = (const h16*)(F.ws + WS_KVA) + (h >> 2) * 64; Vp = (const h16*)(F.ws + WS_KVA) + 128 + (h >> 2) * 64; Zp = (const h16*)(F.ws + WS_ZA) + h * 64; kvpitch = 256; ycol = h * 64; }
    const unsigned* mrow = (const unsigned*)(F.ws + WS_MASK) + row * 64;
    LAS float* lut = (LAS float*)(F.lds + AT_LUT);
    for (int i = tid; i < 320; i += NTHREADS) { const int dist = 223 - i; float v;
        if (ISB) v = dist < 0 ? 0.f : (F.relb[t5_bucket(dist > 127 ? 127 : dist) * 16 + 8 + h] - F.relb[31 * 16 + 8 + h]) * LOG2E;
        else v = (dist >= 0 && dist < 128) ? F.relb[t5_bucket(dist) * 16 + h] * LOG2E : -INFINITY;
        lut[i] = v; }
    if (tid < 16) { u32x2 e; e.x = ((tid & 1) ? 0xffffu : 0u) | ((tid & 2) ? 0xffff0000u : 0u); e.y = ((tid & 4) ? 0xffffu : 0u) | ((tid & 8) ? 0xffff0000u : 0u); *(LAS u32x2*)(F.lds + AT_MTAB + tid * 8) = e; }
    h16x8 qr[4];
    {   const float* qg = ISB ? F.qnb : F.qna; float ss = 0.f;
#pragma unroll
        for (int d0 = 0; d0 < 4; ++d0) { qr[d0] = *(const h16x8*)(Qp + row * 512 + d0 * 16 + hi * 8);
#pragma unroll
            for (int e = 0; e < 8; ++e) { const float f = (float)qr[d0][e]; ss += f * f; } }
        ss += __shfl_xor(ss, 32);
        const float rq = rsqrtf(ss * (1.0f / 64.0f) + RMS_EPS) * QSCALE;
#pragma unroll
        for (int d0 = 0; d0 < 4; ++d0) { const f32x4 g0 = *(const f32x4*)(qg + d0 * 16 + hi * 8), g1 = *(const f32x4*)(qg + d0 * 16 + hi * 8 + 4);
            u32x4 w; w.x = pkh((float)qr[d0][0] * rq * g0[0], (float)qr[d0][1] * rq * g0[1]); w.y = pkh((float)qr[d0][2] * rq * g0[2], (float)qr[d0][3] * rq * g0[3]);
            w.z = pkh((float)qr[d0][4] * rq * g1[0], (float)qr[d0][5] * rq * g1[1]); w.w = pkh((float)qr[d0][6] * rq * g1[2], (float)qr[d0][7] * rq * g1[3]);
            qr[d0] = __builtin_bit_cast(h16x8, w); } }
    float kgn[8];
    {   const float* kgp = (ISB ? F.knb : F.kna) + (tid & 7) * 8; const f32x4 g0 = *(const f32x4*)kgp, g1 = *(const f32x4*)(kgp + 4);
        kgn[0] = g0[0]; kgn[1] = g0[1]; kgn[2] = g0[2]; kgn[3] = g0[3]; kgn[4] = g1[0]; kgn[5] = g1[1]; kgn[6] = g1[2]; kgn[7] = g1[3]; }
#define KNORM(KR) do { const h16x8 kv_ = __builtin_bit_cast(h16x8, KR); float f_[8]; float ss_ = 0.f; \
        _Pragma("unroll") for (int e = 0; e < 8; ++e) { f_[e] = (float)kv_[e]; ss_ += f_[e] * f_[e]; } \
        ss_ += __shfl_xor(ss_, 1); ss_ += __shfl_xor(ss_, 2); ss_ += __shfl_xor(ss_, 4); \
        const float rk_ = rsqrtf(ss_ * (1.0f / 64.0f) + RMS_EPS); \
        KR.x = pkh(f_[0] * rk_ * kgn[0], f_[1] * rk_ * kgn[1]); KR.y = pkh(f_[2] * rk_ * kgn[2], f_[3] * rk_ * kgn[3]); \
        KR.z = pkh(f_[4] * rk_ * kgn[4], f_[5] * rk_ * kgn[5]); KR.w = pkh(f_[6] * rk_ * kgn[6], f_[7] * rk_ * kgn[7]); } while (0)
    const int kt_lo = ISB ? 0 : (4 * qb - 2 < 0 ? 0 : 4 * qb - 2), kt_hi = 4 * qb + 3;
    const int srow = tid >> 3, sch = tid & 7;
    const h16* kg = Kp + ((size_t)b * SEQ + srow) * kvpitch + sch * 8; const h16* vg = Vp + ((size_t)b * SEQ + srow) * kvpitch + sch * 8;
    const int kst = srow * 144 + sch * 16, vst = srow * 192 + sch * 16;
    u32x4 kreg = *(const u32x4*)(kg + (size_t)kt_lo * 64 * kvpitch), vreg = *(const u32x4*)(vg + (size_t)kt_lo * 64 * kvpitch);
    u32x2 mw = {0u, 0u}, mwn = {0u, 0u};
    if (ISB) mw = *(const u32x2*)(mrow + 2 * kt_lo);
    KNORM(kreg);
    *(LAS u32x4*)(F.lds + AT_K + kst) = kreg; *(LAS u32x4*)(F.lds + AT_V + vst) = vreg;
    __syncthreads();
    float m_run = -INFINITY, l_run = 0.f;
    f32x16 o[2];
#pragma unroll
    for (int r = 0; r < 16; ++r) { o[0][r] = 0.f; o[1][r] = 0.f; }
    const int kfo = q * 144 + hi * 16;
    const int vfo = (4 * hi + ((lane & 15) >> 2)) * 192 + ((lane >> 4) & 1) * 32 + (lane & 3) * 8;
    for (int kt = kt_lo; kt <= kt_hi; ++kt) {
        const int cur = (kt - kt_lo) & 1;
        if (kt < kt_hi) { kreg = *(const u32x4*)(kg + (size_t)(kt + 1) * 64 * kvpitch); vreg = *(const u32x4*)(vg + (size_t)(kt + 1) * 64 * kvpitch); if (ISB) mwn = *(const u32x2*)(mrow + 2 * (kt + 1)); }
        const int k0 = kt * 64;
        const bool active = ISB ? (k0 <= r0 + 31) : (k0 <= r0 + 31 && k0 + 63 >= r0 - 127);
        TSTART(31)
        if (active) {
            const LAS unsigned char* kb = F.lds + AT_K + cur * AT_KSZ + kfo;
            const LAS unsigned char* vb = F.lds + AT_V + cur * AT_VSZ + vfo;
            f32x16 p0, p1;
#pragma unroll
            for (int r = 0; r < 16; ++r) { p0[r] = 0.f; p1[r] = 0.f; }
#pragma unroll
            for (int d0 = 0; d0 < 4; ++d0) {
                const h16x8 ka = *(const LAS h16x8*)(kb + d0 * 32), kc = *(const LAS h16x8*)(kb + 32 * 144 + d0 * 32);
                p0 = __builtin_amdgcn_mfma_f32_32x32x16_f16(ka, qr[d0], p0, 0, 0, 0);
                p1 = __builtin_amdgcn_mfma_f32_32x32x16_f16(kc, qr[d0], p1, 0, 0, 0);
            }
            if (!ISB || (r0 - k0 - 63 < 113)) {
                const LAS float* lp = lut + (223 - (t - k0 - 4 * hi));
#pragma unroll
                for (int r = 0; r < 16; ++r) { const int c = (r & 3) + 8 * (r >> 2); p0[r] += lp[c]; p1[r] += lp[32 + c]; }
            }
            h16x2v s2[16];
#pragma unroll
            for (int j = 0; j < 8; ++j) { s2[j] = __builtin_convertvector((f32x2){p0[2 * j], p0[2 * j + 1]}, h16x2v); s2[8 + j] = __builtin_convertvector((f32x2){p1[2 * j], p1[2 * j + 1]}, h16x2v); }
            h16x2v m2 = __builtin_elementwise_max(s2[0], s2[1]);
#pragma unroll
            for (int j = 2; j < 16; ++j) m2 = __builtin_elementwise_max(m2, s2[j]);
            float mx = fmaxf((float)m2.x, (float)m2.y);
            mx = fmaxf(mx, __shfl_xor(mx, 32));
            const float mnew = fmaxf(m_run, mx), muse = (mnew == -INFINITY) ? 0.f : mnew;
            if (__any(mnew > m_run)) {
                const float alpha = __builtin_amdgcn_exp2f(m_run - muse);
                l_run *= alpha;
#pragma unroll
                for (int r = 0; r < 16; ++r) { o[0][r] *= alpha; o[1][r] *= alpha; }
            }
            m_run = mnew;
            const h16 nm = (h16)(-muse); const h16x2v nm2 = {nm, nm};
#pragma unroll
            for (int j = 0; j < 16; ++j) { const h16x2v a = s2[j] + nm2; s2[j].x = __builtin_exp2f16(a.x); s2[j].y = __builtin_exp2f16(a.y); }
            if (ISB) {
                const unsigned mm0 = mw.x >> (4 * hi), mm1 = mw.y >> (4 * hi);
#pragma unroll
                for (int g4 = 0; g4 < 4; ++g4) {
                    const u32x2 e0 = *(const LAS u32x2*)(F.lds + AT_MTAB + ((mm0 >> (8 * g4)) & 15u) * 8), e1 = *(const LAS u32x2*)(F.lds + AT_MTAB + ((mm1 >> (8 * g4)) & 15u) * 8);
                    s2[2 * g4] = __builtin_bit_cast(h16x2v, __builtin_bit_cast(unsigned, s2[2 * g4]) & e0.x); s2[2 * g4 + 1] = __builtin_bit_cast(h16x2v, __builtin_bit_cast(unsigned, s2[2 * g4 + 1]) & e0.y);
                    s2[8 + 2 * g4] = __builtin_bit_cast(h16x2v, __builtin_bit_cast(unsigned, s2[8 + 2 * g4]) & e1.x); s2[8 + 2 * g4 + 1] = __builtin_bit_cast(h16x2v, __builtin_bit_cast(unsigned, s2[8 + 2 * g4 + 1]) & e1.y);
                }
            }
            {   h16x2v a0 = s2[0] + s2[1], a1 = s2[2] + s2[3], a2 = s2[4] + s2[5], a3 = s2[6] + s2[7], a4 = s2[8] + s2[9], a5 = s2[10] + s2[11], a6 = s2[12] + s2[13], a7 = s2[14] + s2[15];
                a0 = a0 + a1; a2 = a2 + a3; a4 = a4 + a5; a6 = a6 + a7;
                l_run += (((float)a0.x + (float)a0.y) + ((float)a2.x + (float)a2.y)) + (((float)a4.x + (float)a4.y) + ((float)a6.x + (float)a6.y)); }
            u32x4 pk[4];
#pragma unroll
            for (int s = 0; s < 4; ++s) pk[s] = (u32x4){__builtin_bit_cast(unsigned, s2[4 * s]), __builtin_bit_cast(unsigned, s2[4 * s + 1]), __builtin_bit_cast(unsigned, s2[4 * s + 2]), __builtin_bit_cast(unsigned, s2[4 * s + 3])};
#pragma unroll
            for (int s = 0; s < 4; ++s)
#pragma unroll
                for (int d1 = 0; d1 < 2; ++d1) {
                    const s16x4 lo4 = vtr_read(vb + (16 * s) * 192 + d1 * 64), hi4 = vtr_read(vb + (16 * s + 8) * 192 + d1 * 64);
                    const h16x4 lf = __builtin_bit_cast(h16x4, lo4), hf = __builtin_bit_cast(h16x4, hi4);
                    const h16x8 vf = {lf[0], lf[1], lf[2], lf[3], hf[0], hf[1], hf[2], hf[3]};
                    o[d1] = __builtin_amdgcn_mfma_f32_32x32x16_f16(vf, __builtin_bit_cast(h16x8, pk[s]), o[d1], 0, 0, 0);
                }
        }
        TSTOP(31)
        TSTART(32)
        if (kt < kt_hi) { KNORM(kreg); *(LAS u32x4*)(F.lds + AT_K + (cur ^ 1) * AT_KSZ + kst) = kreg; *(LAS u32x4*)(F.lds + AT_V + (cur ^ 1) * AT_VSZ + vst) = vreg; mw = mwn; }
        TSTOP(32)
        TSTART(33)
        __syncthreads();
        TSTOP(33)
    }
    TSTART(34)
    l_run += __shfl_xor(l_run, 32);
    if (!ISB) l_run += __builtin_amdgcn_exp2f(F.sinks[h] * LOG2E - m_run);
    const float inv = 1.0f / l_run;
    LAS unsigned char* ost = F.lds + AT_OST + wid * AT_OSTSZ;
#pragma unroll
    for (int d1 = 0; d1 < 2; ++d1)
#pragma unroll
        for (int g4 = 0; g4 < 4; ++g4) { u32x2 w; w.x = pkh(o[d1][4 * g4] * inv, o[d1][4 * g4 + 1] * inv); w.y = pkh(o[d1][4 * g4 + 2] * inv, o[d1][4 * g4 + 3] * inv);
            *(LAS u32x2*)(ost + q * 144 + (32 * d1 + 8 * g4 + 4 * hi) * 2) = w; }
    LDS_WAIT(); asm volatile("" ::: "memory");
    h16* Yp = (h16*)(F.ws + WS_Y);
#pragma unroll
    for (int i = 0; i < 4; ++i) { const int rr = i * 8 + (lane >> 3), ch = lane & 7; const size_t grow = (size_t)b * SEQ + r0 + rr;
        const h16x8 ov = *(const LAS h16x8*)(ost + rr * 144 + ch * 16); const h16x8 zv = *(const h16x8*)(Zp + grow * 512 + ch * 8);
        float y[8];
#pragma unroll
        for (int e = 0; e < 8; ++e) { const float z = (float)zv[e]; y[e] = (float)ov[e] * z * sigmoidf_fast(z); }
        u32x4 w; w.x = pkh(y[0], y[1]); w.y = pkh(y[2], y[3]); w.z = pkh(y[4], y[5]); w.w = pkh(y[6], y[7]);
        *(u32x4*)(Yp + grow * 1024 + ycol + ch * 8) = w; }
    __syncthreads();
    TSTOP(34)
#undef KNORM
}
__device__ __forceinline__ void p3_attention_phase(Frame& F) {
    for (int v = F.vcu; v < 256; v += F.G) {
        const int bh = v >> 2, j = v & 3, b = bh >> 3, h = bh & 7;
        attn_unit<true>(F, b, h, 7 - j); attn_unit<true>(F, b, h, j);
        attn_unit<false>(F, b, h, 2 * j); attn_unit<false>(F, b, h, 2 * j + 1);
    }
}

struct Args { const float* in[12]; float* out; unsigned char* ws; int ph_lo, ph_hi; };
constexpr int N_PHASES = 6;
__global__ void __launch_bounds__(NTHREADS, 2) mk_fwd(Args args) {
    extern __shared__ __attribute__((aligned(16))) unsigned char lds_raw[];
    cg::grid_group grid = cg::this_grid();
    Frame F;
    F.lds = (LAS unsigned char*)lds_raw;
    F.tid = threadIdx.x; F.lane = F.tid & 63; F.wave = __builtin_amdgcn_readfirstlane(F.tid >> 6);
    F.G = gridDim.x; { const int bx = blockIdx.x; F.vcu = (F.G % 8 == 0) ? (bx % 8) * (F.G / 8) + bx / 8 : bx; }
    F.ws = args.ws; F.prof = 0ull;
    F.x = args.in[0]; F.norm_g = args.in[1]; F.w_in = args.in[2]; F.qna = args.in[3]; F.kna = args.in[4]; F.sinks = args.in[5];
    F.qnb = args.in[6]; F.knb = args.in[7]; F.relb = args.in[8]; F.wpa = args.in[9]; F.wpb = args.in[10]; F.wout = args.in[11]; F.out = args.out;
    const int lo = args.ph_lo, hi = args.ph_hi;
    if (lo < 0) grid.sync();
    if (F.tid < 64) ((LAS unsigned*)(F.lds + LDSCTL_OFF))[F.tid] = 0u;
    __syncthreads();
    XcdBarrier bar = xcd_barrier_post((unsigned*)(F.ws + WS_CTL), (volatile LAS unsigned*)(F.lds + LDSCTL_OFF) + 8);
#ifdef ONLY_PH
#define IN(k) ((k) == ONLY_PH && lo <= (k) && (k) < hi)
#else
#define IN(k) (lo <= (k) && (k) < hi)
#endif
#ifdef PROBE_SYNC2
#define SEAM(k) do { if (IN(k) && IN((k) + 1)) { xcd_barrier(bar); xcd_barrier(bar); } } while (0)
#else
#define SEAM(k) do { if (IN(k) && IN((k) + 1)) xcd_barrier(bar); } while (0)
#endif
    { TSTART(1) if (IN(0)) { p0_prologue(F); }
    SEAM(0); TSTOP(1) }
    TSTART(2)
    if (IN(1)) {
        pg8::GemmPlain g{(const h16*)(F.ws + WS_H), (const h16*)(F.ws + WS_WIN), 1024, 1024};
        pg8::StaticOrder S; S.init(MROWS, 23 * 256, F.G, (int)blockIdx.x);
        pg8::EpiIn E{F.ws, (h16*)F.out};
        pg8::gemm_phase<pg8::EpiIn, pg8::StaticOrder, pg8::GemmPlain, true, true>(F.lds, g, S, E);
    }
    SEAM(1);
    TSTOP(2)
    { TSTART(3) if (IN(2)) { p2_index_phase(F); }
    SEAM(2); TSTOP(3) }
    { TSTART(4) if (IN(3)) { p3_attention_phase(F); }
    SEAM(3); TSTOP(4) }
    TSTART(5)
    if (IN(4)) {
        pg8::GemmPlain g{(const h16*)(F.ws + WS_Y), (const h16*)(F.ws + WS_WP), 1024, 1024};
        pg8::StaticOrder S; S.init(MROWS, DM, F.G, (int)blockIdx.x);
        pg8::EpiMerge E{(const h16*)F.out, (h16*)(F.ws + WS_MG)};
        pg8::gemm_phase<pg8::EpiMerge, pg8::StaticOrder, pg8::GemmPlain, true, true>(F.lds, g, S, E);
    }
    SEAM(4);
    TSTOP(5)
    TSTART(6)
    if (IN(5)) {
        pg8::GemmPlain g{(const h16*)(F.ws + WS_MG), (const h16*)(F.ws + WS_WO), 1024, 1024};
        pg8::StaticOrder S; S.init(MROWS, DM, F.G, (int)blockIdx.x);
        pg8::EpiOut E{F.x, F.out};
        pg8::gemm_phase<pg8::EpiOut, pg8::StaticOrder, pg8::GemmPlain, true, true>(F.lds, g, S, E);
    }
    TSTOP(6)
#undef IN
#undef SEAM
#ifdef PROF_SEG
    if (blockIdx.x == PROF_BLK && F.wave == PROF_WAVE && hi == N_PHASES) { const unsigned long long t1 = __builtin_amdgcn_s_memrealtime() + F.prof * PROF_MULT; while (__builtin_amdgcn_s_memrealtime() < t1) __builtin_amdgcn_s_sleep(8); }
#endif
}

extern "C" void kernel_launch(void* const* d_in, const int* in_sizes, int n_in, void* d_out, int out_size, void* d_ws, size_t ws_size, hipStream_t stream) {
    static int grid = 0;
    if (grid == 0) {
        if (n_in != 12 || in_sizes[0] != MROWS * DM || out_size != MROWS * DM || ws_size < WS_END) { fprintf(stderr, "kernel_launch: unexpected problem (n_in %d, ws %zu)\n", n_in, ws_size); grid = -1; return; }
        int dev = 0, cus = 0, per_cu = 0;
        hipGetDevice(&dev); hipDeviceGetAttribute(&cus, hipDeviceAttributeMultiprocessorCount, dev);
        hipFuncSetAttribute((const void*)mk_fwd, hipFuncAttributeMaxDynamicSharedMemorySize, LDS_BYTES);
        hipOccupancyMaxActiveBlocksPerMultiprocessor(&per_cu, (const void*)mk_fwd, NTHREADS, LDS_BYTES);
        (void)hipGetLastError();
        if (per_cu < 1) { fprintf(stderr, "kernel_launch: occupancy query says %d blocks/CU\n", per_cu); per_cu = 1; }
        grid = cus;
        if (grid > 256) grid = 256;
    }
    if (grid < 0) return;
    (void)hipMemsetAsync((char*)d_ws + WS_CTL, 0, CTL_BYTES, stream);
    Args a{};
    for (int i = 0; i < 12; ++i) a.in[i] = (const float*)d_in[i];
    a.out = (float*)d_out; a.ws = (unsigned char*)d_ws;
#ifdef PROBE_PH
    {
        void* kargs[] = {&a};
        a.ph_lo = 0; a.ph_hi = PROBE_PH + 1;
        (void)hipLaunchCooperativeKernel((const void*)mk_fwd, dim3(grid), dim3(NTHREADS), kargs, LDS_BYTES, stream);
        (void)hipMemsetAsync((char*)d_ws + WS_CTL, 0, CTL_BYTES, stream);
#ifdef PROBE_SPLIT_ONLY
        a.ph_lo = PROBE_PH + 1; a.ph_hi = N_PHASES;
#else
        a.ph_lo = PROBE_PH; a.ph_hi = N_PHASES;
#endif
        (void)hipLaunchCooperativeKernel((const void*)mk_fwd, dim3(grid), dim3(NTHREADS), kargs, LDS_BYTES, stream);
    }
#else
    {
        a.ph_lo = 0; a.ph_hi = N_PHASES;
        void* kargs[] = {&a};
        hipError_t e = hipLaunchCooperativeKernel((const void*)mk_fwd, dim3(grid), dim3(NTHREADS), kargs, LDS_BYTES, stream);
        if (e != hipSuccess) fprintf(stderr, "cooperative launch failed: %s (grid %d)\n", hipGetErrorString(e), grid);
    }
#endif
}
```

```cpp
#include <hip/hip_runtime.h>
#include <hip/hip_cooperative_groups.h>
#include <cstdio>
#include <cstdint>
namespace cg = cooperative_groups;
#ifdef PROF_SEG
#ifndef PROF_MULT
#define PROF_MULT 4
#endif
#ifndef PROF_BLK
#define PROF_BLK 100
#endif
#ifndef PROF_WAVE
#define PROF_WAVE 3
#endif
#endif

#define LAS __attribute__((address_space(3)))
typedef _Float16 h16;
typedef _Float16 h16x2 __attribute__((ext_vector_type(2)));
typedef _Float16 h16x4 __attribute__((ext_vector_type(4)));
typedef _Float16 h16x8 __attribute__((ext_vector_type(8)));
typedef float f32x2 __attribute__((ext_vector_type(2)));
typedef float f32x4 __attribute__((ext_vector_type(4)));
typedef float f32x16 __attribute__((ext_vector_type(16)));
typedef unsigned u32x2 __attribute__((ext_vector_type(2)));
typedef unsigned u32x4 __attribute__((ext_vector_type(4)));
typedef short s16x4 __attribute__((ext_vector_type(4)));

__device__ __forceinline__ unsigned pkh(float lo, float hi) { const f32x2 v = {lo, hi}; const h16x2 h = __builtin_convertvector(v, h16x2); return __builtin_bit_cast(unsigned, h); }
__device__ __forceinline__ float sigmoidf_fast(float g) { g = fminf(fmaxf(g, -30.f), 30.f); return __builtin_amdgcn_rcpf(1.0f + __builtin_amdgcn_exp2f(-1.4426950408889634f * g)); }

constexpr int NBATCH = 8, SEQ = 2048, DM = 1024, MROWS = NBATCH * SEQ, INW = 5672;
constexpr float RMS_EPS = 1e-6f, LOG2E = 1.4426950408889634f, QSCALE = 0.125f * 1.4426950408889634f;
constexpr float HSCALE = 16.f, WSCALE = 64.f, INV_HW = 1.0f / (16.f * 64.f);
constexpr size_t MiB = 1u << 20;
constexpr size_t WS_H = 0;
constexpr size_t WS_Y = 0, WS_MG = 32 * MiB;
constexpr size_t WS_QH = 32 * MiB, WS_QL = 40 * MiB, WS_KH = 48 * MiB, WS_KL = 49 * MiB, WS_WI = 50 * MiB;
constexpr size_t WS_WIN = 64 * MiB;
constexpr size_t WS_WP = 77 * MiB, WS_WO = 79 * MiB;
constexpr size_t WS_QA = 81 * MiB, WS_KVA = 97 * MiB, WS_ZA = 105 * MiB, WS_QB = 121 * MiB, WS_KB = 137 * MiB, WS_VB = 153 * MiB, WS_ZB = 169 * MiB;
constexpr size_t WS_MASK = 185 * MiB;
constexpr size_t WS_CTL = 190 * MiB, CTL_BYTES = 16384;
constexpr size_t WS_END = 191 * MiB;

namespace pg8 {
#define PG8_LAS __attribute__((address_space(3)))
constexpr int BM = 256, BK = 64, HALF = 128, HTB = HALF * BK * 2  , STAGE_BYTES = 8 * HTB, NXCD = 8, WGM = 8;

__host__ __device__ __forceinline__ int lds_byte(int r, int c) { const int st = (r >> 4) * 2 + (c >> 5), rr = r & 15, cc = c & 31, ob = rr * 64 + cc * 2; return st * 1024 + (ob ^ (((ob >> 9) & 1) << 5)); }
__host__ __device__ __forceinline__ void stage_rc(int b, int& R, int& C) { const int st = b / 1024, sb = b % 1024, swz = sb ^ (((sb >> 9) & 1) << 5); R = (st >> 1) * 16 + swz / 64; C = (st & 1) * 32 + (swz % 64) / 2; }
__host__ __device__ __forceinline__ int perm32(int rho) { const int n = rho >> 4, i = rho & 15; return 8 * (i >> 2) + 4 * n + (i & 3); }

struct Unit { int pm, pn; };

struct StaticOrder {
    int nM, nN, nwg, G, c;
    __host__ __device__ void init(int M, int N, int G_, int c_) { nM = M / BM; nN = N / BM; nwg = nM * nN; G = G_; c = c_; }
    __host__ __device__ bool next(int i, Unit& u) const {
        const long L = (long)i * G + c; if (L >= nwg) return false;
        int wgid = (int)L; { const int q = nwg / NXCD, r = nwg % NXCD, xcd = wgid % NXCD, off = wgid / NXCD; wgid = (xcd < r ? xcd * (q + 1) : r * (q + 1) + (xcd - r) * q) + off; }
        const int nig = WGM * nN, gid = wgid / nig, fm = gid * WGM, gsz = (nM - fm) < WGM ? (nM - fm) : WGM;
        u.pm = fm + ((wgid % nig) % gsz); u.pn = (wgid % nig) / gsz; return true;
    }
    __device__ __forceinline__ void a_ready(const Unit&) const {}
    __device__ __forceinline__ void done(const Unit&) const {}
};

struct GemmPlain { const h16* A; const h16* Bt; int lda, K;
    __device__ __forceinline__ const char* aptr(const Unit& u) const { return (const char*)(A + (size_t)u.pm * BM * lda); }
    __device__ __forceinline__ const char* bptr(const Unit& u) const { return (const char*)(Bt + (size_t)u.pn * BM * K); } };
struct EpiIn {
    static constexpr bool PERM = true, AFTER_DRAIN = false, MID = false;
    unsigned char* ws; h16* G;
    __device__ __forceinline__ void operator()(const f32x4 (&acc)[2][2][4][2], const Unit& u, int wr, int wc, int fr, int fq) const {
        const int pn = u.pn, row0 = u.pm * BM + wr * 64 + fr, cl = wc * 32 + 8 * fq;
        if (pn < 21) {
            h16* base; int ldc, colt;
            if (pn < 2)       { base = (h16*)(ws + WS_QA);  ldc = 512; colt = pn * 256; }
            else if (pn == 2) { base = (h16*)(ws + WS_KVA); ldc = 256; colt = 0; }
            else if (pn < 5)  { base = (h16*)(ws + WS_ZA);  ldc = 512; colt = (pn - 3) * 256; }
            else if (pn < 7)  { base = (h16*)(ws + WS_QB);  ldc = 512; colt = (pn - 5) * 256; }
            else if (pn < 9)  { base = (h16*)(ws + WS_KB);  ldc = 512; colt = (pn - 7) * 256; }
            else if (pn < 11) { base = (h16*)(ws + WS_VB);  ldc = 512; colt = (pn - 9) * 256; }
            else if (pn < 13) { base = (h16*)(ws + WS_ZB);  ldc = 512; colt = (pn - 11) * 256; }
            else              { base = G;                   ldc = 2048; colt = (pn - 13) * 256; }
#pragma unroll
            for (int ai = 0; ai < 2; ++ai)
#pragma unroll
                for (int m = 0; m < 4; ++m) { h16* rowp = base + (size_t)(row0 + ai * HALF + m * 16) * ldc + colt + cl;
#pragma unroll
                    for (int bj = 0; bj < 2; ++bj) { const f32x4 v0 = acc[ai][bj][m][0] * INV_HW, v1 = acc[ai][bj][m][1] * INV_HW;
                        u32x4 w; w.x = pkh(v0[0], v0[1]); w.y = pkh(v0[2], v0[3]); w.z = pkh(v1[0], v1[1]); w.w = pkh(v1[2], v1[3]);
                        *(u32x4*)(rowp + bj * HALF) = w; } }
        } else {
            const int colt = (pn - 21) * 256 + cl;
#pragma unroll
            for (int ai = 0; ai < 2; ++ai)
#pragma unroll
                for (int m = 0; m < 4; ++m) { const size_t r = (size_t)(row0 + ai * HALF + m * 16);
#pragma unroll
                    for (int bj = 0; bj < 2; ++bj) { const int j = colt + bj * HALF; const f32x4 v0 = acc[ai][bj][m][0] * INV_HW, v1 = acc[ai][bj][m][1] * INV_HW;
                        if (j < 288) {
                            u32x4 hi; hi.x = pkh(v0[0] * 16.f, v0[1] * 16.f); hi.y = pkh(v0[2] * 16.f, v0[3] * 16.f); hi.z = pkh(v1[0] * 16.f, v1[1] * 16.f); hi.w = pkh(v1[2] * 16.f, v1[3] * 16.f);
                            if (j < 256) *(u32x4*)((h16*)(ws + WS_QH) + r * 256 + j) = hi; else *(u32x4*)((h16*)(ws + WS_KH) + r * 32 + (j - 256)) = hi;
                        } else if (j < 296) { float* w = (float*)(ws + WS_WI) + r * 8; *(f32x4*)w = v0; *(f32x4*)(w + 4) = v1; }
                    } }
        }
    }
};
struct EpiMerge {
    static constexpr bool PERM = true, AFTER_DRAIN = false, MID = true;
    const h16* G; h16* MG;
    __device__ __forceinline__ void mid(f32x4 (&acc)[2][2][4][2], const Unit& u, int wr, int wc, int fr, int fq) const {
        const int row0 = u.pm * BM + wr * 64 + fr, col0 = u.pn * BM + wc * 32 + 8 * fq;
#pragma unroll
        for (int ai = 0; ai < 2; ++ai)
#pragma unroll
            for (int m = 0; m < 4; ++m) { unsigned ro = (unsigned)(row0 + ai * HALF + m * 16); asm volatile("" : "+v"(ro)); const h16* gp = G + (size_t)ro * 2048 + col0;
#pragma unroll
                for (int bj = 0; bj < 2; ++bj) { const h16x8 ga = *(const h16x8*)(gp + bj * HALF), gb = *(const h16x8*)(gp + 1024 + bj * HALF);
#pragma unroll
                    for (int e = 0; e < 8; ++e) { const float a = fminf(fmaxf((float)ga[e], -30.f), 30.f), b = fminf(fmaxf((float)gb[e], -30.f), 30.f);
                        const float f = (1.0f + __builtin_amdgcn_exp2f(-LOG2E * b)) * __builtin_amdgcn_rcpf(1.0f + __builtin_amdgcn_exp2f(-LOG2E * a));
                        acc[ai][bj][m][e >> 2][e & 3] *= f; } }
                asm volatile("" ::: "memory"); }
    }
    __device__ __forceinline__ void operator()(const f32x4 (&acc)[2][2][4][2], const Unit& u, int wr, int wc, int fr, int fq) const {
        const int row0 = u.pm * BM + wr * 64 + fr, col0 = u.pn * BM + wc * 32 + 8 * fq;
#pragma unroll
        for (int ai = 0; ai < 2; ++ai)
#pragma unroll
            for (int m = 0; m < 4; ++m) { unsigned ro = (unsigned)(row0 + ai * HALF + m * 16); asm volatile("" : "+v"(ro)); const size_t r = (size_t)ro;
#pragma unroll
                for (int bj = 0; bj < 2; ++bj) { const h16x8 gb = *(const h16x8*)(G + r * 2048 + 1024 + col0 + bj * HALF);
                    float o[8];
#pragma unroll
                    for (int e = 0; e < 8; ++e) o[e] = acc[ai][bj][m][e >> 2][e & 3] * sigmoidf_fast((float)gb[e]);
                    u32x4 w; w.x = pkh(o[0], o[1]); w.y = pkh(o[2], o[3]); w.z = pkh(o[4], o[5]); w.w = pkh(o[6], o[7]);
                    *(u32x4*)(MG + r * 1024 + col0 + bj * HALF) = w; } }
    }
};
struct EpiOut {
    static constexpr bool PERM = true, AFTER_DRAIN = false, MID = false;
    const float* x; float* out;
    __device__ __forceinline__ void operator()(const f32x4 (&acc)[2][2][4][2], const Unit& u, int wr, int wc, int fr, int fq) const {
        const int row0 = u.pm * BM + wr * 64 + fr, col0 = u.pn * BM + wc * 32 + 8 * fq;
#pragma unroll
        for (int ai = 0; ai < 2; ++ai)
#pragma unroll
            for (int m = 0; m < 4; ++m) { const size_t off = (size_t)(row0 + ai * HALF + m * 16) * DM + col0;
#pragma unroll
                for (int bj = 0; bj < 2; ++bj)
#pragma unroll
                    for (int n = 0; n < 2; ++n) { const f32x4 xv = *(const f32x4*)(x + off + bj * HALF + 4 * n); *(f32x4*)(out + off + bj * HALF + 4 * n) = xv + acc[ai][bj][m][n]; }
                if (m & 1) asm volatile("" ::: "memory"); }
    }
};

template <class Epi, class Sched, class GemmT, bool ALIGN_EPI = false, bool SP2 = false>
__device__ __forceinline__ void gemm_phase(PG8_LAS unsigned char* lds, const GemmT g, const Sched& S, const Epi& E) {
    const int tid = threadIdx.x, wid = __builtin_amdgcn_readfirstlane(tid >> 6), lane = tid & 63, wr = wid >> 2, wc = wid & 3, fr = lane & 15, fq = lane >> 4;
    const int K = g.K, nt = K / BK;
    unsigned voffA[2], voffB[2];
#pragma unroll
    for (int i = 0; i < 2; ++i) { int R, C; stage_rc(tid * 16 + i * 8192, R, C); const int Rb = Epi::PERM ? ((R & ~31) + perm32(R & 31)) : R;
        voffA[i] = (unsigned)(R * g.lda + C) * 2u; voffB[i] = (unsigned)(Rb * K + C) * 2u; }
    const size_t kstep = (size_t)(BK * 2);
    const size_t hstepA = (size_t)HALF * g.lda * 2, hstepB = (size_t)HALF * K * 2;
    const unsigned ldsw = (unsigned)wid * 1024u;
    const int aoff = lds_byte(wr * 64 + fr, fq * 8), boff = lds_byte(wc * 32 + fr, fq * 8);
#define PG8_SA(b, h) (((b) * 2 + (h)) * HTB)
#define PG8_SB(b, h) ((4 + (b) * 2 + (h)) * HTB)
#define PG8_STAGE(bufoff, gbase, voff) do { _Pragma("unroll") for (int _i = 0; _i < 2; ++_i) \
        __builtin_amdgcn_global_load_lds((const unsigned*)((const char*)(gbase) + (voff)[_i]), (PG8_LAS unsigned*)(lds + (bufoff) + ldsw + _i * 8192), 16, 0, 0); } while (0)
#define PG8_LDA(dst, b, h) do { _Pragma("unroll") for (int m = 0; m < 4; ++m) _Pragma("unroll") for (int k = 0; k < 2; ++k) dst[m][k] = *(const PG8_LAS h16x8*)(lds + PG8_SA(b, h) + aoff + m * 2048 + k * 1024); } while (0)
#define PG8_LDB(dst, b, h) do { _Pragma("unroll") for (int n = 0; n < 2; ++n) _Pragma("unroll") for (int k = 0; k < 2; ++k) dst[n][k] = *(const PG8_LAS h16x8*)(lds + PG8_SB(b, h) + boff + n * 2048 + k * 1024); } while (0)
#define PG8_MMA(ai, bj, At, Bt) do { __builtin_amdgcn_s_setprio(1); _Pragma("unroll") for (int m = 0; m < 4; ++m) _Pragma("unroll") for (int n = 0; n < 2; ++n) _Pragma("unroll") for (int k = 0; k < 2; ++k) \
        acc[ai][bj][m][n] = __builtin_amdgcn_mfma_f32_16x16x32_f16(Bt[n][k], At[m][k], acc[ai][bj][m][n], 0, 0, 0); __builtin_amdgcn_s_setprio(0); } while (0)
#define PG8_WAIT_V(n) asm volatile("s_waitcnt vmcnt(" #n ")" ::: "memory")
#define PG8_WAIT_L(n) asm volatile("s_waitcnt lgkmcnt(" #n ")" ::: "memory")
#define PG8_BAR __builtin_amdgcn_s_barrier()
#define PG8_SCHED __builtin_amdgcn_sched_barrier(0)
    Unit cur, nxt; int ui = 0;
    if (!S.next(0, cur)) return;
    f32x4 acc[2][2][4][2];
#pragma unroll
    for (int a = 0; a < 2; ++a)
#pragma unroll
        for (int b = 0; b < 2; ++b)
#pragma unroll
            for (int m = 0; m < 4; ++m)
#pragma unroll
                for (int n = 0; n < 2; ++n) acc[a][b][m][n] = (f32x4){0.f, 0.f, 0.f, 0.f};
    h16x8 At[4][2], B0[2][2], B1[2][2];
    const char* cA = g.aptr(cur); const char* cB = g.bptr(cur);
    S.a_ready(cur);
    if constexpr (SP2) {
        PG8_STAGE(PG8_SB(0, 0), cB, voffB); PG8_STAGE(PG8_SB(0, 1), cB + hstepB, voffB); PG8_STAGE(PG8_SA(0, 0), cA, voffA); PG8_STAGE(PG8_SA(0, 1), cA + hstepA, voffA);
        if (wr == 1) PG8_BAR;
        PG8_WAIT_V(2); PG8_BAR;
        PG8_STAGE(PG8_SB(1, 0), cB + kstep, voffB); PG8_STAGE(PG8_SA(1, 0), cA + kstep, voffA); PG8_STAGE(PG8_SB(1, 1), cB + hstepB + kstep, voffB);
        PG8_WAIT_V(6); PG8_BAR;
    } else {
        PG8_STAGE(PG8_SB(0, 0), cB, voffB); PG8_STAGE(PG8_SA(0, 0), cA, voffA); PG8_STAGE(PG8_SB(0, 1), cB + hstepB, voffB); PG8_STAGE(PG8_SA(0, 1), cA + hstepA, voffA);
        if (wr == 1) PG8_BAR;
        PG8_WAIT_V(4); PG8_BAR;
        PG8_STAGE(PG8_SB(1, 0), cB + kstep, voffB); PG8_STAGE(PG8_SA(1, 0), cA + kstep, voffA); PG8_STAGE(PG8_SB(1, 1), cB + hstepB + kstep, voffB);
        PG8_WAIT_V(6); PG8_BAR;
    }
    for (;;) {
        const bool has_next = S.next(ui + 1, nxt);
        const char* nA = has_next ? g.aptr(nxt) : cA; const char* nB = has_next ? g.bptr(nxt) : cB;
        for (int t = 0; t < nt; t += 2) {
            const bool last = (t == nt - 2);
            const char* a1 = cA + (size_t)(t + 1) * kstep;
            const char* a2 = last ? nA : cA + (size_t)(t + 2) * kstep; const char* b2 = last ? nB : cB + (size_t)(t + 2) * kstep;
            const char* a3 = a2 + kstep; const char* b3 = b2 + kstep;
            if (last && has_next) S.a_ready(nxt);
            if constexpr (Epi::MID) { if (t == nt / 2) E.mid(acc, cur, wr, wc, fr, fq); }
            if constexpr (SP2) {
            PG8_LDB(B0, 0, 0); PG8_LDB(B1, 0, 1); PG8_SCHED; PG8_LDA(At, 0, 0); PG8_STAGE(PG8_SA(1, 1), a1 + hstepA, voffA);
            PG8_WAIT_V(8); PG8_WAIT_L(0); PG8_BAR; PG8_MMA(0, 0, At, B0); PG8_MMA(0, 1, At, B1); PG8_BAR; PG8_SCHED;
            PG8_LDA(At, 0, 1); PG8_STAGE(PG8_SB(0, 0), b2, voffB); PG8_STAGE(PG8_SB(0, 1), b2 + hstepB, voffB); PG8_STAGE(PG8_SA(0, 0), a2, voffA);
            PG8_WAIT_V(8); PG8_WAIT_L(0); PG8_BAR; PG8_MMA(1, 0, At, B0); PG8_MMA(1, 1, At, B1); PG8_BAR; PG8_SCHED;
            PG8_LDB(B0, 1, 0); PG8_LDB(B1, 1, 1); PG8_SCHED; PG8_LDA(At, 1, 0); PG8_STAGE(PG8_SA(0, 1), a2 + hstepA, voffA);
            PG8_WAIT_V(8); PG8_WAIT_L(0); PG8_BAR; PG8_MMA(0, 0, At, B0); PG8_MMA(0, 1, At, B1); PG8_BAR; PG8_SCHED;
            PG8_LDA(At, 1, 1); PG8_STAGE(PG8_SB(1, 0), b3, voffB); PG8_STAGE(PG8_SB(1, 1), b3 + hstepB, voffB); PG8_STAGE(PG8_SA(1, 0), a3, voffA);
            PG8_WAIT_V(8); PG8_WAIT_L(0); PG8_BAR; PG8_MMA(1, 0, At, B0); PG8_MMA(1, 1, At, B1); PG8_BAR; PG8_SCHED;
            } else {
            PG8_LDB(B0, 0, 0); PG8_SCHED; PG8_LDA(At, 0, 0); PG8_STAGE(PG8_SA(1, 1), a1 + hstepA, voffA);
            PG8_WAIT_L(8); PG8_BAR; PG8_WAIT_L(0); PG8_MMA(0, 0, At, B0); PG8_BAR; PG8_SCHED;
            PG8_LDB(B1, 0, 1); PG8_STAGE(PG8_SB(0, 0), b2, voffB);
            PG8_BAR; PG8_WAIT_L(0); PG8_MMA(0, 1, At, B1); PG8_BAR;
            PG8_LDA(At, 0, 1); PG8_STAGE(PG8_SA(0, 0), a2, voffA);
            PG8_BAR; PG8_WAIT_L(0); PG8_MMA(1, 0, At, B0); PG8_BAR; PG8_SCHED;
            PG8_STAGE(PG8_SB(0, 1), b2 + hstepB, voffB);
            PG8_WAIT_V(6); PG8_BAR; PG8_MMA(1, 1, At, B1); PG8_BAR;
            PG8_LDB(B0, 1, 0); PG8_SCHED; PG8_LDA(At, 1, 0); PG8_STAGE(PG8_SA(0, 1), a2 + hstepA, voffA);
            PG8_WAIT_L(8); PG8_BAR; PG8_WAIT_L(0); PG8_MMA(0, 0, At, B0); PG8_BAR; PG8_SCHED;
            PG8_LDB(B1, 1, 1); PG8_STAGE(PG8_SB(1, 0), b3, voffB);
            PG8_BAR; PG8_WAIT_L(0); PG8_MMA(0, 1, At, B1); PG8_BAR;
            PG8_LDA(At, 1, 1); PG8_STAGE(PG8_SA(1, 0), a3, voffA);
            PG8_BAR; PG8_WAIT_L(0); PG8_MMA(1, 0, At, B0); PG8_BAR; PG8_SCHED;
            PG8_STAGE(PG8_SB(1, 1), b3 + hstepB, voffB);
            PG8_WAIT_V(6); PG8_BAR; PG8_MMA(1, 1, At, B1); PG8_BAR;
            }
        }
        if constexpr (ALIGN_EPI) { if (wr == 0) PG8_BAR; }
        if constexpr (!Epi::AFTER_DRAIN) { E(acc, cur, wr, wc, fr, fq); S.done(cur); }
        if (!has_next) break;
#pragma unroll
        for (int a = 0; a < 2; ++a)
#pragma unroll
            for (int b = 0; b < 2; ++b)
#pragma unroll
                for (int m = 0; m < 4; ++m)
#pragma unroll
                    for (int n = 0; n < 2; ++n) acc[a][b][m][n] = (f32x4){0.f, 0.f, 0.f, 0.f};
        cur = nxt; cA = nA; cB = nB; ++ui;
        if constexpr (ALIGN_EPI) { if (wr == 1) PG8_BAR; }
    }
    PG8_WAIT_V(0);
    if constexpr (!ALIGN_EPI) { if (wr == 0) PG8_BAR; }
    PG8_BAR;
    if constexpr (Epi::AFTER_DRAIN) { E.fused(acc, cur, wr, wc, fr, fq, lds, wid, lane); S.done(cur); }
#undef PG8_SA
#undef PG8_SB
#undef PG8_STAGE
#undef PG8_LDA
#undef PG8_LDB
#undef PG8_MMA
#undef PG8_WAIT_V
#undef PG8_WAIT_L
#undef PG8_BAR
#undef PG8_SCHED
}
}

constexpr int NWAVES = 8, NTHREADS = 512;
constexpr int RING_BYTES = 131072, LDSCTL_OFF = 159744, LDS_BYTES = 163840;
#define LDS_WAIT() asm volatile("s_waitcnt lgkmcnt(0)" ::: "memory")
#ifdef PROF_SEG
#define TSTART(id) unsigned long long t0_##id = 0; if ((id) == PROF_SEG) { asm volatile("s_waitcnt vmcnt(0) lgkmcnt(0)" ::: "memory"); t0_##id = __builtin_amdgcn_s_memrealtime(); }
#define TSTOP(id) if ((id) == PROF_SEG) { asm volatile("s_waitcnt vmcnt(0) lgkmcnt(0)" ::: "memory"); F.prof += __builtin_amdgcn_s_memrealtime() - t0_##id; }
#else
#define TSTART(id)
#define TSTOP(id)
#endif

#define XB_TMO      128
#define XB_XCNT(j)  (256  + 64 * (j))
#define XB_XSUB(j)  (1280 + 64 * (j))
#define XB_XGEN(j)  (2304 + 64 * (j))
#define XB_TOP      3328
#define XB_TOPGEN   3392
#define XCD_BAR_WORDS 3456
#define XB_SPIN_CAP (1u << 18)

__device__ __forceinline__ unsigned xb_ld(unsigned* p)              { return __hip_atomic_load(p, __ATOMIC_RELAXED, __HIP_MEMORY_SCOPE_AGENT); }
__device__ __forceinline__ unsigned xb_add(unsigned* p, unsigned v) { return __hip_atomic_fetch_add(p, v, __ATOMIC_RELAXED, __HIP_MEMORY_SCOPE_AGENT); }
__device__ __forceinline__ unsigned xb_xcc_id() { return (unsigned)__builtin_amdgcn_s_getreg((3 << 11) | 20) & 0xFu; }
#define XB_SPIN(cond, bar) do { unsigned _sp = 0; while (cond) { __builtin_amdgcn_s_sleep(1); \
    if ((++_sp & 255u) == 0u) { if (xb_ld(&(bar)[XB_TMO])) break; if (_sp > XB_SPIN_CAP) { atomicAdd(&(bar)[XB_TMO], 1u); break; } } } } while (0)

struct XcdBarrier {
    unsigned* bar; unsigned x;
    volatile LAS unsigned* st;
};

__device__ __forceinline__ XcdBarrier xcd_barrier_post(unsigned* bar, volatile LAS unsigned* st) {
    XcdBarrier b; b.bar = bar; b.x = xb_xcc_id(); b.st = st;
    if (threadIdx.x == 0) (void)xb_add(&bar[XB_XCNT(b.x)], 1u);
    return b;
}
__device__ __forceinline__ void xcd_barrier_complete(unsigned* bar, unsigned x, unsigned& nloc, unsigned& nx) {
    const unsigned G = gridDim.x * gridDim.y * gridDim.z;
    unsigned sum, cnt, mine, sp = 0u;
    for (;;) {
        sum = 0u; cnt = 0u; mine = 0u;
#pragma unroll
        for (unsigned j = 0; j < 16; ++j) { const unsigned c = xb_ld(&bar[XB_XCNT(j)]); sum += c; cnt += (c > 0u) ? 1u : 0u; mine = (j == x) ? c : mine; }
        if (sum == G) break;
        __builtin_amdgcn_s_sleep(1);
        if ((++sp & 255u) == 0u) { if (xb_ld(&bar[XB_TMO])) break; if (sp > XB_SPIN_CAP) { atomicAdd(&bar[XB_TMO], 1u); break; } }
    }
    nloc = mine > 0u ? mine : 1u; nx = cnt > 0u ? cnt : 1u;
}

__device__ __forceinline__ void xcd_barrier(const XcdBarrier& b) {
    asm volatile("s_waitcnt vmcnt(0)" ::: "memory");
    __syncthreads();
    if (threadIdx.x == 0) {
        unsigned* bar = b.bar;
        __builtin_amdgcn_s_waitcnt(0);
        unsigned nloc = b.st[0], nx = b.st[1];
        if (nloc == 0u) { xcd_barrier_complete(bar, b.x, nloc, nx); b.st[0] = nloc; b.st[1] = nx; }
        const unsigned old = xb_add(&bar[XB_XSUB(b.x)], 1u);
        const unsigned gen = old / nloc;
        if (old + 1u == (gen + 1u) * nloc) {
            __builtin_amdgcn_fence(__ATOMIC_RELEASE, "agent");
            asm volatile("s_waitcnt vmcnt(0)" ::: "memory");
            const unsigned og = xb_add(&bar[XB_TOP], 1u);
            const unsigned tg = og / nx;
            if (og + 1u == (tg + 1u) * nx) xb_add(&bar[XB_TOPGEN], 1u);
            else XB_SPIN(xb_ld(&bar[XB_TOPGEN]) == tg, bar);
            __builtin_amdgcn_fence(__ATOMIC_ACQUIRE, "agent");
            xb_add(&bar[XB_XGEN(b.x)], 1u);
            asm volatile("s_waitcnt vmcnt(0)" ::: "memory");
        } else {
            XB_SPIN(xb_ld(&bar[XB_XGEN(b.x)]) == gen, bar);
            __builtin_amdgcn_fence(__ATOMIC_ACQUIRE, "agent");
            asm volatile("s_waitcnt vmcnt(0)" ::: "memory");
        }
    }
    __syncthreads();
}

struct Frame {
    LAS unsigned char* lds;
    int tid, lane, wave, vcu, G;
    unsigned char* ws;
    const float *x, *norm_g, *w_in, *qna, *kna, *sinks, *qnb, *knb, *relb, *wpa, *wpb, *wout;
    float* out;
    unsigned long long prof;
};

__device__ __forceinline__ float wave_sum(float v) {
#pragma unroll
    for (int o = 1; o < 64; o <<= 1) v += __shfl_xor(v, o);
    return v;
}
__device__ __forceinline__ int t5_bucket(int n) {
    if (n < 16) return n < 0 ? 0 : n;
    const int l = 16 + (int)(logf((float)n * 0.0625f) / logf(8.0f) * 16.0f);
    return l > 31 ? 31 : l;
}

__device__ __forceinline__ int win_src_col(int n) { return n < 3328 ? n : (n < 5376 ? n + 296 : (n < 5672 ? n - 2048 : -1)); }
template <bool INPROJ>
__device__ __forceinline__ void p0_transpose_item(const float* W, int srcN, int k0, int n0, h16* WT, int ldk, int kdst0, LAS float* scr, int lane, float scale) {
    const int n = n0 + (lane & 31); const int col = INPROJ ? win_src_col(n) : n;
    float wv_[32];
#pragma unroll
    for (int i = 0; i < 32; ++i) { const int kk = 2 * i + (lane >> 5); wv_[i] = (col >= 0) ? W[(size_t)(k0 + kk) * srcN + col] : 0.f; }
#pragma unroll
    for (int i = 0; i < 32; ++i) { const int kk = 2 * i + (lane >> 5); scr[kk * 33 + (lane & 31)] = wv_[i] * scale; }
    LDS_WAIT(); asm volatile("" ::: "memory");
    const int c = lane & 7;
#pragma unroll
    for (int j = 0; j < 4; ++j) { const int nn = (lane >> 3) + 8 * j; const LAS float* s = scr + (8 * c) * 33 + nn;
        float v[8];
#pragma unroll
        for (int e = 0; e < 8; ++e) v[e] = s[e * 33];
        u32x4 o; o.x = pkh(v[0], v[1]); o.y = pkh(v[2], v[3]); o.z = pkh(v[4], v[5]); o.w = pkh(v[6], v[7]);
        *(u32x4*)(WT + (size_t)(n0 + nn) * ldk + kdst0 + k0 + 8 * c) = o;
    }
    LDS_WAIT(); asm volatile("" ::: "memory");
}
__device__ __forceinline__ void p0_norm_rows4(const float* x, const float* g, h16* H, int m0, int mstride, int lane) {
    f32x4 v[4][4];
#pragma unroll
    for (int r = 0; r < 4; ++r)
#pragma unroll
        for (int j = 0; j < 4; ++j) v[r][j] = __builtin_nontemporal_load((const f32x4*)(x + (size_t)(m0 + r * mstride) * DM) + lane + 64 * j);
    f32x4 gg[4];
#pragma unroll
    for (int j = 0; j < 4; ++j) gg[j] = *((const f32x4*)g + lane + 64 * j) * HSCALE;
#pragma unroll
    for (int r = 0; r < 4; ++r) {
        float s = 0.f;
#pragma unroll
        for (int j = 0; j < 4; ++j) s += (v[r][j].x * v[r][j].x + v[r][j].y * v[r][j].y) + (v[r][j].z * v[r][j].z + v[r][j].w * v[r][j].w);
        const float rs = rsqrtf(wave_sum(s) * (1.0f / DM) + RMS_EPS);
#pragma unroll
        for (int j = 0; j < 4; ++j) { const f32x4 hv = v[r][j] * rs * gg[j]; u32x2 hi; hi.x = pkh(hv.x, hv.y); hi.y = pkh(hv.z, hv.w);
            *((u32x2*)(H + (size_t)(m0 + r * mstride) * 1024) + lane + 64 * j) = hi; }
    }
}
__device__ __forceinline__ void p0_prologue(Frame& F) {
    LAS float* scr = (LAS float*)(F.lds + F.wave * 16384);
    const int gw = F.vcu * NWAVES + F.wave, NGW = F.G * NWAVES;
    h16* Win = (h16*)(F.ws + WS_WIN); h16* Wp = (h16*)(F.ws + WS_WP); h16* Wo = (h16*)(F.ws + WS_WO);
    constexpr int I_IN = 16 * 184, I_P = 8 * 32, I_O = 16 * 32;
    constexpr int NITEMS = I_IN + 2 * I_P + I_O;
    for (int it = gw; it < NITEMS; it += NGW) {
        int r = it;
        if (r < I_IN) { p0_transpose_item<true>(F.w_in, INW, 64 * (r / 184), 32 * (r % 184), Win, 1024, 0, scr, F.lane, WSCALE); continue; } r -= I_IN;
        if (r < I_P) { p0_transpose_item<false>(F.wpa, DM, 64 * (r / 32), 32 * (r % 32), Wp, 1024, 0, scr, F.lane, 1.f); continue; } r -= I_P;
        if (r < I_P) { p0_transpose_item<false>(F.wpb, DM, 64 * (r / 32), 32 * (r % 32), Wp, 1024, 512, scr, F.lane, 1.f); continue; } r -= I_P;
        p0_transpose_item<false>(F.wout, DM, 64 * (r / 32), 32 * (r % 32), Wo, 1024, 0, scr, F.lane, 1.f);
    }
    h16* Hb = (h16*)(F.ws + WS_H);
    for (int m = gw; m + 3 * NGW < MROWS; m += 4 * NGW) p0_norm_rows4(F.x, F.norm_g, Hb, m, NGW, F.lane);
    if (MROWS % (4 * NGW) != 0) for (int m = gw + (MROWS / (4 * NGW)) * 4 * NGW; m < MROWS; m += NGW) p0_norm_rows4(F.x, F.norm_g, Hb, m, 0, F.lane);
}

constexpr int NBIN = 256, ICAP = 32;
constexpr int IW_VALS = 0, IW_HIST = 16384, IW_LIST = IW_HIST + 2 * NBIN * 4, IW_LMASK = IW_LIST + 2 * ICAP * 8, IW_BYTES = IW_LMASK + 512;
static_assert(8 * IW_BYTES <= LDSCTL_OFF, "indexer LDS");
__device__ __forceinline__ int idx_bin(float v, float smin, float scale) { const int b = (int)((v - smin) * scale); return b > NBIN - 1 ? NBIN - 1 : b; }
__device__ __forceinline__ float swz16(float x) { return __int_as_float(__builtin_amdgcn_ds_swizzle(__float_as_int(x), 0x401F)); }
__device__ __forceinline__ float half_min(float v) { v = fminf(v, __shfl_xor(v, 1)); v = fminf(v, __shfl_xor(v, 2)); v = fminf(v, __shfl_xor(v, 4)); v = fminf(v, __shfl_xor(v, 8)); return fminf(v, __shfl_xor(v, 16)); }
__device__ __forceinline__ float half_max(float v) { v = fmaxf(v, __shfl_xor(v, 1)); v = fmaxf(v, __shfl_xor(v, 2)); v = fmaxf(v, __shfl_xor(v, 4)); v = fmaxf(v, __shfl_xor(v, 8)); return fmaxf(v, __shfl_xor(v, 16)); }
__device__ __forceinline__ unsigned lowest_bits(unsigned w, unsigned n) { unsigned kept = 0u; while (n && w) { const unsigned bit = w & (0u - w); kept |= bit; w ^= bit; --n; } return kept; }
__device__ __forceinline__ void idx_pair(Frame& F, int b, int u) {
    const int lane = F.lane, k16 = lane & 15, fq = lane >> 4, th = fq >> 1, par = fq & 1;
    const int ta = 2 * u, t = ta + th;
    unsigned* gm = (unsigned*)(F.ws + WS_MASK) + (size_t)(b * SEQ + ta) * 64;
    if (ta < 256) {
        const int lo = lane * 32;
        gm[lane] = (ta >= lo + 31) ? 0xffffffffu : (ta >= lo ? ((2u << (ta - lo)) - 1u) : 0u);
        gm[64 + lane] = (ta + 1 >= lo + 31) ? 0xffffffffu : (ta + 1 >= lo ? ((2u << (ta + 1 - lo)) - 1u) : 0u);
        return;
    }
    LAS unsigned char* wl = F.lds + F.wave * IW_BYTES;
    LAS float* vals = (LAS float*)(wl + IW_VALS) + th * 2048 + 16 * par + k16;
    LAS unsigned* hist = (LAS unsigned*)(wl + IW_HIST) + th * NBIN;
    LAS u32x2* clist = (LAS u32x2*)(wl + IW_LIST) + th * ICAP;
    LAS unsigned* lmask = (LAS unsigned*)(wl + IW_LMASK);
    lmask[lane] = 0u; lmask[64 + lane] = 0u;
    TSTART(20)
    TSTART(21)
    const size_t qrow = (size_t)(b * SEQ + ta + (k16 >> 3));
    const h16x8 qh = *(const h16x8*)((const h16*)(F.ws + WS_QH) + qrow * 256 + (k16 & 7) * 32 + fq * 8);
    const f32x4 wv = *(const f32x4*)((const float*)(F.ws + WS_WI) + (size_t)(b * SEQ + t) * 8 + 4 * par);
    const int nstep = (ta + 1) / 32 + 1;
    const h16* kph = (const h16*)(F.ws + WS_KH) + (size_t)(b * SEQ + k16) * 32 + fq * 8;
    h16x8 kb[4][4];
#define IDX_LOAD(slot, step) do { const int st_ = (step) < 64 ? (step) : 63; const h16* ph_ = kph + (size_t)st_ * 1024; \
        kb[slot][0] = *(const h16x8*)ph_; kb[slot][2] = *(const h16x8*)(ph_ + 512); } while (0)
    IDX_LOAD(0, 0); IDX_LOAD(1, 1); IDX_LOAD(2, 2); IDX_LOAD(3, 3);
    TSTART(25)
    TSTOP(25)
    float vmin = INFINITY, vmax = -INFINITY;
    const int myk = 16 * par + k16;
#define IDX_STEP(slot, step) do { \
        f32x4 a0 = __builtin_amdgcn_mfma_f32_16x16x32_f16(qh, kb[slot][0], (f32x4){0.f, 0.f, 0.f, 0.f}, 0, 0, 0), a1 = __builtin_amdgcn_mfma_f32_16x16x32_f16(qh, kb[slot][2], (f32x4){0.f, 0.f, 0.f, 0.f}, 0, 0, 0); \
        IDX_LOAD(slot, (step) + 4); \
        float s0 = wv[0] * fmaxf(a0[0], 0.f), s1 = wv[0] * fmaxf(a1[0], 0.f); \
        _Pragma("unroll") for (int r = 1; r < 4; ++r) { s0 = fmaf(wv[r], fmaxf(a0[r], 0.f), s0); s1 = fmaf(wv[r], fmaxf(a1[r], 0.f), s1); } \
        const float recv = swz16(par ? s0 : s1); \
        const float mine = (par ? s1 : s0) + recv + 0.0f; \
        const bool valid = (32 * (step) + myk) <= t; \
        vals[32 * (step)] = valid ? mine : __builtin_nanf(""); \
        if (valid) { vmin = fminf(vmin, mine); vmax = fmaxf(vmax, mine); } } while (0)
#pragma unroll 1
    for (int i = 0; i < nstep; i += 8) { IDX_STEP(0, i); IDX_STEP(1, i + 1); IDX_STEP(2, i + 2); IDX_STEP(3, i + 3); IDX_STEP(0, i + 4); IDX_STEP(1, i + 5); IDX_STEP(2, i + 6); IDX_STEP(3, i + 7); }
#undef IDX_STEP
#undef IDX_LOAD
    TSTOP(21)
    TSTART(22)
    TSTART(26)
    float lo = half_min(vmin), hi = half_max(vmax);
    TSTOP(26)
    unsigned need = 256u, wa = 0u, wb = 0u; bool done = false;
#pragma unroll 1
    for (int level = 0; level < 64; ++level) {
        if (__ballot(!done) == 0ull) break;
        const bool tie = !done && !(hi > lo);
        const float scale = (hi > lo) ? ((float)NBIN - 0.5f) / (hi - lo) : 0.f;
        unsigned bst = 0u, rr = 0u, cb = 0u;
        TSTART(23)
        if (__ballot(!done && !tie) != 0ull) {
            *(LAS u32x4*)(wl + IW_HIST + lane * 16) = (u32x4){0u, 0u, 0u, 0u}; *(LAS u32x4*)(wl + IW_HIST + 1024 + lane * 16) = (u32x4){0u, 0u, 0u, 0u};
            asm volatile("s_waitcnt lgkmcnt(0)" ::: "memory");
            if (!done && !tie) {
#pragma unroll 8
                for (int i = 0; i < nstep; ++i) { const float v = vals[32 * i]; if (v >= lo && v <= hi) atomicAdd((unsigned*)&hist[idx_bin(v, lo, scale)], 1u); }
            }
            asm volatile("s_waitcnt lgkmcnt(0)" ::: "memory");
            TSTART(27)
            {
                const int l5 = lane & 31;
                const u32x4 cw0 = *(const LAS u32x4*)(wl + IW_HIST + th * 1024 + l5 * 32), cw1 = *(const LAS u32x4*)(wl + IW_HIST + th * 1024 + l5 * 32 + 16);
                const unsigned cnt[8] = {cw0.x, cw0.y, cw0.z, cw0.w, cw1.x, cw1.y, cw1.z, cw1.w};
                const unsigned s = ((cw0.x + cw0.y) + (cw0.z + cw0.w)) + ((cw1.x + cw1.y) + (cw1.z + cw1.w));
                unsigned v = s;
#pragma unroll
                for (int o = 1; o < 32; o <<= 1) { const unsigned tmp = (unsigned)__shfl_down((int)v, o, 32); if (l5 + o < 32) v += tmp; }
                const unsigned above = v - s; const bool crit = !done && !tie && above < need && need <= above + s;
                unsigned cum = above, b_ = 0, r_ = 0, c_ = 0; bool found = false;
#pragma unroll
                for (int e = 7; e >= 0; --e) { const unsigned cc = cnt[e]; if (!found && cum + cc >= need) { found = true; b_ = 8u * l5 + e; r_ = need - cum; c_ = cc; } if (!found) cum += cc; }
                const unsigned long long cm = __ballot(crit);
                const int cla = (unsigned)cm ? (int)__builtin_ctz((unsigned)cm) : 0, clb = (unsigned)(cm >> 32) ? 32 + (int)__builtin_ctz((unsigned)(cm >> 32)) : 32;
                const unsigned bqa = (unsigned)__builtin_amdgcn_readlane((int)b_, cla), rqa = (unsigned)__builtin_amdgcn_readlane((int)r_, cla), cqa = (unsigned)__builtin_amdgcn_readlane((int)c_, cla);
                const unsigned bqb = (unsigned)__builtin_amdgcn_readlane((int)b_, clb), rqb = (unsigned)__builtin_amdgcn_readlane((int)r_, clb), cqb = (unsigned)__builtin_amdgcn_readlane((int)c_, clb);
                if (!done && !tie) { bst = th ? bqb : bqa; rr = th ? rqb : rqa; cb = th ? cqb : cqa; }
            }
            TSTOP(27)
        }
        TSTOP(23)
        TSTART(24)
        const bool takeall = (cb == rr);
        const int bsel = takeall ? (int)bst : (int)bst + 1;
        bool slow = true;
        if (level == 0 && __ballot(tie) == 0ull) {
            const float inv_scale = (hi - lo) * (1.0f / ((float)NBIN - 0.5f));
            const float thrA = lo + ((float)bsel + 0.02f) * inv_scale, thrB = lo + ((float)bst - 0.02f) * inv_scale;
            unsigned zc_a = 0u, zc_b = 0u;
#pragma unroll 4
            for (int i = 0; i < nstep; ++i) {
                const float v = vals[32 * i];
                const bool isA = v >= thrA, zone = v >= thrB && !isA;
                const unsigned long long sm = __ballot(isA), zm = __ballot(zone);
                const unsigned slot = th ? zc_b + __builtin_amdgcn_mbcnt_hi((unsigned)(zm >> 32), 0u) : zc_a + __builtin_amdgcn_mbcnt_lo((unsigned)zm, 0u);
                if (zone && slot < (unsigned)ICAP) clist[slot] = (u32x2){__float_as_uint(v), (unsigned)(32 * i + myk)};
                zc_a += __popc((unsigned)zm); zc_b += __popc((unsigned)(zm >> 32));
                if (lane == i) { wa |= (unsigned)sm; wb |= (unsigned)(sm >> 32); }
            }
            asm volatile("s_waitcnt lgkmcnt(0)" ::: "memory");
            TSTART(28)
            if (zc_a <= (unsigned)ICAP && zc_b <= (unsigned)ICAP) {
                slow = false;
                const int j = lane & 31; const unsigned zc = th ? zc_b : zc_a;
                const u32x2 me = clist[j]; const float vj = __uint_as_float(me.x);
                const int bj = idx_bin(vj, lo, scale);
                const bool have = (unsigned)j < zc, selj = have && bj >= bsel, memj = have && !takeall && bj == (int)bst;
                const float vmj = memj ? vj : -INFINITY; unsigned rank = 0u;
                const unsigned zmax = zc_a > zc_b ? zc_a : zc_b;
                for (unsigned i2 = 0; i2 < zmax; ++i2) {
                    const float va = __int_as_float(__builtin_amdgcn_readlane(__float_as_int(vmj), (int)i2)), vb2 = __int_as_float(__builtin_amdgcn_readlane(__float_as_int(vmj), (int)i2 + 32));
                    const unsigned ka = (unsigned)__builtin_amdgcn_readlane((int)me.y, (int)i2), kb2 = (unsigned)__builtin_amdgcn_readlane((int)me.y, (int)i2 + 32);
                    const float vi = th ? vb2 : va; const unsigned ki = th ? kb2 : ka;
                    rank += (vi > vj || (vi == vj && ki < me.y)) ? 1u : 0u;
                }
                if (selj || (memj && rank < rr)) atomicOr((unsigned*)&lmask[th * 64 + (me.y >> 5)], 1u << (me.y & 31));
                done = true;
            }
            TSTOP(28)
        }
        if (slow) {
            const bool uselist = !takeall && cb <= (unsigned)ICAP;
            float nlo = INFINITY, nhi = -INFINITY; unsigned cnt_a = 0u, cnt_b = 0u, tie_a = 0u, tie_b = 0u;
            const unsigned need_a = (unsigned)__builtin_amdgcn_readlane((int)need, 0), need_b = (unsigned)__builtin_amdgcn_readlane((int)need, 32);
            const bool tie_any = __ballot(tie) != 0ull;
#pragma unroll 2
            for (int i = 0; i < nstep; ++i) {
                const float v = vals[32 * i]; const bool act = !done && v >= lo && v <= hi;
                const int bn = idx_bin(v, lo, scale);
                const bool sel = act && !tie && bn >= bsel, mem = act && !tie && !takeall && bn == (int)bst;
                unsigned long long sm = __ballot(sel);
                if (tie_any) {
                    const unsigned long long tm = __ballot(act && tie);
                    const unsigned ka = lowest_bits((unsigned)tm, need_a - tie_a), kb = lowest_bits((unsigned)(tm >> 32), need_b - tie_b);
                    tie_a += __popc(ka); tie_b += __popc(kb); sm |= (unsigned long long)ka | ((unsigned long long)kb << 32);
                }
                if (sm) { if (lane == i) { wa |= (unsigned)sm; wb |= (unsigned)(sm >> 32); } }
                const unsigned long long mm = __ballot(mem);
                if (mm) {
                    if (mem) { nlo = fminf(nlo, v); nhi = fmaxf(nhi, v);
                        if (uselist) { const unsigned slot = th ? cnt_b + __builtin_amdgcn_mbcnt_hi((unsigned)(mm >> 32), 0u) : cnt_a + __builtin_amdgcn_mbcnt_lo((unsigned)mm, 0u);
                            if (slot < (unsigned)ICAP) clist[slot] = (u32x2){__float_as_uint(v), (unsigned)(32 * i + myk)}; } }
                    cnt_a += __popc((unsigned)mm); cnt_b += __popc((unsigned)(mm >> 32));
                }
            }
            asm volatile("s_waitcnt lgkmcnt(0)" ::: "memory");
            if (!done) {
                if (tie || takeall) done = true;
                else if (uselist) {
                    const int j = lane & 31; const u32x2 me = clist[j]; const float vj = __uint_as_float(me.x); unsigned rank = 0u;
                    for (unsigned i2 = 0; i2 < cb; ++i2) { const u32x2 o = clist[i2]; const float vi = __uint_as_float(o.x); rank += (vi > vj || (vi == vj && o.y < me.y)) ? 1u : 0u; }
                    if ((unsigned)j < cb && rank < rr) atomicOr((unsigned*)&lmask[th * 64 + (me.y >> 5)], 1u << (me.y & 31));
                    done = true;
                } else { lo = half_min(nlo); hi = half_max(nhi); need = rr; }
            }
        }
        TSTOP(24)
    }
    asm volatile("s_waitcnt lgkmcnt(0)" ::: "memory");
    gm[lane] = wa | lmask[lane]; gm[64 + lane] = wb | lmask[64 + lane];
    TSTOP(22)
    TSTOP(20)
}
__device__ __forceinline__ void p2_index_phase(Frame& F) {
    for (int gw = F.vcu * NWAVES + F.wave; gw < 2048; gw += F.G * NWAVES) {
        const int b = gw >> 8, r = gw & 255;
#pragma unroll 1
        for (int k = 0; k < 4; ++k) { const int u = (k == 0) ? 1023 - r : (k == 1) ? 512 + r : (k == 2) ? 511 - r : r; idx_pair(F, b, u); }
    }
}

constexpr int AT_NSLOT = 5, AT_K = 0, AT_KSZ = 64 * 144, AT_V = AT_NSLOT * AT_KSZ, AT_VSZ = 64 * 192, AT_LUT = AT_V + AT_NSLOT * AT_VSZ, AT_MTAB = AT_LUT + 320 * 4, AT_OST = 0, AT_OSTSZ = 32 * 144;
static_assert(AT_MTAB + 128 <= RING_BYTES && 8 * AT_OSTSZ <= AT_V, "attention LDS");
typedef _Float16 h16x2v __attribute__((ext_vector_type(2)));
__device__ __forceinline__ s16x4 vtr_read(const LAS unsigned char* p) { return __builtin_amdgcn_ds_read_tr16_b64_v4i16((LAS s16x4*)p); }

template <bool ISB>
__device__ __forceinline__ void attn_unit(Frame& F, int b, int h, int qb) {
    const int tid = F.tid, lane = F.lane, wid = F.wave, q = lane & 31, hi = lane >> 5;
    const int q0 = qb * 256, r0 = q0 + wid * 32, t = r0 + q;
    const size_t row = (size_t)b * SEQ + t;
    const h16* Qp; const h16* Kp; const h16* Vp; const h16* Zp; int kvpitch, ycol;
    if (ISB) { Qp = (const h16*)(F.ws + WS_QB) + h * 64; Kp = (const h16*)(F.ws + WS_KB) + h * 64; Vp = (const h16*)(F.ws + WS_VB) + h * 64; Zp = (const h16*)(F.ws + WS_ZB) + h * 64; kvpitch = 512; ycol = 512 + h * 64; }
    else     { Qp = (const h16*)(F.ws + WS_QA) + h * 64; Kp = (const h16*)(F.ws + WS_KVA) + (h >> 2) * 64; Vp = (const h16*)(F.ws + WS_KVA) + 128 + (h >> 2) * 64; Zp = (const h16*)(F.ws + WS_ZA) + h * 64; kvpitch = 256; ycol = h * 64; }
    const unsigned* mrow = (const unsigned*)(F.ws + WS_MASK) + row * 64;
    LAS float* lut = (LAS float*)(F.lds + AT_LUT);
    for (int i = tid; i < 320; i += NTHREADS) { const int dist = 223 - i; float v;
        if (ISB) v = dist < 0 ? 0.f : (F.relb[t5_bucket(dist > 127 ? 127 : dist) * 16 + 8 + h] - F.relb[31 * 16 + 8 + h]) * LOG2E;
        else v = (dist >= 0 && dist < 128) ? F.relb[t5_bucket(dist) * 16 + h] * LOG2E : -INFINITY;
        lut[i] = v; }
    if (tid < 16) { u32x2 e; e.x = ((tid & 1) ? 0xffffu : 0u) | ((tid & 2) ? 0xffff0000u : 0u); e.y = ((tid & 4) ? 0xffffu : 0u) | ((tid & 8) ? 0xffff0000u : 0u); *(LAS u32x2*)(F.lds + AT_MTAB + tid * 8) = e; }
    h16x8 qr[4];
    {   const float* qg = ISB ? F.qnb : F.qna; float ss = 0.f;
#pragma unroll
        for (int d0 = 0; d0 < 4; ++d0) { qr[d0] = *(const h16x8*)(Qp + row * 512 + d0 * 16 + hi * 8);
#pragma unroll
            for (int e = 0; e < 8; ++e) { const float f = (float)qr[d0][e]; ss += f * f; } }
        ss += __shfl_xor(ss, 32);
        const float rq = rsqrtf(ss * (1.0f / 64.0f) + RMS_EPS) * QSCALE;
#pragma unroll
        for (int d0 = 0; d0 < 4; ++d0) { const f32x4 g0 = *(const f32x4*)(qg + d0 * 16 + hi * 8), g1 = *(const f32x4*)(qg + d0 * 16 + hi * 8 + 4);
            u32x4 w; w.x = pkh((float)qr[d0][0] * rq * g0[0], (float)qr[d0][1] * rq * g0[1]); w.y = pkh((float)qr[d0][2] * rq * g0[2], (float)qr[d0][3] * rq * g0[3]);
            w.z = pkh((float)qr[d0][4] * rq * g1[0], (float)qr[d0][5] * rq * g1[1]); w.w = pkh((float)qr[d0][6] * rq * g1[2], (float)qr[d0][7] * rq * g1[3]);
            qr[d0] = __builtin_bit_cast(h16x8, w); } }
    float kgn[8];
    {   const float* kgp = (ISB ? F.knb : F.kna) + (tid & 7) * 8; const f32x4 g0 = *(const f32x4*)kgp, g1 = *(const f32x4*)(kgp + 4);
        kgn[0] = g0[0]; kgn[1] = g0[1]; kgn[2] = g0[2]; kgn[3] = g0[3]; kgn[4] = g1[0]; kgn[5] = g1[1]; kgn[6] = g1[2]; kgn[7] = g1[3]; }
#define KNORM(KR) do { const h16x8 kv_ = __builtin_bit_cast(h16x8, KR); float f_[8]; float ss_ = 0.f; \
        _Pragma("unroll") for (int e = 0; e < 8; ++e) { f_[e] = (float)kv_[e]; ss_ += f_[e] * f_[e]; } \
        ss_ += __shfl_xor(ss_, 1); ss_ += __shfl_xor(ss_, 2); ss_ += __shfl_xor(ss_, 4); \
        const float rk_ = rsqrtf(ss_ * (1.0f / 64.0f) + RMS_EPS); \
        KR.x = pkh(f_[0] * rk_ * kgn[0], f_[1] * rk_ * kgn[1]); KR.y = pkh(f_[2] * rk_ * kgn[2], f_[3] * rk_ * kgn[3]); \
        KR.z = pkh(f_[4] * rk_ * kgn[4], f_[5] * rk_ * kgn[5]); KR.w = pkh(f_[6] * rk_ * kgn[6], f_[7] * rk_ * kgn[7]); } while (0)
    float m_run = -INFINITY, l_run = 0.f;
    f32x16 o[2];
#pragma unroll
    for (int r = 0; r < 16; ++r) { o[0][r] = 0.f; o[1][r] = 0.f; }
    const int kfo = q * 144 + hi * 16;
    const int vfo = (4 * hi + ((lane & 15) >> 2)) * 192 + ((lane >> 4) & 1) * 32 + (lane & 3) * 8;
#define ATT_TILE(SLOT, K0) do { const int k0_ = (K0); const LAS unsigned char* kb = F.lds + AT_K + (SLOT) * AT_KSZ + kfo; const LAS unsigned char* vb = F.lds + AT_V + (SLOT) * AT_VSZ + vfo; \
            f32x16 p0, p1; \
            _Pragma("unroll") \
            for (int r = 0; r < 16; ++r) { p0[r] = 0.f; p1[r] = 0.f; } \
            _Pragma("unroll") \
            for (int d0 = 0; d0 < 4; ++d0) { \
                const h16x8 ka = *(const LAS h16x8*)(kb + d0 * 32), kc = *(const LAS h16x8*)(kb + 32 * 144 + d0 * 32); \
                p0 = __builtin_amdgcn_mfma_f32_32x32x16_f16(ka, qr[d0], p0, 0, 0, 0); \
                p1 = __builtin_amdgcn_mfma_f32_32x32x16_f16(kc, qr[d0], p1, 0, 0, 0); \
            } \
 \
            if (!ISB || (r0 - k0_ - 63 < 113)) { \
                const LAS float* lp = lut + (223 - (t - k0_ - 4 * hi)); \
            _Pragma("unroll") \
                for (int r = 0; r < 16; ++r) { const int c = (r & 3) + 8 * (r >> 2); p0[r] += lp[c]; p1[r] += lp[32 + c]; } \
            } \
 \
            h16x2v s2[16]; \
            _Pragma("unroll") \
            for (int j = 0; j < 8; ++j) { s2[j] = __builtin_convertvector((f32x2){p0[2 * j], p0[2 * j + 1]}, h16x2v); s2[8 + j] = __builtin_convertvector((f32x2){p1[2 * j], p1[2 * j + 1]}, h16x2v); } \
            h16x2v m2 = __builtin_elementwise_max(s2[0], s2[1]); \
            _Pragma("unroll") \
            for (int j = 2; j < 16; ++j) m2 = __builtin_elementwise_max(m2, s2[j]); \
            float mx = fmaxf((float)m2.x, (float)m2.y); \
            mx = fmaxf(mx, __shfl_xor(mx, 32)); \
            const float mnew = fmaxf(m_run, mx), muse = (mnew == -INFINITY) ? 0.f : mnew; \
            if (__any(mnew > m_run)) { \
                const float alpha = __builtin_amdgcn_exp2f(m_run - muse); \
                l_run *= alpha; \
            _Pragma("unroll") \
                for (int r = 0; r < 16; ++r) { o[0][r] *= alpha; o[1][r] *= alpha; } \
            } \
            m_run = mnew; \
            const h16 nm = (h16)(-muse); const h16x2v nm2 = {nm, nm}; \
            _Pragma("unroll") \
            for (int j = 0; j < 16; ++j) { const h16x2v a = s2[j] + nm2; s2[j].x = __builtin_exp2f16(a.x); s2[j].y = __builtin_exp2f16(a.y); } \
            if (ISB) { \
                const unsigned mm0 = mw.x >> (4 * hi), mm1 = mw.y >> (4 * hi); \
            _Pragma("unroll") \
                for (int g4 = 0; g4 < 4; ++g4) { \
                    const u32x2 e0 = *(const LAS u32x2*)(F.lds + AT_MTAB + ((mm0 >> (8 * g4)) & 15u) * 8), e1 = *(const LAS u32x2*)(F.lds + AT_MTAB + ((mm1 >> (8 * g4)) & 15u) * 8); \
                    s2[2 * g4] = __builtin_bit_cast(h16x2v, __builtin_bit_cast(unsigned, s2[2 * g4]) & e0.x); s2[2 * g4 + 1] = __builtin_bit_cast(h16x2v, __builtin_bit_cast(unsigned, s2[2 * g4 + 1]) & e0.y); \
                    s2[8 + 2 * g4] = __builtin_bit_cast(h16x2v, __builtin_bit_cast(unsigned, s2[8 + 2 * g4]) & e1.x); s2[8 + 2 * g4 + 1] = __builtin_bit_cast(h16x2v, __builtin_bit_cast(unsigned, s2[8 + 2 * g4 + 1]) & e1.y); \
                } \
            } \
            {   h16x2v a0 = s2[0] + s2[1], a1 = s2[2] + s2[3], a2 = s2[4] + s2[5], a3 = s2[6] + s2[7], a4 = s2[8] + s2[9], a5 = s2[10] + s2[11], a6 = s2[12] + s2[13], a7 = s2[14] + s2[15]; \
                a0 = a0 + a1; a2 = a2 + a3; a4 = a4 + a5; a6 = a6 + a7; \
                l_run += (((float)a0.x + (float)a0.y) + ((float)a2.x + (float)a2.y)) + (((float)a4.x + (float)a4.y) + ((float)a6.x + (float)a6.y)); } \
            u32x4 pk[4]; \
            _Pragma("unroll") \
            for (int s = 0; s < 4; ++s) pk[s] = (u32x4){__builtin_bit_cast(unsigned, s2[4 * s]), __builtin_bit_cast(unsigned, s2[4 * s + 1]), __builtin_bit_cast(unsigned, s2[4 * s + 2]), __builtin_bit_cast(unsigned, s2[4 * s + 3])}; \
            _Pragma("unroll") \
            for (int s = 0; s < 4; ++s) \
            _Pragma("unroll") \
                for (int d1 = 0; d1 < 2; ++d1) { \
                    const s16x4 lo4 = vtr_read(vb + (16 * s) * 192 + d1 * 64), hi4 = vtr_read(vb + (16 * s + 8) * 192 + d1 * 64); \
                    const h16x4 lf = __builtin_bit_cast(h16x4, lo4), hf = __builtin_bit_cast(h16x4, hi4); \
                    const h16x8 vf = {lf[0], lf[1], lf[2], lf[3], hf[0], hf[1], hf[2], hf[3]}; \
                    o[d1] = __builtin_amdgcn_mfma_f32_32x32x16_f16(vf, __builtin_bit_cast(h16x8, pk[s]), o[d1], 0, 0, 0); \
                } \
        } while (0)
    const int srow = tid >> 3, sch = tid & 7;
    const h16* kg = Kp + ((size_t)b * SEQ + srow) * kvpitch + sch * 8; const h16* vg = Vp + ((size_t)b * SEQ + srow) * kvpitch + sch * 8;
    const int kst = srow * 144 + sch * 16, vst = srow * 192 + sch * 16;
    if (ISB) {
        const int kt_lo = ISB ? 0 : (4 * qb - 2 < 0 ? 0 : 4 * qb - 2), kt_hi = 4 * qb + 3;
        u32x4 kreg = *(const u32x4*)(kg + (size_t)kt_lo * 64 * kvpitch), vreg = *(const u32x4*)(vg + (size_t)kt_lo * 64 * kvpitch);
        u32x2 mw = {0u, 0u}, mwn = {0u, 0u};
        if (ISB) mw = *(const u32x2*)(mrow + 2 * kt_lo);
        KNORM(kreg);
        *(LAS u32x4*)(F.lds + AT_K + kst) = kreg; *(LAS u32x4*)(F.lds + AT_V + vst) = vreg;
        __syncthreads();
        for (int kt = kt_lo; kt <= kt_hi; ++kt) {
            const int cur = (kt - kt_lo) & 1;
            if (kt < kt_hi) { kreg = *(const u32x4*)(kg + (size_t)(kt + 1) * 64 * kvpitch); vreg = *(const u32x4*)(vg + (size_t)(kt + 1) * 64 * kvpitch); if (ISB) mwn = *(const u32x2*)(mrow + 2 * (kt + 1)); }
            const int k0 = kt * 64;
            const bool active = ISB ? (k0 <= r0 + 31) : (k0 <= r0 + 31 && k0 + 63 >= r0 - 127);
            TSTART(31)
            if (active) {
                ATT_TILE(cur, k0);
            }
            TSTOP(31)
            TSTART(32)
            if (kt < kt_hi) { KNORM(kreg); *(LAS u32x4*)(F.lds + AT_K + (cur ^ 1) * AT_KSZ + kst) = kreg; *(LAS u32x4*)(F.lds + AT_V + (cur ^ 1) * AT_VSZ + vst) = vreg; mw = mwn; }
            TSTOP(32)
            TSTART(33)
            __syncthreads();
            TSTOP(33)
        }

    } else {
        u32x4 kr4[4], vr4[4];
#pragma unroll
        for (int jj = 0; jj < 4; ++jj) { const int kt = 4 * qb - 2 + jj; if (kt >= 0) { kr4[jj] = *(const u32x4*)(kg + (size_t)kt * 64 * kvpitch); vr4[jj] = *(const u32x4*)(vg + (size_t)kt * 64 * kvpitch); } }
#pragma unroll
        for (int jj = 0; jj < 4; ++jj) { const int kt = 4 * qb - 2 + jj; if (kt >= 0) { KNORM(kr4[jj]); *(LAS u32x4*)(F.lds + AT_K + jj * AT_KSZ + kst) = kr4[jj]; *(LAS u32x4*)(F.lds + AT_V + jj * AT_VSZ + vst) = vr4[jj]; } }
        __syncthreads();
        const int base_w = wid >> 1;
        u32x4 kreg, vreg; const u32x2 mw = {0u, 0u};
#pragma unroll 1
        for (int s = 0; s < 3; ++s) {
            if (s < 2) { kreg = *(const u32x4*)(kg + (size_t)(4 * qb + 2 + s) * 64 * kvpitch); vreg = *(const u32x4*)(vg + (size_t)(4 * qb + 2 + s) * 64 * kvpitch); }
            const int j = base_w + s, kt = 4 * qb - 2 + j;
            TSTART(31)
            if (kt >= 0) ATT_TILE((j == 5 ? 0 : j), kt * 64);
            TSTOP(31)
            if (s < 2) { const int sl = (s == 0) ? 4 : 0; KNORM(kreg); *(LAS u32x4*)(F.lds + AT_K + sl * AT_KSZ + kst) = kreg; *(LAS u32x4*)(F.lds + AT_V + sl * AT_VSZ + vst) = vreg; }
            TSTART(33)
            __syncthreads();
            TSTOP(33)
        }
    }
    TSTART(34)
    l_run += __shfl_xor(l_run, 32);
    if (!ISB) l_run += __builtin_amdgcn_exp2f(F.sinks[h] * LOG2E - m_run);
    const float inv = 1.0f / l_run;
    LAS unsigned char* ost = F.lds + AT_OST + wid * AT_OSTSZ;
#pragma unroll
    for (int d1 = 0; d1 < 2; ++d1)
#pragma unroll
        for (int g4 = 0; g4 < 4; ++g4) { u32x2 w; w.x = pkh(o[d1][4 * g4] * inv, o[d1][4 * g4 + 1] * inv); w.y = pkh(o[d1][4 * g4 + 2] * inv, o[d1][4 * g4 + 3] * inv);
            *(LAS u32x2*)(ost + q * 144 + (32 * d1 + 8 * g4 + 4 * hi) * 2) = w; }
    LDS_WAIT(); asm volatile("" ::: "memory");
    h16* Yp = (h16*)(F.ws + WS_Y);
#pragma unroll
    for (int i = 0; i < 4; ++i) { const int rr = i * 8 + (lane >> 3), ch = lane & 7; const size_t grow = (size_t)b * SEQ + r0 + rr;
        const h16x8 ov = *(const LAS h16x8*)(ost + rr * 144 + ch * 16); const h16x8 zv = *(const h16x8*)(Zp + grow * 512 + ch * 8);
        float y[8];
#pragma unroll
        for (int e = 0; e < 8; ++e) { const float z = (float)zv[e]; y[e] = (float)ov[e] * z * sigmoidf_fast(z); }
        u32x4 w; w.x = pkh(y[0], y[1]); w.y = pkh(y[2], y[3]); w.z = pkh(y[4], y[5]); w.w = pkh(y[6], y[7]);
        *(u32x4*)(Yp + grow * 1024 + ycol + ch * 8) = w; }
    __syncthreads();
    TSTOP(34)
#undef KNORM
#undef ATT_TILE
}
__device__ __forceinline__ void p3_attention_phase(Frame& F) {
    for (int v = F.vcu; v < 256; v += F.G) {
        const int bh = v >> 2, j = v & 3, b = bh >> 3, h = bh & 7;
        { TSTART(36) attn_unit<true>(F, b, h, 7 - j); attn_unit<true>(F, b, h, j); TSTOP(36) }
        { TSTART(35) attn_unit<false>(F, b, h, 2 * j); attn_unit<false>(F, b, h, 2 * j + 1); TSTOP(35) }
    }
}

struct Args { const float* in[12]; float* out; unsigned char* ws; int ph_lo, ph_hi; };
constexpr int N_PHASES = 6;
__global__ void __launch_bounds__(NTHREADS, 2) mk_fwd(Args args) {
    extern __shared__ __attribute__((aligned(16))) unsigned char lds_raw[];
    cg::grid_group grid = cg::this_grid();
    Frame F;
    F.lds = (LAS unsigned char*)lds_raw;
    F.tid = threadIdx.x; F.lane = F.tid & 63; F.wave = __builtin_amdgcn_readfirstlane(F.tid >> 6);
    F.G = gridDim.x; { const int bx = blockIdx.x; F.vcu = (F.G % 8 == 0) ? (bx % 8) * (F.G / 8) + bx / 8 : bx; }
    F.ws = args.ws; F.prof = 0ull;
    F.x = args.in[0]; F.norm_g = args.in[1]; F.w_in = args.in[2]; F.qna = args.in[3]; F.kna = args.in[4]; F.sinks = args.in[5];
    F.qnb = args.in[6]; F.knb = args.in[7]; F.relb = args.in[8]; F.wpa = args.in[9]; F.wpb = args.in[10]; F.wout = args.in[11]; F.out = args.out;
    const int lo = args.ph_lo, hi = args.ph_hi;
    if (lo < 0) grid.sync();
    if (F.tid < 64) ((LAS unsigned*)(F.lds + LDSCTL_OFF))[F.tid] = 0u;
    __syncthreads();
    XcdBarrier bar = xcd_barrier_post((unsigned*)(F.ws + WS_CTL), (volatile LAS unsigned*)(F.lds + LDSCTL_OFF) + 8);
#ifdef ONLY_PH
#define IN(k) ((k) == ONLY_PH && lo <= (k) && (k) < hi)
#else
#define IN(k) (lo <= (k) && (k) < hi)
#endif
#ifdef PROBE_SYNC2
#define SEAM(k) do { if (IN(k) && IN((k) + 1)) { xcd_barrier(bar); xcd_barrier(bar); } } while (0)
#else
#define SEAM(k) do { if (IN(k) && IN((k) + 1)) xcd_barrier(bar); } while (0)
#endif
    { TSTART(1) if (IN(0)) { p0_prologue(F); }
    SEAM(0); TSTOP(1) }
    TSTART(2)
    if (IN(1)) {
        pg8::GemmPlain g{(const h16*)(F.ws + WS_H), (const h16*)(F.ws + WS_WIN), 1024, 1024};
        pg8::StaticOrder S; S.init(MROWS, 23 * 256, F.G, (int)blockIdx.x);
        pg8::EpiIn E{F.ws, (h16*)F.out};
        pg8::gemm_phase<pg8::EpiIn, pg8::StaticOrder, pg8::GemmPlain, true, true>(F.lds, g, S, E);
    }
    SEAM(1);
    TSTOP(2)
    { TSTART(3) if (IN(2)) { p2_index_phase(F); }
    SEAM(2); TSTOP(3) }
    { TSTART(4) if (IN(3)) { p3_attention_phase(F); }
    SEAM(3); TSTOP(4) }
    TSTART(5)
    if (IN(4)) {
        pg8::GemmPlain g{(const h16*)(F.ws + WS_Y), (const h16*)(F.ws + WS_WP), 1024, 1024};
        pg8::StaticOrder S; S.init(MROWS, DM, F.G, (int)blockIdx.x);
        pg8::EpiMerge E{(const h16*)F.out, (h16*)(F.ws + WS_MG)};
        pg8::gemm_phase<pg8::EpiMerge, pg8::StaticOrder, pg8::GemmPlain, true, true>(F.lds, g, S, E);
    }
    SEAM(4);
    TSTOP(5)
    TSTART(6)
    if (IN(5)) {
        pg8::GemmPlain g{(const h16*)(F.ws + WS_MG), (const h16*)(F.ws + WS_WO), 1024, 1024};
        pg8::StaticOrder S; S.init(MROWS, DM, F.G, (int)blockIdx.x);
        pg8::EpiOut E{F.x, F.out};
        pg8::gemm_phase<pg8::EpiOut, pg8::StaticOrder, pg8::GemmPlain, true, true>(F.lds, g, S, E);
    }
    TSTOP(6)
#undef IN
#undef SEAM
#ifdef PROF_SEG
    if (blockIdx.x == PROF_BLK && F.wave == PROF_WAVE && hi == N_PHASES) { const unsigned long long t1 = __builtin_amdgcn_s_memrealtime() + F.prof * PROF_MULT; while (__builtin_amdgcn_s_memrealtime() < t1) __builtin_amdgcn_s_sleep(8); }
#endif
}

extern "C" void kernel_launch(void* const* d_in, const int* in_sizes, int n_in, void* d_out, int out_size, void* d_ws, size_t ws_size, hipStream_t stream) {
    static int grid = 0;
    if (grid == 0) {
        if (n_in != 12 || in_sizes[0] != MROWS * DM || out_size != MROWS * DM || ws_size < WS_END) { fprintf(stderr, "kernel_launch: unexpected problem (n_in %d, ws %zu)\n", n_in, ws_size); grid = -1; return; }
        int dev = 0, cus = 0, per_cu = 0;
        hipGetDevice(&dev); hipDeviceGetAttribute(&cus, hipDeviceAttributeMultiprocessorCount, dev);
        hipFuncSetAttribute((const void*)mk_fwd, hipFuncAttributeMaxDynamicSharedMemorySize, LDS_BYTES);
        hipOccupancyMaxActiveBlocksPerMultiprocessor(&per_cu, (const void*)mk_fwd, NTHREADS, LDS_BYTES);
        (void)hipGetLastError();
        if (per_cu < 1) { fprintf(stderr, "kernel_launch: occupancy query says %d blocks/CU\n", per_cu); per_cu = 1; }
        grid = cus;
        if (grid > 256) grid = 256;
    }
    if (grid < 0) return;
    (void)hipMemsetAsync((char*)d_ws + WS_CTL, 0, CTL_BYTES, stream);
    Args a{};
    for (int i = 0; i < 12; ++i) a.in[i] = (const float*)d_in[i];
    a.out = (float*)d_out; a.ws = (unsigned char*)d_ws;
#ifdef PROBE_PH
    {
        void* kargs[] = {&a};
        a.ph_lo = 0; a.ph_hi = PROBE_PH + 1;
        (void)hipLaunchCooperativeKernel((const void*)mk_fwd, dim3(grid), dim3(NTHREADS), kargs, LDS_BYTES, stream);
        (void)hipMemsetAsync((char*)d_ws + WS_CTL, 0, CTL_BYTES, stream);
#ifdef PROBE_SPLIT_ONLY
        a.ph_lo = PROBE_PH + 1; a.ph_hi = N_PHASES;
#else
        a.ph_lo = PROBE_PH; a.ph_hi = N_PHASES;
#endif
        (void)hipLaunchCooperativeKernel((const void*)mk_fwd, dim3(grid), dim3(NTHREADS), kargs, LDS_BYTES, stream);
    }
#else
    {
        a.ph_lo = 0; a.ph_hi = N_PHASES;
        void* kargs[] = {&a};
        hipError_t e = hipLaunchCooperativeKernel((const void*)mk_fwd, dim3(grid), dim3(NTHREADS), kargs, LDS_BYTES, stream);
        if (e != hipSuccess) fprintf(stderr, "cooperative launch failed: %s (grid %d)\n", hipGetErrorString(e), grid);
    }
#endif
}
```

```cpp
#include <hip/hip_runtime.h>
#include <hip/hip_cooperative_groups.h>
#include <cstdio>
#include <cstdint>
namespace cg = cooperative_groups;
#ifdef PROF_SEG
#ifndef PROF_MULT
#define PROF_MULT 4
#endif
#ifndef PROF_BLK
#define PROF_BLK 100
#endif
#ifndef PROF_WAVE
#define PROF_WAVE 3
#endif
#endif

#define LAS __attribute__((address_space(3)))
typedef _Float16 h16;
typedef _Float16 h16x2 __attribute__((ext_vector_type(2)));
typedef _Float16 h16x4 __attribute__((ext_vector_type(4)));
typedef _Float16 h16x8 __attribute__((ext_vector_type(8)));
typedef float f32x2 __attribute__((ext_vector_type(2)));
typedef float f32x4 __attribute__((ext_vector_type(4)));
typedef float f32x16 __attribute__((ext_vector_type(16)));
typedef unsigned u32x2 __attribute__((ext_vector_type(2)));
typedef unsigned u32x4 __attribute__((ext_vector_type(4)));
typedef short s16x4 __attribute__((ext_vector_type(4)));

__device__ __forceinline__ unsigned pkh(float lo, float hi) { const f32x2 v = {lo, hi}; const h16x2 h = __builtin_convertvector(v, h16x2); return __builtin_bit_cast(unsigned, h); }
__device__ __forceinline__ float sigmoidf_fast(float g) { g = fminf(fmaxf(g, -30.f), 30.f); return __builtin_amdgcn_rcpf(1.0f + __builtin_amdgcn_exp2f(-1.4426950408889634f * g)); }

constexpr int NBATCH = 8, SEQ = 2048, DM = 1024, MROWS = NBATCH * SEQ, INW = 5672;
constexpr float RMS_EPS = 1e-6f, LOG2E = 1.4426950408889634f, QSCALE = 0.125f * 1.4426950408889634f;
constexpr float HSCALE = 16.f, WSCALE = 64.f, INV_HW = 1.0f / (16.f * 64.f);
constexpr size_t MiB = 1u << 20;
constexpr size_t WS_H = 0;
constexpr size_t WS_Y = 0, WS_MG = 32 * MiB;
constexpr size_t WS_QH = 32 * MiB, WS_QL = 40 * MiB, WS_KH = 48 * MiB, WS_KL = 49 * MiB, WS_WI = 50 * MiB;
constexpr size_t WS_WIN = 64 * MiB;
constexpr size_t WS_WP = 77 * MiB, WS_WO = 79 * MiB;
constexpr size_t WS_QA = 81 * MiB, WS_KVA = 97 * MiB, WS_ZA = 105 * MiB, WS_QB = 121 * MiB, WS_KB = 137 * MiB, WS_VB = 153 * MiB, WS_ZB = 169 * MiB;
constexpr size_t WS_MASK = 185 * MiB;
constexpr size_t WS_CTL = 190 * MiB, CTL_BYTES = 65536;
constexpr size_t WS_END = 191 * MiB;

namespace pg8 {
#define PG8_LAS __attribute__((address_space(3)))
constexpr int BM = 256, BK = 64, HALF = 128, HTB = HALF * BK * 2  , STAGE_BYTES = 8 * HTB, NXCD = 8, WGM = 8;

__host__ __device__ __forceinline__ int lds_byte(int r, int c) { const int st = (r >> 4) * 2 + (c >> 5), rr = r & 15, cc = c & 31, ob = rr * 64 + cc * 2; return st * 1024 + (ob ^ (((ob >> 9) & 1) << 5)); }
__host__ __device__ __forceinline__ void stage_rc(int b, int& R, int& C) { const int st = b / 1024, sb = b % 1024, swz = sb ^ (((sb >> 9) & 1) << 5); R = (st >> 1) * 16 + swz / 64; C = (st & 1) * 32 + (swz % 64) / 2; }
__host__ __device__ __forceinline__ int perm32(int rho) { const int n = rho >> 4, i = rho & 15; return 8 * (i >> 2) + 4 * n + (i & 3); }

struct Unit { int pm, pn; };

struct StaticOrder {
    int nM, nN, nwg, G, c;
    __host__ __device__ void init(int M, int N, int G_, int c_) { nM = M / BM; nN = N / BM; nwg = nM * nN; G = G_; c = c_; }
    __host__ __device__ bool next(int i, Unit& u) const {
        const long L = (long)i * G + c; if (L >= nwg) return false;
        int wgid = (int)L; { const int q = nwg / NXCD, r = nwg % NXCD, xcd = wgid % NXCD, off = wgid / NXCD; wgid = (xcd < r ? xcd * (q + 1) : r * (q + 1) + (xcd - r) * q) + off; }
        const int nig = WGM * nN, gid = wgid / nig, fm = gid * WGM, gsz = (nM - fm) < WGM ? (nM - fm) : WGM;
        u.pm = fm + ((wgid % nig) % gsz); u.pn = (wgid % nig) / gsz; return true;
    }
    __device__ __forceinline__ void a_ready(const Unit&) const {}
    __device__ __forceinline__ void done(const Unit&) const {}
};

struct GemmPlain { const h16* A; const h16* Bt; int lda, K;
    __device__ __forceinline__ const char* aptr(const Unit& u) const { return (const char*)(A + (size_t)u.pm * BM * lda); }
    __device__ __forceinline__ const char* bptr(const Unit& u) const { return (const char*)(Bt + (size_t)u.pn * BM * K); } };
struct EpiIn {
    static constexpr bool PERM = true, AFTER_DRAIN = false, MID = false;
    unsigned char* ws; h16* G;
    __device__ __forceinline__ void operator()(const f32x4 (&acc)[2][2][4][2], const Unit& u, int wr, int wc, int fr, int fq) const {
        const int pn = u.pn, row0 = u.pm * BM + wr * 64 + fr, cl = wc * 32 + 8 * fq;
        if (pn < 21) {
            h16* base; int ldc, colt;
            if (pn < 2)       { base = (h16*)(ws + WS_QA);  ldc = 512; colt = pn * 256; }
            else if (pn == 2) { base = (h16*)(ws + WS_KVA); ldc = 256; colt = 0; }
            else if (pn < 5)  { base = (h16*)(ws + WS_ZA);  ldc = 512; colt = (pn - 3) * 256; }
            else if (pn < 7)  { base = (h16*)(ws + WS_QB);  ldc = 512; colt = (pn - 5) * 256; }
            else if (pn < 9)  { base = (h16*)(ws + WS_KB);  ldc = 512; colt = (pn - 7) * 256; }
            else if (pn < 11) { base = (h16*)(ws + WS_VB);  ldc = 512; colt = (pn - 9) * 256; }
            else if (pn < 13) { base = (h16*)(ws + WS_ZB);  ldc = 512; colt = (pn - 11) * 256; }
            else              { base = G;                   ldc = 2048; colt = (pn - 13) * 256; }
#pragma unroll
            for (int ai = 0; ai < 2; ++ai)
#pragma unroll
                for (int m = 0; m < 4; ++m) { h16* rowp = base + (size_t)(row0 + ai * HALF + m * 16) * ldc + colt + cl;
#pragma unroll
                    for (int bj = 0; bj < 2; ++bj) { const f32x4 v0 = acc[ai][bj][m][0] * INV_HW, v1 = acc[ai][bj][m][1] * INV_HW;
                        u32x4 w; w.x = pkh(v0[0], v0[1]); w.y = pkh(v0[2], v0[3]); w.z = pkh(v1[0], v1[1]); w.w = pkh(v1[2], v1[3]);
                        *(u32x4*)(rowp + bj * HALF) = w; } }
        } else {
            const int colt = (pn - 21) * 256 + cl;
#pragma unroll
            for (int ai = 0; ai < 2; ++ai)
#pragma unroll
                for (int m = 0; m < 4; ++m) { const size_t r = (size_t)(row0 + ai * HALF + m * 16);
#pragma unroll
                    for (int bj = 0; bj < 2; ++bj) { const int j = colt + bj * HALF; const f32x4 v0 = acc[ai][bj][m][0] * INV_HW, v1 = acc[ai][bj][m][1] * INV_HW;
                        if (j < 288) {
                            u32x4 hi; hi.x = pkh(v0[0] * 16.f, v0[1] * 16.f); hi.y = pkh(v0[2] * 16.f, v0[3] * 16.f); hi.z = pkh(v1[0] * 16.f, v1[1] * 16.f); hi.w = pkh(v1[2] * 16.f, v1[3] * 16.f);
                            if (j < 256) *(u32x4*)((h16*)(ws + WS_QH) + r * 256 + j) = hi; else *(u32x4*)((h16*)(ws + WS_KH) + r * 32 + (j - 256)) = hi;
                        } else if (j < 296) { float* w = (float*)(ws + WS_WI) + r * 8; *(f32x4*)w = v0; *(f32x4*)(w + 4) = v1; }
                    } }
        }
    }
};
struct EpiMerge {
    static constexpr bool PERM = true, AFTER_DRAIN = false, MID = true;
    const h16* G; h16* MG;
    __device__ __forceinline__ void mid(f32x4 (&acc)[2][2][4][2], const Unit& u, int wr, int wc, int fr, int fq) const {
        const int row0 = u.pm * BM + wr * 64 + fr, col0 = u.pn * BM + wc * 32 + 8 * fq;
#pragma unroll
        for (int ai = 0; ai < 2; ++ai)
#pragma unroll
            for (int m = 0; m < 4; ++m) { unsigned ro = (unsigned)(row0 + ai * HALF + m * 16); asm volatile("" : "+v"(ro)); const h16* gp = G + (size_t)ro * 2048 + col0;
#pragma unroll
                for (int bj = 0; bj < 2; ++bj) { const h16x8 ga = *(const h16x8*)(gp + bj * HALF), gb = *(const h16x8*)(gp + 1024 + bj * HALF);
#pragma unroll
                    for (int e = 0; e < 8; ++e) { const float a = fminf(fmaxf((float)ga[e], -30.f), 30.f), b = fminf(fmaxf((float)gb[e], -30.f), 30.f);
                        const float f = (1.0f + __builtin_amdgcn_exp2f(-LOG2E * b)) * __builtin_amdgcn_rcpf(1.0f + __builtin_amdgcn_exp2f(-LOG2E * a));
                        acc[ai][bj][m][e >> 2][e & 3] *= f; } }
                asm volatile("" ::: "memory"); }
    }
    __device__ __forceinline__ void operator()(const f32x4 (&acc)[2][2][4][2], const Unit& u, int wr, int wc, int fr, int fq) const {
        const int row0 = u.pm * BM + wr * 64 + fr, col0 = u.pn * BM + wc * 32 + 8 * fq;
#pragma unroll
        for (int ai = 0; ai < 2; ++ai)
#pragma unroll
            for (int m = 0; m < 4; ++m) { unsigned ro = (unsigned)(row0 + ai * HALF + m * 16); asm volatile("" : "+v"(ro)); const size_t r = (size_t)ro;
#pragma unroll
                for (int bj = 0; bj < 2; ++bj) { const h16x8 gb = *(const h16x8*)(G + r * 2048 + 1024 + col0 + bj * HALF);
                    float o[8];
#pragma unroll
                    for (int e = 0; e < 8; ++e) o[e] = acc[ai][bj][m][e >> 2][e & 3] * sigmoidf_fast((float)gb[e]);
                    u32x4 w; w.x = pkh(o[0], o[1]); w.y = pkh(o[2], o[3]); w.z = pkh(o[4], o[5]); w.w = pkh(o[6], o[7]);
                    *(u32x4*)(MG + r * 1024 + col0 + bj * HALF) = w; } }
    }
};
struct EpiOut {
    static constexpr bool PERM = true, AFTER_DRAIN = false, MID = false;
    const float* x; float* out;
    __device__ __forceinline__ void operator()(const f32x4 (&acc)[2][2][4][2], const Unit& u, int wr, int wc, int fr, int fq) const {
        const int row0 = u.pm * BM + wr * 64 + fr, col0 = u.pn * BM + wc * 32 + 8 * fq;
#pragma unroll
        for (int ai = 0; ai < 2; ++ai)
#pragma unroll
            for (int m = 0; m < 4; ++m) { const size_t off = (size_t)(row0 + ai * HALF + m * 16) * DM + col0;
#pragma unroll
                for (int bj = 0; bj < 2; ++bj)
#pragma unroll
                    for (int n = 0; n < 2; ++n) { const f32x4 xv = *(const f32x4*)(x + off + bj * HALF + 4 * n); *(f32x4*)(out + off + bj * HALF + 4 * n) = xv + acc[ai][bj][m][n]; }
                if (m & 1) asm volatile("" ::: "memory"); }
    }
};

template <class Epi, class Sched, class GemmT, bool ALIGN_EPI = false, bool SP2 = false>
__device__ __forceinline__ void gemm_phase(PG8_LAS unsigned char* lds, const GemmT g, const Sched& S, const Epi& E) {
    const int tid = threadIdx.x, wid = __builtin_amdgcn_readfirstlane(tid >> 6), lane = tid & 63, wr = wid >> 2, wc = wid & 3, fr = lane & 15, fq = lane >> 4;
    const int K = g.K, nt = K / BK;
    unsigned voffA[2], voffB[2];
#pragma unroll
    for (int i = 0; i < 2; ++i) { int R, C; stage_rc(tid * 16 + i * 8192, R, C); const int Rb = Epi::PERM ? ((R & ~31) + perm32(R & 31)) : R;
        voffA[i] = (unsigned)(R * g.lda + C) * 2u; voffB[i] = (unsigned)(Rb * K + C) * 2u; }
    const size_t kstep = (size_t)(BK * 2);
    const size_t hstepA = (size_t)HALF * g.lda * 2, hstepB = (size_t)HALF * K * 2;
    const unsigned ldsw = (unsigned)wid * 1024u;
    const int aoff = lds_byte(wr * 64 + fr, fq * 8), boff = lds_byte(wc * 32 + fr, fq * 8);
#define PG8_SA(b, h) (((b) * 2 + (h)) * HTB)
#define PG8_SB(b, h) ((4 + (b) * 2 + (h)) * HTB)
#define PG8_STAGE(bufoff, gbase, voff) do { _Pragma("unroll") for (int _i = 0; _i < 2; ++_i) \
        __builtin_amdgcn_global_load_lds((const unsigned*)((const char*)(gbase) + (voff)[_i]), (PG8_LAS unsigned*)(lds + (bufoff) + ldsw + _i * 8192), 16, 0, 0); } while (0)
#define PG8_LDA(dst, b, h) do { _Pragma("unroll") for (int m = 0; m < 4; ++m) _Pragma("unroll") for (int k = 0; k < 2; ++k) dst[m][k] = *(const PG8_LAS h16x8*)(lds + PG8_SA(b, h) + aoff + m * 2048 + k * 1024); } while (0)
#define PG8_LDB(dst, b, h) do { _Pragma("unroll") for (int n = 0; n < 2; ++n) _Pragma("unroll") for (int k = 0; k < 2; ++k) dst[n][k] = *(const PG8_LAS h16x8*)(lds + PG8_SB(b, h) + boff + n * 2048 + k * 1024); } while (0)
#define PG8_MMA(ai, bj, At, Bt) do { __builtin_amdgcn_s_setprio(1); _Pragma("unroll") for (int m = 0; m < 4; ++m) _Pragma("unroll") for (int n = 0; n < 2; ++n) _Pragma("unroll") for (int k = 0; k < 2; ++k) \
        acc[ai][bj][m][n] = __builtin_amdgcn_mfma_f32_16x16x32_f16(Bt[n][k], At[m][k], acc[ai][bj][m][n], 0, 0, 0); __builtin_amdgcn_s_setprio(0); } while (0)
#define PG8_WAIT_V(n) asm volatile("s_waitcnt vmcnt(" #n ")" ::: "memory")
#define PG8_WAIT_L(n) asm volatile("s_waitcnt lgkmcnt(" #n ")" ::: "memory")
#define PG8_BAR __builtin_amdgcn_s_barrier()
#define PG8_SCHED __builtin_amdgcn_sched_barrier(0)
    Unit cur, nxt; int ui = 0;
    if (!S.next(0, cur)) return;
    f32x4 acc[2][2][4][2];
#pragma unroll
    for (int a = 0; a < 2; ++a)
#pragma unroll
        for (int b = 0; b < 2; ++b)
#pragma unroll
            for (int m = 0; m < 4; ++m)
#pragma unroll
                for (int n = 0; n < 2; ++n) acc[a][b][m][n] = (f32x4){0.f, 0.f, 0.f, 0.f};
    h16x8 At[4][2], B0[2][2], B1[2][2];
    const char* cA = g.aptr(cur); const char* cB = g.bptr(cur);
    S.a_ready(cur);
    if constexpr (SP2) {
        PG8_STAGE(PG8_SB(0, 0), cB, voffB); PG8_STAGE(PG8_SB(0, 1), cB + hstepB, voffB); PG8_STAGE(PG8_SA(0, 0), cA, voffA); PG8_STAGE(PG8_SA(0, 1), cA + hstepA, voffA);
        if (wr == 1) PG8_BAR;
        PG8_WAIT_V(2); PG8_BAR;
        PG8_STAGE(PG8_SB(1, 0), cB + kstep, voffB); PG8_STAGE(PG8_SA(1, 0), cA + kstep, voffA); PG8_STAGE(PG8_SB(1, 1), cB + hstepB + kstep, voffB);
        PG8_WAIT_V(6); PG8_BAR;
    } else {
        PG8_STAGE(PG8_SB(0, 0), cB, voffB); PG8_STAGE(PG8_SA(0, 0), cA, voffA); PG8_STAGE(PG8_SB(0, 1), cB + hstepB, voffB); PG8_STAGE(PG8_SA(0, 1), cA + hstepA, voffA);
        if (wr == 1) PG8_BAR;
        PG8_WAIT_V(4); PG8_BAR;
        PG8_STAGE(PG8_SB(1, 0), cB + kstep, voffB); PG8_STAGE(PG8_SA(1, 0), cA + kstep, voffA); PG8_STAGE(PG8_SB(1, 1), cB + hstepB + kstep, voffB);
        PG8_WAIT_V(6); PG8_BAR;
    }
    for (;;) {
        const bool has_next = S.next(ui + 1, nxt);
        const char* nA = has_next ? g.aptr(nxt) : cA; const char* nB = has_next ? g.bptr(nxt) : cB;
        for (int t = 0; t < nt; t += 2) {
            const bool last = (t == nt - 2);
            const char* a1 = cA + (size_t)(t + 1) * kstep;
            const char* a2 = last ? nA : cA + (size_t)(t + 2) * kstep; const char* b2 = last ? nB : cB + (size_t)(t + 2) * kstep;
            const char* a3 = a2 + kstep; const char* b3 = b2 + kstep;
            if (last && has_next) S.a_ready(nxt);
            if constexpr (Epi::MID) { if (t == nt / 2) E.mid(acc, cur, wr, wc, fr, fq); }
            if constexpr (SP2) {
            PG8_LDB(B0, 0, 0); PG8_LDB(B1, 0, 1); PG8_SCHED; PG8_LDA(At, 0, 0); PG8_STAGE(PG8_SA(1, 1), a1 + hstepA, voffA);
            PG8_WAIT_V(8); PG8_WAIT_L(0); PG8_BAR; PG8_MMA(0, 0, At, B0); PG8_MMA(0, 1, At, B1); PG8_BAR; PG8_SCHED;
            PG8_LDA(At, 0, 1); PG8_STAGE(PG8_SB(0, 0), b2, voffB); PG8_STAGE(PG8_SB(0, 1), b2 + hstepB, voffB); PG8_STAGE(PG8_SA(0, 0), a2, voffA);
            PG8_WAIT_V(8); PG8_WAIT_L(0); PG8_BAR; PG8_MMA(1, 0, At, B0); PG8_MMA(1, 1, At, B1); PG8_BAR; PG8_SCHED;
            PG8_LDB(B0, 1, 0); PG8_LDB(B1, 1, 1); PG8_SCHED; PG8_LDA(At, 1, 0); PG8_STAGE(PG8_SA(0, 1), a2 + hstepA, voffA);
            PG8_WAIT_V(8); PG8_WAIT_L(0); PG8_BAR; PG8_MMA(0, 0, At, B0); PG8_MMA(0, 1, At, B1); PG8_BAR; PG8_SCHED;
            PG8_LDA(At, 1, 1); PG8_STAGE(PG8_SB(1, 0), b3, voffB); PG8_STAGE(PG8_SB(1, 1), b3 + hstepB, voffB); PG8_STAGE(PG8_SA(1, 0), a3, voffA);
            PG8_WAIT_V(8); PG8_WAIT_L(0); PG8_BAR; PG8_MMA(1, 0, At, B0); PG8_MMA(1, 1, At, B1); PG8_BAR; PG8_SCHED;
            } else {
            PG8_LDB(B0, 0, 0); PG8_SCHED; PG8_LDA(At, 0, 0); PG8_STAGE(PG8_SA(1, 1), a1 + hstepA, voffA);
            PG8_WAIT_L(8); PG8_BAR; PG8_WAIT_L(0); PG8_MMA(0, 0, At, B0); PG8_BAR; PG8_SCHED;
            PG8_LDB(B1, 0, 1); PG8_STAGE(PG8_SB(0, 0), b2, voffB);
            PG8_BAR; PG8_WAIT_L(0); PG8_MMA(0, 1, At, B1); PG8_BAR;
            PG8_LDA(At, 0, 1); PG8_STAGE(PG8_SA(0, 0), a2, voffA);
            PG8_BAR; PG8_WAIT_L(0); PG8_MMA(1, 0, At, B0); PG8_BAR; PG8_SCHED;
            PG8_STAGE(PG8_SB(0, 1), b2 + hstepB, voffB);
            PG8_WAIT_V(6); PG8_BAR; PG8_MMA(1, 1, At, B1); PG8_BAR;
            PG8_LDB(B0, 1, 0); PG8_SCHED; PG8_LDA(At, 1, 0); PG8_STAGE(PG8_SA(0, 1), a2 + hstepA, voffA);
            PG8_WAIT_L(8); PG8_BAR; PG8_WAIT_L(0); PG8_MMA(0, 0, At, B0); PG8_BAR; PG8_SCHED;
            PG8_LDB(B1, 1, 1); PG8_STAGE(PG8_SB(1, 0), b3, voffB);
            PG8_BAR; PG8_WAIT_L(0); PG8_MMA(0, 1, At, B1); PG8_BAR;
            PG8_LDA(At, 1, 1); PG8_STAGE(PG8_SA(1, 0), a3, voffA);
            PG8_BAR; PG8_WAIT_L(0); PG8_MMA(1, 0, At, B0); PG8_BAR; PG8_SCHED;
            PG8_STAGE(PG8_SB(1, 1), b3 + hstepB, voffB);
            PG8_WAIT_V(6); PG8_BAR; PG8_MMA(1, 1, At, B1); PG8_BAR;
            }
        }
        if constexpr (ALIGN_EPI) { if (wr == 0) PG8_BAR; }
        if constexpr (!Epi::AFTER_DRAIN) { E(acc, cur, wr, wc, fr, fq); S.done(cur); }
        if (!has_next) break;
#pragma unroll
        for (int a = 0; a < 2; ++a)
#pragma unroll
            for (int b = 0; b < 2; ++b)
#pragma unroll
                for (int m = 0; m < 4; ++m)
#pragma unroll
                    for (int n = 0; n < 2; ++n) acc[a][b][m][n] = (f32x4){0.f, 0.f, 0.f, 0.f};
        cur = nxt; cA = nA; cB = nB; ++ui;
        if constexpr (ALIGN_EPI) { if (wr == 1) PG8_BAR; }
    }
    PG8_WAIT_V(0);
    if constexpr (!ALIGN_EPI) { if (wr == 0) PG8_BAR; }
    PG8_BAR;
    if constexpr (Epi::AFTER_DRAIN) { E.fused(acc, cur, wr, wc, fr, fq, lds, wid, lane); S.done(cur); }
#undef PG8_SA
#undef PG8_SB
#undef PG8_STAGE
#undef PG8_LDA
#undef PG8_LDB
#undef PG8_MMA
#undef PG8_WAIT_V
#undef PG8_WAIT_L
#undef PG8_BAR
#undef PG8_SCHED
}
}

constexpr int NWAVES = 8, NTHREADS = 512;
constexpr int RING_BYTES = 131072, LDSCTL_OFF = 159744, LDS_BYTES = 163840;
#define LDS_WAIT() asm volatile("s_waitcnt lgkmcnt(0)" ::: "memory")
#ifdef PROF_SEG
#define TSTART(id) unsigned long long t0_##id = 0; if ((id) == PROF_SEG) { asm volatile("s_waitcnt vmcnt(0) lgkmcnt(0)" ::: "memory"); t0_##id = __builtin_amdgcn_s_memrealtime(); }
#define TSTOP(id) if ((id) == PROF_SEG) { asm volatile("s_waitcnt vmcnt(0) lgkmcnt(0)" ::: "memory"); F.prof += __builtin_amdgcn_s_memrealtime() - t0_##id; }
#else
#define TSTART(id)
#define TSTOP(id)
#endif

#define XB_TMO      128
#define XB_XCNT(j)  (256  + 64 * (j))
#define XB_XSUB(j)  (1280 + 64 * (j))
#define XB_XGEN(j)  (2304 + 64 * (j))
#define XB_TOP      3328
#define XB_TOPGEN   3392
#define XCD_BAR_WORDS 3456
#define XB_SPIN_CAP (1u << 18)

__device__ __forceinline__ unsigned xb_ld(unsigned* p)              { return __hip_atomic_load(p, __ATOMIC_RELAXED, __HIP_MEMORY_SCOPE_AGENT); }
__device__ __forceinline__ unsigned xb_add(unsigned* p, unsigned v) { return __hip_atomic_fetch_add(p, v, __ATOMIC_RELAXED, __HIP_MEMORY_SCOPE_AGENT); }
__device__ __forceinline__ unsigned xb_xcc_id() { return (unsigned)__builtin_amdgcn_s_getreg((3 << 11) | 20) & 0xFu; }
#define XB_SPIN(cond, bar) do { unsigned _sp = 0; while (cond) { __builtin_amdgcn_s_sleep(1); \
    if ((++_sp & 255u) == 0u) { if (xb_ld(&(bar)[XB_TMO])) break; if (_sp > XB_SPIN_CAP) { atomicAdd(&(bar)[XB_TMO], 1u); break; } } } } while (0)

struct XcdBarrier {
    unsigned* bar; unsigned x;
    volatile LAS unsigned* st;
};

__device__ __forceinline__ XcdBarrier xcd_barrier_post(unsigned* bar, volatile LAS unsigned* st) {
    XcdBarrier b; b.bar = bar; b.x = xb_xcc_id(); b.st = st;
    if (threadIdx.x == 0) (void)xb_add(&bar[XB_XCNT(b.x)], 1u);
    return b;
}
__device__ __forceinline__ void xcd_barrier_complete(unsigned* bar, unsigned x, unsigned& nloc, unsigned& nx) {
    const unsigned G = gridDim.x * gridDim.y * gridDim.z;
    unsigned sum, cnt, mine, sp = 0u;
    for (;;) {
        sum = 0u; cnt = 0u; mine = 0u;
#pragma unroll
        for (unsigned j = 0; j < 16; ++j) { const unsigned c = xb_ld(&bar[XB_XCNT(j)]); sum += c; cnt += (c > 0u) ? 1u : 0u; mine = (j == x) ? c : mine; }
        if (sum == G) break;
        __builtin_amdgcn_s_sleep(1);
        if ((++sp & 255u) == 0u) { if (xb_ld(&bar[XB_TMO])) break; if (sp > XB_SPIN_CAP) { atomicAdd(&bar[XB_TMO], 1u); break; } }
    }
    nloc = mine > 0u ? mine : 1u; nx = cnt > 0u ? cnt : 1u;
}

__device__ __forceinline__ void xcd_barrier(const XcdBarrier& b) {
    asm volatile("s_waitcnt vmcnt(0)" ::: "memory");
    __syncthreads();
    if (threadIdx.x == 0) {
        unsigned* bar = b.bar;
        __builtin_amdgcn_s_waitcnt(0);
        unsigned nloc = b.st[0], nx = b.st[1];
        if (nloc == 0u) { xcd_barrier_complete(bar, b.x, nloc, nx); b.st[0] = nloc; b.st[1] = nx; }
        const unsigned old = xb_add(&bar[XB_XSUB(b.x)], 1u);
        const unsigned gen = old / nloc;
        if (old + 1u == (gen + 1u) * nloc) {
            __builtin_amdgcn_fence(__ATOMIC_RELEASE, "agent");
            asm volatile("s_waitcnt vmcnt(0)" ::: "memory");
            const unsigned og = xb_add(&bar[XB_TOP], 1u);
            const unsigned tg = og / nx;
            if (og + 1u == (tg + 1u) * nx) xb_add(&bar[XB_TOPGEN], 1u);
            else XB_SPIN(xb_ld(&bar[XB_TOPGEN]) == tg, bar);
            __builtin_amdgcn_fence(__ATOMIC_ACQUIRE, "agent");
            xb_add(&bar[XB_XGEN(b.x)], 1u);
            asm volatile("s_waitcnt vmcnt(0)" ::: "memory");
        } else {
            XB_SPIN(xb_ld(&bar[XB_XGEN(b.x)]) == gen, bar);
            __builtin_amdgcn_fence(__ATOMIC_ACQUIRE, "agent");
            asm volatile("s_waitcnt vmcnt(0)" ::: "memory");
        }
    }
    __syncthreads();
}

struct Frame {
    LAS unsigned char* lds;
    int tid, lane, wave, vcu, G;
    unsigned char* ws;
    const float *x, *norm_g, *w_in, *qna, *kna, *sinks, *qnb, *knb, *relb, *wpa, *wpb, *wout;
    float* out;
    unsigned long long prof;
};

__device__ __forceinline__ float wave_sum(float v) {
#pragma unroll
    for (int o = 1; o < 64; o <<= 1) v += __shfl_xor(v, o);
    return v;
}
__device__ __forceinline__ int t5_bucket(int n) {
    if (n < 16) return n < 0 ? 0 : n;
    const int l = 16 + (int)(logf((float)n * 0.0625f) / logf(8.0f) * 16.0f);
    return l > 31 ? 31 : l;
}

__device__ __forceinline__ int win_src_col(int n) { return n < 3328 ? n : (n < 5376 ? n + 296 : (n < 5672 ? n - 2048 : -1)); }
template <bool INPROJ>
__device__ __forceinline__ void p0_transpose_item(const float* W, int srcN, int k0, int n0, h16* WT, int ldk, int kdst0, LAS float* scr, int lane, float scale) {
    const int n = n0 + (lane & 31); const int col = INPROJ ? win_src_col(n) : n;
    float wv_[32];
#pragma unroll
    for (int i = 0; i < 32; ++i) { const int kk = 2 * i + (lane >> 5); wv_[i] = (col >= 0) ? W[(size_t)(k0 + kk) * srcN + col] : 0.f; }
#pragma unroll
    for (int i = 0; i < 32; ++i) { const int kk = 2 * i + (lane >> 5); scr[kk * 33 + (lane & 31)] = wv_[i] * scale; }
    LDS_WAIT(); asm volatile("" ::: "memory");
    const int c = lane & 7;
#pragma unroll
    for (int j = 0; j < 4; ++j) { const int nn = (lane >> 3) + 8 * j; const LAS float* s = scr + (8 * c) * 33 + nn;
        float v[8];
#pragma unroll
        for (int e = 0; e < 8; ++e) v[e] = s[e * 33];
        u32x4 o; o.x = pkh(v[0], v[1]); o.y = pkh(v[2], v[3]); o.z = pkh(v[4], v[5]); o.w = pkh(v[6], v[7]);
        *(u32x4*)(WT + (size_t)(n0 + nn) * ldk + kdst0 + k0 + 8 * c) = o;
    }
    LDS_WAIT(); asm volatile("" ::: "memory");
}
__device__ __forceinline__ void p0_norm_rows4(const float* x, const float* g, h16* H, int m0, int mstride, int lane) {
    f32x4 v[4][4];
#pragma unroll
    for (int r = 0; r < 4; ++r)
#pragma unroll
        for (int j = 0; j < 4; ++j) v[r][j] = __builtin_nontemporal_load((const f32x4*)(x + (size_t)(m0 + r * mstride) * DM) + lane + 64 * j);
    f32x4 gg[4];
#pragma unroll
    for (int j = 0; j < 4; ++j) gg[j] = *((const f32x4*)g + lane + 64 * j) * HSCALE;
#pragma unroll
    for (int r = 0; r < 4; ++r) {
        float s = 0.f;
#pragma unroll
        for (int j = 0; j < 4; ++j) s += (v[r][j].x * v[r][j].x + v[r][j].y * v[r][j].y) + (v[r][j].z * v[r][j].z + v[r][j].w * v[r][j].w);
        const float rs = rsqrtf(wave_sum(s) * (1.0f / DM) + RMS_EPS);
#pragma unroll
        for (int j = 0; j < 4; ++j) { const f32x4 hv = v[r][j] * rs * gg[j]; u32x2 hi; hi.x = pkh(hv.x, hv.y); hi.y = pkh(hv.z, hv.w);
            *((u32x2*)(H + (size_t)(m0 + r * mstride) * 1024) + lane + 64 * j) = hi; }
    }
}
__device__ __forceinline__ void p0_prologue(Frame& F) {
    LAS float* scr = (LAS float*)(F.lds + F.wave * 16384);
    const int gw = F.vcu * NWAVES + F.wave, NGW = F.G * NWAVES;
    h16* Win = (h16*)(F.ws + WS_WIN); h16* Wp = (h16*)(F.ws + WS_WP); h16* Wo = (h16*)(F.ws + WS_WO);
    constexpr int I_IN = 16 * 184, I_P = 8 * 32, I_O = 16 * 32;
    constexpr int NITEMS = I_IN + 2 * I_P + I_O;
    for (int it = gw; it < NITEMS; it += NGW) {
        int r = it;
        if (r < I_IN) { p0_transpose_item<true>(F.w_in, INW, 64 * (r / 184), 32 * (r % 184), Win, 1024, 0, scr, F.lane, WSCALE); continue; } r -= I_IN;
        if (r < I_P) { p0_transpose_item<false>(F.wpa, DM, 64 * (r / 32), 32 * (r % 32), Wp, 1024, 0, scr, F.lane, 1.f); continue; } r -= I_P;
        if (r < I_P) { p0_transpose_item<false>(F.wpb, DM, 64 * (r / 32), 32 * (r % 32), Wp, 1024, 512, scr, F.lane, 1.f); continue; } r -= I_P;
        p0_transpose_item<false>(F.wout, DM, 64 * (r / 32), 32 * (r % 32), Wo, 1024, 0, scr, F.lane, 1.f);
    }
    h16* Hb = (h16*)(F.ws + WS_H);
    for (int m = gw; m + 3 * NGW < MROWS; m += 4 * NGW) p0_norm_rows4(F.x, F.norm_g, Hb, m, NGW, F.lane);
    if (MROWS % (4 * NGW) != 0) for (int m = gw + (MROWS / (4 * NGW)) * 4 * NGW; m < MROWS; m += NGW) p0_norm_rows4(F.x, F.norm_g, Hb, m, 0, F.lane);
}

constexpr int NBIN = 256, ICAP = 32;
constexpr int IW_VALS = 0, IW_HIST = 16384, IW_LIST = IW_HIST + 2 * NBIN * 4, IW_LMASK = IW_LIST + 2 * ICAP * 8, IW_BYTES = IW_LMASK + 512;
static_assert(8 * IW_BYTES <= LDSCTL_OFF, "indexer LDS");
__device__ __forceinline__ int idx_bin(float v, float smin, float scale) { const int b = (int)((v - smin) * scale); return b > NBIN - 1 ? NBIN - 1 : b; }
__device__ __forceinline__ float swz16(float x) { return __int_as_float(__builtin_amdgcn_ds_swizzle(__float_as_int(x), 0x401F)); }
__device__ __forceinline__ float half_min(float v) { v = fminf(v, __shfl_xor(v, 1)); v = fminf(v, __shfl_xor(v, 2)); v = fminf(v, __shfl_xor(v, 4)); v = fminf(v, __shfl_xor(v, 8)); return fminf(v, __shfl_xor(v, 16)); }
__device__ __forceinline__ float half_max(float v) { v = fmaxf(v, __shfl_xor(v, 1)); v = fmaxf(v, __shfl_xor(v, 2)); v = fmaxf(v, __shfl_xor(v, 4)); v = fmaxf(v, __shfl_xor(v, 8)); return fmaxf(v, __shfl_xor(v, 16)); }
__device__ __forceinline__ unsigned lowest_bits(unsigned w, unsigned n) { unsigned kept = 0u; while (n && w) { const unsigned bit = w & (0u - w); kept |= bit; w ^= bit; --n; } return kept; }
__device__ __forceinline__ void idx_pair(Frame& F, int b, int u) {
    const int lane = F.lane, k16 = lane & 15, fq = lane >> 4, th = fq >> 1, par = fq & 1;
    const int ta = 2 * u, t = ta + th;
    unsigned* gm = (unsigned*)(F.ws + WS_MASK) + (size_t)(b * SEQ + ta) * 64;
    if (ta < 256) {
        const int lo = lane * 32;
        gm[lane] = (ta >= lo + 31) ? 0xffffffffu : (ta >= lo ? ((2u << (ta - lo)) - 1u) : 0u);
        gm[64 + lane] = (ta + 1 >= lo + 31) ? 0xffffffffu : (ta + 1 >= lo ? ((2u << (ta + 1 - lo)) - 1u) : 0u);
        return;
    }
    LAS unsigned char* wl = F.lds + F.wave * IW_BYTES;
    LAS float* vals = (LAS float*)(wl + IW_VALS) + th * 2048 + 16 * par + k16;
    LAS unsigned* hist = (LAS unsigned*)(wl + IW_HIST) + th * NBIN;
    LAS u32x2* clist = (LAS u32x2*)(wl + IW_LIST) + th * ICAP;
    LAS unsigned* lmask = (LAS unsigned*)(wl + IW_LMASK);
    lmask[lane] = 0u; lmask[64 + lane] = 0u;
    TSTART(20)
    TSTART(21)
    const size_t qrow = (size_t)(b * SEQ + ta + (k16 >> 3));
    const h16x8 qh = *(const h16x8*)((const h16*)(F.ws + WS_QH) + qrow * 256 + (k16 & 7) * 32 + fq * 8);
    const f32x4 wv = *(const f32x4*)((const float*)(F.ws + WS_WI) + (size_t)(b * SEQ + t) * 8 + 4 * par);
    const int nstep = (ta + 1) / 32 + 1;
    const h16* kph = (const h16*)(F.ws + WS_KH) + (size_t)(b * SEQ + k16) * 32 + fq * 8;
    h16x8 kb[4][4];
#define IDX_LOAD(slot, step) do { const int st_ = (step) < 64 ? (step) : 63; const h16* ph_ = kph + (size_t)st_ * 1024; \
        kb[slot][0] = *(const h16x8*)ph_; kb[slot][2] = *(const h16x8*)(ph_ + 512); } while (0)
    IDX_LOAD(0, 0); IDX_LOAD(1, 1); IDX_LOAD(2, 2); IDX_LOAD(3, 3);
    TSTART(25)
    TSTOP(25)
    float vmin = INFINITY, vmax = -INFINITY;
    const int myk = 16 * par + k16;
#define IDX_STEP(slot, step) do { \
        f32x4 a0 = __builtin_amdgcn_mfma_f32_16x16x32_f16(qh, kb[slot][0], (f32x4){0.f, 0.f, 0.f, 0.f}, 0, 0, 0), a1 = __builtin_amdgcn_mfma_f32_16x16x32_f16(qh, kb[slot][2], (f32x4){0.f, 0.f, 0.f, 0.f}, 0, 0, 0); \
        IDX_LOAD(slot, (step) + 4); \
        float s0 = wv[0] * fmaxf(a0[0], 0.f), s1 = wv[0] * fmaxf(a1[0], 0.f); \
        _Pragma("unroll") for (int r = 1; r < 4; ++r) { s0 = fmaf(wv[r], fmaxf(a0[r], 0.f), s0); s1 = fmaf(wv[r], fmaxf(a1[r], 0.f), s1); } \
        const float recv = swz16(par ? s0 : s1); \
        const float mine = (par ? s1 : s0) + recv + 0.0f; \
        const bool valid = (32 * (step) + myk) <= t; \
        vals[32 * (step)] = valid ? mine : __builtin_nanf(""); \
        if (valid) { vmin = fminf(vmin, mine); vmax = fmaxf(vmax, mine); } } while (0)
#pragma unroll 1
    for (int i = 0; i < nstep; i += 8) { IDX_STEP(0, i); IDX_STEP(1, i + 1); IDX_STEP(2, i + 2); IDX_STEP(3, i + 3); IDX_STEP(0, i + 4); IDX_STEP(1, i + 5); IDX_STEP(2, i + 6); IDX_STEP(3, i + 7); }
#undef IDX_STEP
#undef IDX_LOAD
    TSTOP(21)
    TSTART(22)
    TSTART(26)
    float lo = half_min(vmin), hi = half_max(vmax);
    TSTOP(26)
    unsigned need = 256u, wa = 0u, wb = 0u; bool done = false;
#pragma unroll 1
    for (int level = 0; level < 64; ++level) {
        if (__ballot(!done) == 0ull) break;
        const bool tie = !done && !(hi > lo);
        const float scale = (hi > lo) ? ((float)NBIN - 0.5f) / (hi - lo) : 0.f;
        unsigned bst = 0u, rr = 0u, cb = 0u;
        TSTART(23)
        if (__ballot(!done && !tie) != 0ull) {
            *(LAS u32x4*)(wl + IW_HIST + lane * 16) = (u32x4){0u, 0u, 0u, 0u}; *(LAS u32x4*)(wl + IW_HIST + 1024 + lane * 16) = (u32x4){0u, 0u, 0u, 0u};
            asm volatile("s_waitcnt lgkmcnt(0)" ::: "memory");
            if (!done && !tie) {
#pragma unroll 8
                for (int i = 0; i < nstep; ++i) { const float v = vals[32 * i]; if (v >= lo && v <= hi) atomicAdd((unsigned*)&hist[idx_bin(v, lo, scale)], 1u); }
            }
            asm volatile("s_waitcnt lgkmcnt(0)" ::: "memory");
            TSTART(27)
            {
                const int l5 = lane & 31;
                const u32x4 cw0 = *(const LAS u32x4*)(wl + IW_HIST + th * 1024 + l5 * 32), cw1 = *(const LAS u32x4*)(wl + IW_HIST + th * 1024 + l5 * 32 + 16);
                const unsigned cnt[8] = {cw0.x, cw0.y, cw0.z, cw0.w, cw1.x, cw1.y, cw1.z, cw1.w};
                const unsigned s = ((cw0.x + cw0.y) + (cw0.z + cw0.w)) + ((cw1.x + cw1.y) + (cw1.z + cw1.w));
                unsigned v = s;
#pragma unroll
                for (int o = 1; o < 32; o <<= 1) { const unsigned tmp = (unsigned)__shfl_down((int)v, o, 32); if (l5 + o < 32) v += tmp; }
                const unsigned above = v - s; const bool crit = !done && !tie && above < need && need <= above + s;
                unsigned cum = above, b_ = 0, r_ = 0, c_ = 0; bool found = false;
#pragma unroll
                for (int e = 7; e >= 0; --e) { const unsigned cc = cnt[e]; if (!found && cum + cc >= need) { found = true; b_ = 8u * l5 + e; r_ = need - cum; c_ = cc; } if (!found) cum += cc; }
                const unsigned long long cm = __ballot(crit);
                const int cla = (unsigned)cm ? (int)__builtin_ctz((unsigned)cm) : 0, clb = (unsigned)(cm >> 32) ? 32 + (int)__builtin_ctz((unsigned)(cm >> 32)) : 32;
                const unsigned bqa = (unsigned)__builtin_amdgcn_readlane((int)b_, cla), rqa = (unsigned)__builtin_amdgcn_readlane((int)r_, cla), cqa = (unsigned)__builtin_amdgcn_readlane((int)c_, cla);
                const unsigned bqb = (unsigned)__builtin_amdgcn_readlane((int)b_, clb), rqb = (unsigned)__builtin_amdgcn_readlane((int)r_, clb), cqb = (unsigned)__builtin_amdgcn_readlane((int)c_, clb);
                if (!done && !tie) { bst = th ? bqb : bqa; rr = th ? rqb : rqa; cb = th ? cqb : cqa; }
            }
            TSTOP(27)
        }
        TSTOP(23)
        TSTART(24)
        const bool takeall = (cb == rr);
        const int bsel = takeall ? (int)bst : (int)bst + 1;
        bool slow = true;
        if (level == 0 && __ballot(tie) == 0ull) {
            const float inv_scale = (hi - lo) * (1.0f / ((float)NBIN - 0.5f));
            const float thrA = lo + ((float)bsel + 0.02f) * inv_scale, thrB = lo + ((float)bst - 0.02f) * inv_scale;
            unsigned zc_a = 0u, zc_b = 0u;
#pragma unroll 4
            for (int i = 0; i < nstep; ++i) {
                const float v = vals[32 * i];
                const bool isA = v >= thrA, zone = v >= thrB && !isA;
                const unsigned long long sm = __ballot(isA), zm = __ballot(zone);
                const unsigned slot = th ? zc_b + __builtin_amdgcn_mbcnt_hi((unsigned)(zm >> 32), 0u) : zc_a + __builtin_amdgcn_mbcnt_lo((unsigned)zm, 0u);
                if (zone && slot < (unsigned)ICAP) clist[slot] = (u32x2){__float_as_uint(v), (unsigned)(32 * i + myk)};
                zc_a += __popc((unsigned)zm); zc_b += __popc((unsigned)(zm >> 32));
                if (lane == i) { wa |= (unsigned)sm; wb |= (unsigned)(sm >> 32); }
            }
            asm volatile("s_waitcnt lgkmcnt(0)" ::: "memory");
            TSTART(28)
            if (zc_a <= (unsigned)ICAP && zc_b <= (unsigned)ICAP) {
                slow = false;
                const int j = lane & 31; const unsigned zc = th ? zc_b : zc_a;
                const u32x2 me = clist[j]; const float vj = __uint_as_float(me.x);
                const int bj = idx_bin(vj, lo, scale);
                const bool have = (unsigned)j < zc, selj = have && bj >= bsel, memj = have && !takeall && bj == (int)bst;
                const float vmj = memj ? vj : -INFINITY; unsigned rank = 0u;
                const unsigned zmax = zc_a > zc_b ? zc_a : zc_b;
                for (unsigned i2 = 0; i2 < zmax; ++i2) {
                    const float va = __int_as_float(__builtin_amdgcn_readlane(__float_as_int(vmj), (int)i2)), vb2 = __int_as_float(__builtin_amdgcn_readlane(__float_as_int(vmj), (int)i2 + 32));
                    const unsigned ka = (unsigned)__builtin_amdgcn_readlane((int)me.y, (int)i2), kb2 = (unsigned)__builtin_amdgcn_readlane((int)me.y, (int)i2 + 32);
                    const float vi = th ? vb2 : va; const unsigned ki = th ? kb2 : ka;
                    rank += (vi > vj || (vi == vj && ki < me.y)) ? 1u : 0u;
                }
                if (selj || (memj && rank < rr)) atomicOr((unsigned*)&lmask[th * 64 + (me.y >> 5)], 1u << (me.y & 31));
                done = true;
            }
            TSTOP(28)
        }
        if (slow) {
            const bool uselist = !takeall && cb <= (unsigned)ICAP;
            float nlo = INFINITY, nhi = -INFINITY; unsigned cnt_a = 0u, cnt_b = 0u, tie_a = 0u, tie_b = 0u;
            const unsigned need_a = (unsigned)__builtin_amdgcn_readlane((int)need, 0), need_b = (unsigned)__builtin_amdgcn_readlane((int)need, 32);
            const bool tie_any = __ballot(tie) != 0ull;
#pragma unroll 2
            for (int i = 0; i < nstep; ++i) {
                const float v = vals[32 * i]; const bool act = !done && v >= lo && v <= hi;
                const int bn = idx_bin(v, lo, scale);
                const bool sel = act && !tie && bn >= bsel, mem = act && !tie && !takeall && bn == (int)bst;
                unsigned long long sm = __ballot(sel);
                if (tie_any) {
                    const unsigned long long tm = __ballot(act && tie);
                    const unsigned ka = lowest_bits((unsigned)tm, need_a - tie_a), kb = lowest_bits((unsigned)(tm >> 32), need_b - tie_b);
                    tie_a += __popc(ka); tie_b += __popc(kb); sm |= (unsigned long long)ka | ((unsigned long long)kb << 32);
                }
                if (sm) { if (lane == i) { wa |= (unsigned)sm; wb |= (unsigned)(sm >> 32); } }
                const unsigned long long mm = __ballot(mem);
                if (mm) {
                    if (mem) { nlo = fminf(nlo, v); nhi = fmaxf(nhi, v);
                        if (uselist) { const unsigned slot = th ? cnt_b + __builtin_amdgcn_mbcnt_hi((unsigned)(mm >> 32), 0u) : cnt_a + __builtin_amdgcn_mbcnt_lo((unsigned)mm, 0u);
                            if (slot < (unsigned)ICAP) clist[slot] = (u32x2){__float_as_uint(v), (unsigned)(32 * i + myk)}; } }
                    cnt_a += __popc((unsigned)mm); cnt_b += __popc((unsigned)(mm >> 32));
                }
            }
            asm volatile("s_waitcnt lgkmcnt(0)" ::: "memory");
            if (!done) {
                if (tie || takeall) done = true;
                else if (uselist) {
                    const int j = lane & 31; const u32x2 me = clist[j]; const float vj = __uint_as_float(me.x); unsigned rank = 0u;
                    for (unsigned i2 = 0; i2 < cb; ++i2) { const u32x2 o = clist[i2]; const float vi = __uint_as_float(o.x); rank += (vi > vj || (vi == vj && o.y < me.y)) ? 1u : 0u; }
                    if ((unsigned)j < cb && rank < rr) atomicOr((unsigned*)&lmask[th * 64 + (me.y >> 5)], 1u << (me.y & 31));
                    done = true;
                } else { lo = half_min(nlo); hi = half_max(nhi); need = rr; }
            }
        }
        TSTOP(24)
    }
    asm volatile("s_waitcnt lgkmcnt(0)" ::: "memory");
    gm[lane] = wa | lmask[lane]; gm[64 + lane] = wb | lmask[64 + lane];
    TSTOP(22)
    TSTOP(20)
}
__device__ __forceinline__ void p2_index_phase(Frame& F) {
    for (int s = F.vcu >> 2; s < 64; s += (F.G + 3) >> 2) {
        unsigned* ctr = (unsigned*)(F.ws + WS_CTL + 16384) + s * 64;
        for (;;) {
            unsigned k = 0u;
            if (F.lane == 0) k = __hip_atomic_fetch_add(ctr, 1u, __ATOMIC_RELAXED, __HIP_MEMORY_SCOPE_AGENT);
            k = (unsigned)__builtin_amdgcn_readfirstlane((int)k);
            if (k >= 128u) break;
            idx_pair(F, s & 7, 1023 - (s >> 3) - 8 * (int)k);
        }
    }
}

constexpr int AT_NSLOT = 5, AT_K = 0, AT_KSZ = 64 * 144, AT_V = AT_NSLOT * AT_KSZ, AT_VSZ = 64 * 192, AT_LUT = AT_V + AT_NSLOT * AT_VSZ, AT_MTAB = AT_LUT + 320 * 4, AT_OST = 0, AT_OSTSZ = 32 * 144;
static_assert(AT_MTAB + 128 <= RING_BYTES && 8 * AT_OSTSZ <= AT_V, "attention LDS");
typedef _Float16 h16x2v __attribute__((ext_vector_type(2)));
__device__ __forceinline__ s16x4 vtr_read(const LAS unsigned char* p) { return __builtin_amdgcn_ds_read_tr16_b64_v4i16((LAS s16x4*)p); }

template <bool ISB>
__device__ __forceinline__ void attn_unit(Frame& F, int b, int h, int qb) {
    const int tid = F.tid, lane = F.lane, wid = F.wave, q = lane & 31, hi = lane >> 5;
    const int q0 = qb * 256, r0 = q0 + wid * 32, t = r0 + q;
    const size_t row = (size_t)b * SEQ + t;
    const h16* Qp; const h16* Kp; const h16* Vp; const h16* Zp; int kvpitch, ycol;
    if (ISB) { Qp = (const h16*)(F.ws + WS_QB) + h * 64; Kp = (const h16*)(F.ws + WS_KB) + h * 64; Vp = (const h16*)(F.ws + WS_VB) + h * 64; Zp = (const h16*)(F.ws + WS_ZB) + h * 64; kvpitch = 512; ycol = 512 + h * 64; }
    else     { Qp = (const h16*)(F.ws + WS_QA) + h * 64; Kp = (const h16*)(F.ws + WS_KVA) + (h >> 2) * 64; Vp = (const h16*)(F.ws + WS_KVA) + 128 + (h >> 2) * 64; Zp = (const h16*)(F.ws + WS_ZA) + h * 64; kvpitch = 256; ycol = h * 64; }
    const unsigned* mrow = (const unsigned*)(F.ws + WS_MASK) + row * 64;
    LAS float* lut = (LAS float*)(F.lds + AT_LUT);
    for (int i = tid; i < 320; i += NTHREADS) { const int dist = 223 - i; float v;
        if (ISB) v = dist < 0 ? 0.f : (F.relb[t5_bucket(dist > 127 ? 127 : dist) * 16 + 8 + h] - F.relb[31 * 16 + 8 + h]) * LOG2E;
        else v = (dist >= 0 && dist < 128) ? F.relb[t5_bucket(dist) * 16 + h] * LOG2E : -INFINITY;
        lut[i] = v; }
    if (tid < 16) { u32x2 e; e.x = ((tid & 1) ? 0xffffu : 0u) | ((tid & 2) ? 0xffff0000u : 0u); e.y = ((tid & 4) ? 0xffffu : 0u) | ((tid & 8) ? 0xffff0000u : 0u); *(LAS u32x2*)(F.lds + AT_MTAB + tid * 8) = e; }
    h16x8 qr[4];
    {   const float* qg = ISB ? F.qnb : F.qna; float ss = 0.f;
#pragma unroll
        for (int d0 = 0; d0 < 4; ++d0) { qr[d0] = *(const h16x8*)(Qp + row * 512 + d0 * 16 + hi * 8);
#pragma unroll
            for (int e = 0; e < 8; ++e) { const float f = (float)qr[d0][e]; ss += f * f; } }
        ss += __shfl_xor(ss, 32);
        const float rq = rsqrtf(ss * (1.0f / 64.0f) + RMS_EPS) * QSCALE;
#pragma unroll
        for (int d0 = 0; d0 < 4; ++d0) { const f32x4 g0 = *(const f32x4*)(qg + d0 * 16 + hi * 8), g1 = *(const f32x4*)(qg + d0 * 16 + hi * 8 + 4);
            u32x4 w; w.x = pkh((float)qr[d0][0] * rq * g0[0], (float)qr[d0][1] * rq * g0[1]); w.y = pkh((float)qr[d0][2] * rq * g0[2], (float)qr[d0][3] * rq * g0[3]);
            w.z = pkh((float)qr[d0][4] * rq * g1[0], (float)qr[d0][5] * rq * g1[1]); w.w = pkh((float)qr[d0][6] * rq * g1[2], (float)qr[d0][7] * rq * g1[3]);
            qr[d0] = __builtin_bit_cast(h16x8, w); } }
    float kgn[8];
    {   const float* kgp = (ISB ? F.knb : F.kna) + (tid & 7) * 8; const f32x4 g0 = *(const f32x4*)kgp, g1 = *(const f32x4*)(kgp + 4);
        kgn[0] = g0[0]; kgn[1] = g0[1]; kgn[2] = g0[2]; kgn[3] = g0[3]; kgn[4] = g1[0]; kgn[5] = g1[1]; kgn[6] = g1[2]; kgn[7] = g1[3]; }
#define KNORM(KR) do { const h16x8 kv_ = __builtin_bit_cast(h16x8, KR); float f_[8]; float ss_ = 0.f; \
        _Pragma("unroll") for (int e = 0; e < 8; ++e) { f_[e] = (float)kv_[e]; ss_ += f_[e] * f_[e]; } \
        ss_ += __shfl_xor(ss_, 1); ss_ += __shfl_xor(ss_, 2); ss_ += __shfl_xor(ss_, 4); \
        const float rk_ = rsqrtf(ss_ * (1.0f / 64.0f) + RMS_EPS); \
        KR.x = pkh(f_[0] * rk_ * kgn[0], f_[1] * rk_ * kgn[1]); KR.y = pkh(f_[2] * rk_ * kgn[2], f_[3] * rk_ * kgn[3]); \
        KR.z = pkh(f_[4] * rk_ * kgn[4], f_[5] * rk_ * kgn[5]); KR.w = pkh(f_[6] * rk_ * kgn[6], f_[7] * rk_ * kgn[7]); } while (0)
    float m_run = -INFINITY, l_run = 0.f;
    f32x16 o[2];
#pragma unroll
    for (int r = 0; r < 16; ++r) { o[0][r] = 0.f; o[1][r] = 0.f; }
    const int kfo = q * 144 + hi * 16;
    const int vfo = (4 * hi + ((lane & 15) >> 2)) * 192 + ((lane >> 4) & 1) * 32 + (lane & 3) * 8;
#define ATT_TILE(SLOT, K0) do { const int k0_ = (K0); const LAS unsigned char* kb = F.lds + AT_K + (SLOT) * AT_KSZ + kfo; const LAS unsigned char* vb = F.lds + AT_V + (SLOT) * AT_VSZ + vfo; \
            f32x16 p0, p1; \
            _Pragma("unroll") \
            for (int r = 0; r < 16; ++r) { p0[r] = 0.f; p1[r] = 0.f; } \
            _Pragma("unroll") \
            for (int d0 = 0; d0 < 4; ++d0) { \
                const h16x8 ka = *(const LAS h16x8*)(kb + d0 * 32), kc = *(const LAS h16x8*)(kb + 32 * 144 + d0 * 32); \
                p0 = __builtin_amdgcn_mfma_f32_32x32x16_f16(ka, qr[d0], p0, 0, 0, 0); \
                p1 = __builtin_amdgcn_mfma_f32_32x32x16_f16(kc, qr[d0], p1, 0, 0, 0); \
            } \
 \
            if (!ISB || (r0 - k0_ - 63 < 113)) { \
                const LAS float* lp = lut + (223 - (t - k0_ - 4 * hi)); \
            _Pragma("unroll") \
                for (int r = 0; r < 16; ++r) { const int c = (r & 3) + 8 * (r >> 2); p0[r] += lp[c]; p1[r] += lp[32 + c]; } \
            } \
 \
            h16x2v s2[16]; \
            _Pragma("unroll") \
            for (int j = 0; j < 8; ++j) { s2[j] = __builtin_convertvector((f32x2){p0[2 * j], p0[2 * j + 1]}, h16x2v); s2[8 + j] = __builtin_convertvector((f32x2){p1[2 * j], p1[2 * j + 1]}, h16x2v); } \
            h16x2v m2 = __builtin_elementwise_max(s2[0], s2[1]); \
            _Pragma("unroll") \
            for (int j = 2; j < 16; ++j) m2 = __builtin_elementwise_max(m2, s2[j]); \
            float mx = fmaxf((float)m2.x, (float)m2.y); \
            mx = fmaxf(mx, __shfl_xor(mx, 32)); \
            const float mnew = fmaxf(m_run, mx), muse = (mnew == -INFINITY) ? 0.f : mnew; \
            if (__any(mnew > m_run)) { \
                const float alpha = __builtin_amdgcn_exp2f(m_run - muse); \
                l_run *= alpha; \
            _Pragma("unroll") \
                for (int r = 0; r < 16; ++r) { o[0][r] *= alpha; o[1][r] *= alpha; } \
            } \
            m_run = mnew; \
            const h16 nm = (h16)(-muse); const h16x2v nm2 = {nm, nm}; \
            _Pragma("unroll") \
            for (int j = 0; j < 16; ++j) { const h16x2v a = s2[j] + nm2; s2[j].x = __builtin_exp2f16(a.x); s2[j].y = __builtin_exp2f16(a.y); } \
            if (ISB) { \
                const unsigned mm0 = mw.x >> (4 * hi), mm1 = mw.y >> (4 * hi); \
            _Pragma("unroll") \
                for (int g4 = 0; g4 < 4; ++g4) { \
                    const u32x2 e0 = *(const LAS u32x2*)(F.lds + AT_MTAB + ((mm0 >> (8 * g4)) & 15u) * 8), e1 = *(const LAS u32x2*)(F.lds + AT_MTAB + ((mm1 >> (8 * g4)) & 15u) * 8); \
                    s2[2 * g4] = __builtin_bit_cast(h16x2v, __builtin_bit_cast(unsigned, s2[2 * g4]) & e0.x); s2[2 * g4 + 1] = __builtin_bit_cast(h16x2v, __builtin_bit_cast(unsigned, s2[2 * g4 + 1]) & e0.y); \
                    s2[8 + 2 * g4] = __builtin_bit_cast(h16x2v, __builtin_bit_cast(unsigned, s2[8 + 2 * g4]) & e1.x); s2[8 + 2 * g4 + 1] = __builtin_bit_cast(h16x2v, __builtin_bit_cast(unsigned, s2[8 + 2 * g4 + 1]) & e1.y); \
                } \
            } \
            {   h16x2v a0 = s2[0] + s2[1], a1 = s2[2] + s2[3], a2 = s2[4] + s2[5], a3 = s2[6] + s2[7], a4 = s2[8] + s2[9], a5 = s2[10] + s2[11], a6 = s2[12] + s2[13], a7 = s2[14] + s2[15]; \
                a0 = a0 + a1; a2 = a2 + a3; a4 = a4 + a5; a6 = a6 + a7; \
                l_run += (((float)a0.x + (float)a0.y) + ((float)a2.x + (float)a2.y)) + (((float)a4.x + (float)a4.y) + ((float)a6.x + (float)a6.y)); } \
            u32x4 pk[4]; \
            _Pragma("unroll") \
            for (int s = 0; s < 4; ++s) pk[s] = (u32x4){__builtin_bit_cast(unsigned, s2[4 * s]), __builtin_bit_cast(unsigned, s2[4 * s + 1]), __builtin_bit_cast(unsigned, s2[4 * s + 2]), __builtin_bit_cast(unsigned, s2[4 * s + 3])}; \
            _Pragma("unroll") \
            for (int s = 0; s < 4; ++s) \
            _Pragma("unroll") \
                for (int d1 = 0; d1 < 2; ++d1) { \
                    const s16x4 lo4 = vtr_read(vb + (16 * s) * 192 + d1 * 64), hi4 = vtr_read(vb + (16 * s + 8) * 192 + d1 * 64); \
                    const h16x4 lf = __builtin_bit_cast(h16x4, lo4), hf = __builtin_bit_cast(h16x4, hi4); \
                    const h16x8 vf = {lf[0], lf[1], lf[2], lf[3], hf[0], hf[1], hf[2], hf[3]}; \
                    o[d1] = __builtin_amdgcn_mfma_f32_32x32x16_f16(vf, __builtin_bit_cast(h16x8, pk[s]), o[d1], 0, 0, 0); \
                } \
        } while (0)
    const int srow = tid >> 3, sch = tid & 7;
    const h16* kg = Kp + ((size_t)b * SEQ + srow) * kvpitch + sch * 8; const h16* vg = Vp + ((size_t)b * SEQ + srow) * kvpitch + sch * 8;
    const int kst = srow * 144 + sch * 16, vst = srow * 192 + sch * 16;
    if (ISB) {
        const int kt_lo = ISB ? 0 : (4 * qb - 2 < 0 ? 0 : 4 * qb - 2), kt_hi = 4 * qb + 3;
        u32x4 kreg = *(const u32x4*)(kg + (size_t)kt_lo * 64 * kvpitch), vreg = *(const u32x4*)(vg + (size_t)kt_lo * 64 * kvpitch);
        u32x2 mw = {0u, 0u}, mwn = {0u, 0u};
        if (ISB) mw = *(const u32x2*)(mrow + 2 * kt_lo);
        KNORM(kreg);
        *(LAS u32x4*)(F.lds + AT_K + kst) = kreg; *(LAS u32x4*)(F.lds + AT_V + vst) = vreg;
        __syncthreads();
        for (int kt = kt_lo; kt <= kt_hi; ++kt) {
            const int cur = (kt - kt_lo) & 1;
            if (kt < kt_hi) { kreg = *(const u32x4*)(kg + (size_t)(kt + 1) * 64 * kvpitch); vreg = *(const u32x4*)(vg + (size_t)(kt + 1) * 64 * kvpitch); if (ISB) mwn = *(const u32x2*)(mrow + 2 * (kt + 1)); }
            const int k0 = kt * 64;
            const bool active = ISB ? (k0 <= r0 + 31) : (k0 <= r0 + 31 && k0 + 63 >= r0 - 127);
            TSTART(31)
            if (active) {
                ATT_TILE(cur, k0);
            }
            TSTOP(31)
            TSTART(32)
            if (kt < kt_hi) { KNORM(kreg); *(LAS u32x4*)(F.lds + AT_K + (cur ^ 1) * AT_KSZ + kst) = kreg; *(LAS u32x4*)(F.lds + AT_V + (cur ^ 1) * AT_VSZ + vst) = vreg; mw = mwn; }
            TSTOP(32)
            TSTART(33)
            __syncthreads();
            TSTOP(33)
        }

    } else {
        u32x4 kr4[4], vr4[4];
#pragma unroll
        for (int jj = 0; jj < 4; ++jj) { const int kt = 4 * qb - 2 + jj; if (kt >= 0) { kr4[jj] = *(const u32x4*)(kg + (size_t)kt * 64 * kvpitch); vr4[jj] = *(const u32x4*)(vg + (size_t)kt * 64 * kvpitch); } }
#pragma unroll
        for (int jj = 0; jj < 4; ++jj) { const int kt = 4 * qb - 2 + jj; if (kt >= 0) { KNORM(kr4[jj]); *(LAS u32x4*)(F.lds + AT_K + jj * AT_KSZ + kst) = kr4[jj]; *(LAS u32x4*)(F.lds + AT_V + jj * AT_VSZ + vst) = vr4[jj]; } }
        __syncthreads();
        const int base_w = wid >> 1;
        u32x4 kreg, vreg; const u32x2 mw = {0u, 0u};
#pragma unroll 1
        for (int s = 0; s < 3; ++s) {
            if (s < 2) { kreg = *(const u32x4*)(kg + (size_t)(4 * qb + 2 + s) * 64 * kvpitch); vreg = *(const u32x4*)(vg + (size_t)(4 * qb + 2 + s) * 64 * kvpitch); }
            const int j = base_w + s, kt = 4 * qb - 2 + j;
            TSTART(31)
            if (kt >= 0) ATT_TILE((j == 5 ? 0 : j), kt * 64);
            TSTOP(31)
            if (s < 2) { const int sl = (s == 0) ? 4 : 0; KNORM(kreg); *(LAS u32x4*)(F.lds + AT_K + sl * AT_KSZ + kst) = kreg; *(LAS u32x4*)(F.lds + AT_V + sl * AT_VSZ + vst) = vreg; }
            TSTART(33)
            __syncthreads();
            TSTOP(33)
        }
    }
    TSTART(34)
    l_run += __shfl_xor(l_run, 32);
    if (!ISB) l_run += __builtin_amdgcn_exp2f(F.sinks[h] * LOG2E - m_run);
    const float inv = 1.0f / l_run;
    LAS unsigned char* ost = F.lds + AT_OST + wid * AT_OSTSZ;
#pragma unroll
    for (int d1 = 0; d1 < 2; ++d1)
#pragma unroll
        for (int g4 = 0; g4 < 4; ++g4) { u32x2 w; w.x = pkh(o[d1][4 * g4] * inv, o[d1][4 * g4 + 1] * inv); w.y = pkh(o[d1][4 * g4 + 2] * inv, o[d1][4 * g4 + 3] * inv);
            *(LAS u32x2*)(ost + q * 144 + (32 * d1 + 8 * g4 + 4 * hi) * 2) = w; }
    LDS_WAIT(); asm volatile("" ::: "memory");
    h16* Yp = (h16*)(F.ws + WS_Y);
#pragma unroll
    for (int i = 0; i < 4; ++i) { const int rr = i * 8 + (lane >> 3), ch = lane & 7; const size_t grow = (size_t)b * SEQ + r0 + rr;
        const h16x8 ov = *(const LAS h16x8*)(ost + rr * 144 + ch * 16); const h16x8 zv = *(const h16x8*)(Zp + grow * 512 + ch * 8);
        float y[8];
#pragma unroll
        for (int e = 0; e < 8; ++e) { const float z = (float)zv[e]; y[e] = (float)ov[e] * z * sigmoidf_fast(z); }
        u32x4 w; w.x = pkh(y[0], y[1]); w.y = pkh(y[2], y[3]); w.z = pkh(y[4], y[5]); w.w = pkh(y[6], y[7]);
        *(u32x4*)(Yp + grow * 1024 + ycol + ch * 8) = w; }
    __syncthreads();
    TSTOP(34)
#undef KNORM
#undef ATT_TILE
}
__device__ __forceinline__ void p3_attention_phase(Frame& F) {
    for (int v = F.vcu; v < 256; v += F.G) {
        const int bh = v >> 2, j = v & 3, b = bh >> 3, h = bh & 7;
        { TSTART(36) attn_unit<true>(F, b, h, 7 - j); attn_unit<true>(F, b, h, j); TSTOP(36) }
        { TSTART(35) attn_unit<false>(F, b, h, 2 * j); attn_unit<false>(F, b, h, 2 * j + 1); TSTOP(35) }
    }
}

struct Args { const float* in[12]; float* out; unsigned char* ws; int ph_lo, ph_hi; };
constexpr int N_PHASES = 6;
__global__ void __launch_bounds__(NTHREADS, 2) mk_fwd(Args args) {
    extern __shared__ __attribute__((aligned(16))) unsigned char lds_raw[];
    cg::grid_group grid = cg::this_grid();
    Frame F;
    F.lds = (LAS unsigned char*)lds_raw;
    F.tid = threadIdx.x; F.lane = F.tid & 63; F.wave = __builtin_amdgcn_readfirstlane(F.tid >> 6);
    F.G = gridDim.x; { const int bx = blockIdx.x; F.vcu = (F.G % 8 == 0) ? (bx % 8) * (F.G / 8) + bx / 8 : bx; }
    F.ws = args.ws; F.prof = 0ull;
    F.x = args.in[0]; F.norm_g = args.in[1]; F.w_in = args.in[2]; F.qna = args.in[3]; F.kna = args.in[4]; F.sinks = args.in[5];
    F.qnb = args.in[6]; F.knb = args.in[7]; F.relb = args.in[8]; F.wpa = args.in[9]; F.wpb = args.in[10]; F.wout = args.in[11]; F.out = args.out;
    const int lo = args.ph_lo, hi = args.ph_hi;
    if (lo < 0) grid.sync();
    if (F.tid < 64) ((LAS unsigned*)(F.lds + LDSCTL_OFF))[F.tid] = 0u;
    __syncthreads();
    XcdBarrier bar = xcd_barrier_post((unsigned*)(F.ws + WS_CTL), (volatile LAS unsigned*)(F.lds + LDSCTL_OFF) + 8);
#ifdef ONLY_PH
#define IN(k) ((k) == ONLY_PH && lo <= (k) && (k) < hi)
#else
#define IN(k) (lo <= (k) && (k) < hi)
#endif
#ifdef PROBE_SYNC2
#define SEAM(k) do { if (IN(k) && IN((k) + 1)) { xcd_barrier(bar); xcd_barrier(bar); } } while (0)
#else
#define SEAM(k) do { if (IN(k) && IN((k) + 1)) xcd_barrier(bar); } while (0)
#endif
    { TSTART(1) if (IN(0)) { p0_prologue(F); }
    SEAM(0); TSTOP(1) }
    TSTART(2)
    if (IN(1)) {
        pg8::GemmPlain g{(const h16*)(F.ws + WS_H), (const h16*)(F.ws + WS_WIN), 1024, 1024};
        pg8::StaticOrder S; S.init(MROWS, 23 * 256, F.G, (int)blockIdx.x);
        pg8::EpiIn E{F.ws, (h16*)F.out};
        pg8::gemm_phase<pg8::EpiIn, pg8::StaticOrder, pg8::GemmPlain, true, true>(F.lds, g, S, E);
    }
    SEAM(1);
    TSTOP(2)
    { TSTART(3) if (IN(2)) { p2_index_phase(F); }
#if defined(PROF_SEG) && defined(PROF_MAXWAVE)
    if (F.lane == 0) atomicMax((unsigned long long*)(F.ws + WS_CTL + 32768), F.prof);
#endif
    SEAM(2); TSTOP(3) }
    { TSTART(4) if (IN(3)) { p3_attention_phase(F); }
    SEAM(3); TSTOP(4) }
    TSTART(5)
    if (IN(4)) {
        pg8::GemmPlain g{(const h16*)(F.ws + WS_Y), (const h16*)(F.ws + WS_WP), 1024, 1024};
        pg8::StaticOrder S; S.init(MROWS, DM, F.G, (int)blockIdx.x);
        pg8::EpiMerge E{(const h16*)F.out, (h16*)(F.ws + WS_MG)};
        pg8::gemm_phase<pg8::EpiMerge, pg8::StaticOrder, pg8::GemmPlain, true, true>(F.lds, g, S, E);
    }
    SEAM(4);
    TSTOP(5)
    TSTART(6)
    if (IN(5)) {
        pg8::GemmPlain g{(const h16*)(F.ws + WS_MG), (const h16*)(F.ws + WS_WO), 1024, 1024};
        pg8::StaticOrder S; S.init(MROWS, DM, F.G, (int)blockIdx.x);
        pg8::EpiOut E{F.x, F.out};
        pg8::gemm_phase<pg8::EpiOut, pg8::StaticOrder, pg8::GemmPlain, true, true>(F.lds, g, S, E);
    }
    TSTOP(6)
#undef IN
#undef SEAM
#ifdef PROF_SEG
#ifdef PROF_MAXWAVE
    if (blockIdx.x == PROF_BLK && F.wave == PROF_WAVE) F.prof = __hip_atomic_load((unsigned long long*)(F.ws + WS_CTL + 32768), __ATOMIC_RELAXED, __HIP_MEMORY_SCOPE_AGENT);
#endif
    if (blockIdx.x == PROF_BLK && F.wave == PROF_WAVE && hi == N_PHASES) { const unsigned long long t1 = __builtin_amdgcn_s_memrealtime() + F.prof * PROF_MULT; while (__builtin_amdgcn_s_memrealtime() < t1) __builtin_amdgcn_s_sleep(8); }
#endif
}

extern "C" void kernel_launch(void* const* d_in, const int* in_sizes, int n_in, void* d_out, int out_size, void* d_ws, size_t ws_size, hipStream_t stream) {
    static int grid = 0;
    if (grid == 0) {
        if (n_in != 12 || in_sizes[0] != MROWS * DM || out_size != MROWS * DM || ws_size < WS_END) { fprintf(stderr, "kernel_launch: unexpected problem (n_in %d, ws %zu)\n", n_in, ws_size); grid = -1; return; }
        int dev = 0, cus = 0, per_cu = 0;
        hipGetDevice(&dev); hipDeviceGetAttribute(&cus, hipDeviceAttributeMultiprocessorCount, dev);
        hipFuncSetAttribute((const void*)mk_fwd, hipFuncAttributeMaxDynamicSharedMemorySize, LDS_BYTES);
        hipOccupancyMaxActiveBlocksPerMultiprocessor(&per_cu, (const void*)mk_fwd, NTHREADS, LDS_BYTES);
        (void)hipGetLastError();
        if (per_cu < 1) { fprintf(stderr, "kernel_launch: occupancy query says %d blocks/CU\n", per_cu); per_cu = 1; }
        grid = cus;
        if (grid > 256) grid = 256;
    }
    if (grid < 0) return;
    (void)hipMemsetAsync((char*)d_ws + WS_CTL, 0, CTL_BYTES, stream);
    Args a{};
    for (int i = 0; i < 12; ++i) a.in[i] = (const float*)d_in[i];
    a.out = (float*)d_out; a.ws = (unsigned char*)d_ws;
#ifdef PROBE_PH
    {
        void* kargs[] = {&a};
        a.ph_lo = 0; a.ph_hi = PROBE_PH + 1;
        (void)hipLaunchCooperativeKernel((const void*)mk_fwd, dim3(grid), dim3(NTHREADS), kargs, LDS_BYTES, stream);
        (void)hipMemsetAsync((char*)d_ws + WS_CTL, 0, CTL_BYTES, stream);
#ifdef PROBE_SPLIT_ONLY
        a.ph_lo = PROBE_PH + 1; a.ph_hi = N_PHASES;
#else
        a.ph_lo = PROBE_PH; a.ph_hi = N_PHASES;
#endif
        (void)hipLaunchCooperativeKernel((const void*)mk_fwd, dim3(grid), dim3(NTHREADS), kargs, LDS_BYTES, stream);
    }
#else
    {
        a.ph_lo = 0; a.ph_hi = N_PHASES;
        void* kargs[] = {&a};
        hipError_t e = hipLaunchCooperativeKernel((const void*)mk_fwd, dim3(grid), dim3(NTHREADS), kargs, LDS_BYTES, stream);
        if (e != hipSuccess) fprintf(stderr, "cooperative launch failed: %s (grid %d)\n", hipGetErrorString(e), grid);
    }
#endif
}
```

```cpp
#include <hip/hip_runtime.h>
#include <hip/hip_cooperative_groups.h>
#include <cstdio>
#include <cstdint>
namespace cg = cooperative_groups;
#ifdef PROF_SEG
#ifndef PROF_MULT
#define PROF_MULT 4
#endif
#ifndef PROF_BLK
#define PROF_BLK 100
#endif
#ifndef PROF_WAVE
#define PROF_WAVE 3
#endif
#endif

#define LAS __attribute__((address_space(3)))
typedef _Float16 h16;
typedef _Float16 h16x2 __attribute__((ext_vector_type(2)));
typedef _Float16 h16x4 __attribute__((ext_vector_type(4)));
typedef _Float16 h16x8 __attribute__((ext_vector_type(8)));
typedef float f32x2 __attribute__((ext_vector_type(2)));
typedef float f32x4 __attribute__((ext_vector_type(4)));
typedef float f32x16 __attribute__((ext_vector_type(16)));
typedef unsigned u32x2 __attribute__((ext_vector_type(2)));
typedef unsigned u32x4 __attribute__((ext_vector_type(4)));
typedef short s16x4 __attribute__((ext_vector_type(4)));

__device__ __forceinline__ unsigned pkh(float lo, float hi) { const f32x2 v = {lo, hi}; const h16x2 h = __builtin_convertvector(v, h16x2); return __builtin_bit_cast(unsigned, h); }
__device__ __forceinline__ float sigmoidf_fast(float g) { g = fminf(fmaxf(g, -30.f), 30.f); return __builtin_amdgcn_rcpf(1.0f + __builtin_amdgcn_exp2f(-1.4426950408889634f * g)); }

constexpr int NBATCH = 8, SEQ = 2048, DM = 1024, MROWS = NBATCH * SEQ, INW = 5672;
constexpr float RMS_EPS = 1e-6f, LOG2E = 1.4426950408889634f, QSCALE = 0.125f * 1.4426950408889634f;
constexpr float HSCALE = 16.f, WSCALE = 64.f, INV_HW = 1.0f / (16.f * 64.f);
constexpr size_t MiB = 1u << 20;
constexpr size_t WS_H = 0;
constexpr size_t WS_Y = 0, WS_MG = 32 * MiB;
constexpr size_t WS_QH = 32 * MiB, WS_QL = 40 * MiB, WS_KH = 48 * MiB, WS_KL = 49 * MiB, WS_WI = 50 * MiB;
constexpr size_t WS_WIN = 64 * MiB;
constexpr size_t WS_WP = 77 * MiB, WS_WO = 79 * MiB;
constexpr size_t WS_QA = 81 * MiB, WS_KVA = 97 * MiB, WS_ZA = 105 * MiB, WS_QB = 121 * MiB, WS_KB = 137 * MiB, WS_VB = 153 * MiB, WS_ZB = 169 * MiB;
constexpr size_t WS_MASK = 185 * MiB;
constexpr size_t WS_CTL = 190 * MiB, CTL_BYTES = 65536;
constexpr size_t WS_END = 191 * MiB;

namespace pg8 {
#define PG8_LAS __attribute__((address_space(3)))
constexpr int BM = 256, BK = 64, HALF = 128, HTB = HALF * BK * 2  , STAGE_BYTES = 8 * HTB, NXCD = 8, WGM = 8;

__host__ __device__ __forceinline__ int lds_byte(int r, int c) { const int st = (r >> 4) * 2 + (c >> 5), rr = r & 15, cc = c & 31, ob = rr * 64 + cc * 2; return st * 1024 + (ob ^ (((ob >> 9) & 1) << 5)); }
__host__ __device__ __forceinline__ void stage_rc(int b, int& R, int& C) { const int st = b / 1024, sb = b % 1024, swz = sb ^ (((sb >> 9) & 1) << 5); R = (st >> 1) * 16 + swz / 64; C = (st & 1) * 32 + (swz % 64) / 2; }
__host__ __device__ __forceinline__ int perm32(int rho) { const int n = rho >> 4, i = rho & 15; return 8 * (i >> 2) + 4 * n + (i & 3); }

struct Unit { int pm, pn; };

struct StaticOrder {
    int nM, nN, nwg, G, c;
    __host__ __device__ void init(int M, int N, int G_, int c_) { nM = M / BM; nN = N / BM; nwg = nM * nN; G = G_; c = c_; }
    __host__ __device__ bool next(int i, Unit& u) const {
        const long L = (long)i * G + c; if (L >= nwg) return false;
        int wgid = (int)L; { const int q = nwg / NXCD, r = nwg % NXCD, xcd = wgid % NXCD, off = wgid / NXCD; wgid = (xcd < r ? xcd * (q + 1) : r * (q + 1) + (xcd - r) * q) + off; }
        const int nig = WGM * nN, gid = wgid / nig, fm = gid * WGM, gsz = (nM - fm) < WGM ? (nM - fm) : WGM;
        u.pm = fm + ((wgid % nig) % gsz); u.pn = (wgid % nig) / gsz; return true;
    }
    __device__ __forceinline__ void a_ready(const Unit&) const {}
    __device__ __forceinline__ void done(const Unit&) const {}
};

struct GemmPlain { const h16* A; const h16* Bt; int lda, K;
    __device__ __forceinline__ const char* aptr(const Unit& u) const { return (const char*)(A + (size_t)u.pm * BM * lda); }
    __device__ __forceinline__ const char* bptr(const Unit& u) const { return (const char*)(Bt + (size_t)u.pn * BM * K); } };
struct EpiIn {
    static constexpr bool PERM = true, AFTER_DRAIN = false, MID = false;
    unsigned char* ws; h16* G;
    __device__ __forceinline__ void operator()(const f32x4 (&acc)[2][2][4][2], const Unit& u, int wr, int wc, int fr, int fq) const {
        const int pn = u.pn, row0 = u.pm * BM + wr * 64 + fr, cl = wc * 32 + 8 * fq;
        if (pn < 21) {
            h16* base; int ldc, colt;
            if (pn < 2)       { base = (h16*)(ws + WS_QA);  ldc = 512; colt = pn * 256; }
            else if (pn == 2) { base = (h16*)(ws + WS_KVA); ldc = 256; colt = 0; }
            else if (pn < 5)  { base = (h16*)(ws + WS_ZA);  ldc = 512; colt = (pn - 3) * 256; }
            else if (pn < 7)  { base = (h16*)(ws + WS_QB);  ldc = 512; colt = (pn - 5) * 256; }
            else if (pn < 9)  { base = (h16*)(ws + WS_KB);  ldc = 512; colt = (pn - 7) * 256; }
            else if (pn < 11) { base = (h16*)(ws + WS_VB);  ldc = 512; colt = (pn - 9) * 256; }
            else if (pn < 13) { base = (h16*)(ws + WS_ZB);  ldc = 512; colt = (pn - 11) * 256; }
            else              { base = G;                   ldc = 2048; colt = (pn - 13) * 256; }
#pragma unroll
            for (int ai = 0; ai < 2; ++ai)
#pragma unroll
                for (int m = 0; m < 4; ++m) { h16* rowp = base + (size_t)(row0 + ai * HALF + m * 16) * ldc + colt + cl;
#pragma unroll
                    for (int bj = 0; bj < 2; ++bj) { const f32x4 v0 = acc[ai][bj][m][0] * INV_HW, v1 = acc[ai][bj][m][1] * INV_HW;
                        u32x4 w; w.x = pkh(v0[0], v0[1]); w.y = pkh(v0[2], v0[3]); w.z = pkh(v1[0], v1[1]); w.w = pkh(v1[2], v1[3]);
                        *(u32x4*)(rowp + bj * HALF) = w; } }
        } else {
            const int colt = (pn - 21) * 256 + cl;
#pragma unroll
            for (int ai = 0; ai < 2; ++ai)
#pragma unroll
                for (int m = 0; m < 4; ++m) { const size_t r = (size_t)(row0 + ai * HALF + m * 16);
#pragma unroll
                    for (int bj = 0; bj < 2; ++bj) { const int j = colt + bj * HALF; const f32x4 v0 = acc[ai][bj][m][0] * INV_HW, v1 = acc[ai][bj][m][1] * INV_HW;
                        if (j < 288) {
                            u32x4 hi; hi.x = pkh(v0[0] * 16.f, v0[1] * 16.f); hi.y = pkh(v0[2] * 16.f, v0[3] * 16.f); hi.z = pkh(v1[0] * 16.f, v1[1] * 16.f); hi.w = pkh(v1[2] * 16.f, v1[3] * 16.f);
                            if (j < 256) *(u32x4*)((h16*)(ws + WS_QH) + r * 256 + j) = hi; else *(u32x4*)((h16*)(ws + WS_KH) + r * 32 + (j - 256)) = hi;
                        } else if (j < 296) { float* w = (float*)(ws + WS_WI) + r * 8; *(f32x4*)w = v0; *(f32x4*)(w + 4) = v1; }
                    } }
        }
    }
};
struct EpiMerge {
    static constexpr bool PERM = true, AFTER_DRAIN = false, MID = true;
    const h16* G; h16* MG;
    __device__ __forceinline__ void mid(f32x4 (&acc)[2][2][4][2], const Unit& u, int wr, int wc, int fr, int fq) const {
        const int row0 = u.pm * BM + wr * 64 + fr, col0 = u.pn * BM + wc * 32 + 8 * fq;
#pragma unroll
        for (int ai = 0; ai < 2; ++ai)
#pragma unroll
            for (int m = 0; m < 4; ++m) { unsigned ro = (unsigned)(row0 + ai * HALF + m * 16); asm volatile("" : "+v"(ro)); const h16* gp = G + (size_t)ro * 2048 + col0;
#pragma unroll
                for (int bj = 0; bj < 2; ++bj) { const h16x8 ga = *(const h16x8*)(gp + bj * HALF), gb = *(const h16x8*)(gp + 1024 + bj * HALF);
#pragma unroll
                    for (int e = 0; e < 8; ++e) { const float a = fminf(fmaxf((float)ga[e], -30.f), 30.f), b = fminf(fmaxf((float)gb[e], -30.f), 30.f);
                        const float f = (1.0f + __builtin_amdgcn_exp2f(-LOG2E * b)) * __builtin_amdgcn_rcpf(1.0f + __builtin_amdgcn_exp2f(-LOG2E * a));
                        acc[ai][bj][m][e >> 2][e & 3] *= f; } }
                asm volatile("" ::: "memory"); }
    }
    __device__ __forceinline__ void operator()(const f32x4 (&acc)[2][2][4][2], const Unit& u, int wr, int wc, int fr, int fq) const {
        const int row0 = u.pm * BM + wr * 64 + fr, col0 = u.pn * BM + wc * 32 + 8 * fq;
#pragma unroll
        for (int ai = 0; ai < 2; ++ai)
#pragma unroll
            for (int m = 0; m < 4; ++m) { unsigned ro = (unsigned)(row0 + ai * HALF + m * 16); asm volatile("" : "+v"(ro)); const size_t r = (size_t)ro;
#pragma unroll
                for (int bj = 0; bj < 2; ++bj) { const h16x8 gb = *(const h16x8*)(G + r * 2048 + 1024 + col0 + bj * HALF);
                    float o[8];
#pragma unroll
                    for (int e = 0; e < 8; ++e) o[e] = acc[ai][bj][m][e >> 2][e & 3] * sigmoidf_fast((float)gb[e]);
                    u32x4 w; w.x = pkh(o[0], o[1]); w.y = pkh(o[2], o[3]); w.z = pkh(o[4], o[5]); w.w = pkh(o[6], o[7]);
                    *(u32x4*)(MG + r * 1024 + col0 + bj * HALF) = w; } }
    }
};
struct EpiOut {
    static constexpr bool PERM = true, AFTER_DRAIN = false, MID = false;
    const float* x; float* out;
    __device__ __forceinline__ void operator()(const f32x4 (&acc)[2][2][4][2], const Unit& u, int wr, int wc, int fr, int fq) const {
        const int row0 = u.pm * BM + wr * 64 + fr, col0 = u.pn * BM + wc * 32 + 8 * fq;
#pragma unroll
        for (int ai = 0; ai < 2; ++ai)
#pragma unroll
            for (int m = 0; m < 4; ++m) { const size_t off = (size_t)(row0 + ai * HALF + m * 16) * DM + col0;
#pragma unroll
                for (int bj = 0; bj < 2; ++bj)
#pragma unroll
                    for (int n = 0; n < 2; ++n) { const f32x4 xv = *(const f32x4*)(x + off + bj * HALF + 4 * n); *(f32x4*)(out + off + bj * HALF + 4 * n) = xv + acc[ai][bj][m][n]; }
                if (m & 1) asm volatile("" ::: "memory"); }
    }
};

template <class Epi, class Sched, class GemmT, bool ALIGN_EPI = false, bool SP2 = false>
__device__ __forceinline__ void gemm_phase(PG8_LAS unsigned char* lds, const GemmT g, const Sched& S, const Epi& E) {
    const int tid = threadIdx.x, wid = __builtin_amdgcn_readfirstlane(tid >> 6), lane = tid & 63, wr = wid >> 2, wc = wid & 3, fr = lane & 15, fq = lane >> 4;
    const int K = g.K, nt = K / BK;
    unsigned voffA[2], voffB[2];
#pragma unroll
    for (int i = 0; i < 2; ++i) { int R, C; stage_rc(tid * 16 + i * 8192, R, C); const int Rb = Epi::PERM ? ((R & ~31) + perm32(R & 31)) : R;
        voffA[i] = (unsigned)(R * g.lda + C) * 2u; voffB[i] = (unsigned)(Rb * K + C) * 2u; }
    const size_t kstep = (size_t)(BK * 2);
    const size_t hstepA = (size_t)HALF * g.lda * 2, hstepB = (size_t)HALF * K * 2;
    const unsigned ldsw = (unsigned)wid * 1024u;
    const int aoff = lds_byte(wr * 64 + fr, fq * 8), boff = lds_byte(wc * 32 + fr, fq * 8);
#define PG8_SA(b, h) (((b) * 2 + (h)) * HTB)
#define PG8_SB(b, h) ((4 + (b) * 2 + (h)) * HTB)
#define PG8_STAGE(bufoff, gbase, voff) do { _Pragma("unroll") for (int _i = 0; _i < 2; ++_i) \
        __builtin_amdgcn_global_load_lds((const unsigned*)((const char*)(gbase) + (voff)[_i]), (PG8_LAS unsigned*)(lds + (bufoff) + ldsw + _i * 8192), 16, 0, 0); } while (0)
#define PG8_LDA(dst, b, h) do { _Pragma("unroll") for (int m = 0; m < 4; ++m) _Pragma("unroll") for (int k = 0; k < 2; ++k) dst[m][k] = *(const PG8_LAS h16x8*)(lds + PG8_SA(b, h) + aoff + m * 2048 + k * 1024); } while (0)
#define PG8_LDB(dst, b, h) do { _Pragma("unroll") for (int n = 0; n < 2; ++n) _Pragma("unroll") for (int k = 0; k < 2; ++k) dst[n][k] = *(const PG8_LAS h16x8*)(lds + PG8_SB(b, h) + boff + n * 2048 + k * 1024); } while (0)
#define PG8_MMA(ai, bj, At, Bt) do { __builtin_amdgcn_s_setprio(1); _Pragma("unroll") for (int m = 0; m < 4; ++m) _Pragma("unroll") for (int n = 0; n < 2; ++n) _Pragma("unroll") for (int k = 0; k < 2; ++k) \
        acc[ai][bj][m][n] = __builtin_amdgcn_mfma_f32_16x16x32_f16(Bt[n][k], At[m][k], acc[ai][bj][m][n], 0, 0, 0); __builtin_amdgcn_s_setprio(0); } while (0)
#define PG8_WAIT_V(n) asm volatile("s_waitcnt vmcnt(" #n ")" ::: "memory")
#define PG8_WAIT_L(n) asm volatile("s_waitcnt lgkmcnt(" #n ")" ::: "memory")
#define PG8_BAR __builtin_amdgcn_s_barrier()
#define PG8_SCHED __builtin_amdgcn_sched_barrier(0)
    Unit cur, nxt; int ui = 0;
    if (!S.next(0, cur)) return;
    f32x4 acc[2][2][4][2];
#pragma unroll
    for (int a = 0; a < 2; ++a)
#pragma unroll
        for (int b = 0; b < 2; ++b)
#pragma unroll
            for (int m = 0; m < 4; ++m)
#pragma unroll
                for (int n = 0; n < 2; ++n) acc[a][b][m][n] = (f32x4){0.f, 0.f, 0.f, 0.f};
    h16x8 At[4][2], B0[2][2], B1[2][2];
    const char* cA = g.aptr(cur); const char* cB = g.bptr(cur);
    S.a_ready(cur);
    if constexpr (SP2) {
        PG8_STAGE(PG8_SB(0, 0), cB, voffB); PG8_STAGE(PG8_SB(0, 1), cB + hstepB, voffB); PG8_STAGE(PG8_SA(0, 0), cA, voffA); PG8_STAGE(PG8_SA(0, 1), cA + hstepA, voffA);
        if (wr == 1) PG8_BAR;
        PG8_WAIT_V(2); PG8_BAR;
        PG8_STAGE(PG8_SB(1, 0), cB + kstep, voffB); PG8_STAGE(PG8_SA(1, 0), cA + kstep, voffA); PG8_STAGE(PG8_SB(1, 1), cB + hstepB + kstep, voffB);
        PG8_WAIT_V(6); PG8_BAR;
    } else {
        PG8_STAGE(PG8_SB(0, 0), cB, voffB); PG8_STAGE(PG8_SA(0, 0), cA, voffA); PG8_STAGE(PG8_SB(0, 1), cB + hstepB, voffB); PG8_STAGE(PG8_SA(0, 1), cA + hstepA, voffA);
        if (wr == 1) PG8_BAR;
        PG8_WAIT_V(4); PG8_BAR;
        PG8_STAGE(PG8_SB(1, 0), cB + kstep, voffB); PG8_STAGE(PG8_SA(1, 0), cA + kstep, voffA); PG8_STAGE(PG8_SB(1, 1), cB + hstepB + kstep, voffB);
        PG8_WAIT_V(6); PG8_BAR;
    }
    for (;;) {
        const bool has_next = S.next(ui + 1, nxt);
        const char* nA = has_next ? g.aptr(nxt) : cA; const char* nB = has_next ? g.bptr(nxt) : cB;
        for (int t = 0; t < nt; t += 2) {
            const bool last = (t == nt - 2);
            const char* a1 = cA + (size_t)(t + 1) * kstep;
            const char* a2 = last ? nA : cA + (size_t)(t + 2) * kstep; const char* b2 = last ? nB : cB + (size_t)(t + 2) * kstep;
            const char* a3 = a2 + kstep; const char* b3 = b2 + kstep;
            if (last && has_next) S.a_ready(nxt);
            if constexpr (Epi::MID) { if (t == nt / 2) E.mid(acc, cur, wr, wc, fr, fq); }
            if constexpr (SP2) {
            PG8_LDB(B0, 0, 0); PG8_LDB(B1, 0, 1); PG8_SCHED; PG8_LDA(At, 0, 0); PG8_STAGE(PG8_SA(1, 1), a1 + hstepA, voffA);
            PG8_WAIT_V(8); PG8_WAIT_L(0); PG8_BAR; PG8_MMA(0, 0, At, B0); PG8_MMA(0, 1, At, B1); PG8_BAR; PG8_SCHED;
            PG8_LDA(At, 0, 1); PG8_STAGE(PG8_SB(0, 0), b2, voffB); PG8_STAGE(PG8_SB(0, 1), b2 + hstepB, voffB); PG8_STAGE(PG8_SA(0, 0), a2, voffA);
            PG8_WAIT_V(8); PG8_WAIT_L(0); PG8_BAR; PG8_MMA(1, 0, At, B0); PG8_MMA(1, 1, At, B1); PG8_BAR; PG8_SCHED;
            PG8_LDB(B0, 1, 0); PG8_LDB(B1, 1, 1); PG8_SCHED; PG8_LDA(At, 1, 0); PG8_STAGE(PG8_SA(0, 1), a2 + hstepA, voffA);
            PG8_WAIT_V(8); PG8_WAIT_L(0); PG8_BAR; PG8_MMA(0, 0, At, B0); PG8_MMA(0, 1, At, B1); PG8_BAR; PG8_SCHED;
            PG8_LDA(At, 1, 1); PG8_STAGE(PG8_SB(1, 0), b3, voffB); PG8_STAGE(PG8_SB(1, 1), b3 + hstepB, voffB); PG8_STAGE(PG8_SA(1, 0), a3, voffA);
            PG8_WAIT_V(8); PG8_WAIT_L(0); PG8_BAR; PG8_MMA(1, 0, At, B0); PG8_MMA(1, 1, At, B1); PG8_BAR; PG8_SCHED;
            } else {
            PG8_LDB(B0, 0, 0); PG8_SCHED; PG8_LDA(At, 0, 0); PG8_STAGE(PG8_SA(1, 1), a1 + hstepA, voffA);
            PG8_WAIT_L(8); PG8_BAR; PG8_WAIT_L(0); PG8_MMA(0, 0, At, B0); PG8_BAR; PG8_SCHED;
            PG8_LDB(B1, 0, 1); PG8_STAGE(PG8_SB(0, 0), b2, voffB);
            PG8_BAR; PG8_WAIT_L(0); PG8_MMA(0, 1, At, B1); PG8_BAR;
            PG8_LDA(At, 0, 1); PG8_STAGE(PG8_SA(0, 0), a2, voffA);
            PG8_BAR; PG8_WAIT_L(0); PG8_MMA(1, 0, At, B0); PG8_BAR; PG8_SCHED;
            PG8_STAGE(PG8_SB(0, 1), b2 + hstepB, voffB);
            PG8_WAIT_V(6); PG8_BAR; PG8_MMA(1, 1, At, B1); PG8_BAR;
            PG8_LDB(B0, 1, 0); PG8_SCHED; PG8_LDA(At, 1, 0); PG8_STAGE(PG8_SA(0, 1), a2 + hstepA, voffA);
            PG8_WAIT_L(8); PG8_BAR; PG8_WAIT_L(0); PG8_MMA(0, 0, At, B0); PG8_BAR; PG8_SCHED;
            PG8_LDB(B1, 1, 1); PG8_STAGE(PG8_SB(1, 0), b3, voffB);
            PG8_BAR; PG8_WAIT_L(0); PG8_MMA(0, 1, At, B1); PG8_BAR;
            PG8_LDA(At, 1, 1); PG8_STAGE(PG8_SA(1, 0), a3, voffA);
            PG8_BAR; PG8_WAIT_L(0); PG8_MMA(1, 0, At, B0); PG8_BAR; PG8_SCHED;
            PG8_STAGE(PG8_SB(1, 1), b3 + hstepB, voffB);
            PG8_WAIT_V(6); PG8_BAR; PG8_MMA(1, 1, At, B1); PG8_BAR;
            }
        }
        if constexpr (ALIGN_EPI) { if (wr == 0) PG8_BAR; }
        if constexpr (!Epi::AFTER_DRAIN) { E(acc, cur, wr, wc, fr, fq); S.done(cur); }
        if (!has_next) break;
#pragma unroll
        for (int a = 0; a < 2; ++a)
#pragma unroll
            for (int b = 0; b < 2; ++b)
#pragma unroll
                for (int m = 0; m < 4; ++m)
#pragma unroll
                    for (int n = 0; n < 2; ++n) acc[a][b][m][n] = (f32x4){0.f, 0.f, 0.f, 0.f};
        cur = nxt; cA = nA; cB = nB; ++ui;
        if constexpr (ALIGN_EPI) { if (wr == 1) PG8_BAR; }
    }
    PG8_WAIT_V(0);
    if constexpr (!ALIGN_EPI) { if (wr == 0) PG8_BAR; }
    PG8_BAR;
    if constexpr (Epi::AFTER_DRAIN) { E.fused(acc, cur, wr, wc, fr, fq, lds, wid, lane); S.done(cur); }
#undef PG8_SA
#undef PG8_SB
#undef PG8_STAGE
#undef PG8_LDA
#undef PG8_LDB
#undef PG8_MMA
#undef PG8_WAIT_V
#undef PG8_WAIT_L
#undef PG8_BAR
#undef PG8_SCHED
}
}

constexpr int NWAVES = 8, NTHREADS = 512;
constexpr int RING_BYTES = 131072, LDSCTL_OFF = 159744, LDS_BYTES = 163840;
#define LDS_WAIT() asm volatile("s_waitcnt lgkmcnt(0)" ::: "memory")
#ifdef PROF_SEG
#define TSTART(id) unsigned long long t0_##id = 0; if ((id) == PROF_SEG) { asm volatile("s_waitcnt vmcnt(0) lgkmcnt(0)" ::: "memory"); t0_##id = __builtin_amdgcn_s_memrealtime(); }
#define TSTOP(id) if ((id) == PROF_SEG) { asm volatile("s_waitcnt vmcnt(0) lgkmcnt(0)" ::: "memory"); F.prof += __builtin_amdgcn_s_memrealtime() - t0_##id; }
#else
#define TSTART(id)
#define TSTOP(id)
#endif

#define XB_TMO      128
#define XB_XCNT(j)  (256  + 64 * (j))
#define XB_XSUB(j)  (1280 + 64 * (j))
#define XB_XGEN(j)  (2304 + 64 * (j))
#define XB_TOP      3328
#define XB_TOPGEN   3392
#define XCD_BAR_WORDS 3456
#define XB_SPIN_CAP (1u << 18)

__device__ __forceinline__ unsigned xb_ld(unsigned* p)              { return __hip_atomic_load(p, __ATOMIC_RELAXED, __HIP_MEMORY_SCOPE_AGENT); }
__device__ __forceinline__ unsigned xb_add(unsigned* p, unsigned v) { return __hip_atomic_fetch_add(p, v, __ATOMIC_RELAXED, __HIP_MEMORY_SCOPE_AGENT); }
__device__ __forceinline__ unsigned xb_xcc_id() { return (unsigned)__builtin_amdgcn_s_getreg((3 << 11) | 20) & 0xFu; }
#define XB_SPIN(cond, bar) do { unsigned _sp = 0; while (cond) { __builtin_amdgcn_s_sleep(1); \
    if ((++_sp & 255u) == 0u) { if (xb_ld(&(bar)[XB_TMO])) break; if (_sp > XB_SPIN_CAP) { atomicAdd(&(bar)[XB_TMO], 1u); break; } } } } while (0)

struct XcdBarrier {
    unsigned* bar; unsigned x;
    volatile LAS unsigned* st;
};

__device__ __forceinline__ XcdBarrier xcd_barrier_post(unsigned* bar, volatile LAS unsigned* st) {
    XcdBarrier b; b.bar = bar; b.x = xb_xcc_id(); b.st = st;
    if (threadIdx.x == 0) (void)xb_add(&bar[XB_XCNT(b.x)], 1u);
    return b;
}
__device__ __forceinline__ void xcd_barrier_complete(unsigned* bar, unsigned x, unsigned& nloc, unsigned& nx) {
    const unsigned G = gridDim.x * gridDim.y * gridDim.z;
    unsigned sum, cnt, mine, sp = 0u;
    for (;;) {
        sum = 0u; cnt = 0u; mine = 0u;
#pragma unroll
        for (unsigned j = 0; j < 16; ++j) { const unsigned c = xb_ld(&bar[XB_XCNT(j)]); sum += c; cnt += (c > 0u) ? 1u : 0u; mine = (j == x) ? c : mine; }
        if (sum == G) break;
        __builtin_amdgcn_s_sleep(1);
        if ((++sp & 255u) == 0u) { if (xb_ld(&bar[XB_TMO])) break; if (sp > XB_SPIN_CAP) { atomicAdd(&bar[XB_TMO], 1u); break; } }
    }
    nloc = mine > 0u ? mine : 1u; nx = cnt > 0u ? cnt : 1u;
}

__device__ __forceinline__ void xcd_barrier(const XcdBarrier& b) {
    asm volatile("s_waitcnt vmcnt(0)" ::: "memory");
    __syncthreads();
    if (threadIdx.x == 0) {
        unsigned* bar = b.bar;
        __builtin_amdgcn_s_waitcnt(0);
        unsigned nloc = b.st[0], nx = b.st[1];
        if (nloc == 0u) { xcd_barrier_complete(bar, b.x, nloc, nx); b.st[0] = nloc; b.st[1] = nx; }
        const unsigned old = xb_add(&bar[XB_XSUB(b.x)], 1u);
        const unsigned gen = old / nloc;
        if (old + 1u == (gen + 1u) * nloc) {
            __builtin_amdgcn_fence(__ATOMIC_RELEASE, "agent");
            asm volatile("s_waitcnt vmcnt(0)" ::: "memory");
            const unsigned og = xb_add(&bar[XB_TOP], 1u);
            const unsigned tg = og / nx;
            if (og + 1u == (tg + 1u) * nx) xb_add(&bar[XB_TOPGEN], 1u);
            else XB_SPIN(xb_ld(&bar[XB_TOPGEN]) == tg, bar);
            __builtin_amdgcn_fence(__ATOMIC_ACQUIRE, "agent");
            xb_add(&bar[XB_XGEN(b.x)], 1u);
            asm volatile("s_waitcnt vmcnt(0)" ::: "memory");
        } else {
            XB_SPIN(xb_ld(&bar[XB_XGEN(b.x)]) == gen, bar);
            __builtin_amdgcn_fence(__ATOMIC_ACQUIRE, "agent");
            asm volatile("s_waitcnt vmcnt(0)" ::: "memory");
        }
    }
    __syncthreads();
}

struct Frame {
    LAS unsigned char* lds;
    int tid, lane, wave, vcu, G;
    unsigned char* ws;
    const float *x, *norm_g, *w_in, *qna, *kna, *sinks, *qnb, *knb, *relb, *wpa, *wpb, *wout;
    float* out;
    unsigned long long prof;
};

__device__ __forceinline__ float wave_sum(float v) {
#pragma unroll
    for (int o = 1; o < 64; o <<= 1) v += __shfl_xor(v, o);
    return v;
}
__device__ __forceinline__ int t5_bucket(int n) {
    if (n < 16) return n < 0 ? 0 : n;
    const int l = 16 + (int)(logf((float)n * 0.0625f) / logf(8.0f) * 16.0f);
    return l > 31 ? 31 : l;
}

__device__ __forceinline__ int win_src_col(int n) { return n < 3328 ? n : (n < 5376 ? n + 296 : (n < 5672 ? n - 2048 : -1)); }
template <bool INPROJ>
__device__ __forceinline__ void p0_transpose_item(const float* W, int srcN, int k0, int n0, h16* WT, int ldk, int kdst0, LAS float* scr, int lane, float scale) {
    const int n = n0 + (lane & 31); const int col = INPROJ ? win_src_col(n) : n;
    float wv_[32];
#pragma unroll
    for (int i = 0; i < 32; ++i) { const int kk = 2 * i + (lane >> 5); wv_[i] = (col >= 0) ? W[(size_t)(k0 + kk) * srcN + col] : 0.f; }
#pragma unroll
    for (int i = 0; i < 32; ++i) { const int kk = 2 * i + (lane >> 5); scr[kk * 33 + (lane & 31)] = wv_[i] * scale; }
    LDS_WAIT(); asm volatile("" ::: "memory");
    const int c = lane & 7;
#pragma unroll
    for (int j = 0; j < 4; ++j) { const int nn = (lane >> 3) + 8 * j; const LAS float* s = scr + (8 * c) * 33 + nn;
        float v[8];
#pragma unroll
        for (int e = 0; e < 8; ++e) v[e] = s[e * 33];
        u32x4 o; o.x = pkh(v[0], v[1]); o.y = pkh(v[2], v[3]); o.z = pkh(v[4], v[5]); o.w = pkh(v[6], v[7]);
        *(u32x4*)(WT + (size_t)(n0 + nn) * ldk + kdst0 + k0 + 8 * c) = o;
    }
    LDS_WAIT(); asm volatile("" ::: "memory");
}
__device__ __forceinline__ void p0_norm_rows4(const float* x, const float* g, h16* H, int m0, int mstride, int lane) {
    f32x4 v[4][4];
#pragma unroll
    for (int r = 0; r < 4; ++r)
#pragma unroll
        for (int j = 0; j < 4; ++j) v[r][j] = __builtin_nontemporal_load((const f32x4*)(x + (size_t)(m0 + r * mstride) * DM) + lane + 64 * j);
    f32x4 gg[4];
#pragma unroll
    for (int j = 0; j < 4; ++j) gg[j] = *((const f32x4*)g + lane + 64 * j) * HSCALE;
#pragma unroll
    for (int r = 0; r < 4; ++r) {
        float s = 0.f;
#pragma unroll
        for (int j = 0; j < 4; ++j) s += (v[r][j].x * v[r][j].x + v[r][j].y * v[r][j].y) + (v[r][j].z * v[r][j].z + v[r][j].w * v[r][j].w);
        const float rs = rsqrtf(wave_sum(s) * (1.0f / DM) + RMS_EPS);
#pragma unroll
        for (int j = 0; j < 4; ++j) { const f32x4 hv = v[r][j] * rs * gg[j]; u32x2 hi; hi.x = pkh(hv.x, hv.y); hi.y = pkh(hv.z, hv.w);
            *((u32x2*)(H + (size_t)(m0 + r * mstride) * 1024) + lane + 64 * j) = hi; }
    }
}
__device__ __forceinline__ void p0_prologue(Frame& F) {
    LAS float* scr = (LAS float*)(F.lds + F.wave * 16384);
    const int gw = F.vcu * NWAVES + F.wave, NGW = F.G * NWAVES;
    h16* Win = (h16*)(F.ws + WS_WIN); h16* Wp = (h16*)(F.ws + WS_WP); h16* Wo = (h16*)(F.ws + WS_WO);
    constexpr int I_IN = 16 * 184, I_P = 8 * 32, I_O = 16 * 32;
    constexpr int NITEMS = I_IN + 2 * I_P + I_O;
    for (int it = gw; it < NITEMS; it += NGW) {
        int r = it;
        if (r < I_IN) { p0_transpose_item<true>(F.w_in, INW, 64 * (r / 184), 32 * (r % 184), Win, 1024, 0, scr, F.lane, WSCALE); continue; } r -= I_IN;
        if (r < I_P) { p0_transpose_item<false>(F.wpa, DM, 64 * (r / 32), 32 * (r % 32), Wp, 1024, 0, scr, F.lane, 1.f); continue; } r -= I_P;
        if (r < I_P) { p0_transpose_item<false>(F.wpb, DM, 64 * (r / 32), 32 * (r % 32), Wp, 1024, 512, scr, F.lane, 1.f); continue; } r -= I_P;
        p0_transpose_item<false>(F.wout, DM, 64 * (r / 32), 32 * (r % 32), Wo, 1024, 0, scr, F.lane, 1.f);
    }
    h16* Hb = (h16*)(F.ws + WS_H);
    for (int m = gw; m + 3 * NGW < MROWS; m += 4 * NGW) p0_norm_rows4(F.x, F.norm_g, Hb, m, NGW, F.lane);
    if (MROWS % (4 * NGW) != 0) for (int m = gw + (MROWS / (4 * NGW)) * 4 * NGW; m < MROWS; m += NGW) p0_norm_rows4(F.x, F.norm_g, Hb, m, 0, F.lane);
}

constexpr int NBIN = 256, ICAP = 32;
constexpr int IW_VALS = 0, IW_HIST = 16384, IW_LIST = IW_HIST + 2 * NBIN * 4, IW_LMASK = IW_LIST + 2 * ICAP * 8, IW_BYTES = IW_LMASK + 512;
static_assert(8 * IW_BYTES <= LDSCTL_OFF, "indexer LDS");
__device__ __forceinline__ int idx_bin(float v, float smin, float scale) { const int b = (int)((v - smin) * scale); return b > NBIN - 1 ? NBIN - 1 : b; }
__device__ __forceinline__ float swz16(float x) { return __int_as_float(__builtin_amdgcn_ds_swizzle(__float_as_int(x), 0x401F)); }
__device__ __forceinline__ float half_min(float v) { v = fminf(v, __shfl_xor(v, 1)); v = fminf(v, __shfl_xor(v, 2)); v = fminf(v, __shfl_xor(v, 4)); v = fminf(v, __shfl_xor(v, 8)); return fminf(v, __shfl_xor(v, 16)); }
__device__ __forceinline__ float half_max(float v) { v = fmaxf(v, __shfl_xor(v, 1)); v = fmaxf(v, __shfl_xor(v, 2)); v = fmaxf(v, __shfl_xor(v, 4)); v = fmaxf(v, __shfl_xor(v, 8)); return fmaxf(v, __shfl_xor(v, 16)); }
__device__ __forceinline__ unsigned lowest_bits(unsigned w, unsigned n) { unsigned kept = 0u; while (n && w) { const unsigned bit = w & (0u - w); kept |= bit; w ^= bit; --n; } return kept; }
__device__ __forceinline__ void idx_pair(Frame& F, int b, int u) {
    const int lane = F.lane, k16 = lane & 15, fq = lane >> 4, th = fq >> 1, par = fq & 1;
    const int ta = 2 * u, t = ta + th;
    unsigned* gm = (unsigned*)(F.ws + WS_MASK) + (size_t)(b * SEQ + ta) * 64;
    if (ta < 256) {
        const int lo = lane * 32;
        gm[lane] = (ta >= lo + 31) ? 0xffffffffu : (ta >= lo ? ((2u << (ta - lo)) - 1u) : 0u);
        gm[64 + lane] = (ta + 1 >= lo + 31) ? 0xffffffffu : (ta + 1 >= lo ? ((2u << (ta + 1 - lo)) - 1u) : 0u);
        return;
    }
    LAS unsigned char* wl = F.lds + F.wave * IW_BYTES;
    LAS float* vals = (LAS float*)(wl + IW_VALS) + th * 2048 + 16 * par + k16;
    LAS unsigned* hist = (LAS unsigned*)(wl + IW_HIST) + th * NBIN;
    LAS u32x2* clist = (LAS u32x2*)(wl + IW_LIST) + th * ICAP;
    LAS unsigned* lmask = (LAS unsigned*)(wl + IW_LMASK);
    lmask[lane] = 0u; lmask[64 + lane] = 0u;
    TSTART(20)
    TSTART(21)
    const size_t qrow = (size_t)(b * SEQ + ta + (k16 >> 3));
    const h16x8 qh = *(const h16x8*)((const h16*)(F.ws + WS_QH) + qrow * 256 + (k16 & 7) * 32 + fq * 8);
    const f32x4 wv = *(const f32x4*)((const float*)(F.ws + WS_WI) + (size_t)(b * SEQ + t) * 8 + 4 * par);
    const int nstep = (ta + 1) / 32 + 1;
    const h16* kph = (const h16*)(F.ws + WS_KH) + (size_t)(b * SEQ + k16) * 32 + fq * 8;
    h16x8 kb[4][4];
#define IDX_LOAD(slot, step) do { const int st_ = (step) < 64 ? (step) : 63; const h16* ph_ = kph + (size_t)st_ * 1024; \
        kb[slot][0] = *(const h16x8*)ph_; kb[slot][2] = *(const h16x8*)(ph_ + 512); } while (0)
    IDX_LOAD(0, 0); IDX_LOAD(1, 1); IDX_LOAD(2, 2); IDX_LOAD(3, 3);
    TSTART(25)
    TSTOP(25)
    float vmin = INFINITY, vmax = -INFINITY;
    const int myk = 16 * par + k16;
#define IDX_STEP(slot, step) do { \
        f32x4 a0 = __builtin_amdgcn_mfma_f32_16x16x32_f16(qh, kb[slot][0], (f32x4){0.f, 0.f, 0.f, 0.f}, 0, 0, 0), a1 = __builtin_amdgcn_mfma_f32_16x16x32_f16(qh, kb[slot][2], (f32x4){0.f, 0.f, 0.f, 0.f}, 0, 0, 0); \
        IDX_LOAD(slot, (step) + 4); \
        float s0 = wv[0] * fmaxf(a0[0], 0.f), s1 = wv[0] * fmaxf(a1[0], 0.f); \
        _Pragma("unroll") for (int r = 1; r < 4; ++r) { s0 = fmaf(wv[r], fmaxf(a0[r], 0.f), s0); s1 = fmaf(wv[r], fmaxf(a1[r], 0.f), s1); } \
        const float recv = swz16(par ? s0 : s1); \
        const float mine = (par ? s1 : s0) + recv + 0.0f; \
        const bool valid = (32 * (step) + myk) <= t; \
        vals[32 * (step)] = valid ? mine : __builtin_nanf(""); \
        if (valid) { vmin = fminf(vmin, mine); vmax = fmaxf(vmax, mine); } } while (0)
#pragma unroll 1
    for (int i = 0; i < nstep; i += 8) { IDX_STEP(0, i); IDX_STEP(1, i + 1); IDX_STEP(2, i + 2); IDX_STEP(3, i + 3); IDX_STEP(0, i + 4); IDX_STEP(1, i + 5); IDX_STEP(2, i + 6); IDX_STEP(3, i + 7); }
#undef IDX_STEP
#undef IDX_LOAD
    TSTOP(21)
    TSTART(22)
    TSTART(26)
    float lo = half_min(vmin), hi = half_max(vmax);
    TSTOP(26)
    unsigned need = 256u, wa = 0u, wb = 0u; bool done = false;
#pragma unroll 1
    for (int level = 0; level < 64; ++level) {
        if (__ballot(!done) == 0ull) break;
        const bool tie = !done && !(hi > lo);
        const float scale = (hi > lo) ? ((float)NBIN - 0.5f) / (hi - lo) : 0.f;
        unsigned bst = 0u, rr = 0u, cb = 0u;
        TSTART(23)
        if (__ballot(!done && !tie) != 0ull) {
            *(LAS u32x4*)(wl + IW_HIST + lane * 16) = (u32x4){0u, 0u, 0u, 0u}; *(LAS u32x4*)(wl + IW_HIST + 1024 + lane * 16) = (u32x4){0u, 0u, 0u, 0u};
            asm volatile("s_waitcnt lgkmcnt(0)" ::: "memory");
            if (!done && !tie) {
#pragma unroll 8
                for (int i = 0; i < nstep; ++i) { const float v = vals[32 * i]; if (v >= lo && v <= hi) atomicAdd((unsigned*)&hist[idx_bin(v, lo, scale)], 1u); }
            }
            asm volatile("s_waitcnt lgkmcnt(0)" ::: "memory");
            TSTART(27)
            {
                const int l5 = lane & 31;
                const u32x4 cw0 = *(const LAS u32x4*)(wl + IW_HIST + th * 1024 + l5 * 32), cw1 = *(const LAS u32x4*)(wl + IW_HIST + th * 1024 + l5 * 32 + 16);
                const unsigned cnt[8] = {cw0.x, cw0.y, cw0.z, cw0.w, cw1.x, cw1.y, cw1.z, cw1.w};
                const unsigned s = ((cw0.x + cw0.y) + (cw0.z + cw0.w)) + ((cw1.x + cw1.y) + (cw1.z + cw1.w));
                unsigned v = s;
#pragma unroll
                for (int o = 1; o < 32; o <<= 1) { const unsigned tmp = (unsigned)__shfl_down((int)v, o, 32); if (l5 + o < 32) v += tmp; }
                const unsigned above = v - s; const bool crit = !done && !tie && above < need && need <= above + s;
                unsigned cum = above, b_ = 0, r_ = 0, c_ = 0; bool found = false;
#pragma unroll
                for (int e = 7; e >= 0; --e) { const unsigned cc = cnt[e]; if (!found && cum + cc >= need) { found = true; b_ = 8u * l5 + e; r_ = need - cum; c_ = cc; } if (!found) cum += cc; }
                const unsigned long long cm = __ballot(crit);
                const int cla = (unsigned)cm ? (int)__builtin_ctz((unsigned)cm) : 0, clb = (unsigned)(cm >> 32) ? 32 + (int)__builtin_ctz((unsigned)(cm >> 32)) : 32;
                const unsigned bqa = (unsigned)__builtin_amdgcn_readlane((int)b_, cla), rqa = (unsigned)__builtin_amdgcn_readlane((int)r_, cla), cqa = (unsigned)__builtin_amdgcn_readlane((int)c_, cla);
                const unsigned bqb = (unsigned)__builtin_amdgcn_readlane((int)b_, clb), rqb = (unsigned)__builtin_amdgcn_readlane((int)r_, clb), cqb = (unsigned)__builtin_amdgcn_readlane((int)c_, clb);
                if (!done && !tie) { bst = th ? bqb : bqa; rr = th ? rqb : rqa; cb = th ? cqb : cqa; }
            }
            TSTOP(27)
        }
        TSTOP(23)
        TSTART(24)
        const bool takeall = (cb == rr);
        const int bsel = takeall ? (int)bst : (int)bst + 1;
        bool slow = true;
        if (level == 0 && __ballot(tie) == 0ull) {
            const float inv_scale = (hi - lo) * (1.0f / ((float)NBIN - 0.5f));
            const float thrA = lo + ((float)bsel + 0.02f) * inv_scale, thrB = lo + ((float)bst - 0.02f) * inv_scale;
            unsigned zc_a = 0u, zc_b = 0u;
#pragma unroll 4
            for (int i = 0; i < nstep; ++i) {
                const float v = vals[32 * i];
                const bool isA = v >= thrA, zone = v >= thrB && !isA;
                const unsigned long long sm = __ballot(isA), zm = __ballot(zone);
                const unsigned slot = th ? zc_b + __builtin_amdgcn_mbcnt_hi((unsigned)(zm >> 32), 0u) : zc_a + __builtin_amdgcn_mbcnt_lo((unsigned)zm, 0u);
                if (zone && slot < (unsigned)ICAP) clist[slot] = (u32x2){__float_as_uint(v), (unsigned)(32 * i + myk)};
                zc_a += __popc((unsigned)zm); zc_b += __popc((unsigned)(zm >> 32));
                if (lane == i) { wa |= (unsigned)sm; wb |= (unsigned)(sm >> 32); }
            }
            asm volatile("s_waitcnt lgkmcnt(0)" ::: "memory");
            TSTART(28)
            if (zc_a <= (unsigned)ICAP && zc_b <= (unsigned)ICAP) {
                slow = false;
                const int j = lane & 31; const unsigned zc = th ? zc_b : zc_a;
                const u32x2 me = clist[j]; const float vj = __uint_as_float(me.x);
                const int bj = idx_bin(vj, lo, scale);
                const bool have = (unsigned)j < zc, selj = have && bj >= bsel, memj = have && !takeall && bj == (int)bst;
                const float vmj = memj ? vj : -INFINITY; unsigned rank = 0u;
                const unsigned zmax = zc_a > zc_b ? zc_a : zc_b;
                for (unsigned i2 = 0; i2 < zmax; ++i2) {
                    const float va = __int_as_float(__builtin_amdgcn_readlane(__float_as_int(vmj), (int)i2)), vb2 = __int_as_float(__builtin_amdgcn_readlane(__float_as_int(vmj), (int)i2 + 32));
                    const unsigned ka = (unsigned)__builtin_amdgcn_readlane((int)me.y, (int)i2), kb2 = (unsigned)__builtin_amdgcn_readlane((int)me.y, (int)i2 + 32);
                    const float vi = th ? vb2 : va; const unsigned ki = th ? kb2 : ka;
                    rank += (vi > vj || (vi == vj && ki < me.y)) ? 1u : 0u;
                }
                if (selj || (memj && rank < rr)) atomicOr((unsigned*)&lmask[th * 64 + (me.y >> 5)], 1u << (me.y & 31));
                done = true;
            }
            TSTOP(28)
        }
        if (slow) {
            const bool uselist = !takeall && cb <= (unsigned)ICAP;
            float nlo = INFINITY, nhi = -INFINITY; unsigned cnt_a = 0u, cnt_b = 0u, tie_a = 0u, tie_b = 0u;
            const unsigned need_a = (unsigned)__builtin_amdgcn_readlane((int)need, 0), need_b = (unsigned)__builtin_amdgcn_readlane((int)need, 32);
            const bool tie_any = __ballot(tie) != 0ull;
#pragma unroll 2
            for (int i = 0; i < nstep; ++i) {
                const float v = vals[32 * i]; const bool act = !done && v >= lo && v <= hi;
                const int bn = idx_bin(v, lo, scale);
                const bool sel = act && !tie && bn >= bsel, mem = act && !tie && !takeall && bn == (int)bst;
                unsigned long long sm = __ballot(sel);
                if (tie_any) {
                    const unsigned long long tm = __ballot(act && tie);
                    const unsigned ka = lowest_bits((unsigned)tm, need_a - tie_a), kb = lowest_bits((unsigned)(tm >> 32), need_b - tie_b);
                    tie_a += __popc(ka); tie_b += __popc(kb); sm |= (unsigned long long)ka | ((unsigned long long)kb << 32);
                }
                if (sm) { if (lane == i) { wa |= (unsigned)sm; wb |= (unsigned)(sm >> 32); } }
                const unsigned long long mm = __ballot(mem);
                if (mm) {
                    if (mem) { nlo = fminf(nlo, v); nhi = fmaxf(nhi, v);
                        if (uselist) { const unsigned slot = th ? cnt_b + __builtin_amdgcn_mbcnt_hi((unsigned)(mm >> 32), 0u) : cnt_a + __builtin_amdgcn_mbcnt_lo((unsigned)mm, 0u);
                            if (slot < (unsigned)ICAP) clist[slot] = (u32x2){__float_as_uint(v), (unsigned)(32 * i + myk)}; } }
                    cnt_a += __popc((unsigned)mm); cnt_b += __popc((unsigned)(mm >> 32));
                }
            }
            asm volatile("s_waitcnt lgkmcnt(0)" ::: "memory");
            if (!done) {
                if (tie || takeall) done = true;
                else if (uselist) {
                    const int j = lane & 31; const u32x2 me = clist[j]; const float vj = __uint_as_float(me.x); unsigned rank = 0u;
                    for (unsigned i2 = 0; i2 < cb; ++i2) { const u32x2 o = clist[i2]; const float vi = __uint_as_float(o.x); rank += (vi > vj || (vi == vj && o.y < me.y)) ? 1u : 0u; }
                    if ((unsigned)j < cb && rank < rr) atomicOr((unsigned*)&lmask[th * 64 + (me.y >> 5)], 1u << (me.y & 31));
                    done = true;
                } else { lo = half_min(nlo); hi = half_max(nhi); need = rr; }
            }
        }
        TSTOP(24)
    }
    asm volatile("s_waitcnt lgkmcnt(0)" ::: "memory");
    gm[lane] = wa | lmask[lane]; gm[64 + lane] = wb | lmask[64 + lane];
    TSTOP(22)
    TSTOP(20)
}
__device__ __forceinline__ void p2_index_phase(Frame& F) {
    for (int s = F.vcu >> 2; s < 64; s += (F.G + 3) >> 2) {
        unsigned* ctr = (unsigned*)(F.ws + WS_CTL + 16384) + s * 64;
        for (;;) {
            unsigned k = 0u;
            if (F.lane == 0) k = __hip_atomic_fetch_add(ctr, 1u, __ATOMIC_RELAXED, __HIP_MEMORY_SCOPE_AGENT);
            k = (unsigned)__builtin_amdgcn_readfirstlane((int)k);
            if (k >= 128u) break;
            idx_pair(F, s & 7, 1023 - (s >> 3) - 8 * (int)k);
        }
    }
}

constexpr int AT_NSLOT = 5, AT_K = 0, AT_KSZ = 64 * 144, AT_V = AT_NSLOT * AT_KSZ, AT_VSZ = 64 * 192, AT_LUT = AT_V + AT_NSLOT * AT_VSZ, AT_MTAB = AT_LUT + 320 * 4, AT_OST = 0, AT_OSTSZ = 32 * 144;
static_assert(AT_MTAB + 128 <= RING_BYTES && 8 * AT_OSTSZ <= AT_V, "attention LDS");
typedef _Float16 h16x2v __attribute__((ext_vector_type(2)));
__device__ __forceinline__ s16x4 vtr_read(const LAS unsigned char* p) { return __builtin_amdgcn_ds_read_tr16_b64_v4i16((LAS s16x4*)p); }

template <bool ISB>
__device__ __forceinline__ void attn_unit(Frame& F, int b, int h, int qb) {
    const int tid = F.tid, lane = F.lane, wid = F.wave, q = lane & 31, hi = lane >> 5;
    const int q0 = qb * 256, r0 = q0 + wid * 32, t = r0 + q;
    const size_t row = (size_t)b * SEQ + t;
    const h16* Qp; const h16* Kp; const h16* Vp; const h16* Zp; int kvpitch, ycol;
    if (ISB) { Qp = (const h16*)(F.ws + WS_QB) + h * 64; Kp = (const h16*)(F.ws + WS_KB) + h * 64; Vp = (const h16*)(F.ws + WS_VB) + h * 64; Zp = (const h16*)(F.ws + WS_ZB) + h * 64; kvpitch = 512; ycol = 512 + h * 64; }
    else     { Qp = (const h16*)(F.ws + WS_QA) + h * 64; Kp = (const h16*)(F.ws + WS_KVA) + (h >> 2) * 64; Vp = (const h16*)(F.ws + WS_KVA) + 128 + (h >> 2) * 64; Zp = (const h16*)(F.ws + WS_ZA) + h * 64; kvpitch = 256; ycol = h * 64; }
    const unsigned* mrow = (const unsigned*)(F.ws + WS_MASK) + row * 64;
    LAS float* lut = (LAS float*)(F.lds + AT_LUT);
    for (int i = tid; i < 320; i += NTHREADS) { const int dist = 223 - i; float v;
        if (ISB) v = dist < 0 ? 0.f : (F.relb[t5_bucket(dist > 127 ? 127 : dist) * 16 + 8 + h] - F.relb[31 * 16 + 8 + h]) * LOG2E;
        else v = (dist >= 0 && dist < 128) ? F.relb[t5_bucket(dist) * 16 + h] * LOG2E : -INFINITY;
        lut[i] = v; }
    if (tid < 16) { u32x2 e; e.x = ((tid & 1) ? 0xffffu : 0u) | ((tid & 2) ? 0xffff0000u : 0u); e.y = ((tid & 4) ? 0xffffu : 0u) | ((tid & 8) ? 0xffff0000u : 0u); *(LAS u32x2*)(F.lds + AT_MTAB + tid * 8) = e; }
    h16x8 qr[4];
    {   const float* qg = ISB ? F.qnb : F.qna; float ss = 0.f;
#pragma unroll
        for (int d0 = 0; d0 < 4; ++d0) { qr[d0] = *(const h16x8*)(Qp + row * 512 + d0 * 16 + hi * 8);
#pragma unroll
            for (int e = 0; e < 8; ++e) { const float f = (float)qr[d0][e]; ss += f * f; } }
        ss += __shfl_xor(ss, 32);
        const float rq = rsqrtf(ss * (1.0f / 64.0f) + RMS_EPS) * QSCALE;
#pragma unroll
        for (int d0 = 0; d0 < 4; ++d0) { const f32x4 g0 = *(const f32x4*)(qg + d0 * 16 + hi * 8), g1 = *(const f32x4*)(qg + d0 * 16 + hi * 8 + 4);
            u32x4 w; w.x = pkh((float)qr[d0][0] * rq * g0[0], (float)qr[d0][1] * rq * g0[1]); w.y = pkh((float)qr[d0][2] * rq * g0[2], (float)qr[d0][3] * rq * g0[3]);
            w.z = pkh((float)qr[d0][4] * rq * g1[0], (float)qr[d0][5] * rq * g1[1]); w.w = pkh((float)qr[d0][6] * rq * g1[2], (float)qr[d0][7] * rq * g1[3]);
            qr[d0] = __builtin_bit_cast(h16x8, w); } }
    float kgn[8];
    {   const float* kgp = (ISB ? F.knb : F.kna) + (tid & 7) * 8; const f32x4 g0 = *(const f32x4*)kgp, g1 = *(const f32x4*)(kgp + 4);
        kgn[0] = g0[0]; kgn[1] = g0[1]; kgn[2] = g0[2]; kgn[3] = g0[3]; kgn[4] = g1[0]; kgn[5] = g1[1]; kgn[6] = g1[2]; kgn[7] = g1[3]; }
#define KNORM(KR) do { const h16x8 kv_ = __builtin_bit_cast(h16x8, KR); float f_[8]; float ss_ = 0.f; \
        _Pragma("unroll") for (int e = 0; e < 8; ++e) { f_[e] = (float)kv_[e]; ss_ += f_[e] * f_[e]; } \
        ss_ += __shfl_xor(ss_, 1); ss_ += __shfl_xor(ss_, 2); ss_ += __shfl_xor(ss_, 4); \
        const float rk_ = rsqrtf(ss_ * (1.0f / 64.0f) + RMS_EPS); \
        KR.x = pkh(f_[0] * rk_ * kgn[0], f_[1] * rk_ * kgn[1]); KR.y = pkh(f_[2] * rk_ * kgn[2], f_[3] * rk_ * kgn[3]); \
        KR.z = pkh(f_[4] * rk_ * kgn[4], f_[5] * rk_ * kgn[5]); KR.w = pkh(f_[6] * rk_ * kgn[6], f_[7] * rk_ * kgn[7]); } while (0)
    float m_run = -INFINITY, l_run = 0.f;
    f32x16 o[2];
#pragma unroll
    for (int r = 0; r < 16; ++r) { o[0][r] = 0.f; o[1][r] = 0.f; }
    const int kfo = q * 144 + hi * 16;
    const int vfo = (4 * hi + ((lane & 15) >> 2)) * 192 + ((lane >> 4) & 1) * 32 + (lane & 3) * 8;
#define ATT_TILE(SLOT, K0) do { const int k0_ = (K0); const LAS unsigned char* kb = F.lds + AT_K + (SLOT) * AT_KSZ + kfo; const LAS unsigned char* vb = F.lds + AT_V + (SLOT) * AT_VSZ + vfo; \
            f32x16 p0, p1; \
            _Pragma("unroll") \
            for (int r = 0; r < 16; ++r) { p0[r] = 0.f; p1[r] = 0.f; } \
            _Pragma("unroll") \
            for (int d0 = 0; d0 < 4; ++d0) { \
                const h16x8 ka = *(const LAS h16x8*)(kb + d0 * 32), kc = *(const LAS h16x8*)(kb + 32 * 144 + d0 * 32); \
                p0 = __builtin_amdgcn_mfma_f32_32x32x16_f16(ka, qr[d0], p0, 0, 0, 0); \
                p1 = __builtin_amdgcn_mfma_f32_32x32x16_f16(kc, qr[d0], p1, 0, 0, 0); \
            } \
 \
            if (!ISB || (r0 - k0_ - 63 < 113)) { \
                const LAS float* lp = lut + (223 - (t - k0_ - 4 * hi)); \
            _Pragma("unroll") \
                for (int r = 0; r < 16; ++r) { const int c = (r & 3) + 8 * (r >> 2); p0[r] += lp[c]; p1[r] += lp[32 + c]; } \
            } \
 \
            h16x2v s2[16]; \
            _Pragma("unroll") \
            for (int j = 0; j < 8; ++j) { s2[j] = __builtin_convertvector((f32x2){p0[2 * j], p0[2 * j + 1]}, h16x2v); s2[8 + j] = __builtin_convertvector((f32x2){p1[2 * j], p1[2 * j + 1]}, h16x2v); } \
            h16x2v m2 = __builtin_elementwise_max(s2[0], s2[1]); \
            _Pragma("unroll") \
            for (int j = 2; j < 16; ++j) m2 = __builtin_elementwise_max(m2, s2[j]); \
            float mx = fmaxf((float)m2.x, (float)m2.y); \
            mx = fmaxf(mx, __shfl_xor(mx, 32)); \
            const float mnew = fmaxf(m_run, mx), muse = (mnew == -INFINITY) ? 0.f : mnew; \
            if (__any(mnew > m_run)) { \
                const float alpha = __builtin_amdgcn_exp2f(m_run - muse); \
                l_run *= alpha; \
            _Pragma("unroll") \
                for (int r = 0; r < 16; ++r) { o[0][r] *= alpha; o[1][r] *= alpha; } \
            } \
            m_run = mnew; \
            const h16 nm = (h16)(-muse); const h16x2v nm2 = {nm, nm}; \
            _Pragma("unroll") \
            for (int j = 0; j < 16; ++j) { const h16x2v a = s2[j] + nm2; s2[j].x = __builtin_exp2f16(a.x); s2[j].y = __builtin_exp2f16(a.y); } \
            if (ISB) { \
                const unsigned mm0 = mw.x >> (4 * hi), mm1 = mw.y >> (4 * hi); \
            _Pragma("unroll") \
                for (int g4 = 0; g4 < 4; ++g4) { \
                    const u32x2 e0 = *(const LAS u32x2*)(F.lds + AT_MTAB + ((mm0 >> (8 * g4)) & 15u) * 8), e1 = *(const LAS u32x2*)(F.lds + AT_MTAB + ((mm1 >> (8 * g4)) & 15u) * 8); \
                    s2[2 * g4] = __builtin_bit_cast(h16x2v, __builtin_bit_cast(unsigned, s2[2 * g4]) & e0.x); s2[2 * g4 + 1] = __builtin_bit_cast(h16x2v, __builtin_bit_cast(unsigned, s2[2 * g4 + 1]) & e0.y); \
                    s2[8 + 2 * g4] = __builtin_bit_cast(h16x2v, __builtin_bit_cast(unsigned, s2[8 + 2 * g4]) & e1.x); s2[8 + 2 * g4 + 1] = __builtin_bit_cast(h16x2v, __builtin_bit_cast(unsigned, s2[8 + 2 * g4 + 1]) & e1.y); \
                } \
            } \
            {   h16x2v a0 = s2[0] + s2[1], a1 = s2[2] + s2[3], a2 = s2[4] + s2[5], a3 = s2[6] + s2[7], a4 = s2[8] + s2[9], a5 = s2[10] + s2[11], a6 = s2[12] + s2[13], a7 = s2[14] + s2[15]; \
                a0 = a0 + a1; a2 = a2 + a3; a4 = a4 + a5; a6 = a6 + a7; \
                l_run += (((float)a0.x + (float)a0.y) + ((float)a2.x + (float)a2.y)) + (((float)a4.x + (float)a4.y) + ((float)a6.x + (float)a6.y)); } \
            u32x4 pk[4]; \
            _Pragma("unroll") \
            for (int s = 0; s < 4; ++s) pk[s] = (u32x4){__builtin_bit_cast(unsigned, s2[4 * s]), __builtin_bit_cast(unsigned, s2[4 * s + 1]), __builtin_bit_cast(unsigned, s2[4 * s + 2]), __builtin_bit_cast(unsigned, s2[4 * s + 3])}; \
            _Pragma("unroll") \
            for (int s = 0; s < 4; ++s) \
            _Pragma("unroll") \
                for (int d1 = 0; d1 < 2; ++d1) { \
                    const s16x4 lo4 = vtr_read(vb + (16 * s) * 192 + d1 * 64), hi4 = vtr_read(vb + (16 * s + 8) * 192 + d1 * 64); \
                    const h16x4 lf = __builtin_bit_cast(h16x4, lo4), hf = __builtin_bit_cast(h16x4, hi4); \
                    const h16x8 vf = {lf[0], lf[1], lf[2], lf[3], hf[0], hf[1], hf[2], hf[3]}; \
                    o[d1] = __builtin_amdgcn_mfma_f32_32x32x16_f16(vf, __builtin_bit_cast(h16x8, pk[s]), o[d1], 0, 0, 0); \
                } \
        } while (0)
    const int srow = tid >> 3, sch = tid & 7;
    const h16* kg = Kp + ((size_t)b * SEQ + srow) * kvpitch + sch * 8; const h16* vg = Vp + ((size_t)b * SEQ + srow) * kvpitch + sch * 8;
    const int kst = srow * 144 + sch * 16, vst = srow * 192 + sch * 16;
    if (ISB) {
        const int npair = 2 * qb + 2;
        u32x4 kreg0 = *(const u32x4*)kg, vreg0 = *(const u32x4*)vg, kreg1 = *(const u32x4*)(kg + (size_t)64 * kvpitch), vreg1 = *(const u32x4*)(vg + (size_t)64 * kvpitch);
        u32x4 mw4 = *(const u32x4*)mrow, mw4n = {0u, 0u, 0u, 0u};
        KNORM(kreg0); KNORM(kreg1);
        *(LAS u32x4*)(F.lds + AT_K + kst) = kreg0; *(LAS u32x4*)(F.lds + AT_V + vst) = vreg0; *(LAS u32x4*)(F.lds + AT_K + AT_KSZ + kst) = kreg1; *(LAS u32x4*)(F.lds + AT_V + AT_VSZ + vst) = vreg1;
        __syncthreads();
#pragma unroll 1
        for (int pr = 0; pr < npair; ++pr) {
            const int sb = (pr & 1) * 2, kt = 2 * pr;
            if (pr + 1 < npair) { const size_t go = (size_t)(kt + 2) * 64 * kvpitch; kreg0 = *(const u32x4*)(kg + go); vreg0 = *(const u32x4*)(vg + go); kreg1 = *(const u32x4*)(kg + go + (size_t)64 * kvpitch); vreg1 = *(const u32x4*)(vg + go + (size_t)64 * kvpitch);
                mw4n = *(const u32x4*)(mrow + 2 * (kt + 2)); }
            TSTART(31)
            { const u32x2 mw = {mw4.x, mw4.y}; const int k0 = kt * 64; if (k0 <= r0 + 31) ATT_TILE(sb, k0); }
            { const u32x2 mw = {mw4.z, mw4.w}; const int k0 = kt * 64 + 64; if (k0 <= r0 + 31) ATT_TILE(sb + 1, k0); }
            TSTOP(31)
            TSTART(32)
            if (pr + 1 < npair) { KNORM(kreg0); KNORM(kreg1); const int sn = 2 - sb;
                *(LAS u32x4*)(F.lds + AT_K + sn * AT_KSZ + kst) = kreg0; *(LAS u32x4*)(F.lds + AT_V + sn * AT_VSZ + vst) = vreg0;
                *(LAS u32x4*)(F.lds + AT_K + (sn + 1) * AT_KSZ + kst) = kreg1; *(LAS u32x4*)(F.lds + AT_V + (sn + 1) * AT_VSZ + vst) = vreg1; mw4 = mw4n; }
            TSTOP(32)
            TSTART(33)
            __syncthreads();
            TSTOP(33)
        }
    } else {
        u32x4 kr4[4], vr4[4];
#pragma unroll
        for (int jj = 0; jj < 4; ++jj) { const int kt = 4 * qb - 2 + jj; if (kt >= 0) { kr4[jj] = *(const u32x4*)(kg + (size_t)kt * 64 * kvpitch); vr4[jj] = *(const u32x4*)(vg + (size_t)kt * 64 * kvpitch); } }
#pragma unroll
        for (int jj = 0; jj < 4; ++jj) { const int kt = 4 * qb - 2 + jj; if (kt >= 0) { KNORM(kr4[jj]); *(LAS u32x4*)(F.lds + AT_K + jj * AT_KSZ + kst) = kr4[jj]; *(LAS u32x4*)(F.lds + AT_V + jj * AT_VSZ + vst) = vr4[jj]; } }
        __syncthreads();
        const int base_w = wid >> 1;
        u32x4 kreg, vreg; const u32x2 mw = {0u, 0u};
#pragma unroll 1
        for (int s = 0; s < 3; ++s) {
            if (s < 2) { kreg = *(const u32x4*)(kg + (size_t)(4 * qb + 2 + s) * 64 * kvpitch); vreg = *(const u32x4*)(vg + (size_t)(4 * qb + 2 + s) * 64 * kvpitch); }
            const int j = base_w + s, kt = 4 * qb - 2 + j;
            TSTART(31)
            if (kt >= 0) ATT_TILE((j == 5 ? 0 : j), kt * 64);
            TSTOP(31)
            if (s < 2) { const int sl = (s == 0) ? 4 : 0; KNORM(kreg); *(LAS u32x4*)(F.lds + AT_K + sl * AT_KSZ + kst) = kreg; *(LAS u32x4*)(F.lds + AT_V + sl * AT_VSZ + vst) = vreg; }
            TSTART(33)
            __syncthreads();
            TSTOP(33)
        }
    }
    TSTART(34)
    l_run += __shfl_xor(l_run, 32);
    if (!ISB) l_run += __builtin_amdgcn_exp2f(F.sinks[h] * LOG2E - m_run);
    const float inv = 1.0f / l_run;
    LAS unsigned char* ost = F.lds + AT_OST + wid * AT_OSTSZ;
#pragma unroll
    for (int d1 = 0; d1 < 2; ++d1)
#pragma unroll
        for (int g4 = 0; g4 < 4; ++g4) { u32x2 w; w.x = pkh(o[d1][4 * g4] * inv, o[d1][4 * g4 + 1] * inv); w.y = pkh(o[d1][4 * g4 + 2] * inv, o[d1][4 * g4 + 3] * inv);
            *(LAS u32x2*)(ost + q * 144 + (32 * d1 + 8 * g4 + 4 * hi) * 2) = w; }
    LDS_WAIT(); asm volatile("" ::: "memory");
    h16* Yp = (h16*)(F.ws + WS_Y);
#pragma unroll
    for (int i = 0; i < 4; ++i) { const int rr = i * 8 + (lane >> 3), ch = lane & 7; const size_t grow = (size_t)b * SEQ + r0 + rr;
        const h16x8 ov = *(const LAS h16x8*)(ost + rr * 144 + ch * 16); const h16x8 zv = *(const h16x8*)(Zp + grow * 512 + ch * 8);
        float y[8];
#pragma unroll
        for (int e = 0; e < 8; ++e) { const float z = (float)zv[e]; y[e] = (float)ov[e] * z * sigmoidf_fast(z); }
        u32x4 w; w.x = pkh(y[0], y[1]); w.y = pkh(y[2], y[3]); w.z = pkh(y[4], y[5]); w.w = pkh(y[6], y[7]);
        *(u32x4*)(Yp + grow * 1024 + ycol + ch * 8) = w; }
    __syncthreads();
    TSTOP(34)
#undef KNORM
#undef ATT_TILE
}
__device__ __forceinline__ void p3_attention_phase(Frame& F) {
    for (int v = F.vcu; v < 256; v += F.G) {
        const int bh = v >> 2, j = v & 3, b = bh >> 3, h = bh & 7;
        { TSTART(36) attn_unit<true>(F, b, h, 7 - j); attn_unit<true>(F, b, h, j); TSTOP(36) }
        { TSTART(35) attn_unit<false>(F, b, h, 2 * j); attn_unit<false>(F, b, h, 2 * j + 1); TSTOP(35) }
    }
}

struct Args { const float* in[12]; float* out; unsigned char* ws; int ph_lo, ph_hi; };
constexpr int N_PHASES = 6;
__global__ void __launch_bounds__(NTHREADS, 2) mk_fwd(Args args) {
    extern __shared__ __attribute__((aligned(16))) unsigned char lds_raw[];
    cg::grid_group grid = cg::this_grid();
    Frame F;
    F.lds = (LAS unsigned char*)lds_raw;
    F.tid = threadIdx.x; F.lane = F.tid & 63; F.wave = __builtin_amdgcn_readfirstlane(F.tid >> 6);
    F.G = gridDim.x; { const int bx = blockIdx.x; F.vcu = (F.G % 8 == 0) ? (bx % 8) * (F.G / 8) + bx / 8 : bx; }
    F.ws = args.ws; F.prof = 0ull;
    F.x = args.in[0]; F.norm_g = args.in[1]; F.w_in = args.in[2]; F.qna = args.in[3]; F.kna = args.in[4]; F.sinks = args.in[5];
    F.qnb = args.in[6]; F.knb = args.in[7]; F.relb = args.in[8]; F.wpa = args.in[9]; F.wpb = args.in[10]; F.wout = args.in[11]; F.out = args.out;
    const int lo = args.ph_lo, hi = args.ph_hi;
    if (lo < 0) grid.sync();
    if (F.tid < 64) ((LAS unsigned*)(F.lds + LDSCTL_OFF))[F.tid] = 0u;
    __syncthreads();
    XcdBarrier bar = xcd_barrier_post((unsigned*)(F.ws + WS_CTL), (volatile LAS unsigned*)(F.lds + LDSCTL_OFF) + 8);
#ifdef ONLY_PH
#define IN(k) ((k) == ONLY_PH && lo <= (k) && (k) < hi)
#else
#define IN(k) (lo <= (k) && (k) < hi)
#endif
#ifdef PROBE_SYNC2
#define SEAM(k) do { if (IN(k) && IN((k) + 1)) { xcd_barrier(bar); xcd_barrier(bar); } } while (0)
#else
#define SEAM(k) do { if (IN(k) && IN((k) + 1)) xcd_barrier(bar); } while (0)
#endif
    { TSTART(1) if (IN(0)) { p0_prologue(F); }
    SEAM(0); TSTOP(1) }
    TSTART(2)
    if (IN(1)) {
        pg8::GemmPlain g{(const h16*)(F.ws + WS_H), (const h16*)(F.ws + WS_WIN), 1024, 1024};
        pg8::StaticOrder S; S.init(MROWS, 23 * 256, F.G, (int)blockIdx.x);
        pg8::EpiIn E{F.ws, (h16*)F.out};
        pg8::gemm_phase<pg8::EpiIn, pg8::StaticOrder, pg8::GemmPlain, true, true>(F.lds, g, S, E);
    }
    SEAM(1);
    TSTOP(2)
    { TSTART(3) if (IN(2)) { p2_index_phase(F); }
#if defined(PROF_SEG) && defined(PROF_MAXWAVE)
    if (F.lane == 0) atomicMax((unsigned long long*)(F.ws + WS_CTL + 32768), F.prof);
#endif
    SEAM(2); TSTOP(3) }
    { TSTART(4) if (IN(3)) { p3_attention_phase(F); }
    SEAM(3); TSTOP(4) }
    TSTART(5)
    if (IN(4)) {
        pg8::GemmPlain g{(const h16*)(F.ws + WS_Y), (const h16*)(F.ws + WS_WP), 1024, 1024};
        pg8::StaticOrder S; S.init(MROWS, DM, F.G, (int)blockIdx.x);
        pg8::EpiMerge E{(const h16*)F.out, (h16*)(F.ws + WS_MG)};
        pg8::gemm_phase<pg8::EpiMerge, pg8::StaticOrder, pg8::GemmPlain, true, true>(F.lds, g, S, E);
    }
    SEAM(4);
    TSTOP(5)
    TSTART(6)
    if (IN(5)) {
        pg8::GemmPlain g{(const h16*)(F.ws + WS_MG), (const h16*)(F.ws + WS_WO), 1024, 1024};
        pg8::StaticOrder S; S.init(MROWS, DM, F.G, (int)blockIdx.x);
        pg8::EpiOut E{F.x, F.out};
        pg8::gemm_phase<pg8::EpiOut, pg8::StaticOrder, pg8::GemmPlain, true, true>(F.lds, g, S, E);
    }
    TSTOP(6)
#undef IN
#undef SEAM
#ifdef PROF_SEG
#ifdef PROF_MAXWAVE
    if (blockIdx.x == PROF_BLK && F.wave == PROF_WAVE) F.prof = __hip_atomic_load((unsigned long long*)(F.ws + WS_CTL + 32768), __ATOMIC_RELAXED, __HIP_MEMORY_SCOPE_AGENT);
#endif
    if (blockIdx.x == PROF_BLK && F.wave == PROF_WAVE && hi == N_PHASES) { const unsigned long long t1 = __builtin_amdgcn_s_memrealtime() + F.prof * PROF_MULT; while (__builtin_amdgcn_s_memrealtime() < t1) __builtin_amdgcn_s_sleep(8); }
#endif
}

extern "C" void kernel_launch(void* const* d_in, const int* in_sizes, int n_in, void* d_out, int out_size, void* d_ws, size_t ws_size, hipStream_t stream) {
    static int grid = 0;
    if (grid == 0) {
        if (n_in != 12 || in_sizes[0] != MROWS * DM || out_size != MROWS * DM || ws_size < WS_END) { fprintf(stderr, "kernel_launch: unexpected problem (n_in %d, ws %zu)\n", n_in, ws_size); grid = -1; return; }
        int dev = 0, cus = 0, per_cu = 0;
        hipGetDevice(&dev); hipDeviceGetAttribute(&cus, hipDeviceAttributeMultiprocessorCount, dev);
        hipFuncSetAttribute((const void*)mk_fwd, hipFuncAttributeMaxDynamicSharedMemorySize, LDS_BYTES);
        hipOccupancyMaxActiveBlocksPerMultiprocessor(&per_cu, (const void*)mk_fwd, NTHREADS, LDS_BYTES);
        (void)hipGetLastError();
        if (per_cu < 1) { fprintf(stderr, "kernel_launch: occupancy query says %d blocks/CU\n", per_cu); per_cu = 1; }
        grid = cus;
        if (grid > 256) grid = 256;
    }
    if (grid < 0) return;
    (void)hipMemsetAsync((char*)d_ws + WS_CTL, 0, CTL_BYTES, stream);
    Args a{};
    for (int i = 0; i < 12; ++i) a.in[i] = (const float*)d_in[i];
    a.out = (float*)d_out; a.ws = (unsigned char*)d_ws;
#ifdef PROBE_PH
    {
        void* kargs[] = {&a};
        a.ph_lo = 0; a.ph_hi = PROBE_PH + 1;
        (void)hipLaunchCooperativeKernel((const void*)mk_fwd, dim3(grid), dim3(NTHREADS), kargs, LDS_BYTES, stream);
        (void)hipMemsetAsync((char*)d_ws + WS_CTL, 0, CTL_BYTES, stream);
#ifdef PROBE_SPLIT_ONLY
        a.ph_lo = PROBE_PH + 1; a.ph_hi = N_PHASES;
#else
        a.ph_lo = PROBE_PH; a.ph_hi = N_PHASES;
#endif
        (void)hipLaunchCooperativeKernel((const void*)mk_fwd, dim3(grid), dim3(NTHREADS), kargs, LDS_BYTES, stream);
    }
#else
    {
        a.ph_lo = 0; a.ph_hi = N_PHASES;
        void* kargs[] = {&a};
        hipError_t e = hipLaunchCooperativeKernel((const void*)mk_fwd, dim3(grid), dim3(NTHREADS), kargs, LDS_BYTES, stream);
        if (e != hipSuccess) fprintf(stderr, "cooperative launch failed: %s (grid %d)\n", hipGetErrorString(e), grid);
    }
#endif
}
```

```cpp
#include <hip/hip_runtime.h>
#include <hip/hip_cooperative_groups.h>
#include <cstdio>
#include <cstdint>
namespace cg = cooperative_groups;
#ifdef PROF_SEG
#ifndef PROF_MULT
#define PROF_MULT 4
#endif
#ifndef PROF_BLK
#define PROF_BLK 100
#endif
#ifndef PROF_WAVE
#define PROF_WAVE 3
#endif
#endif

#define LAS __attribute__((address_space(3)))
typedef _Float16 h16;
typedef _Float16 h16x2 __attribute__((ext_vector_type(2)));
typedef _Float16 h16x4 __attribute__((ext_vector_type(4)));
typedef _Float16 h16x8 __attribute__((ext_vector_type(8)));
typedef float f32x2 __attribute__((ext_vector_type(2)));
typedef float f32x4 __attribute__((ext_vector_type(4)));
typedef float f32x16 __attribute__((ext_vector_type(16)));
typedef unsigned u32x2 __attribute__((ext_vector_type(2)));
typedef unsigned u32x4 __attribute__((ext_vector_type(4)));
typedef short s16x4 __attribute__((ext_vector_type(4)));

__device__ __forceinline__ unsigned pkh(float lo, float hi) { const f32x2 v = {lo, hi}; const h16x2 h = __builtin_convertvector(v, h16x2); return __builtin_bit_cast(unsigned, h); }
__device__ __forceinline__ float sigmoidf_fast(float g) { g = fminf(fmaxf(g, -30.f), 30.f); return __builtin_amdgcn_rcpf(1.0f + __builtin_amdgcn_exp2f(-1.4426950408889634f * g)); }

constexpr int NBATCH = 8, SEQ = 2048, DM = 1024, MROWS = NBATCH * SEQ, INW = 5672;
constexpr float RMS_EPS = 1e-6f, LOG2E = 1.4426950408889634f, QSCALE = 0.125f * 1.4426950408889634f;
constexpr float HSCALE = 16.f, WSCALE = 64.f, INV_HW = 1.0f / (16.f * 64.f);
constexpr size_t MiB = 1u << 20;
constexpr size_t WS_H = 0;
constexpr size_t WS_Y = 0, WS_MG = 32 * MiB;
constexpr size_t WS_QH = 32 * MiB, WS_QL = 40 * MiB, WS_KH = 48 * MiB, WS_KL = 49 * MiB, WS_WI = 50 * MiB;
constexpr size_t WS_WIN = 64 * MiB;
constexpr size_t WS_WP = 77 * MiB, WS_WO = 79 * MiB;
constexpr size_t WS_QA = 81 * MiB, WS_KVA = 97 * MiB, WS_ZA = 105 * MiB, WS_QB = 121 * MiB, WS_KB = 137 * MiB, WS_VB = 153 * MiB, WS_ZB = 169 * MiB;
constexpr size_t WS_MASK = 185 * MiB;
constexpr size_t WS_CTL = 190 * MiB, CTL_BYTES = 65536;
constexpr size_t WS_END = 191 * MiB;

namespace pg8 {
#define PG8_LAS __attribute__((address_space(3)))
constexpr int BM = 256, BK = 64, HALF = 128, HTB = HALF * BK * 2  , STAGE_BYTES = 8 * HTB, NXCD = 8, WGM = 8;

__host__ __device__ __forceinline__ int lds_byte(int r, int c) { const int st = (r >> 4) * 2 + (c >> 5), rr = r & 15, cc = c & 31, ob = rr * 64 + cc * 2; return st * 1024 + (ob ^ (((ob >> 9) & 1) << 5)); }
__host__ __device__ __forceinline__ void stage_rc(int b, int& R, int& C) { const int st = b / 1024, sb = b % 1024, swz = sb ^ (((sb >> 9) & 1) << 5); R = (st >> 1) * 16 + swz / 64; C = (st & 1) * 32 + (swz % 64) / 2; }
__host__ __device__ __forceinline__ int perm32(int rho) { const int n = rho >> 4, i = rho & 15; return 8 * (i >> 2) + 4 * n + (i & 3); }

struct Unit { int pm, pn; };

struct StaticOrder {
    int nM, nN, nwg, G, c;
    __host__ __device__ void init(int M, int N, int G_, int c_) { nM = M / BM; nN = N / BM; nwg = nM * nN; G = G_; c = c_; }
    __host__ __device__ bool next(int i, Unit& u) const {
        const long L = (long)i * G + c; if (L >= nwg) return false;
        int wgid = (int)L; { const int q = nwg / NXCD, r = nwg % NXCD, xcd = wgid % NXCD, off = wgid / NXCD; wgid = (xcd < r ? xcd * (q + 1) : r * (q + 1) + (xcd - r) * q) + off; }
        const int nig = WGM * nN, gid = wgid / nig, fm = gid * WGM, gsz = (nM - fm) < WGM ? (nM - fm) : WGM;
        u.pm = fm + ((wgid % nig) % gsz); u.pn = (wgid % nig) / gsz; return true;
    }
    __device__ __forceinline__ void a_ready(const Unit&) const {}
    __device__ __forceinline__ void done(const Unit&) const {}
};

struct GemmPlain { const h16* A; const h16* Bt; int lda, K;
    __device__ __forceinline__ const char* aptr(const Unit& u) const { return (const char*)(A + (size_t)u.pm * BM * lda); }
    __device__ __forceinline__ const char* bptr(const Unit& u) const { return (const char*)(Bt + (size_t)u.pn * BM * K); } };
struct EpiIn {
    static constexpr bool PERM = true, AFTER_DRAIN = false, MID = false;
    unsigned char* ws; h16* G;
    __device__ __forceinline__ void operator()(const f32x4 (&acc)[2][2][4][2], const Unit& u, int wr, int wc, int fr, int fq) const {
        const int pn = u.pn, row0 = u.pm * BM + wr * 64 + fr, cl = wc * 32 + 8 * fq;
        if (pn < 21) {
            h16* base; int ldc, colt;
            if (pn < 2)       { base = (h16*)(ws + WS_QA);  ldc = 512; colt = pn * 256; }
            else if (pn == 2) { base = (h16*)(ws + WS_KVA); ldc = 256; colt = 0; }
            else if (pn < 5)  { base = (h16*)(ws + WS_ZA);  ldc = 512; colt = (pn - 3) * 256; }
            else if (pn < 7)  { base = (h16*)(ws + WS_QB);  ldc = 512; colt = (pn - 5) * 256; }
            else if (pn < 9)  { base = (h16*)(ws + WS_KB);  ldc = 512; colt = (pn - 7) * 256; }
            else if (pn < 11) { base = (h16*)(ws + WS_VB);  ldc = 512; colt = (pn - 9) * 256; }
            else if (pn < 13) { base = (h16*)(ws + WS_ZB);  ldc = 512; colt = (pn - 11) * 256; }
            else              { base = G;                   ldc = 2048; colt = (pn - 13) * 256; }
#pragma unroll
            for (int ai = 0; ai < 2; ++ai)
#pragma unroll
                for (int m = 0; m < 4; ++m) { h16* rowp = base + (size_t)(row0 + ai * HALF + m * 16) * ldc + colt + cl;
#pragma unroll
                    for (int bj = 0; bj < 2; ++bj) { const f32x4 v0 = acc[ai][bj][m][0] * INV_HW, v1 = acc[ai][bj][m][1] * INV_HW;
                        u32x4 w; w.x = pkh(v0[0], v0[1]); w.y = pkh(v0[2], v0[3]); w.z = pkh(v1[0], v1[1]); w.w = pkh(v1[2], v1[3]);
                        *(u32x4*)(rowp + bj * HALF) = w; } }
        } else {
            const int colt = (pn - 21) * 256 + cl;
#pragma unroll
            for (int ai = 0; ai < 2; ++ai)
#pragma unroll
                for (int m = 0; m < 4; ++m) { const size_t r = (size_t)(row0 + ai * HALF + m * 16);
#pragma unroll
                    for (int bj = 0; bj < 2; ++bj) { const int j = colt + bj * HALF; const f32x4 v0 = acc[ai][bj][m][0] * INV_HW, v1 = acc[ai][bj][m][1] * INV_HW;
                        if (j < 288) {
                            u32x4 hi; hi.x = pkh(v0[0] * 16.f, v0[1] * 16.f); hi.y = pkh(v0[2] * 16.f, v0[3] * 16.f); hi.z = pkh(v1[0] * 16.f, v1[1] * 16.f); hi.w = pkh(v1[2] * 16.f, v1[3] * 16.f);
                            if (j < 256) *(u32x4*)((h16*)(ws + WS_QH) + r * 256 + j) = hi; else *(u32x4*)((h16*)(ws + WS_KH) + r * 32 + (j - 256)) = hi;
                        } else if (j < 296) { float* w = (float*)(ws + WS_WI) + r * 8; *(f32x4*)w = v0; *(f32x4*)(w + 4) = v1; }
                    } }
        }
    }
};
struct EpiMerge {
    static constexpr bool PERM = true, AFTER_DRAIN = false, MID = true;
    const h16* G; h16* MG;
    __device__ __forceinline__ void mid(f32x4 (&acc)[2][2][4][2], const Unit& u, int wr, int wc, int fr, int fq) const {
        const int row0 = u.pm * BM + wr * 64 + fr, col0 = u.pn * BM + wc * 32 + 8 * fq;
#pragma unroll
        for (int ai = 0; ai < 2; ++ai)
#pragma unroll
            for (int m = 0; m < 4; ++m) { unsigned ro = (unsigned)(row0 + ai * HALF + m * 16); asm volatile("" : "+v"(ro)); const h16* gp = G + (size_t)ro * 2048 + col0;
#pragma unroll
                for (int bj = 0; bj < 2; ++bj) { const h16x8 ga = *(const h16x8*)(gp + bj * HALF), gb = *(const h16x8*)(gp + 1024 + bj * HALF);
#pragma unroll
                    for (int e = 0; e < 8; ++e) { const float a = fminf(fmaxf((float)ga[e], -30.f), 30.f), b = fminf(fmaxf((float)gb[e], -30.f), 30.f);
                        const float f = (1.0f + __builtin_amdgcn_exp2f(-LOG2E * b)) * __builtin_amdgcn_rcpf(1.0f + __builtin_amdgcn_exp2f(-LOG2E * a));
                        acc[ai][bj][m][e >> 2][e & 3] *= f; } }
                asm volatile("" ::: "memory"); }
    }
    __device__ __forceinline__ void operator()(const f32x4 (&acc)[2][2][4][2], const Unit& u, int wr, int wc, int fr, int fq) const {
        const int row0 = u.pm * BM + wr * 64 + fr, col0 = u.pn * BM + wc * 32 + 8 * fq;
#pragma unroll
        for (int ai = 0; ai < 2; ++ai)
#pragma unroll
            for (int m = 0; m < 4; ++m) { unsigned ro = (unsigned)(row0 + ai * HALF + m * 16); asm volatile("" : "+v"(ro)); const size_t r = (size_t)ro;
#pragma unroll
                for (int bj = 0; bj < 2; ++bj) { const h16x8 gb = *(const h16x8*)(G + r * 2048 + 1024 + col0 + bj * HALF);
                    float o[8];
#pragma unroll
                    for (int e = 0; e < 8; ++e) o[e] = acc[ai][bj][m][e >> 2][e & 3] * sigmoidf_fast((float)gb[e]);
                    u32x4 w; w.x = pkh(o[0], o[1]); w.y = pkh(o[2], o[3]); w.z = pkh(o[4], o[5]); w.w = pkh(o[6], o[7]);
                    *(u32x4*)(MG + r * 1024 + col0 + bj * HALF) = w; } }
    }
};
struct EpiOut {
    static constexpr bool PERM = true, AFTER_DRAIN = false, MID = false;
    const float* x; float* out;
    __device__ __forceinline__ void operator()(const f32x4 (&acc)[2][2][4][2], const Unit& u, int wr, int wc, int fr, int fq) const {
        const int row0 = u.pm * BM + wr * 64 + fr, col0 = u.pn * BM + wc * 32 + 8 * fq;
#pragma unroll
        for (int ai = 0; ai < 2; ++ai)
#pragma unroll
            for (int m = 0; m < 4; ++m) { const size_t off = (size_t)(row0 + ai * HALF + m * 16) * DM + col0;
#pragma unroll
                for (int bj = 0; bj < 2; ++bj)
#pragma unroll
                    for (int n = 0; n < 2; ++n) { const f32x4 xv = *(const f32x4*)(x + off + bj * HALF + 4 * n); *(f32x4*)(out + off + bj * HALF + 4 * n) = xv + acc[ai][bj][m][n]; }
                if (m & 1) asm volatile("" ::: "memory"); }
    }
};

template <class Epi, class Sched, class GemmT, bool ALIGN_EPI = false, bool SP2 = false>
__device__ __forceinline__ void gemm_phase(PG8_LAS unsigned char* lds, const GemmT g, const Sched& S, const Epi& E) {
    const int tid = threadIdx.x, wid = __builtin_amdgcn_readfirstlane(tid >> 6), lane = tid & 63, wr = wid >> 2, wc = wid & 3, fr = lane & 15, fq = lane >> 4;
    const int K = g.K, nt = K / BK;
    unsigned voffA[2], voffB[2];
#pragma unroll
    for (int i = 0; i < 2; ++i) { int R, C; stage_rc(tid * 16 + i * 8192, R, C); const int Rb = Epi::PERM ? ((R & ~31) + perm32(R & 31)) : R;
        voffA[i] = (unsigned)(R * g.lda + C) * 2u; voffB[i] = (unsigned)(Rb * K + C) * 2u; }
    const size_t kstep = (size_t)(BK * 2);
    const size_t hstepA = (size_t)HALF * g.lda * 2, hstepB = (size_t)HALF * K * 2;
    const unsigned ldsw = (unsigned)wid * 1024u;
    const int aoff = lds_byte(wr * 64 + fr, fq * 8), boff = lds_byte(wc * 32 + fr, fq * 8);
#define PG8_SA(b, h) (((b) * 2 + (h)) * HTB)
#define PG8_SB(b, h) ((4 + (b) * 2 + (h)) * HTB)
#define PG8_STAGE(bufoff, gbase, voff) do { _Pragma("unroll") for (int _i = 0; _i < 2; ++_i) \
        __builtin_amdgcn_global_load_lds((const unsigned*)((const char*)(gbase) + (voff)[_i]), (PG8_LAS unsigned*)(lds + (bufoff) + ldsw + _i * 8192), 16, 0, 0); } while (0)
#define PG8_LDA(dst, b, h) do { _Pragma("unroll") for (int m = 0; m < 4; ++m) _Pragma("unroll") for (int k = 0; k < 2; ++k) dst[m][k] = *(const PG8_LAS h16x8*)(lds + PG8_SA(b, h) + aoff + m * 2048 + k * 1024); } while (0)
#define PG8_LDB(dst, b, h) do { _Pragma("unroll") for (int n = 0; n < 2; ++n) _Pragma("unroll") for (int k = 0; k < 2; ++k) dst[n][k] = *(const PG8_LAS h16x8*)(lds + PG8_SB(b, h) + boff + n * 2048 + k * 1024); } while (0)
#define PG8_MMA(ai, bj, At, Bt) do { __builtin_amdgcn_s_setprio(1); _Pragma("unroll") for (int m = 0; m < 4; ++m) _Pragma("unroll") for (int n = 0; n < 2; ++n) _Pragma("unroll") for (int k = 0; k < 2; ++k) \
        acc[ai][bj][m][n] = __builtin_amdgcn_mfma_f32_16x16x32_f16(Bt[n][k], At[m][k], acc[ai][bj][m][n], 0, 0, 0); __builtin_amdgcn_s_setprio(0); } while (0)
#define PG8_WAIT_V(n) asm volatile("s_waitcnt vmcnt(" #n ")" ::: "memory")
#define PG8_WAIT_L(n) asm volatile("s_waitcnt lgkmcnt(" #n ")" ::: "memory")
#define PG8_BAR __builtin_amdgcn_s_barrier()
#define PG8_SCHED __builtin_amdgcn_sched_barrier(0)
    Unit cur, nxt; int ui = 0;
    if (!S.next(0, cur)) return;
    f32x4 acc[2][2][4][2];
#pragma unroll
    for (int a = 0; a < 2; ++a)
#pragma unroll
        for (int b = 0; b < 2; ++b)
#pragma unroll
            for (int m = 0; m < 4; ++m)
#pragma unroll
                for (int n = 0; n < 2; ++n) acc[a][b][m][n] = (f32x4){0.f, 0.f, 0.f, 0.f};
    h16x8 At[4][2], B0[2][2], B1[2][2];
    const char* cA = g.aptr(cur); const char* cB = g.bptr(cur);
    S.a_ready(cur);
    if constexpr (SP2) {
        PG8_STAGE(PG8_SB(0, 0), cB, voffB); PG8_STAGE(PG8_SB(0, 1), cB + hstepB, voffB); PG8_STAGE(PG8_SA(0, 0), cA, voffA); PG8_STAGE(PG8_SA(0, 1), cA + hstepA, voffA);
        if (wr == 1) PG8_BAR;
        PG8_WAIT_V(2); PG8_BAR;
        PG8_STAGE(PG8_SB(1, 0), cB + kstep, voffB); PG8_STAGE(PG8_SA(1, 0), cA + kstep, voffA); PG8_STAGE(PG8_SB(1, 1), cB + hstepB + kstep, voffB);
        PG8_WAIT_V(6); PG8_BAR;
    } else {
        PG8_STAGE(PG8_SB(0, 0), cB, voffB); PG8_STAGE(PG8_SA(0, 0), cA, voffA); PG8_STAGE(PG8_SB(0, 1), cB + hstepB, voffB); PG8_STAGE(PG8_SA(0, 1), cA + hstepA, voffA);
        if (wr == 1) PG8_BAR;
        PG8_WAIT_V(4); PG8_BAR;
        PG8_STAGE(PG8_SB(1, 0), cB + kstep, voffB); PG8_STAGE(PG8_SA(1, 0), cA + kstep, voffA); PG8_STAGE(PG8_SB(1, 1), cB + hstepB + kstep, voffB);
        PG8_WAIT_V(6); PG8_BAR;
    }
    for (;;) {
        const bool has_next = S.next(ui + 1, nxt);
        const char* nA = has_next ? g.aptr(nxt) : cA; const char* nB = has_next ? g.bptr(nxt) : cB;
        for (int t = 0; t < nt; t += 2) {
            const bool last = (t == nt - 2);
            const char* a1 = cA + (size_t)(t + 1) * kstep;
            const char* a2 = last ? nA : cA + (size_t)(t + 2) * kstep; const char* b2 = last ? nB : cB + (size_t)(t + 2) * kstep;
            const char* a3 = a2 + kstep; const char* b3 = b2 + kstep;
            if (last && has_next) S.a_ready(nxt);
            if constexpr (Epi::MID) { if (t == nt / 2) E.mid(acc, cur, wr, wc, fr, fq); }
            if constexpr (SP2) {
            PG8_LDB(B0, 0, 0); PG8_LDB(B1, 0, 1); PG8_SCHED; PG8_LDA(At, 0, 0); PG8_STAGE(PG8_SA(1, 1), a1 + hstepA, voffA);
            PG8_WAIT_V(8); PG8_WAIT_L(0); PG8_BAR; PG8_MMA(0, 0, At, B0); PG8_MMA(0, 1, At, B1); PG8_BAR; PG8_SCHED;
            PG8_LDA(At, 0, 1); PG8_STAGE(PG8_SB(0, 0), b2, voffB); PG8_STAGE(PG8_SB(0, 1), b2 + hstepB, voffB); PG8_STAGE(PG8_SA(0, 0), a2, voffA);
            PG8_WAIT_V(8); PG8_WAIT_L(0); PG8_BAR; PG8_MMA(1, 0, At, B0); PG8_MMA(1, 1, At, B1); PG8_BAR; PG8_SCHED;
            PG8_LDB(B0, 1, 0); PG8_LDB(B1, 1, 1); PG8_SCHED; PG8_LDA(At, 1, 0); PG8_STAGE(PG8_SA(0, 1), a2 + hstepA, voffA);
            PG8_WAIT_V(8); PG8_WAIT_L(0); PG8_BAR; PG8_MMA(0, 0, At, B0); PG8_MMA(0, 1, At, B1); PG8_BAR; PG8_SCHED;
            PG8_LDA(At, 1, 1); PG8_STAGE(PG8_SB(1, 0), b3, voffB); PG8_STAGE(PG8_SB(1, 1), b3 + hstepB, voffB); PG8_STAGE(PG8_SA(1, 0), a3, voffA);
            PG8_WAIT_V(8); PG8_WAIT_L(0); PG8_BAR; PG8_MMA(1, 0, At, B0); PG8_MMA(1, 1, At, B1); PG8_BAR; PG8_SCHED;
            } else {
            PG8_LDB(B0, 0, 0); PG8_SCHED; PG8_LDA(At, 0, 0); PG8_STAGE(PG8_SA(1, 1), a1 + hstepA, voffA);
            PG8_WAIT_L(8); PG8_BAR; PG8_WAIT_L(0); PG8_MMA(0, 0, At, B0); PG8_BAR; PG8_SCHED;
            PG8_LDB(B1, 0, 1); PG8_STAGE(PG8_SB(0, 0), b2, voffB);
            PG8_BAR; PG8_WAIT_L(0); PG8_MMA(0, 1, At, B1); PG8_BAR;
            PG8_LDA(At, 0, 1); PG8_STAGE(PG8_SA(0, 0), a2, voffA);
            PG8_BAR; PG8_WAIT_L(0); PG8_MMA(1, 0, At, B0); PG8_BAR; PG8_SCHED;
            PG8_STAGE(PG8_SB(0, 1), b2 + hstepB, voffB);
            PG8_WAIT_V(6); PG8_BAR; PG8_MMA(1, 1, At, B1); PG8_BAR;
            PG8_LDB(B0, 1, 0); PG8_SCHED; PG8_LDA(At, 1, 0); PG8_STAGE(PG8_SA(0, 1), a2 + hstepA, voffA);
            PG8_WAIT_L(8); PG8_BAR; PG8_WAIT_L(0); PG8_MMA(0, 0, At, B0); PG8_BAR; PG8_SCHED;
            PG8_LDB(B1, 1, 1); PG8_STAGE(PG8_SB(1, 0), b3, voffB);
            PG8_BAR; PG8_WAIT_L(0); PG8_MMA(0, 1, At, B1); PG8_BAR;
            PG8_LDA(At, 1, 1); PG8_STAGE(PG8_SA(1, 0), a3, voffA);
            PG8_BAR; PG8_WAIT_L(0); PG8_MMA(1, 0, At, B0); PG8_BAR; PG8_SCHED;
            PG8_STAGE(PG8_SB(1, 1), b3 + hstepB, voffB);
            PG8_WAIT_V(6); PG8_BAR; PG8_MMA(1, 1, At, B1); PG8_BAR;
            }
        }
        if constexpr (ALIGN_EPI) { if (wr == 0) PG8_BAR; }
        if constexpr (!Epi::AFTER_DRAIN) { E(acc, cur, wr, wc, fr, fq); S.done(cur); }
        if (!has_next) break;
#pragma unroll
        for (int a = 0; a < 2; ++a)
#pragma unroll
            for (int b = 0; b < 2; ++b)
#pragma unroll
                for (int m = 0; m < 4; ++m)
#pragma unroll
                    for (int n = 0; n < 2; ++n) acc[a][b][m][n] = (f32x4){0.f, 0.f, 0.f, 0.f};
        cur = nxt; cA = nA; cB = nB; ++ui;
        if constexpr (ALIGN_EPI) { if (wr == 1) PG8_BAR; }
    }
    PG8_WAIT_V(0);
    if constexpr (!ALIGN_EPI) { if (wr == 0) PG8_BAR; }
    PG8_BAR;
    if constexpr (Epi::AFTER_DRAIN) { E.fused(acc, cur, wr, wc, fr, fq, lds, wid, lane); S.done(cur); }
#undef PG8_SA
#undef PG8_SB
#undef PG8_STAGE
#undef PG8_LDA
#undef PG8_LDB
#undef PG8_MMA
#undef PG8_WAIT_V
#undef PG8_WAIT_L
#undef PG8_BAR
#undef PG8_SCHED
}
}

constexpr int NWAVES = 8, NTHREADS = 512;
constexpr int RING_BYTES = 131072, LDSCTL_OFF = 159744, LDS_BYTES = 163840;
#define LDS_WAIT() asm volatile("s_waitcnt lgkmcnt(0)" ::: "memory")
#ifdef PROF_SEG
#define TSTART(id) unsigned long long t0_##id = 0; if ((id) == PROF_SEG) { asm volatile("s_waitcnt vmcnt(0) lgkmcnt(0)" ::: "memory"); t0_##id = __builtin_amdgcn_s_memrealtime(); }
#define TSTOP(id) if ((id) == PROF_SEG) { asm volatile("s_waitcnt vmcnt(0) lgkmcnt(0)" ::: "memory"); F.prof += __builtin_amdgcn_s_memrealtime() - t0_##id; }
#else
#define TSTART(id)
#define TSTOP(id)
#endif

#define XB_TMO      128
#define XB_XCNT(j)  (256  + 64 * (j))
#define XB_XSUB(j)  (1280 + 64 * (j))
#define XB_XGEN(j)  (2304 + 64 * (j))
#define XB_TOP      3328
#define XB_TOPGEN   3392
#define XCD_BAR_WORDS 3456
#define XB_SPIN_CAP (1u << 18)

__device__ __forceinline__ unsigned xb_ld(unsigned* p)              { return __hip_atomic_load(p, __ATOMIC_RELAXED, __HIP_MEMORY_SCOPE_AGENT); }
__device__ __forceinline__ unsigned xb_add(unsigned* p, unsigned v) { return __hip_atomic_fetch_add(p, v, __ATOMIC_RELAXED, __HIP_MEMORY_SCOPE_AGENT); }
__device__ __forceinline__ unsigned xb_xcc_id() { return (unsigned)__builtin_amdgcn_s_getreg((3 << 11) | 20) & 0xFu; }
#define XB_SPIN(cond, bar) do { unsigned _sp = 0; while (cond) { __builtin_amdgcn_s_sleep(1); \
    if ((++_sp & 255u) == 0u) { if (xb_ld(&(bar)[XB_TMO])) break; if (_sp > XB_SPIN_CAP) { atomicAdd(&(bar)[XB_TMO], 1u); break; } } } } while (0)

struct XcdBarrier {
    unsigned* bar; unsigned x;
    volatile LAS unsigned* st;
};

__device__ __forceinline__ XcdBarrier xcd_barrier_post(unsigned* bar, volatile LAS unsigned* st) {
    XcdBarrier b; b.bar = bar; b.x = xb_xcc_id(); b.st = st;
    if (threadIdx.x == 0) (void)xb_add(&bar[XB_XCNT(b.x)], 1u);
    return b;
}
__device__ __forceinline__ void xcd_barrier_complete(unsigned* bar, unsigned x, unsigned& nloc, unsigned& nx) {
    const unsigned G = gridDim.x * gridDim.y * gridDim.z;
    unsigned sum, cnt, mine, sp = 0u;
    for (;;) {
        sum = 0u; cnt = 0u; mine = 0u;
#pragma unroll
        for (unsigned j = 0; j < 16; ++j) { const unsigned c = xb_ld(&bar[XB_XCNT(j)]); sum += c; cnt += (c > 0u) ? 1u : 0u; mine = (j == x) ? c : mine; }
        if (sum == G) break;
        __builtin_amdgcn_s_sleep(1);
        if ((++sp & 255u) == 0u) { if (xb_ld(&bar[XB_TMO])) break; if (sp > XB_SPIN_CAP) { atomicAdd(&bar[XB_TMO], 1u); break; } }
    }
    nloc = mine > 0u ? mine : 1u; nx = cnt > 0u ? cnt : 1u;
}

__device__ __forceinline__ void xcd_barrier(const XcdBarrier& b) {
    asm volatile("s_waitcnt vmcnt(0)" ::: "memory");
    __syncthreads();
    if (threadIdx.x == 0) {
        unsigned* bar = b.bar;
        __builtin_amdgcn_s_waitcnt(0);
        unsigned nloc = b.st[0], nx = b.st[1];
        if (nloc == 0u) { xcd_barrier_complete(bar, b.x, nloc, nx); b.st[0] = nloc; b.st[1] = nx; }
        const unsigned old = xb_add(&bar[XB_XSUB(b.x)], 1u);
        const unsigned gen = old / nloc;
        if (old + 1u == (gen + 1u) * nloc) {
            __builtin_amdgcn_fence(__ATOMIC_RELEASE, "agent");
            asm volatile("s_waitcnt vmcnt(0)" ::: "memory");
            const unsigned og = xb_add(&bar[XB_TOP], 1u);
            const unsigned tg = og / nx;
            if (og + 1u == (tg + 1u) * nx) xb_add(&bar[XB_TOPGEN], 1u);
            else XB_SPIN(xb_ld(&bar[XB_TOPGEN]) == tg, bar);
            __builtin_amdgcn_fence(__ATOMIC_ACQUIRE, "agent");
            xb_add(&bar[XB_XGEN(b.x)], 1u);
            asm volatile("s_waitcnt vmcnt(0)" ::: "memory");
        } else {
            XB_SPIN(xb_ld(&bar[XB_XGEN(b.x)]) == gen, bar);
            __builtin_amdgcn_fence(__ATOMIC_ACQUIRE, "agent");
            asm volatile("s_waitcnt vmcnt(0)" ::: "memory");
        }
    }
    __syncthreads();
}

struct Frame {
    LAS unsigned char* lds;
    int tid, lane, wave, vcu, G;
    unsigned char* ws;
    const float *x, *norm_g, *w_in, *qna, *kna, *sinks, *qnb, *knb, *relb, *wpa, *wpb, *wout;
    float* out;
    unsigned long long prof;
};

__device__ __forceinline__ float wave_sum(float v) {
#pragma unroll
    for (int o = 1; o < 64; o <<= 1) v += __shfl_xor(v, o);
    return v;
}
__device__ __forceinline__ int t5_bucket(int n) {
    if (n < 16) return n < 0 ? 0 : n;
    const int l = 16 + (int)(logf((float)n * 0.0625f) / logf(8.0f) * 16.0f);
    return l > 31 ? 31 : l;
}

__device__ __forceinline__ int win_src_col(int n) { return n < 3328 ? n : (n < 5376 ? n + 296 : (n < 5672 ? n - 2048 : -1)); }
template <bool INPROJ>
__device__ __forceinline__ void p0_transpose_item(const float* W, int srcN, int k0, int n0, h16* WT, int ldk, int kdst0, LAS float* scr, int lane, float scale) {
    const int n = n0 + (lane & 31); const int col = INPROJ ? win_src_col(n) : n;
    float wv_[32];
#pragma unroll
    for (int i = 0; i < 32; ++i) { const int kk = 2 * i + (lane >> 5); wv_[i] = (col >= 0) ? W[(size_t)(k0 + kk) * srcN + col] : 0.f; }
#pragma unroll
    for (int i = 0; i < 32; ++i) { const int kk = 2 * i + (lane >> 5); scr[kk * 33 + (lane & 31)] = wv_[i] * scale; }
    LDS_WAIT(); asm volatile("" ::: "memory");
    const int c = lane & 7;
#pragma unroll
    for (int j = 0; j < 4; ++j) { const int nn = (lane >> 3) + 8 * j; const LAS float* s = scr + (8 * c) * 33 + nn;
        float v[8];
#pragma unroll
        for (int e = 0; e < 8; ++e) v[e] = s[e * 33];
        u32x4 o; o.x = pkh(v[0], v[1]); o.y = pkh(v[2], v[3]); o.z = pkh(v[4], v[5]); o.w = pkh(v[6], v[7]);
        *(u32x4*)(WT + (size_t)(n0 + nn) * ldk + kdst0 + k0 + 8 * c) = o;
    }
    LDS_WAIT(); asm volatile("" ::: "memory");
}
__device__ __forceinline__ void p0_norm_rows4(const float* x, const float* g, h16* H, int m0, int mstride, int lane) {
    f32x4 v[4][4];
#pragma unroll
    for (int r = 0; r < 4; ++r)
#pragma unroll
        for (int j = 0; j < 4; ++j) v[r][j] = __builtin_nontemporal_load((const f32x4*)(x + (size_t)(m0 + r * mstride) * DM) + lane + 64 * j);
    f32x4 gg[4];
#pragma unroll
    for (int j = 0; j < 4; ++j) gg[j] = *((const f32x4*)g + lane + 64 * j) * HSCALE;
#pragma unroll
    for (int r = 0; r < 4; ++r) {
        float s = 0.f;
#pragma unroll
        for (int j = 0; j < 4; ++j) s += (v[r][j].x * v[r][j].x + v[r][j].y * v[r][j].y) + (v[r][j].z * v[r][j].z + v[r][j].w * v[r][j].w);
        const float rs = rsqrtf(wave_sum(s) * (1.0f / DM) + RMS_EPS);
#pragma unroll
        for (int j = 0; j < 4; ++j) { const f32x4 hv = v[r][j] * rs * gg[j]; u32x2 hi; hi.x = pkh(hv.x, hv.y); hi.y = pkh(hv.z, hv.w);
            *((u32x2*)(H + (size_t)(m0 + r * mstride) * 1024) + lane + 64 * j) = hi; }
    }
}
__device__ __forceinline__ void p0_prologue(Frame& F) {
    LAS float* scr = (LAS float*)(F.lds + F.wave * 16384);
    h16* Win = (h16*)(F.ws + WS_WIN); h16* Wp = (h16*)(F.ws + WS_WP); h16* Wo = (h16*)(F.ws + WS_WO); h16* Hb = (h16*)(F.ws + WS_H);
    constexpr int I_IN = 16 * 184, I_P = 8 * 32, I_O = 16 * 32;
    static_assert(I_IN + 2 * I_P + I_O == 62 * 64 && MROWS / 4 == 64 * 64, "prologue shards");
    for (int s = F.vcu >> 2; s < 64; s += (F.G + 3) >> 2) {
        unsigned* ctr = (unsigned*)(F.ws + WS_CTL + 40960) + s * 64;
        for (;;) {
            unsigned k = 0u;
            if (F.lane == 0) k = __hip_atomic_fetch_add(ctr, 1u, __ATOMIC_RELAXED, __HIP_MEMORY_SCOPE_AGENT);
            k = (unsigned)__builtin_amdgcn_readfirstlane((int)k);
            if (k >= 126u) break;
            if (k < 62u) {
                int r = s + 64 * (int)k;
                if (r < I_IN) { p0_transpose_item<true>(F.w_in, INW, 64 * (r / 184), 32 * (r % 184), Win, 1024, 0, scr, F.lane, WSCALE); continue; } r -= I_IN;
                if (r < I_P) { p0_transpose_item<false>(F.wpa, DM, 64 * (r / 32), 32 * (r % 32), Wp, 1024, 0, scr, F.lane, 1.f); continue; } r -= I_P;
                if (r < I_P) { p0_transpose_item<false>(F.wpb, DM, 64 * (r / 32), 32 * (r % 32), Wp, 1024, 512, scr, F.lane, 1.f); continue; } r -= I_P;
                p0_transpose_item<false>(F.wout, DM, 64 * (r / 32), 32 * (r % 32), Wo, 1024, 0, scr, F.lane, 1.f);
            } else p0_norm_rows4(F.x, F.norm_g, Hb, 4 * (s + 64 * ((int)k - 62)), 1, F.lane);
        }
    }
}

constexpr int NBIN = 256, ICAP = 32;
constexpr int IW_VALS = 0, IW_HIST = 16384, IW_LIST = IW_HIST + 2 * NBIN * 4, IW_LMASK = IW_LIST + 2 * ICAP * 8, IW_BYTES = IW_LMASK + 512;
static_assert(8 * IW_BYTES <= LDSCTL_OFF, "indexer LDS");
typedef _Float16 h16x4v __attribute__((ext_vector_type(4)));
__device__ __forceinline__ int idx_bin(float v, float smin, float scale) { const int b = (int)((v - smin) * scale); return b > NBIN - 1 ? NBIN - 1 : b; }
__device__ __forceinline__ float wave_minf(float v) {
#pragma unroll
    for (int o = 1; o < 64; o <<= 1) v = fminf(v, __shfl_xor(v, o));
    return v; }
__device__ __forceinline__ float wave_maxf(float v) {
#pragma unroll
    for (int o = 1; o < 64; o <<= 1) v = fmaxf(v, __shfl_xor(v, o));
    return v; }
__device__ __forceinline__ unsigned lowest_bits64(unsigned long long w, unsigned n, unsigned long long& kept) { kept = 0ull; unsigned took = 0u; while (n && w) { const unsigned long long bit = w & (0ull - w); kept |= bit; w ^= bit; --n; ++took; } return took; }
__device__ __forceinline__ unsigned mbcnt64(unsigned long long m) { return __builtin_amdgcn_mbcnt_hi((unsigned)(m >> 32), __builtin_amdgcn_mbcnt_lo((unsigned)m, 0u)); }
__device__ __forceinline__ void idx_select_exact(LAS unsigned char* wl, const LAS float* vals, LAS unsigned* hist, LAS u32x2* clist, LAS unsigned* lm, int ngroup, float lo, float hi, unsigned need, int lane) {
#pragma unroll 1
    for (int level = 0; level < 64; ++level) {
        if (!(hi > lo)) {
            unsigned taken = 0u;
            for (int g = 0; g < ngroup && taken < need; ++g) { const float v = vals[64 * g + lane]; const unsigned long long tm = __ballot(v >= lo && v <= hi); unsigned long long kept;
                taken += lowest_bits64(tm, need - taken, kept); if (lane == 0 && kept) { atomicOr((unsigned*)&lm[2 * g], (unsigned)kept); atomicOr((unsigned*)&lm[2 * g + 1], (unsigned)(kept >> 32)); } }
            return;
        }
        const float scale = ((float)NBIN - 0.5f) / (hi - lo);
        *(LAS u32x4*)((LAS unsigned char*)hist + lane * 16) = (u32x4){0u, 0u, 0u, 0u};
        asm volatile("s_waitcnt lgkmcnt(0)" ::: "memory");
        for (int g = 0; g < ngroup; ++g) { const float v = vals[64 * g + lane]; if (v >= lo && v <= hi) atomicAdd((unsigned*)&hist[idx_bin(v, lo, scale)], 1u); }
        asm volatile("s_waitcnt lgkmcnt(0)" ::: "memory");
        const u32x4 cw = *(const LAS u32x4*)((const LAS unsigned char*)hist + lane * 16);
        const unsigned cnt[4] = {cw.x, cw.y, cw.z, cw.w}; const unsigned s = (cw.x + cw.y) + (cw.z + cw.w);
        unsigned v = s;
#pragma unroll
        for (int o = 1; o < 64; o <<= 1) { const unsigned tmp = (unsigned)__shfl_down((int)v, o); if (lane + o < 64) v += tmp; }
        const unsigned above = v - s; const bool crit = above < need && need <= above + s;
        unsigned cum = above, b_ = 0, r_ = 0, c_ = 0; bool found = false;
#pragma unroll
        for (int e = 3; e >= 0; --e) { const unsigned cc = cnt[e]; if (!found && cum + cc >= need) { found = true; b_ = 4u * lane + e; r_ = need - cum; c_ = cc; } if (!found) cum += cc; }
        const unsigned long long cm = __ballot(crit); const int cl = cm ? (int)__builtin_ctzll(cm) : 0;
        const int bst = __builtin_amdgcn_readlane((int)b_, cl); const unsigned rr = (unsigned)__builtin_amdgcn_readlane((int)r_, cl), cb = (unsigned)__builtin_amdgcn_readlane((int)c_, cl);
        const bool takeall = cb == rr, uselist = !takeall && cb <= (unsigned)ICAP; const int bsel = takeall ? bst : bst + 1;
        float nlo = INFINITY, nhi = -INFINITY; unsigned nm = 0u;
        for (int g = 0; g < ngroup; ++g) {
            const float v = vals[64 * g + lane]; const bool act = v >= lo && v <= hi; const int bn = idx_bin(v, lo, scale);
            const unsigned long long sm = __ballot(act && bn >= bsel), mm = __ballot(act && !takeall && bn == bst);
            if (lane == 0 && sm) { atomicOr((unsigned*)&lm[2 * g], (unsigned)sm); atomicOr((unsigned*)&lm[2 * g + 1], (unsigned)(sm >> 32)); }
            if (mm) { if (act && !takeall && bn == bst) { nlo = fminf(nlo, v); nhi = fmaxf(nhi, v); const unsigned slot = nm + mbcnt64(mm); if (uselist && slot < (unsigned)ICAP) clist[slot] = (u32x2){__float_as_uint(v), (unsigned)(64 * g + lane)}; }
                nm += (unsigned)__popcll(mm); }
        }
        asm volatile("s_waitcnt lgkmcnt(0)" ::: "memory");
        if (takeall) return;
        if (uselist) {
            const u32x2 me = clist[lane & 31]; const float vj = __uint_as_float(me.x); unsigned rank = 0u;
            for (unsigned i2 = 0; i2 < cb; ++i2) { const u32x2 o = clist[i2]; const float vi = __uint_as_float(o.x); rank += (vi > vj || (vi == vj && o.y < me.y)) ? 1u : 0u; }
            if ((unsigned)lane < cb && rank < rr) atomicOr((unsigned*)&lm[me.y >> 5], 1u << (me.y & 31));
            return;
        }
        lo = wave_minf(nlo); hi = wave_maxf(nhi); need = rr;
    }
}
__device__ __forceinline__ void idx_pair(Frame& F, int b, int u) {
    const int lane = F.lane, k16 = lane & 15, fq = lane >> 4, th = lane >> 5;
    const int ta = 2 * u;
    unsigned* gm = (unsigned*)(F.ws + WS_MASK) + (size_t)(b * SEQ + ta) * 64;
    if (ta < 256) {
        const int lo = lane * 32;
        gm[lane] = (ta >= lo + 31) ? 0xffffffffu : (ta >= lo ? ((2u << (ta - lo)) - 1u) : 0u);
        gm[64 + lane] = (ta + 1 >= lo + 31) ? 0xffffffffu : (ta + 1 >= lo ? ((2u << (ta + 1 - lo)) - 1u) : 0u);
        return;
    }
    LAS unsigned char* wl = F.lds + F.wave * IW_BYTES;
    LAS float* vals = (LAS float*)(wl + IW_VALS);
    LAS unsigned* hist = (LAS unsigned*)(wl + IW_HIST);
    LAS u32x2* clist = (LAS u32x2*)(wl + IW_LIST);
    LAS unsigned* lmask = (LAS unsigned*)(wl + IW_LMASK);
    lmask[lane] = 0u; lmask[64 + lane] = 0u;
    TSTART(20)
    TSTART(21)
    const size_t qrow = (size_t)(b * SEQ + ta + (k16 >> 3));
    const h16x8 qh = *(const h16x8*)((const h16*)(F.ws + WS_QH) + qrow * 256 + (k16 & 7) * 32 + fq * 8);
    h16x4v a2[4];
    {   const f32x4 wv = *(const f32x4*)((const float*)(F.ws + WS_WI) + (size_t)(b * SEQ + ta + (fq >> 1)) * 8 + 4 * (fq & 1));
        const h16x4v w16 = __builtin_convertvector(wv, h16x4v); const h16x4v z16 = {(h16)0.f, (h16)0.f, (h16)0.f, (h16)0.f};
        const int myc = ((k16 & 3) == (fq >> 1)) ? (k16 >> 2) : -1;
#pragma unroll
        for (int c4 = 0; c4 < 4; ++c4) a2[c4] = (myc == c4) ? w16 : z16; }
    const int ngroup = (ta + 1) / 64 + 1;
    const h16* kph = (const h16*)(F.ws + WS_KH) + (size_t)(b * SEQ + k16) * 32 + fq * 8;
    h16x8 kb[2][4];
#define IDX_LOADT(slot, c4, grp) do { const int gg_ = (grp) < 32 ? (grp) : 31; kb[slot][c4] = *(const h16x8*)(kph + (size_t)gg_ * 2048 + (c4) * 512); } while (0)
#pragma unroll
    for (int c4 = 0; c4 < 4; ++c4) { IDX_LOADT(0, c4, 0); IDX_LOADT(1, c4, 1); }
    float vmin0 = INFINITY, vmax0 = -INFINITY, vmin1 = INFINITY, vmax1 = -INFINITY;
#define IDX_GROUP(slot, grp) do { f32x4 d2 = {0.f, 0.f, 0.f, 0.f}; \
        _Pragma("unroll") for (int c4 = 0; c4 < 4; ++c4) { \
            const f32x4 d1 = __builtin_amdgcn_mfma_f32_16x16x32_f16(qh, kb[slot][c4], (f32x4){0.f, 0.f, 0.f, 0.f}, 0, 0, 0); \
            IDX_LOADT(slot, c4, (grp) + 2); \
            const f32x4 rl = {fmaxf(d1[0], 0.f), fmaxf(d1[1], 0.f), fmaxf(d1[2], 0.f), fmaxf(d1[3], 0.f)}; \
            d2 = __builtin_amdgcn_mfma_f32_16x16x16f16(a2[c4], __builtin_convertvector(rl, h16x4v), d2, 0, 0, 0); } \
        const int key_ = 64 * (grp) + lane; const float sa_ = d2[0] + 0.0f, sb_ = d2[1] + 0.0f; const bool va_ = key_ <= ta, vb_ = key_ <= ta + 1; \
        vals[key_] = va_ ? sa_ : __builtin_nanf(""); vals[2048 + key_] = vb_ ? sb_ : __builtin_nanf(""); \
        if (va_) { vmin0 = fminf(vmin0, sa_); vmax0 = fmaxf(vmax0, sa_); } if (vb_) { vmin1 = fminf(vmin1, sb_); vmax1 = fmaxf(vmax1, sb_); } } while (0)
#pragma unroll 1
    for (int g = 0; g < ngroup; g += 2) { IDX_GROUP(0, g); IDX_GROUP(1, g + 1); }
#undef IDX_GROUP
#undef IDX_LOADT
    const int ng2 = (ngroup + 1) & ~1;
    TSTOP(21)
    TSTART(22)
    const float lo0 = wave_minf(vmin0), hi0 = wave_maxf(vmax0), lo1 = wave_minf(vmin1), hi1 = wave_maxf(vmax1);
    unsigned wa0 = 0u, wa1 = 0u;
    bool exact0 = !(hi0 > lo0), exact1 = !(hi1 > lo1);
#ifdef FORCE_SLOW
    exact0 = true; exact1 = true;
#endif
    if (!(exact0 && exact1)) {
        const float sc0 = exact0 ? 0.f : ((float)NBIN - 0.5f) / (hi0 - lo0), sc1 = exact1 ? 0.f : ((float)NBIN - 0.5f) / (hi1 - lo1);
        TSTART(23)
        *(LAS u32x4*)(wl + IW_HIST + lane * 16) = (u32x4){0u, 0u, 0u, 0u}; *(LAS u32x4*)(wl + IW_HIST + 1024 + lane * 16) = (u32x4){0u, 0u, 0u, 0u};
        asm volatile("s_waitcnt lgkmcnt(0)" ::: "memory");
#pragma unroll 4
        for (int g = 0; g < ngroup; ++g) { const float va = vals[64 * g + lane], vb = vals[2048 + 64 * g + lane];
            if (!exact0 && va >= lo0) atomicAdd((unsigned*)&hist[idx_bin(va, lo0, sc0)], 1u);
            if (!exact1 && vb >= lo1) atomicAdd((unsigned*)&hist[NBIN + idx_bin(vb, lo1, sc1)], 1u); }
        asm volatile("s_waitcnt lgkmcnt(0)" ::: "memory");
        TSTART(27)
        int bst; unsigned rr, cb;
        {   const int l5 = lane & 31;
            const u32x4 cw0 = *(const LAS u32x4*)(wl + IW_HIST + th * 1024 + l5 * 32), cw1 = *(const LAS u32x4*)(wl + IW_HIST + th * 1024 + l5 * 32 + 16);
            const unsigned cnt[8] = {cw0.x, cw0.y, cw0.z, cw0.w, cw1.x, cw1.y, cw1.z, cw1.w};
            const unsigned s = ((cw0.x + cw0.y) + (cw0.z + cw0.w)) + ((cw1.x + cw1.y) + (cw1.z + cw1.w));
            unsigned v = s;
#pragma unroll
            for (int o = 1; o < 32; o <<= 1) { const unsigned tmp = (unsigned)__shfl_down((int)v, o, 32); if (l5 + o < 32) v += tmp; }
            const unsigned above = v - s, need = 256u; const bool crit = above < need && need <= above + s;
            unsigned cum = above, b_ = 0, r_ = 0, c_ = 0; bool found = false;
#pragma unroll
            for (int e = 7; e >= 0; --e) { const unsigned cc = cnt[e]; if (!found && cum + cc >= need) { found = true; b_ = 8u * l5 + e; r_ = need - cum; c_ = cc; } if (!found) cum += cc; }
            const unsigned long long cm = __ballot(crit);
            const int cla = (unsigned)cm ? (int)__builtin_ctz((unsigned)cm) : 0, clb = (unsigned)(cm >> 32) ? 32 + (int)__builtin_ctz((unsigned)(cm >> 32)) : 32;
            const int bqa = __builtin_amdgcn_readlane((int)b_, cla), bqb = __builtin_amdgcn_readlane((int)b_, clb);
            const unsigned rqa = (unsigned)__builtin_amdgcn_readlane((int)r_, cla), rqb = (unsigned)__builtin_amdgcn_readlane((int)r_, clb), cqa = (unsigned)__builtin_amdgcn_readlane((int)c_, cla), cqb = (unsigned)__builtin_amdgcn_readlane((int)c_, clb);
            const int bst0 = bqa, bst1 = bqb; const unsigned rr0 = rqa, rr1 = rqb, cb0 = cqa, cb1 = cqb;
            TSTOP(27)
            TSTOP(23)
            TSTART(24)
            const bool ta0 = cb0 == rr0, ta1 = cb1 == rr1; const int bsel0 = ta0 ? bst0 : bst0 + 1, bsel1 = ta1 ? bst1 : bst1 + 1;
            const float is0 = exact0 ? 0.f : (hi0 - lo0) * (1.0f / ((float)NBIN - 0.5f)), is1 = exact1 ? 0.f : (hi1 - lo1) * (1.0f / ((float)NBIN - 0.5f));
            const float thrA0 = exact0 ? INFINITY : lo0 + ((float)bsel0 + 0.02f) * is0, thrB0 = exact0 ? INFINITY : lo0 + ((float)bst0 - 0.02f) * is0;
            const float thrA1 = exact1 ? INFINITY : lo1 + ((float)bsel1 + 0.02f) * is1, thrB1 = exact1 ? INFINITY : lo1 + ((float)bst1 - 0.02f) * is1;
            unsigned zc0 = 0u, zc1 = 0u;
#pragma unroll 4
            for (int g = 0; g < ngroup; ++g) {
                const float va = vals[64 * g + lane], vb = vals[2048 + 64 * g + lane];
                const bool a0 = va >= thrA0, a1 = vb >= thrA1, z0 = va >= thrB0 && !a0, z1 = vb >= thrB1 && !a1;
                const unsigned long long sm0 = __ballot(a0), sm1 = __ballot(a1), zm0 = __ballot(z0), zm1 = __ballot(z1);
                if ((lane >> 1) == g) { wa0 = (lane & 1) ? (unsigned)(sm0 >> 32) : (unsigned)sm0; wa1 = (lane & 1) ? (unsigned)(sm1 >> 32) : (unsigned)sm1; }
                if (zm0 | zm1) {
                    const unsigned s0 = zc0 + mbcnt64(zm0), s1 = zc1 + mbcnt64(zm1);
                    if (z0 && s0 < (unsigned)ICAP) clist[s0] = (u32x2){__float_as_uint(va), (unsigned)(64 * g + lane)};
                    if (z1 && s1 < (unsigned)ICAP) clist[ICAP + s1] = (u32x2){__float_as_uint(vb), (unsigned)(64 * g + lane)};
                    zc0 += (unsigned)__popcll(zm0); zc1 += (unsigned)__popcll(zm1);
                }
            }
            asm volatile("s_waitcnt lgkmcnt(0)" ::: "memory");
            TSTART(28)
            if (zc0 > (unsigned)ICAP) exact0 = true;
            if (zc1 > (unsigned)ICAP) exact1 = true;
            {
                const int j = lane & 31; const unsigned zc = th ? zc1 : zc0; const bool skip = th ? exact1 : exact0;
                const float lo_ = th ? lo1 : lo0, sc_ = th ? sc1 : sc0; const int bst_ = th ? bst1 : bst0, bsel_ = th ? bsel1 : bsel0; const bool tka = th ? ta1 : ta0; const unsigned rr_ = th ? rr1 : rr0;
                const u32x2 me = clist[th * ICAP + j]; const float vj = __uint_as_float(me.x);
                const int bj = idx_bin(vj, lo_, sc_);
                const bool have = !skip && (unsigned)j < zc, selj = have && bj >= bsel_, memj = have && !tka && bj == bst_;
                const float vmj = memj ? vj : -INFINITY; unsigned rank = 0u;
                const unsigned zmax = (zc0 > zc1 ? zc0 : zc1) < (unsigned)ICAP ? (zc0 > zc1 ? zc0 : zc1) : (unsigned)ICAP;
                for (unsigned i2 = 0; i2 < zmax; ++i2) {
                    const float va = __int_as_float(__builtin_amdgcn_readlane(__float_as_int(vmj), (int)i2)), vb2 = __int_as_float(__builtin_amdgcn_readlane(__float_as_int(vmj), (int)i2 + 32));
                    const unsigned ka = (unsigned)__builtin_amdgcn_readlane((int)me.y, (int)i2), kb2 = (unsigned)__builtin_amdgcn_readlane((int)me.y, (int)i2 + 32);
                    const float vi = th ? vb2 : va; const unsigned ki = th ? kb2 : ka;
                    rank += (vi > vj || (vi == vj && ki < me.y)) ? 1u : 0u;
                }
                if (selj || (memj && rank < rr_)) atomicOr((unsigned*)&lmask[th * 64 + (me.y >> 5)], 1u << (me.y & 31));
            }
            TSTOP(28)
            TSTOP(24)
            (void)bst; (void)rr; (void)cb;
        }
    }
    if (exact0) { wa0 = 0u; lmask[lane] = 0u; asm volatile("s_waitcnt lgkmcnt(0)" ::: "memory"); idx_select_exact(wl, vals, hist, clist, lmask, ng2 < 32 ? ngroup : ngroup, lo0, hi0, 256u, lane); }
    if (exact1) { wa1 = 0u; lmask[64 + lane] = 0u; asm volatile("s_waitcnt lgkmcnt(0)" ::: "memory"); idx_select_exact(wl, vals + 2048, hist + NBIN, clist + ICAP, lmask + 64, ngroup, lo1, hi1, 256u, lane); }
    asm volatile("s_waitcnt lgkmcnt(0)" ::: "memory");
    gm[lane] = wa0 | lmask[lane]; gm[64 + lane] = wa1 | lmask[64 + lane];
    TSTOP(22)
    TSTOP(20)
}
__device__ __forceinline__ void p2_index_phase(Frame& F) {
    for (int s = F.vcu >> 2; s < 64; s += (F.G + 3) >> 2) {
        unsigned* ctr = (unsigned*)(F.ws + WS_CTL + 16384) + s * 64;
        for (;;) {
            unsigned k = 0u;
            if (F.lane == 0) k = __hip_atomic_fetch_add(ctr, 1u, __ATOMIC_RELAXED, __HIP_MEMORY_SCOPE_AGENT);
            k = (unsigned)__builtin_amdgcn_readfirstlane((int)k);
            if (k >= 128u) break;
            idx_pair(F, s & 7, 1023 - (s >> 3) - 8 * (int)k);
        }
    }
}

constexpr int AT_NSLOT = 5, AT_K = 0, AT_KSZ = 64 * 144, AT_V = AT_NSLOT * AT_KSZ, AT_VSZ = 64 * 192, AT_LUT = AT_V + AT_NSLOT * AT_VSZ, AT_MTAB = AT_LUT + 320 * 4, AT_OST = 0, AT_OSTSZ = 32 * 144;
static_assert(AT_MTAB + 128 <= RING_BYTES && 8 * AT_OSTSZ <= AT_V, "attention LDS");
typedef _Float16 h16x2v __attribute__((ext_vector_type(2)));
__device__ __forceinline__ s16x4 vtr_read(const LAS unsigned char* p) { return __builtin_amdgcn_ds_read_tr16_b64_v4i16((LAS s16x4*)p); }

template <bool ISB>
__device__ __forceinline__ void attn_unit(Frame& F, int b, int h, int qb) {
    const int tid = F.tid, lane = F.lane, wid = F.wave, q = lane & 31, hi = lane >> 5;
    const int q0 = qb * 256, r0 = q0 + wid * 32, t = r0 + q;
    const size_t row = (size_t)b * SEQ + t;
    const h16* Qp; const h16* Kp; const h16* Vp; const h16* Zp; int kvpitch, ycol;
    if (ISB) { Qp = (const h16*)(F.ws + WS_QB) + h * 64; Kp = (const h16*)(F.ws + WS_KB) + h * 64; Vp = (const h16*)(F.ws + WS_VB) + h * 64; Zp = (const h16*)(F.ws + WS_ZB) + h * 64; kvpitch = 512; ycol = 512 + h * 64; }
    else     { Qp = (const h16*)(F.ws + WS_QA) + h * 64; Kp = (const h16*)(F.ws + WS_KVA) + (h >> 2) * 64; Vp = (const h16*)(F.ws + WS_KVA) + 128 + (h >> 2) * 64; Zp = (const h16*)(F.ws + WS_ZA) + h * 64; kvpitch = 256; ycol = h * 64; }
    const unsigned* mrow = (const unsigned*)(F.ws + WS_MASK) + row * 64;
    LAS float* lut = (LAS float*)(F.lds + AT_LUT);
    for (int i = tid; i < 320; i += NTHREADS) { const int dist = 223 - i; float v;
        if (ISB) v = dist < 0 ? 0.f : (F.relb[t5_bucket(dist > 127 ? 127 : dist) * 16 + 8 + h] - F.relb[31 * 16 + 8 + h]) * LOG2E;
        else v = (dist >= 0 && dist < 128) ? F.relb[t5_bucket(dist) * 16 + h] * LOG2E : -INFINITY;
        lut[i] = v; }
    if (tid < 16) { u32x2 e; e.x = ((tid & 1) ? 0xffffu : 0u) | ((tid & 2) ? 0xffff0000u : 0u); e.y = ((tid & 4) ? 0xffffu : 0u) | ((tid & 8) ? 0xffff0000u : 0u); *(LAS u32x2*)(F.lds + AT_MTAB + tid * 8) = e; }
    h16x8 qr[4];
    {   const float* qg = ISB ? F.qnb : F.qna; float ss = 0.f;
#pragma unroll
        for (int d0 = 0; d0 < 4; ++d0) { qr[d0] = *(const h16x8*)(Qp + row * 512 + d0 * 16 + hi * 8);
#pragma unroll
            for (int e = 0; e < 8; ++e) { const float f = (float)qr[d0][e]; ss += f * f; } }
        ss += __shfl_xor(ss, 32);
        const float rq = rsqrtf(ss * (1.0f / 64.0f) + RMS_EPS) * QSCALE;
#pragma unroll
        for (int d0 = 0; d0 < 4; ++d0) { const f32x4 g0 = *(const f32x4*)(qg + d0 * 16 + hi * 8), g1 = *(const f32x4*)(qg + d0 * 16 + hi * 8 + 4);
            u32x4 w; w.x = pkh((float)qr[d0][0] * rq * g0[0], (float)qr[d0][1] * rq * g0[1]); w.y = pkh((float)qr[d0][2] * rq * g0[2], (float)qr[d0][3] * rq * g0[3]);
            w.z = pkh((float)qr[d0][4] * rq * g1[0], (float)qr[d0][5] * rq * g1[1]); w.w = pkh((float)qr[d0][6] * rq * g1[2], (float)qr[d0][7] * rq * g1[3]);
            qr[d0] = __builtin_bit_cast(h16x8, w); } }
    float kgn[8];
    {   const float* kgp = (ISB ? F.knb : F.kna) + (tid & 7) * 8; const f32x4 g0 = *(const f32x4*)kgp, g1 = *(const f32x4*)(kgp + 4);
        kgn[0] = g0[0]; kgn[1] = g0[1]; kgn[2] = g0[2]; kgn[3] = g0[3]; kgn[4] = g1[0]; kgn[5] = g1[1]; kgn[6] = g1[2]; kgn[7] = g1[3]; }
#define KNORM(KR) do { const h16x8 kv_ = __builtin_bit_cast(h16x8, KR); float f_[8]; float ss_ = 0.f; \
        _Pragma("unroll") for (int e = 0; e < 8; ++e) { f_[e] = (float)kv_[e]; ss_ += f_[e] * f_[e]; } \
        ss_ += __shfl_xor(ss_, 1); ss_ += __shfl_xor(ss_, 2); ss_ += __shfl_xor(ss_, 4); \
        const float rk_ = rsqrtf(ss_ * (1.0f / 64.0f) + RMS_EPS); \
        KR.x = pkh(f_[0] * rk_ * kgn[0], f_[1] * rk_ * kgn[1]); KR.y = pkh(f_[2] * rk_ * kgn[2], f_[3] * rk_ * kgn[3]); \
        KR.z = pkh(f_[4] * rk_ * kgn[4], f_[5] * rk_ * kgn[5]); KR.w = pkh(f_[6] * rk_ * kgn[6], f_[7] * rk_ * kgn[7]); } while (0)
    float m_run = -INFINITY, l_run = 0.f;
    f32x16 o[2];
#pragma unroll
    for (int r = 0; r < 16; ++r) { o[0][r] = 0.f; o[1][r] = 0.f; }
    const int kfo = q * 144 + hi * 16;
    const int vfo = (4 * hi + ((lane & 15) >> 2)) * 192 + ((lane >> 4) & 1) * 32 + (lane & 3) * 8;
#define ATT_TILE(SLOT, K0) do { const int k0_ = (K0); const LAS unsigned char* kb = F.lds + AT_K + (SLOT) * AT_KSZ + kfo; const LAS unsigned char* vb = F.lds + AT_V + (SLOT) * AT_VSZ + vfo; \
            f32x16 p0, p1; \
            _Pragma("unroll") \
            for (int r = 0; r < 16; ++r) { p0[r] = 0.f; p1[r] = 0.f; } \
            _Pragma("unroll") \
            for (int d0 = 0; d0 < 4; ++d0) { \
                const h16x8 ka = *(const LAS h16x8*)(kb + d0 * 32), kc = *(const LAS h16x8*)(kb + 32 * 144 + d0 * 32); \
                p0 = __builtin_amdgcn_mfma_f32_32x32x16_f16(ka, qr[d0], p0, 0, 0, 0); \
                p1 = __builtin_amdgcn_mfma_f32_32x32x16_f16(kc, qr[d0], p1, 0, 0, 0); \
            } \
 \
            if (!ISB || (r0 - k0_ - 63 < 113)) { \
                const LAS float* lp = lut + (223 - (t - k0_ - 4 * hi)); \
            _Pragma("unroll") \
                for (int r = 0; r < 16; ++r) { const int c = (r & 3) + 8 * (r >> 2); p0[r] += lp[c]; p1[r] += lp[32 + c]; } \
            } \
 \
            h16x2v s2[16]; \
            _Pragma("unroll") \
            for (int j = 0; j < 8; ++j) { s2[j] = __builtin_convertvector((f32x2){p0[2 * j], p0[2 * j + 1]}, h16x2v); s2[8 + j] = __builtin_convertvector((f32x2){p1[2 * j], p1[2 * j + 1]}, h16x2v); } \
            h16x2v m2 = __builtin_elementwise_max(s2[0], s2[1]); \
            _Pragma("unroll") \
            for (int j = 2; j < 16; ++j) m2 = __builtin_elementwise_max(m2, s2[j]); \
            float mx = fmaxf((float)m2.x, (float)m2.y); \
            mx = fmaxf(mx, __shfl_xor(mx, 32)); \
            const float mnew = fmaxf(m_run, mx), muse = (mnew == -INFINITY) ? 0.f : mnew; \
            if (__any(mnew > m_run)) { \
                const float alpha = __builtin_amdgcn_exp2f(m_run - muse); \
                l_run *= alpha; \
            _Pragma("unroll") \
                for (int r = 0; r < 16; ++r) { o[0][r] *= alpha; o[1][r] *= alpha; } \
            } \
            m_run = mnew; \
            const h16 nm = (h16)(-muse); const h16x2v nm2 = {nm, nm}; \
            _Pragma("unroll") \
            for (int j = 0; j < 16; ++j) { const h16x2v a = s2[j] + nm2; s2[j].x = __builtin_exp2f16(a.x); s2[j].y = __builtin_exp2f16(a.y); } \
            if (ISB) { \
                const unsigned mm0 = mw.x >> (4 * hi), mm1 = mw.y >> (4 * hi); \
            _Pragma("unroll") \
                for (int g4 = 0; g4 < 4; ++g4) { \
                    const u32x2 e0 = *(const LAS u32x2*)(F.lds + AT_MTAB + ((mm0 >> (8 * g4)) & 15u) * 8), e1 = *(const LAS u32x2*)(F.lds + AT_MTAB + ((mm1 >> (8 * g4)) & 15u) * 8); \
                    s2[2 * g4] = __builtin_bit_cast(h16x2v, __builtin_bit_cast(unsigned, s2[2 * g4]) & e0.x); s2[2 * g4 + 1] = __builtin_bit_cast(h16x2v, __builtin_bit_cast(unsigned, s2[2 * g4 + 1]) & e0.y); \
                    s2[8 + 2 * g4] = __builtin_bit_cast(h16x2v, __builtin_bit_cast(unsigned, s2[8 + 2 * g4]) & e1.x); s2[8 + 2 * g4 + 1] = __builtin_bit_cast(h16x2v, __builtin_bit_cast(unsigned, s2[8 + 2 * g4 + 1]) & e1.y); \
                } \
            } \
            {   h16x2v a0 = s2[0] + s2[1], a1 = s2[2] + s2[3], a2 = s2[4] + s2[5], a3 = s2[6] + s2[7], a4 = s2[8] + s2[9], a5 = s2[10] + s2[11], a6 = s2[12] + s2[13], a7 = s2[14] + s2[15]; \
                a0 = a0 + a1; a2 = a2 + a3; a4 = a4 + a5; a6 = a6 + a7; \
                l_run += (((float)a0.x + (float)a0.y) + ((float)a2.x + (float)a2.y)) + (((float)a4.x + (float)a4.y) + ((float)a6.x + (float)a6.y)); } \
            u32x4 pk[4]; \
            _Pragma("unroll") \
            for (int s = 0; s < 4; ++s) pk[s] = (u32x4){__builtin_bit_cast(unsigned, s2[4 * s]), __builtin_bit_cast(unsigned, s2[4 * s + 1]), __builtin_bit_cast(unsigned, s2[4 * s + 2]), __builtin_bit_cast(unsigned, s2[4 * s + 3])}; \
            _Pragma("unroll") \
            for (int s = 0; s < 4; ++s) \
            _Pragma("unroll") \
                for (int d1 = 0; d1 < 2; ++d1) { \
                    const s16x4 lo4 = vtr_read(vb + (16 * s) * 192 + d1 * 64), hi4 = vtr_read(vb + (16 * s + 8) * 192 + d1 * 64); \
                    const h16x4 lf = __builtin_bit_cast(h16x4, lo4), hf = __builtin_bit_cast(h16x4, hi4); \
                    const h16x8 vf = {lf[0], lf[1], lf[2], lf[3], hf[0], hf[1], hf[2], hf[3]}; \
                    o[d1] = __builtin_amdgcn_mfma_f32_32x32x16_f16(vf, __builtin_bit_cast(h16x8, pk[s]), o[d1], 0, 0, 0); \
                } \
        } while (0)
    const int srow = tid >> 3, sch = tid & 7;
    const h16* kg = Kp + ((size_t)b * SEQ + srow) * kvpitch + sch * 8; const h16* vg = Vp + ((size_t)b * SEQ + srow) * kvpitch + sch * 8;
    const int kst = srow * 144 + sch * 16, vst = srow * 192 + sch * 16;
    if (ISB) {
        const int npair = 2 * qb + 2;
        u32x4 kreg0 = *(const u32x4*)kg, vreg0 = *(const u32x4*)vg, kreg1 = *(const u32x4*)(kg + (size_t)64 * kvpitch), vreg1 = *(const u32x4*)(vg + (size_t)64 * kvpitch);
        u32x4 mw4 = *(const u32x4*)mrow, mw4n = {0u, 0u, 0u, 0u};
        KNORM(kreg0); KNORM(kreg1);
        *(LAS u32x4*)(F.lds + AT_K + kst) = kreg0; *(LAS u32x4*)(F.lds + AT_V + vst) = vreg0; *(LAS u32x4*)(F.lds + AT_K + AT_KSZ + kst) = kreg1; *(LAS u32x4*)(F.lds + AT_V + AT_VSZ + vst) = vreg1;
        __syncthreads();
#pragma unroll 1
        for (int pr = 0; pr < npair; ++pr) {
            const int sb = (pr & 1) * 2, kt = 2 * pr;
            if (pr + 1 < npair) { const size_t go = (size_t)(kt + 2) * 64 * kvpitch; kreg0 = *(const u32x4*)(kg + go); vreg0 = *(const u32x4*)(vg + go); kreg1 = *(const u32x4*)(kg + go + (size_t)64 * kvpitch); vreg1 = *(const u32x4*)(vg + go + (size_t)64 * kvpitch);
                mw4n = *(const u32x4*)(mrow + 2 * (kt + 2)); }
            TSTART(31)
            { const u32x2 mw = {mw4.x, mw4.y}; const int k0 = kt * 64; if (k0 <= r0 + 31) ATT_TILE(sb, k0); }
            { const u32x2 mw = {mw4.z, mw4.w}; const int k0 = kt * 64 + 64; if (k0 <= r0 + 31) ATT_TILE(sb + 1, k0); }
            TSTOP(31)
            TSTART(32)
            if (pr + 1 < npair) { KNORM(kreg0); KNORM(kreg1); const int sn = 2 - sb;
                *(LAS u32x4*)(F.lds + AT_K + sn * AT_KSZ + kst) = kreg0; *(LAS u32x4*)(F.lds + AT_V + sn * AT_VSZ + vst) = vreg0;
                *(LAS u32x4*)(F.lds + AT_K + (sn + 1) * AT_KSZ + kst) = kreg1; *(LAS u32x4*)(F.lds + AT_V + (sn + 1) * AT_VSZ + vst) = vreg1; mw4 = mw4n; }
            TSTOP(32)
            TSTART(33)
            __syncthreads();
            TSTOP(33)
        }
    } else {
        u32x4 kr4[4], vr4[4];
#pragma unroll
        for (int jj = 0; jj < 4; ++jj) { const int kt = 4 * qb - 2 + jj; if (kt >= 0) { kr4[jj] = *(const u32x4*)(kg + (size_t)kt * 64 * kvpitch); vr4[jj] = *(const u32x4*)(vg + (size_t)kt * 64 * kvpitch); } }
#pragma unroll
        for (int jj = 0; jj < 4; ++jj) { const int kt = 4 * qb - 2 + jj; if (kt >= 0) { KNORM(kr4[jj]); *(LAS u32x4*)(F.lds + AT_K + jj * AT_KSZ + kst) = kr4[jj]; *(LAS u32x4*)(F.lds + AT_V + jj * AT_VSZ + vst) = vr4[jj]; } }
        __syncthreads();
        const int base_w = wid >> 1;
        u32x4 kreg, vreg; const u32x2 mw = {0u, 0u};
#pragma unroll 1
        for (int s = 0; s < 3; ++s) {
            if (s < 2) { kreg = *(const u32x4*)(kg + (size_t)(4 * qb + 2 + s) * 64 * kvpitch); vreg = *(const u32x4*)(vg + (size_t)(4 * qb + 2 + s) * 64 * kvpitch); }
            const int j = base_w + s, kt = 4 * qb - 2 + j;
            TSTART(31)
            if (kt >= 0) ATT_TILE((j == 5 ? 0 : j), kt * 64);
            TSTOP(31)
            if (s < 2) { const int sl = (s == 0) ? 4 : 0; KNORM(kreg); *(LAS u32x4*)(F.lds + AT_K + sl * AT_KSZ + kst) = kreg; *(LAS u32x4*)(F.lds + AT_V + sl * AT_VSZ + vst) = vreg; }
            TSTART(33)
            __syncthreads();
            TSTOP(33)
        }
    }
    TSTART(34)
    l_run += __shfl_xor(l_run, 32);
    if (!ISB) l_run += __builtin_amdgcn_exp2f(F.sinks[h] * LOG2E - m_run);
    const float inv = 1.0f / l_run;
    LAS unsigned char* ost = F.lds + AT_OST + wid * AT_OSTSZ;
#pragma unroll
    for (int d1 = 0; d1 < 2; ++d1)
#pragma unroll
        for (int g4 = 0; g4 < 4; ++g4) { u32x2 w; w.x = pkh(o[d1][4 * g4] * inv, o[d1][4 * g4 + 1] * inv); w.y = pkh(o[d1][4 * g4 + 2] * inv, o[d1][4 * g4 + 3] * inv);
            *(LAS u32x2*)(ost + q * 144 + (32 * d1 + 8 * g4 + 4 * hi) * 2) = w; }
    LDS_WAIT(); asm volatile("" ::: "memory");
    h16* Yp = (h16*)(F.ws + WS_Y);
#pragma unroll
    for (int i = 0; i < 4; ++i) { const int rr = i * 8 + (lane >> 3), ch = lane & 7; const size_t grow = (size_t)b * SEQ + r0 + rr;
        const h16x8 ov = *(const LAS h16x8*)(ost + rr * 144 + ch * 16); const h16x8 zv = *(const h16x8*)(Zp + grow * 512 + ch * 8);
        float y[8];
#pragma unroll
        for (int e = 0; e < 8; ++e) { const float z = (float)zv[e]; y[e] = (float)ov[e] * z * sigmoidf_fast(z); }
        u32x4 w; w.x = pkh(y[0], y[1]); w.y = pkh(y[2], y[3]); w.z = pkh(y[4], y[5]); w.w = pkh(y[6], y[7]);
        *(u32x4*)(Yp + grow * 1024 + ycol + ch * 8) = w; }
    __syncthreads();
    TSTOP(34)
#undef KNORM
#undef ATT_TILE
}
__device__ __forceinline__ void p3_attention_phase(Frame& F) {
    for (int v = F.vcu; v < 256; v += F.G) {
        const int bh = v >> 2, j = v & 3, b = bh >> 3, h = bh & 7;
        { TSTART(36) attn_unit<true>(F, b, h, 7 - j); attn_unit<true>(F, b, h, j); TSTOP(36) }
        { TSTART(35) attn_unit<false>(F, b, h, 2 * j); attn_unit<false>(F, b, h, 2 * j + 1); TSTOP(35) }
    }
}

struct Args { const float* in[12]; float* out; unsigned char* ws; int ph_lo, ph_hi; };
constexpr int N_PHASES = 6;
__global__ void __launch_bounds__(NTHREADS, 2) mk_fwd(Args args) {
    extern __shared__ __attribute__((aligned(16))) unsigned char lds_raw[];
    cg::grid_group grid = cg::this_grid();
    Frame F;
    F.lds = (LAS unsigned char*)lds_raw;
    F.tid = threadIdx.x; F.lane = F.tid & 63; F.wave = __builtin_amdgcn_readfirstlane(F.tid >> 6);
    F.G = gridDim.x; { const int bx = blockIdx.x; F.vcu = (F.G % 8 == 0) ? (bx % 8) * (F.G / 8) + bx / 8 : bx; }
    F.ws = args.ws; F.prof = 0ull;
    F.x = args.in[0]; F.norm_g = args.in[1]; F.w_in = args.in[2]; F.qna = args.in[3]; F.kna = args.in[4]; F.sinks = args.in[5];
    F.qnb = args.in[6]; F.knb = args.in[7]; F.relb = args.in[8]; F.wpa = args.in[9]; F.wpb = args.in[10]; F.wout = args.in[11]; F.out = args.out;
    const int lo = args.ph_lo, hi = args.ph_hi;
    if (lo < 0) grid.sync();
    if (F.tid < 64) ((LAS unsigned*)(F.lds + LDSCTL_OFF))[F.tid] = 0u;
    __syncthreads();
    XcdBarrier bar = xcd_barrier_post((unsigned*)(F.ws + WS_CTL), (volatile LAS unsigned*)(F.lds + LDSCTL_OFF) + 8);
#ifdef ONLY_PH
#define IN(k) ((k) == ONLY_PH && lo <= (k) && (k) < hi)
#else
#define IN(k) (lo <= (k) && (k) < hi)
#endif
#ifdef PROBE_SYNC2
#define SEAM(k) do { if (IN(k) && IN((k) + 1)) { xcd_barrier(bar); xcd_barrier(bar); } } while (0)
#else
#define SEAM(k) do { if (IN(k) && IN((k) + 1)) xcd_barrier(bar); } while (0)
#endif
    { TSTART(1) if (IN(0)) { p0_prologue(F); }
    SEAM(0); TSTOP(1) }
    TSTART(2)
    if (IN(1)) {
        pg8::GemmPlain g{(const h16*)(F.ws + WS_H), (const h16*)(F.ws + WS_WIN), 1024, 1024};
        pg8::StaticOrder S; S.init(MROWS, 23 * 256, F.G, (int)blockIdx.x);
        pg8::EpiIn E{F.ws, (h16*)F.out};
        pg8::gemm_phase<pg8::EpiIn, pg8::StaticOrder, pg8::GemmPlain, true, true>(F.lds, g, S, E);
    }
    SEAM(1);
    TSTOP(2)
    { TSTART(3) if (IN(2)) { p2_index_phase(F); }
#if defined(PROF_SEG) && defined(PROF_MAXWAVE)
    if (F.lane == 0) atomicMax((unsigned long long*)(F.ws + WS_CTL + 32768), F.prof);
#endif
    SEAM(2); TSTOP(3) }
    { TSTART(4) if (IN(3)) { p3_attention_phase(F); }
    SEAM(3); TSTOP(4) }
    TSTART(5)
    if (IN(4)) {
        pg8::GemmPlain g{(const h16*)(F.ws + WS_Y), (const h16*)(F.ws + WS_WP), 1024, 1024};
        pg8::StaticOrder S; S.init(MROWS, DM, F.G, (int)blockIdx.x);
        pg8::EpiMerge E{(const h16*)F.out, (h16*)(F.ws + WS_MG)};
        pg8::gemm_phase<pg8::EpiMerge, pg8::StaticOrder, pg8::GemmPlain, true, true>(F.lds, g, S, E);
    }
    SEAM(4);
    TSTOP(5)
    TSTART(6)
    if (IN(5)) {
        pg8::GemmPlain g{(const h16*)(F.ws + WS_MG), (const h16*)(F.ws + WS_WO), 1024, 1024};
        pg8::StaticOrder S; S.init(MROWS, DM, F.G, (int)blockIdx.x);
        pg8::EpiOut E{F.x, F.out};
        pg8::gemm_phase<pg8::EpiOut, pg8::StaticOrder, pg8::GemmPlain, true, true>(F.lds, g, S, E);
    }
    TSTOP(6)
#undef IN
#undef SEAM
#ifdef PROF_SEG
#ifdef PROF_MAXWAVE
    if (blockIdx.x == PROF_BLK && F.wave == PROF_WAVE) F.prof = __hip_atomic_load((unsigned long long*)(F.ws + WS_CTL + 32768), __ATOMIC_RELAXED, __HIP_MEMORY_SCOPE_AGENT);
#endif
    if (blockIdx.x == PROF_BLK && F.wave == PROF_WAVE && hi == N_PHASES) { const unsigned long long t1 = __builtin_amdgcn_s_memrealtime() + F.prof * PROF_MULT; while (__builtin_amdgcn_s_memrealtime() < t1) __builtin_amdgcn_s_sleep(8); }
#endif
}

extern "C" void kernel_launch(void* const* d_in, const int* in_sizes, int n_in, void* d_out, int out_size, void* d_ws, size_t ws_size, hipStream_t stream) {
    static int grid = 0;
    if (grid == 0) {
        if (n_in != 12 || in_sizes[0] != MROWS * DM || out_size != MROWS * DM || ws_size < WS_END) { fprintf(stderr, "kernel_launch: unexpected problem (n_in %d, ws %zu)\n", n_in, ws_size); grid = -1; return; }
        int dev = 0, cus = 0, per_cu = 0;
        hipGetDevice(&dev); hipDeviceGetAttribute(&cus, hipDeviceAttributeMultiprocessorCount, dev);
        hipFuncSetAttribute((const void*)mk_fwd, hipFuncAttributeMaxDynamicSharedMemorySize, LDS_BYTES);
        hipOccupancyMaxActiveBlocksPerMultiprocessor(&per_cu, (const void*)mk_fwd, NTHREADS, LDS_BYTES);
        (void)hipGetLastError();
        if (per_cu < 1) { fprintf(stderr, "kernel_launch: occupancy query says %d blocks/CU\n", per_cu); per_cu = 1; }
        grid = cus;
        if (grid > 256) grid = 256;
    }
    if (grid < 0) return;
    (void)hipMemsetAsync((char*)d_ws + WS_CTL, 0, CTL_BYTES, stream);
    Args a{};
    for (int i = 0; i < 12; ++i) a.in[i] = (const float*)d_in[i];
    a.out = (float*)d_out; a.ws = (unsigned char*)d_ws;
#ifdef PROBE_PH
    {
        void* kargs[] = {&a};
        a.ph_lo = 0; a.ph_hi = PROBE_PH + 1;
        (void)hipLaunchCooperativeKernel((const void*)mk_fwd, dim3(grid), dim3(NTHREADS), kargs, LDS_BYTES, stream);
        (void)hipMemsetAsync((char*)d_ws + WS_CTL, 0, CTL_BYTES, stream);
#ifdef PROBE_SPLIT_ONLY
        a.ph_lo = PROBE_PH + 1; a.ph_hi = N_PHASES;
#else
        a.ph_lo = PROBE_PH; a.ph_hi = N_PHASES;
#endif
        (void)hipLaunchCooperativeKernel((const void*)mk_fwd, dim3(grid), dim3(NTHREADS), kargs, LDS_BYTES, stream);
    }
#else
    {
        a.ph_lo = 0; a.ph_hi = N_PHASES;
        void* kargs[] = {&a};
        hipError_t e = hipLaunchCooperativeKernel((const void*)mk_fwd, dim3(grid), dim3(NTHREADS), kargs, LDS_BYTES, stream);
        if (e != hipSuccess) fprintf(stderr, "cooperative launch failed: %s (grid %d)\n", hipGetErrorString(e), grid);
    }
#endif
}
```

```cpp
#include <hip/hip_runtime.h>
#include <hip/hip_cooperative_groups.h>
#include <cstdio>
#include <cstdint>
namespace cg = cooperative_groups;
#ifdef PROF_SEG
#ifndef PROF_MULT
#define PROF_MULT 4
#endif
#ifndef PROF_BLK
#define PROF_BLK 100
#endif
#ifndef PROF_WAVE
#define PROF_WAVE 3
#endif
#endif

#define LAS __attribute__((address_space(3)))
typedef _Float16 h16;
typedef _Float16 h16x2 __attribute__((ext_vector_type(2)));
typedef _Float16 h16x4 __attribute__((ext_vector_type(4)));
typedef _Float16 h16x8 __attribute__((ext_vector_type(8)));
typedef float f32x2 __attribute__((ext_vector_type(2)));
typedef float f32x4 __attribute__((ext_vector_type(4)));
typedef float f32x16 __attribute__((ext_vector_type(16)));
typedef unsigned u32x2 __attribute__((ext_vector_type(2)));
typedef unsigned u32x4 __attribute__((ext_vector_type(4)));
typedef short s16x4 __attribute__((ext_vector_type(4)));

__device__ __forceinline__ unsigned pkh(float lo, float hi) { const f32x2 v = {lo, hi}; const h16x2 h = __builtin_convertvector(v, h16x2); return __builtin_bit_cast(unsigned, h); }
__device__ __forceinline__ float sigmoidf_fast(float g) { g = fminf(fmaxf(g, -30.f), 30.f); return __builtin_amdgcn_rcpf(1.0f + __builtin_amdgcn_exp2f(-1.4426950408889634f * g)); }

constexpr int NBATCH = 8, SEQ = 2048, DM = 1024, MROWS = NBATCH * SEQ, INW = 5672;
constexpr float RMS_EPS = 1e-6f, LOG2E = 1.4426950408889634f, QSCALE = 0.125f * 1.4426950408889634f;
constexpr float HSCALE = 16.f, WSCALE = 64.f, INV_HW = 1.0f / (16.f * 64.f);
constexpr size_t MiB = 1u << 20;
constexpr size_t WS_H = 0;
constexpr size_t WS_Y = 0, WS_MG = 32 * MiB;
constexpr size_t WS_QH = 32 * MiB, WS_QL = 40 * MiB, WS_KH = 48 * MiB, WS_KL = 49 * MiB, WS_WI = 50 * MiB;
constexpr size_t WS_WIN = 64 * MiB;
constexpr size_t WS_WP = 77 * MiB, WS_WO = 79 * MiB;
constexpr size_t WS_QA = 81 * MiB, WS_KVA = 97 * MiB, WS_ZA = 105 * MiB, WS_QB = 121 * MiB, WS_KB = 137 * MiB, WS_VB = 153 * MiB, WS_ZB = 169 * MiB;
constexpr size_t WS_MASK = 185 * MiB;
constexpr size_t WS_CTL = 190 * MiB, CTL_BYTES = 65536;
constexpr size_t WS_END = 191 * MiB;

namespace pg8 {
#define PG8_LAS __attribute__((address_space(3)))
constexpr int BM = 256, BK = 64, HALF = 128, HTB = HALF * BK * 2  , STAGE_BYTES = 8 * HTB, NXCD = 8, WGM = 8;

__host__ __device__ __forceinline__ int lds_byte(int r, int c) { const int st = (r >> 4) * 2 + (c >> 5), rr = r & 15, cc = c & 31, ob = rr * 64 + cc * 2; return st * 1024 + (ob ^ (((ob >> 9) & 1) << 5)); }
__host__ __device__ __forceinline__ void stage_rc(int b, int& R, int& C) { const int st = b / 1024, sb = b % 1024, swz = sb ^ (((sb >> 9) & 1) << 5); R = (st >> 1) * 16 + swz / 64; C = (st & 1) * 32 + (swz % 64) / 2; }
__host__ __device__ __forceinline__ int perm32(int rho) { const int n = rho >> 4, i = rho & 15; return 8 * (i >> 2) + 4 * n + (i & 3); }

struct Unit { int pm, pn; };

struct StaticOrder {
    int nM, nN, nwg, G, c;
    __host__ __device__ void init(int M, int N, int G_, int c_) { nM = M / BM; nN = N / BM; nwg = nM * nN; G = G_; c = c_; }
    __host__ __device__ bool next(int i, Unit& u) const {
        const long L = (long)i * G + c; if (L >= nwg) return false;
        int wgid = (int)L; { const int q = nwg / NXCD, r = nwg % NXCD, xcd = wgid % NXCD, off = wgid / NXCD; wgid = (xcd < r ? xcd * (q + 1) : r * (q + 1) + (xcd - r) * q) + off; }
        const int nig = WGM * nN, gid = wgid / nig, fm = gid * WGM, gsz = (nM - fm) < WGM ? (nM - fm) : WGM;
        u.pm = fm + ((wgid % nig) % gsz); u.pn = (wgid % nig) / gsz; return true;
    }
    __device__ __forceinline__ void a_ready(const Unit&) const {}
    __device__ __forceinline__ void done(const Unit&) const {}
};

struct GemmPlain { const h16* A; const h16* Bt; int lda, K;
    __device__ __forceinline__ const char* aptr(const Unit& u) const { return (const char*)(A + (size_t)u.pm * BM * lda); }
    __device__ __forceinline__ const char* bptr(const Unit& u) const { return (const char*)(Bt + (size_t)u.pn * BM * K); } };
struct EpiIn {
    static constexpr bool PERM = true, AFTER_DRAIN = false, MID = false;
    unsigned char* ws; h16* G;
    __device__ __forceinline__ void operator()(const f32x4 (&acc)[2][2][4][2], const Unit& u, int wr, int wc, int fr, int fq) const {
        const int pn = u.pn, row0 = u.pm * BM + wr * 64 + fr, cl = wc * 32 + 8 * fq;
        if (pn < 21) {
            h16* base; int ldc, colt;
            if (pn < 2)       { base = (h16*)(ws + WS_QA);  ldc = 512; colt = pn * 256; }
            else if (pn == 2) { base = (h16*)(ws + WS_KVA); ldc = 256; colt = 0; }
            else if (pn < 5)  { base = (h16*)(ws + WS_ZA);  ldc = 512; colt = (pn - 3) * 256; }
            else if (pn < 7)  { base = (h16*)(ws + WS_QB);  ldc = 512; colt = (pn - 5) * 256; }
            else if (pn < 9)  { base = (h16*)(ws + WS_KB);  ldc = 512; colt = (pn - 7) * 256; }
            else if (pn < 11) { base = (h16*)(ws + WS_VB);  ldc = 512; colt = (pn - 9) * 256; }
            else if (pn < 13) { base = (h16*)(ws + WS_ZB);  ldc = 512; colt = (pn - 11) * 256; }
            else              { base = G;                   ldc = 2048; colt = (pn - 13) * 256; }
#pragma unroll
            for (int ai = 0; ai < 2; ++ai)
#pragma unroll
                for (int m = 0; m < 4; ++m) { h16* rowp = base + (size_t)(row0 + ai * HALF + m * 16) * ldc + colt + cl;
#pragma unroll
                    for (int bj = 0; bj < 2; ++bj) { const f32x4 v0 = acc[ai][bj][m][0] * INV_HW, v1 = acc[ai][bj][m][1] * INV_HW;
                        u32x4 w; w.x = pkh(v0[0], v0[1]); w.y = pkh(v0[2], v0[3]); w.z = pkh(v1[0], v1[1]); w.w = pkh(v1[2], v1[3]);
                        *(u32x4*)(rowp + bj * HALF) = w; } }
        } else {
            const int colt = (pn - 21) * 256 + cl;
#pragma unroll
            for (int ai = 0; ai < 2; ++ai)
#pragma unroll
                for (int m = 0; m < 4; ++m) { const size_t r = (size_t)(row0 + ai * HALF + m * 16);
#pragma unroll
                    for (int bj = 0; bj < 2; ++bj) { const int j = colt + bj * HALF; const f32x4 v0 = acc[ai][bj][m][0] * INV_HW, v1 = acc[ai][bj][m][1] * INV_HW;
                        if (j < 288) {
                            u32x4 hi; hi.x = pkh(v0[0] * 16.f, v0[1] * 16.f); hi.y = pkh(v0[2] * 16.f, v0[3] * 16.f); hi.z = pkh(v1[0] * 16.f, v1[1] * 16.f); hi.w = pkh(v1[2] * 16.f, v1[3] * 16.f);
                            if (j < 256) *(u32x4*)((h16*)(ws + WS_QH) + r * 256 + j) = hi; else *(u32x4*)((h16*)(ws + WS_KH) + r * 32 + (j - 256)) = hi;
                        } else if (j < 296) { float* w = (float*)(ws + WS_WI) + r * 8; *(f32x4*)w = v0; *(f32x4*)(w + 4) = v1; }
                    } }
        }
    }
};
struct EpiMerge {
    static constexpr bool PERM = true, AFTER_DRAIN = false, MID = true;
    const h16* G; h16* MG;
    __device__ __forceinline__ void mid(f32x4 (&acc)[2][2][4][2], const Unit& u, int wr, int wc, int fr, int fq) const {
        const int row0 = u.pm * BM + wr * 64 + fr, col0 = u.pn * BM + wc * 32 + 8 * fq;
#pragma unroll
        for (int ai = 0; ai < 2; ++ai)
#pragma unroll
            for (int m = 0; m < 4; ++m) { unsigned ro = (unsigned)(row0 + ai * HALF + m * 16); asm volatile("" : "+v"(ro)); const h16* gp = G + (size_t)ro * 2048 + col0;
#pragma unroll
                for (int bj = 0; bj < 2; ++bj) { const h16x8 ga = *(const h16x8*)(gp + bj * HALF), gb = *(const h16x8*)(gp + 1024 + bj * HALF);
#pragma unroll
                    for (int e = 0; e < 8; ++e) { const float a = fminf(fmaxf((float)ga[e], -30.f), 30.f), b = fminf(fmaxf((float)gb[e], -30.f), 30.f);
                        const float f = (1.0f + __builtin_amdgcn_exp2f(-LOG2E * b)) * __builtin_amdgcn_rcpf(1.0f + __builtin_amdgcn_exp2f(-LOG2E * a));
                        acc[ai][bj][m][e >> 2][e & 3] *= f; } }
                asm volatile("" ::: "memory"); }
    }
    __device__ __forceinline__ void operator()(const f32x4 (&acc)[2][2][4][2], const Unit& u, int wr, int wc, int fr, int fq) const {
        const int row0 = u.pm * BM + wr * 64 + fr, col0 = u.pn * BM + wc * 32 + 8 * fq;
#pragma unroll
        for (int ai = 0; ai < 2; ++ai)
#pragma unroll
            for (int m = 0; m < 4; ++m) { unsigned ro = (unsigned)(row0 + ai * HALF + m * 16); asm volatile("" : "+v"(ro)); const size_t r = (size_t)ro;
#pragma unroll
                for (int bj = 0; bj < 2; ++bj) { const h16x8 gb = *(const h16x8*)(G + r * 2048 + 1024 + col0 + bj * HALF);
                    float o[8];
#pragma unroll
                    for (int e = 0; e < 8; ++e) o[e] = acc[ai][bj][m][e >> 2][e & 3] * sigmoidf_fast((float)gb[e]);
                    u32x4 w; w.x = pkh(o[0], o[1]); w.y = pkh(o[2], o[3]); w.z = pkh(o[4], o[5]); w.w = pkh(o[6], o[7]);
                    *(u32x4*)(MG + r * 1024 + col0 + bj * HALF) = w; } }
    }
};
struct EpiOut {
    static constexpr bool PERM = true, AFTER_DRAIN = false, MID = false;
    const float* x; float* out;
    __device__ __forceinline__ void operator()(const f32x4 (&acc)[2][2][4][2], const Unit& u, int wr, int wc, int fr, int fq) const {
        const int row0 = u.pm * BM + wr * 64 + fr, col0 = u.pn * BM + wc * 32 + 8 * fq;
#pragma unroll
        for (int ai = 0; ai < 2; ++ai)
#pragma unroll
            for (int m = 0; m < 4; ++m) { const size_t off = (size_t)(row0 + ai * HALF + m * 16) * DM + col0;
#pragma unroll
                for (int bj = 0; bj < 2; ++bj)
#pragma unroll
                    for (int n = 0; n < 2; ++n) { const f32x4 xv = *(const f32x4*)(x + off + bj * HALF + 4 * n); *(f32x4*)(out + off + bj * HALF + 4 * n) = xv + acc[ai][bj][m][n]; }
                if (m & 1) asm volatile("" ::: "memory"); }
    }
};

template <class Epi, class Sched, class GemmT, bool ALIGN_EPI = false, bool SP2 = false>
__device__ __forceinline__ void gemm_phase(PG8_LAS unsigned char* lds, const GemmT g, const Sched& S, const Epi& E) {
    const int tid = threadIdx.x, wid = __builtin_amdgcn_readfirstlane(tid >> 6), lane = tid & 63, wr = wid >> 2, wc = wid & 3, fr = lane & 15, fq = lane >> 4;
    const int K = g.K, nt = K / BK;
    unsigned voffA[2], voffB[2];
#pragma unroll
    for (int i = 0; i < 2; ++i) { int R, C; stage_rc(tid * 16 + i * 8192, R, C); const int Rb = Epi::PERM ? ((R & ~31) + perm32(R & 31)) : R;
        voffA[i] = (unsigned)(R * g.lda + C) * 2u; voffB[i] = (unsigned)(Rb * K + C) * 2u; }
    const size_t kstep = (size_t)(BK * 2);
    const size_t hstepA = (size_t)HALF * g.lda * 2, hstepB = (size_t)HALF * K * 2;
    const unsigned ldsw = (unsigned)wid * 1024u;
    const int aoff = lds_byte(wr * 64 + fr, fq * 8), boff = lds_byte(wc * 32 + fr, fq * 8);
#define PG8_SA(b, h) (((b) * 2 + (h)) * HTB)
#define PG8_SB(b, h) ((4 + (b) * 2 + (h)) * HTB)
#define PG8_STAGE(bufoff, gbase, voff) do { _Pragma("unroll") for (int _i = 0; _i < 2; ++_i) \
        __builtin_amdgcn_global_load_lds((const unsigned*)((const char*)(gbase) + (voff)[_i]), (PG8_LAS unsigned*)(lds + (bufoff) + ldsw + _i * 8192), 16, 0, 0); } while (0)
#define PG8_LDA(dst, b, h) do { _Pragma("unroll") for (int m = 0; m < 4; ++m) _Pragma("unroll") for (int k = 0; k < 2; ++k) dst[m][k] = *(const PG8_LAS h16x8*)(lds + PG8_SA(b, h) + aoff + m * 2048 + k * 1024); } while (0)
#define PG8_LDB(dst, b, h) do { _Pragma("unroll") for (int n = 0; n < 2; ++n) _Pragma("unroll") for (int k = 0; k < 2; ++k) dst[n][k] = *(const PG8_LAS h16x8*)(lds + PG8_SB(b, h) + boff + n * 2048 + k * 1024); } while (0)
#define PG8_MMA(ai, bj, At, Bt) do { __builtin_amdgcn_s_setprio(1); _Pragma("unroll") for (int m = 0; m < 4; ++m) _Pragma("unroll") for (int n = 0; n < 2; ++n) _Pragma("unroll") for (int k = 0; k < 2; ++k) \
        acc[ai][bj][m][n] = __builtin_amdgcn_mfma_f32_16x16x32_f16(Bt[n][k], At[m][k], acc[ai][bj][m][n], 0, 0, 0); __builtin_amdgcn_s_setprio(0); } while (0)
#define PG8_WAIT_V(n) asm volatile("s_waitcnt vmcnt(" #n ")" ::: "memory")
#define PG8_WAIT_L(n) asm volatile("s_waitcnt lgkmcnt(" #n ")" ::: "memory")
#define PG8_BAR __builtin_amdgcn_s_barrier()
#define PG8_SCHED __builtin_amdgcn_sched_barrier(0)
    Unit cur, nxt; int ui = 0;
    if (!S.next(0, cur)) return;
    f32x4 acc[2][2][4][2];
#pragma unroll
    for (int a = 0; a < 2; ++a)
#pragma unroll
        for (int b = 0; b < 2; ++b)
#pragma unroll
            for (int m = 0; m < 4; ++m)
#pragma unroll
                for (int n = 0; n < 2; ++n) acc[a][b][m][n] = (f32x4){0.f, 0.f, 0.f, 0.f};
    h16x8 At[4][2], B0[2][2], B1[2][2];
    const char* cA = g.aptr(cur); const char* cB = g.bptr(cur);
    S.a_ready(cur);
    if constexpr (SP2) {
        PG8_STAGE(PG8_SB(0, 0), cB, voffB); PG8_STAGE(PG8_SB(0, 1), cB + hstepB, voffB); PG8_STAGE(PG8_SA(0, 0), cA, voffA); PG8_STAGE(PG8_SA(0, 1), cA + hstepA, voffA);
        if (wr == 1) PG8_BAR;
        PG8_WAIT_V(2); PG8_BAR;
        PG8_STAGE(PG8_SB(1, 0), cB + kstep, voffB); PG8_STAGE(PG8_SA(1, 0), cA + kstep, voffA); PG8_STAGE(PG8_SB(1, 1), cB + hstepB + kstep, voffB);
        PG8_WAIT_V(6); PG8_BAR;
    } else {
        PG8_STAGE(PG8_SB(0, 0), cB, voffB); PG8_STAGE(PG8_SA(0, 0), cA, voffA); PG8_STAGE(PG8_SB(0, 1), cB + hstepB, voffB); PG8_STAGE(PG8_SA(0, 1), cA + hstepA, voffA);
        if (wr == 1) PG8_BAR;
        PG8_WAIT_V(4); PG8_BAR;
        PG8_STAGE(PG8_SB(1, 0), cB + kstep, voffB); PG8_STAGE(PG8_SA(1, 0), cA + kstep, voffA); PG8_STAGE(PG8_SB(1, 1), cB + hstepB + kstep, voffB);
        PG8_WAIT_V(6); PG8_BAR;
    }
    for (;;) {
        const bool has_next = S.next(ui + 1, nxt);
        const char* nA = has_next ? g.aptr(nxt) : cA; const char* nB = has_next ? g.bptr(nxt) : cB;
        for (int t = 0; t < nt; t += 2) {
            const bool last = (t == nt - 2);
            const char* a1 = cA + (size_t)(t + 1) * kstep;
            const char* a2 = last ? nA : cA + (size_t)(t + 2) * kstep; const char* b2 = last ? nB : cB + (size_t)(t + 2) * kstep;
            const char* a3 = a2 + kstep; const char* b3 = b2 + kstep;
            if (last && has_next) S.a_ready(nxt);
            if constexpr (Epi::MID) { if (t == nt / 2) E.mid(acc, cur, wr, wc, fr, fq); }
            if constexpr (SP2) {
            PG8_LDB(B0, 0, 0); PG8_LDB(B1, 0, 1); PG8_SCHED; PG8_LDA(At, 0, 0); PG8_STAGE(PG8_SA(1, 1), a1 + hstepA, voffA);
            PG8_WAIT_V(8); PG8_WAIT_L(0); PG8_BAR; PG8_MMA(0, 0, At, B0); PG8_MMA(0, 1, At, B1); PG8_BAR; PG8_SCHED;
            PG8_LDA(At, 0, 1); PG8_STAGE(PG8_SB(0, 0), b2, voffB); PG8_STAGE(PG8_SB(0, 1), b2 + hstepB, voffB); PG8_STAGE(PG8_SA(0, 0), a2, voffA);
            PG8_WAIT_V(8); PG8_WAIT_L(0); PG8_BAR; PG8_MMA(1, 0, At, B0); PG8_MMA(1, 1, At, B1); PG8_BAR; PG8_SCHED;
            PG8_LDB(B0, 1, 0); PG8_LDB(B1, 1, 1); PG8_SCHED; PG8_LDA(At, 1, 0); PG8_STAGE(PG8_SA(0, 1), a2 + hstepA, voffA);
            PG8_WAIT_V(8); PG8_WAIT_L(0); PG8_BAR; PG8_MMA(0, 0, At, B0); PG8_MMA(0, 1, At, B1); PG8_BAR; PG8_SCHED;
            PG8_LDA(At, 1, 1); PG8_STAGE(PG8_SB(1, 0), b3, voffB); PG8_STAGE(PG8_SB(1, 1), b3 + hstepB, voffB); PG8_STAGE(PG8_SA(1, 0), a3, voffA);
            PG8_WAIT_V(8); PG8_WAIT_L(0); PG8_BAR; PG8_MMA(1, 0, At, B0); PG8_MMA(1, 1, At, B1); PG8_BAR; PG8_SCHED;
            } else {
            PG8_LDB(B0, 0, 0); PG8_SCHED; PG8_LDA(At, 0, 0); PG8_STAGE(PG8_SA(1, 1), a1 + hstepA, voffA);
            PG8_WAIT_L(8); PG8_BAR; PG8_WAIT_L(0); PG8_MMA(0, 0, At, B0); PG8_BAR; PG8_SCHED;
            PG8_LDB(B1, 0, 1); PG8_STAGE(PG8_SB(0, 0), b2, voffB);
            PG8_BAR; PG8_WAIT_L(0); PG8_MMA(0, 1, At, B1); PG8_BAR;
            PG8_LDA(At, 0, 1); PG8_STAGE(PG8_SA(0, 0), a2, voffA);
            PG8_BAR; PG8_WAIT_L(0); PG8_MMA(1, 0, At, B0); PG8_BAR; PG8_SCHED;
            PG8_STAGE(PG8_SB(0, 1), b2 + hstepB, voffB);
            PG8_WAIT_V(6); PG8_BAR; PG8_MMA(1, 1, At, B1); PG8_BAR;
            PG8_LDB(B0, 1, 0); PG8_SCHED; PG8_LDA(At, 1, 0); PG8_STAGE(PG8_SA(0, 1), a2 + hstepA, voffA);
            PG8_WAIT_L(8); PG8_BAR; PG8_WAIT_L(0); PG8_MMA(0, 0, At, B0); PG8_BAR; PG8_SCHED;
            PG8_LDB(B1, 1, 1); PG8_STAGE(PG8_SB(1, 0), b3, voffB);
            PG8_BAR; PG8_WAIT_L(0); PG8_MMA(0, 1, At, B1); PG8_BAR;
            PG8_LDA(At, 1, 1); PG8_STAGE(PG8_SA(1, 0), a3, voffA);
            PG8_BAR; PG8_WAIT_L(0); PG8_MMA(1, 0, At, B0); PG8_BAR; PG8_SCHED;
            PG8_STAGE(PG8_SB(1, 1), b3 + hstepB, voffB);
            PG8_WAIT_V(6); PG8_BAR; PG8_MMA(1, 1, At, B1); PG8_BAR;
            }
        }
        if constexpr (ALIGN_EPI) { if (wr == 0) PG8_BAR; }
        if constexpr (!Epi::AFTER_DRAIN) { E(acc, cur, wr, wc, fr, fq); S.done(cur); }
        if (!has_next) break;
#pragma unroll
        for (int a = 0; a < 2; ++a)
#pragma unroll
            for (int b = 0; b < 2; ++b)
#pragma unroll
                for (int m = 0; m < 4; ++m)
#pragma unroll
                    for (int n = 0; n < 2; ++n) acc[a][b][m][n] = (f32x4){0.f, 0.f, 0.f, 0.f};
        cur = nxt; cA = nA; cB = nB; ++ui;
        if constexpr (ALIGN_EPI) { if (wr == 1) PG8_BAR; }
    }
    PG8_WAIT_V(0);
    if constexpr (!ALIGN_EPI) { if (wr == 0) PG8_BAR; }
    PG8_BAR;
    if constexpr (Epi::AFTER_DRAIN) { E.fused(acc, cur, wr, wc, fr, fq, lds, wid, lane); S.done(cur); }
#undef PG8_SA
#undef PG8_SB
#undef PG8_STAGE
#undef PG8_LDA
#undef PG8_LDB
#undef PG8_MMA
#undef PG8_WAIT_V
#undef PG8_WAIT_L
#undef PG8_BAR
#undef PG8_SCHED
}
}

constexpr int NWAVES = 8, NTHREADS = 512;
constexpr int RING_BYTES = 131072, LDSCTL_OFF = 159744, LDS_BYTES = 163840;
#define LDS_WAIT() asm volatile("s_waitcnt lgkmcnt(0)" ::: "memory")
#ifdef PROF_SEG
#define TSTART(id) unsigned long long t0_##id = 0; if ((id) == PROF_SEG) { asm volatile("s_waitcnt vmcnt(0) lgkmcnt(0)" ::: "memory"); t0_##id = __builtin_amdgcn_s_memrealtime(); }
#define TSTOP(id) if ((id) == PROF_SEG) { asm volatile("s_waitcnt vmcnt(0) lgkmcnt(0)" ::: "memory"); F.prof += __builtin_amdgcn_s_memrealtime() - t0_##id; }
#else
#define TSTART(id)
#define TSTOP(id)
#endif

#define XB_TMO      128
#define XB_XCNT(j)  (256  + 64 * (j))
#define XB_XSUB(j)  (1280 + 64 * (j))
#define XB_XGEN(j)  (2304 + 64 * (j))
#define XB_TOP      3328
#define XB_TOPGEN   3392
#define XCD_BAR_WORDS 3456
#define XB_SPIN_CAP (1u << 18)

__device__ __forceinline__ unsigned xb_ld(unsigned* p)              { return __hip_atomic_load(p, __ATOMIC_RELAXED, __HIP_MEMORY_SCOPE_AGENT); }
__device__ __forceinline__ unsigned xb_add(unsigned* p, unsigned v) { return __hip_atomic_fetch_add(p, v, __ATOMIC_RELAXED, __HIP_MEMORY_SCOPE_AGENT); }
__device__ __forceinline__ unsigned xb_xcc_id() { return (unsigned)__builtin_amdgcn_s_getreg((3 << 11) | 20) & 0xFu; }
#define XB_SPIN(cond, bar) do { unsigned _sp = 0; while (cond) { __builtin_amdgcn_s_sleep(1); \
    if ((++_sp & 255u) == 0u) { if (xb_ld(&(bar)[XB_TMO])) break; if (_sp > XB_SPIN_CAP) { atomicAdd(&(bar)[XB_TMO], 1u); break; } } } } while (0)

struct XcdBarrier {
    unsigned* bar; unsigned x;
    volatile LAS unsigned* st;
};

__device__ __forceinline__ XcdBarrier xcd_barrier_post(unsigned* bar, volatile LAS unsigned* st) {
    XcdBarrier b; b.bar = bar; b.x = xb_xcc_id(); b.st = st;
    if (threadIdx.x == 0) (void)xb_add(&bar[XB_XCNT(b.x)], 1u);
    return b;
}
__device__ __forceinline__ void xcd_barrier_complete(unsigned* bar, unsigned x, unsigned& nloc, unsigned& nx) {
    const unsigned G = gridDim.x * gridDim.y * gridDim.z;
    unsigned sum, cnt, mine, sp = 0u;
    for (;;) {
        sum = 0u; cnt = 0u; mine = 0u;
#pragma unroll
        for (unsigned j = 0; j < 16; ++j) { const unsigned c = xb_ld(&bar[XB_XCNT(j)]); sum += c; cnt += (c > 0u) ? 1u : 0u; mine = (j == x) ? c : mine; }
        if (sum == G) break;
        __builtin_amdgcn_s_sleep(1);
        if ((++sp & 255u) == 0u) { if (xb_ld(&bar[XB_TMO])) break; if (sp > XB_SPIN_CAP) { atomicAdd(&bar[XB_TMO], 1u); break; } }
    }
    nloc = mine > 0u ? mine : 1u; nx = cnt > 0u ? cnt : 1u;
}

__device__ __forceinline__ void xcd_barrier(const XcdBarrier& b) {
    asm volatile("s_waitcnt vmcnt(0)" ::: "memory");
    __syncthreads();
    if (threadIdx.x == 0) {
        unsigned* bar = b.bar;
        __builtin_amdgcn_s_waitcnt(0);
        unsigned nloc = b.st[0], nx = b.st[1];
        if (nloc == 0u) { xcd_barrier_complete(bar, b.x, nloc, nx); b.st[0] = nloc; b.st[1] = nx; }
        const unsigned old = xb_add(&bar[XB_XSUB(b.x)], 1u);
        const unsigned gen = old / nloc;
        if (old + 1u == (gen + 1u) * nloc) {
            __builtin_amdgcn_fence(__ATOMIC_RELEASE, "agent");
            asm volatile("s_waitcnt vmcnt(0)" ::: "memory");
            const unsigned og = xb_add(&bar[XB_TOP], 1u);
            const unsigned tg = og / nx;
            if (og + 1u == (tg + 1u) * nx) xb_add(&bar[XB_TOPGEN], 1u);
            else XB_SPIN(xb_ld(&bar[XB_TOPGEN]) == tg, bar);
            __builtin_amdgcn_fence(__ATOMIC_ACQUIRE, "agent");
            xb_add(&bar[XB_XGEN(b.x)], 1u);
            asm volatile("s_waitcnt vmcnt(0)" ::: "memory");
        } else {
            XB_SPIN(xb_ld(&bar[XB_XGEN(b.x)]) == gen, bar);
            __builtin_amdgcn_fence(__ATOMIC_ACQUIRE, "agent");
            asm volatile("s_waitcnt vmcnt(0)" ::: "memory");
        }
    }
    __syncthreads();
}

struct Frame {
    LAS unsigned char* lds;
    int tid, lane, wave, vcu, G;
    unsigned char* ws;
    const float *x, *norm_g, *w_in, *qna, *kna, *sinks, *qnb, *knb, *relb, *wpa, *wpb, *wout;
    float* out;
    unsigned long long prof;
};

__device__ __forceinline__ float wave_sum(float v) {
#pragma unroll
    for (int o = 1; o < 64; o <<= 1) v += __shfl_xor(v, o);
    return v;
}
__device__ __forceinline__ int t5_bucket(int n) {
    if (n < 16) return n < 0 ? 0 : n;
    const int l = 16 + (int)(logf((float)n * 0.0625f) / logf(8.0f) * 16.0f);
    return l > 31 ? 31 : l;
}

__device__ __forceinline__ int win_src_col(int n) { return n < 3328 ? n : (n < 5376 ? n + 296 : (n < 5672 ? n - 2048 : -1)); }
template <bool INPROJ>
__device__ __forceinline__ void p0_transpose_item(const float* W, int srcN, int k0, int n0, h16* WT, int ldk, int kdst0, LAS float* scr, int lane, float scale) {
    const int n = n0 + (lane & 31); const int col = INPROJ ? win_src_col(n) : n;
    float wv_[32];
#pragma unroll
    for (int i = 0; i < 32; ++i) { const int kk = 2 * i + (lane >> 5); wv_[i] = (col >= 0) ? W[(size_t)(k0 + kk) * srcN + col] : 0.f; }
#pragma unroll
    for (int i = 0; i < 32; ++i) { const int kk = 2 * i + (lane >> 5); scr[kk * 33 + (lane & 31)] = wv_[i] * scale; }
    LDS_WAIT(); asm volatile("" ::: "memory");
    const int c = lane & 7;
#pragma unroll
    for (int j = 0; j < 4; ++j) { const int nn = (lane >> 3) + 8 * j; const LAS float* s = scr + (8 * c) * 33 + nn;
        float v[8];
#pragma unroll
        for (int e = 0; e < 8; ++e) v[e] = s[e * 33];
        u32x4 o; o.x = pkh(v[0], v[1]); o.y = pkh(v[2], v[3]); o.z = pkh(v[4], v[5]); o.w = pkh(v[6], v[7]);
        *(u32x4*)(WT + (size_t)(n0 + nn) * ldk + kdst0 + k0 + 8 * c) = o;
    }
    LDS_WAIT(); asm volatile("" ::: "memory");
}
__device__ __forceinline__ void p0_norm_rows4(const float* x, const float* g, h16* H, int m0, int mstride, int lane) {
    f32x4 v[4][4];
#pragma unroll
    for (int r = 0; r < 4; ++r)
#pragma unroll
        for (int j = 0; j < 4; ++j) v[r][j] = __builtin_nontemporal_load((const f32x4*)(x + (size_t)(m0 + r * mstride) * DM) + lane + 64 * j);
    f32x4 gg[4];
#pragma unroll
    for (int j = 0; j < 4; ++j) gg[j] = *((const f32x4*)g + lane + 64 * j) * HSCALE;
#pragma unroll
    for (int r = 0; r < 4; ++r) {
        float s = 0.f;
#pragma unroll
        for (int j = 0; j < 4; ++j) s += (v[r][j].x * v[r][j].x + v[r][j].y * v[r][j].y) + (v[r][j].z * v[r][j].z + v[r][j].w * v[r][j].w);
        const float rs = rsqrtf(wave_sum(s) * (1.0f / DM) + RMS_EPS);
#pragma unroll
        for (int j = 0; j < 4; ++j) { const f32x4 hv = v[r][j] * rs * gg[j]; u32x2 hi; hi.x = pkh(hv.x, hv.y); hi.y = pkh(hv.z, hv.w);
            *((u32x2*)(H + (size_t)(m0 + r * mstride) * 1024) + lane + 64 * j) = hi; }
    }
}
__device__ __forceinline__ void p0_prologue(Frame& F) {
    LAS float* scr = (LAS float*)(F.lds + F.wave * 16384);
    h16* Win = (h16*)(F.ws + WS_WIN); h16* Wp = (h16*)(F.ws + WS_WP); h16* Wo = (h16*)(F.ws + WS_WO); h16* Hb = (h16*)(F.ws + WS_H);
    constexpr int I_IN = 16 * 184, I_P = 8 * 32, I_O = 16 * 32;
    static_assert(I_IN + 2 * I_P + I_O == 62 * 64 && MROWS / 4 == 64 * 64, "prologue shards");
    for (int s = F.vcu >> 2; s < 64; s += (F.G + 3) >> 2) {
        unsigned* ctr = (unsigned*)(F.ws + WS_CTL + 40960) + s * 64;
        for (;;) {
            unsigned k = 0u;
            if (F.lane == 0) k = __hip_atomic_fetch_add(ctr, 1u, __ATOMIC_RELAXED, __HIP_MEMORY_SCOPE_AGENT);
            k = (unsigned)__builtin_amdgcn_readfirstlane((int)k);
            if (k >= 126u) break;
            if (k < 62u) {
                int r = s + 64 * (int)k;
                if (r < I_IN) { p0_transpose_item<true>(F.w_in, INW, 64 * (r / 184), 32 * (r % 184), Win, 1024, 0, scr, F.lane, WSCALE); continue; } r -= I_IN;
                if (r < I_P) { p0_transpose_item<false>(F.wpa, DM, 64 * (r / 32), 32 * (r % 32), Wp, 1024, 0, scr, F.lane, 1.f); continue; } r -= I_P;
                if (r < I_P) { p0_transpose_item<false>(F.wpb, DM, 64 * (r / 32), 32 * (r % 32), Wp, 1024, 512, scr, F.lane, 1.f); continue; } r -= I_P;
                p0_transpose_item<false>(F.wout, DM, 64 * (r / 32), 32 * (r % 32), Wo, 1024, 0, scr, F.lane, 1.f);
            } else p0_norm_rows4(F.x, F.norm_g, Hb, 4 * (s + 64 * ((int)k - 62)), 1, F.lane);
        }
    }
}

constexpr int NBIN = 256, ICAP = 32;
constexpr int IW_VALS = 0, IW_HIST = 16384, IW_LIST = IW_HIST + 2 * NBIN * 4, IW_LMASK = IW_LIST + 2 * ICAP * 8, IW_BYTES = IW_LMASK + 512;
static_assert(8 * IW_BYTES <= LDSCTL_OFF, "indexer LDS");
typedef _Float16 h16x4v __attribute__((ext_vector_type(4)));
__device__ __forceinline__ int idx_bin(float v, float smin, float scale) { const int b = (int)((v - smin) * scale); return b > NBIN - 1 ? NBIN - 1 : b; }
__device__ __forceinline__ float wave_minf(float v) {
#pragma unroll
    for (int o = 1; o < 64; o <<= 1) v = fminf(v, __shfl_xor(v, o));
    return v; }
__device__ __forceinline__ float wave_maxf(float v) {
#pragma unroll
    for (int o = 1; o < 64; o <<= 1) v = fmaxf(v, __shfl_xor(v, o));
    return v; }
__device__ __forceinline__ unsigned lowest_bits64(unsigned long long w, unsigned n, unsigned long long& kept) { kept = 0ull; unsigned took = 0u; while (n && w) { const unsigned long long bit = w & (0ull - w); kept |= bit; w ^= bit; --n; ++took; } return took; }
__device__ __forceinline__ unsigned mbcnt64(unsigned long long m) { return __builtin_amdgcn_mbcnt_hi((unsigned)(m >> 32), __builtin_amdgcn_mbcnt_lo((unsigned)m, 0u)); }
__device__ __forceinline__ void idx_select_exact(LAS unsigned char* wl, const LAS float* vals, LAS unsigned* hist, LAS u32x2* clist, LAS unsigned* lm, int ngroup, float lo, float hi, unsigned need, int lane) {
#pragma unroll 1
    for (int level = 0; level < 64; ++level) {
        if (!(hi > lo)) {
            unsigned taken = 0u;
            for (int g = 0; g < ngroup && taken < need; ++g) { const float v = vals[64 * g + lane]; const unsigned long long tm = __ballot(v >= lo && v <= hi); unsigned long long kept;
                taken += lowest_bits64(tm, need - taken, kept); if (lane == 0 && kept) { atomicOr((unsigned*)&lm[2 * g], (unsigned)kept); atomicOr((unsigned*)&lm[2 * g + 1], (unsigned)(kept >> 32)); } }
            return;
        }
        const float scale = ((float)NBIN - 0.5f) / (hi - lo);
        *(LAS u32x4*)((LAS unsigned char*)hist + lane * 16) = (u32x4){0u, 0u, 0u, 0u};
        asm volatile("s_waitcnt lgkmcnt(0)" ::: "memory");
        for (int g = 0; g < ngroup; ++g) { const float v = vals[64 * g + lane]; if (v >= lo && v <= hi) atomicAdd((unsigned*)&hist[idx_bin(v, lo, scale)], 1u); }
        asm volatile("s_waitcnt lgkmcnt(0)" ::: "memory");
        const u32x4 cw = *(const LAS u32x4*)((const LAS unsigned char*)hist + lane * 16);
        const unsigned cnt[4] = {cw.x, cw.y, cw.z, cw.w}; const unsigned s = (cw.x + cw.y) + (cw.z + cw.w);
        unsigned v = s;
#pragma unroll
        for (int o = 1; o < 64; o <<= 1) { const unsigned tmp = (unsigned)__shfl_down((int)v, o); if (lane + o < 64) v += tmp; }
        const unsigned above = v - s; const bool crit = above < need && need <= above + s;
        unsigned cum = above, b_ = 0, r_ = 0, c_ = 0; bool found = false;
#pragma unroll
        for (int e = 3; e >= 0; --e) { const unsigned cc = cnt[e]; if (!found && cum + cc >= need) { found = true; b_ = 4u * lane + e; r_ = need - cum; c_ = cc; } if (!found) cum += cc; }
        const unsigned long long cm = __ballot(crit); const int cl = cm ? (int)__builtin_ctzll(cm) : 0;
        const int bst = __builtin_amdgcn_readlane((int)b_, cl); const unsigned rr = (unsigned)__builtin_amdgcn_readlane((int)r_, cl), cb = (unsigned)__builtin_amdgcn_readlane((int)c_, cl);
        const bool takeall = cb == rr, uselist = !takeall && cb <= (unsigned)ICAP; const int bsel = takeall ? bst : bst + 1;
        float nlo = INFINITY, nhi = -INFINITY; unsigned nm = 0u;
        for (int g = 0; g < ngroup; ++g) {
            const float v = vals[64 * g + lane]; const bool act = v >= lo && v <= hi; const int bn = idx_bin(v, lo, scale);
            const unsigned long long sm = __ballot(act && bn >= bsel), mm = __ballot(act && !takeall && bn == bst);
            if (lane == 0 && sm) { atomicOr((unsigned*)&lm[2 * g], (unsigned)sm); atomicOr((unsigned*)&lm[2 * g + 1], (unsigned)(sm >> 32)); }
            if (mm) { if (act && !takeall && bn == bst) { nlo = fminf(nlo, v); nhi = fmaxf(nhi, v); const unsigned slot = nm + mbcnt64(mm); if (uselist && slot < (unsigned)ICAP) clist[slot] = (u32x2){__float_as_uint(v), (unsigned)(64 * g + lane)}; }
                nm += (unsigned)__popcll(mm); }
        }
        asm volatile("s_waitcnt lgkmcnt(0)" ::: "memory");
        if (takeall) return;
        if (uselist) {
            const u32x2 me = clist[lane & 31]; const float vj = __uint_as_float(me.x); unsigned rank = 0u;
            for (unsigned i2 = 0; i2 < cb; ++i2) { const u32x2 o = clist[i2]; const float vi = __uint_as_float(o.x); rank += (vi > vj || (vi == vj && o.y < me.y)) ? 1u : 0u; }
            if ((unsigned)lane < cb && rank < rr) atomicOr((unsigned*)&lm[me.y >> 5], 1u << (me.y & 31));
            return;
        }
        lo = wave_minf(nlo); hi = wave_maxf(nhi); need = rr;
    }
}
__device__ __forceinline__ void idx_pair(Frame& F, int b, int u) {
    const int lane = F.lane, k16 = lane & 15, fq = lane >> 4, th = lane >> 5;
    const int ta = 2 * u;
    unsigned* gm = (unsigned*)(F.ws + WS_MASK) + (size_t)(b * SEQ + ta) * 64;
    if (ta < 256) {
        const int lo = lane * 32;
        gm[lane] = (ta >= lo + 31) ? 0xffffffffu : (ta >= lo ? ((2u << (ta - lo)) - 1u) : 0u);
        gm[64 + lane] = (ta + 1 >= lo + 31) ? 0xffffffffu : (ta + 1 >= lo ? ((2u << (ta + 1 - lo)) - 1u) : 0u);
        return;
    }
    LAS unsigned char* wl = F.lds + F.wave * IW_BYTES;
    LAS float* vals = (LAS float*)(wl + IW_VALS);
    LAS unsigned* hist = (LAS unsigned*)(wl + IW_HIST);
    LAS u32x2* clist = (LAS u32x2*)(wl + IW_LIST);
    LAS unsigned* lmask = (LAS unsigned*)(wl + IW_LMASK);
    lmask[lane] = 0u; lmask[64 + lane] = 0u;
    TSTART(20)
    TSTART(21)
    const size_t qrow = (size_t)(b * SEQ + ta + (k16 >> 3));
    const h16x8 qh = *(const h16x8*)((const h16*)(F.ws + WS_QH) + qrow * 256 + (k16 & 7) * 32 + fq * 8);
    h16x4v a2[4];
    {   const f32x4 wv = *(const f32x4*)((const float*)(F.ws + WS_WI) + (size_t)(b * SEQ + ta + (fq >> 1)) * 8 + 4 * (fq & 1));
        const h16x4v w16 = __builtin_convertvector(wv, h16x4v); const h16x4v z16 = {(h16)0.f, (h16)0.f, (h16)0.f, (h16)0.f};
        const int myc = ((k16 & 3) == (fq >> 1)) ? (k16 >> 2) : -1;
#pragma unroll
        for (int c4 = 0; c4 < 4; ++c4) a2[c4] = (myc == c4) ? w16 : z16; }
    const int ngroup = (ta + 1) / 64 + 1;
    const h16* kph = (const h16*)(F.ws + WS_KH) + (size_t)(b * SEQ + k16) * 32 + fq * 8;
    h16x8 kb[4][4];
#define IDX_LOADT(slot, c4, grp) do { const int gg_ = (grp) < 32 ? (grp) : 31; kb[slot][c4] = *(const h16x8*)(kph + (size_t)gg_ * 2048 + (c4) * 512); } while (0)
#pragma unroll
    for (int c4 = 0; c4 < 4; ++c4) { IDX_LOADT(0, c4, 0); IDX_LOADT(1, c4, 1); IDX_LOADT(2, c4, 2); IDX_LOADT(3, c4, 3); }
    float vmin0 = INFINITY, vmax0 = -INFINITY, vmin1 = INFINITY, vmax1 = -INFINITY;
#define IDX_GROUP(slot, grp) do { f32x4 d1_[4]; \
        _Pragma("unroll") for (int c4 = 0; c4 < 4; ++c4) d1_[c4] = __builtin_amdgcn_mfma_f32_16x16x32_f16(qh, kb[slot][c4], (f32x4){0.f, 0.f, 0.f, 0.f}, 0, 0, 0); \
        _Pragma("unroll") for (int c4 = 0; c4 < 4; ++c4) IDX_LOADT(slot, c4, (grp) + 4); \
        h16x4v r_[4]; \
        _Pragma("unroll") for (int c4 = 0; c4 < 4; ++c4) r_[c4] = __builtin_elementwise_max(__builtin_convertvector(d1_[c4], h16x4v), (h16x4v){(h16)0.f, (h16)0.f, (h16)0.f, (h16)0.f});     \
        f32x4 d2 = __builtin_amdgcn_mfma_f32_16x16x16f16(a2[0], r_[0], (f32x4){0.f, 0.f, 0.f, 0.f}, 0, 0, 0); \
        d2 = __builtin_amdgcn_mfma_f32_16x16x16f16(a2[1], r_[1], d2, 0, 0, 0); d2 = __builtin_amdgcn_mfma_f32_16x16x16f16(a2[2], r_[2], d2, 0, 0, 0); d2 = __builtin_amdgcn_mfma_f32_16x16x16f16(a2[3], r_[3], d2, 0, 0, 0); \
        const int key_ = 64 * (grp) + lane; const float sa_ = d2[0] + 0.0f, sb_ = d2[1] + 0.0f; const bool va_ = key_ <= ta, vb_ = key_ <= ta + 1; \
        vals[key_] = va_ ? sa_ : __builtin_nanf(""); vals[2048 + key_] = vb_ ? sb_ : __builtin_nanf(""); \
        if (va_) { vmin0 = fminf(vmin0, sa_); vmax0 = fmaxf(vmax0, sa_); } if (vb_) { vmin1 = fminf(vmin1, sb_); vmax1 = fmaxf(vmax1, sb_); } } while (0)
#pragma unroll 1
    for (int g = 0; g < ngroup; g += 4) { IDX_GROUP(0, g); IDX_GROUP(1, g + 1); IDX_GROUP(2, g + 2); IDX_GROUP(3, g + 3); }
#undef IDX_GROUP
#undef IDX_LOADT
    const int ng2 = (ngroup + 3) & ~3;
    TSTOP(21)
    TSTART(22)
    const float lo0 = wave_minf(vmin0), hi0 = wave_maxf(vmax0), lo1 = wave_minf(vmin1), hi1 = wave_maxf(vmax1);
    unsigned wa0 = 0u, wa1 = 0u;
    bool exact0 = !(hi0 > lo0), exact1 = !(hi1 > lo1);
#ifdef FORCE_SLOW
    exact0 = true; exact1 = true;
#endif
    if (!(exact0 && exact1)) {
        const float sc0 = exact0 ? 0.f : ((float)NBIN - 0.5f) / (hi0 - lo0), sc1 = exact1 ? 0.f : ((float)NBIN - 0.5f) / (hi1 - lo1);
        TSTART(23)
        *(LAS u32x4*)(wl + IW_HIST + lane * 16) = (u32x4){0u, 0u, 0u, 0u}; *(LAS u32x4*)(wl + IW_HIST + 1024 + lane * 16) = (u32x4){0u, 0u, 0u, 0u};
        asm volatile("s_waitcnt lgkmcnt(0)" ::: "memory");
#pragma unroll 4
        for (int g = 0; g < ngroup; ++g) { const float va = vals[64 * g + lane], vb = vals[2048 + 64 * g + lane];
            if (!exact0 && va >= lo0) atomicAdd((unsigned*)&hist[idx_bin(va, lo0, sc0)], 1u);
            if (!exact1 && vb >= lo1) atomicAdd((unsigned*)&hist[NBIN + idx_bin(vb, lo1, sc1)], 1u); }
        asm volatile("s_waitcnt lgkmcnt(0)" ::: "memory");
        TSTART(27)
        int bst; unsigned rr, cb;
        {   const int l5 = lane & 31;
            const u32x4 cw0 = *(const LAS u32x4*)(wl + IW_HIST + th * 1024 + l5 * 32), cw1 = *(const LAS u32x4*)(wl + IW_HIST + th * 1024 + l5 * 32 + 16);
            const unsigned cnt[8] = {cw0.x, cw0.y, cw0.z, cw0.w, cw1.x, cw1.y, cw1.z, cw1.w};
            const unsigned s = ((cw0.x + cw0.y) + (cw0.z + cw0.w)) + ((cw1.x + cw1.y) + (cw1.z + cw1.w));
            unsigned v = s;
#pragma unroll
            for (int o = 1; o < 32; o <<= 1) { const unsigned tmp = (unsigned)__shfl_down((int)v, o, 32); if (l5 + o < 32) v += tmp; }
            const unsigned above = v - s, need = 256u; const bool crit = above < need && need <= above + s;
            unsigned cum = above, b_ = 0, r_ = 0, c_ = 0; bool found = false;
#pragma unroll
            for (int e = 7; e >= 0; --e) { const unsigned cc = cnt[e]; if (!found && cum + cc >= need) { found = true; b_ = 8u * l5 + e; r_ = need - cum; c_ = cc; } if (!found) cum += cc; }
            const unsigned long long cm = __ballot(crit);
            const int cla = (unsigned)cm ? (int)__builtin_ctz((unsigned)cm) : 0, clb = (unsigned)(cm >> 32) ? 32 + (int)__builtin_ctz((unsigned)(cm >> 32)) : 32;
            const int bqa = __builtin_amdgcn_readlane((int)b_, cla), bqb = __builtin_amdgcn_readlane((int)b_, clb);
            const unsigned rqa = (unsigned)__builtin_amdgcn_readlane((int)r_, cla), rqb = (unsigned)__builtin_amdgcn_readlane((int)r_, clb), cqa = (unsigned)__builtin_amdgcn_readlane((int)c_, cla), cqb = (unsigned)__builtin_amdgcn_readlane((int)c_, clb);
            const int bst0 = bqa, bst1 = bqb; const unsigned rr0 = rqa, rr1 = rqb, cb0 = cqa, cb1 = cqb;
            TSTOP(27)
            TSTOP(23)
            TSTART(24)
            const bool ta0 = cb0 == rr0, ta1 = cb1 == rr1; const int bsel0 = ta0 ? bst0 : bst0 + 1, bsel1 = ta1 ? bst1 : bst1 + 1;
            const float is0 = exact0 ? 0.f : (hi0 - lo0) * (1.0f / ((float)NBIN - 0.5f)), is1 = exact1 ? 0.f : (hi1 - lo1) * (1.0f / ((float)NBIN - 0.5f));
            const float thrA0 = exact0 ? INFINITY : lo0 + ((float)bsel0 + 0.02f) * is0, thrB0 = exact0 ? INFINITY : lo0 + ((float)bst0 - 0.02f) * is0;
            const float thrA1 = exact1 ? INFINITY : lo1 + ((float)bsel1 + 0.02f) * is1, thrB1 = exact1 ? INFINITY : lo1 + ((float)bst1 - 0.02f) * is1;
            unsigned zc0 = 0u, zc1 = 0u;
#pragma unroll 4
            for (int g = 0; g < ngroup; ++g) {
                const float va = vals[64 * g + lane], vb = vals[2048 + 64 * g + lane];
                const bool a0 = va >= thrA0, a1 = vb >= thrA1, z0 = va >= thrB0 && !a0, z1 = vb >= thrB1 && !a1;
                const unsigned long long sm0 = __ballot(a0), sm1 = __ballot(a1), zm0 = __ballot(z0), zm1 = __ballot(z1);
                if ((lane >> 1) == g) { wa0 = (lane & 1) ? (unsigned)(sm0 >> 32) : (unsigned)sm0; wa1 = (lane & 1) ? (unsigned)(sm1 >> 32) : (unsigned)sm1; }
                if (zm0 | zm1) {
                    const unsigned s0 = zc0 + mbcnt64(zm0), s1 = zc1 + mbcnt64(zm1);
                    if (z0 && s0 < (unsigned)ICAP) clist[s0] = (u32x2){__float_as_uint(va), (unsigned)(64 * g + lane)};
                    if (z1 && s1 < (unsigned)ICAP) clist[ICAP + s1] = (u32x2){__float_as_uint(vb), (unsigned)(64 * g + lane)};
                    zc0 += (unsigned)__popcll(zm0); zc1 += (unsigned)__popcll(zm1);
                }
            }
            asm volatile("s_waitcnt lgkmcnt(0)" ::: "memory");
            TSTART(28)
            if (zc0 > (unsigned)ICAP) exact0 = true;
            if (zc1 > (unsigned)ICAP) exact1 = true;
            {
                const int j = lane & 31; const unsigned zc = th ? zc1 : zc0; const bool skip = th ? exact1 : exact0;
                const float lo_ = th ? lo1 : lo0, sc_ = th ? sc1 : sc0; const int bst_ = th ? bst1 : bst0, bsel_ = th ? bsel1 : bsel0; const bool tka = th ? ta1 : ta0; const unsigned rr_ = th ? rr1 : rr0;
                const u32x2 me = clist[th * ICAP + j]; const float vj = __uint_as_float(me.x);
                const int bj = idx_bin(vj, lo_, sc_);
                const bool have = !skip && (unsigned)j < zc, selj = have && bj >= bsel_, memj = have && !tka && bj == bst_;
                const float vmj = memj ? vj : -INFINITY; unsigned rank = 0u;
                const unsigned zmax = (zc0 > zc1 ? zc0 : zc1) < (unsigned)ICAP ? (zc0 > zc1 ? zc0 : zc1) : (unsigned)ICAP;
                for (unsigned i2 = 0; i2 < zmax; ++i2) {
                    const float va = __int_as_float(__builtin_amdgcn_readlane(__float_as_int(vmj), (int)i2)), vb2 = __int_as_float(__builtin_amdgcn_readlane(__float_as_int(vmj), (int)i2 + 32));
                    const unsigned ka = (unsigned)__builtin_amdgcn_readlane((int)me.y, (int)i2), kb2 = (unsigned)__builtin_amdgcn_readlane((int)me.y, (int)i2 + 32);
                    const float vi = th ? vb2 : va; const unsigned ki = th ? kb2 : ka;
                    rank += (vi > vj || (vi == vj && ki < me.y)) ? 1u : 0u;
                }
                if (selj || (memj && rank < rr_)) atomicOr((unsigned*)&lmask[th * 64 + (me.y >> 5)], 1u << (me.y & 31));
            }
            TSTOP(28)
            TSTOP(24)
            (void)bst; (void)rr; (void)cb;
        }
    }
    if (exact0) { wa0 = 0u; lmask[lane] = 0u; asm volatile("s_waitcnt lgkmcnt(0)" ::: "memory"); idx_select_exact(wl, vals, hist, clist, lmask, ng2 < 32 ? ngroup : ngroup, lo0, hi0, 256u, lane); }
    if (exact1) { wa1 = 0u; lmask[64 + lane] = 0u; asm volatile("s_waitcnt lgkmcnt(0)" ::: "memory"); idx_select_exact(wl, vals + 2048, hist + NBIN, clist + ICAP, lmask + 64, ngroup, lo1, hi1, 256u, lane); }
    asm volatile("s_waitcnt lgkmcnt(0)" ::: "memory");
    gm[lane] = wa0 | lmask[lane]; gm[64 + lane] = wa1 | lmask[64 + lane];
    TSTOP(22)
    TSTOP(20)
}
__device__ __forceinline__ void p2_index_phase(Frame& F) {
    for (int s = F.vcu >> 2; s < 64; s += (F.G + 3) >> 2) {
        unsigned* ctr = (unsigned*)(F.ws + WS_CTL + 16384) + s * 64;
        for (;;) {
            unsigned k = 0u;
            if (F.lane == 0) k = __hip_atomic_fetch_add(ctr, 1u, __ATOMIC_RELAXED, __HIP_MEMORY_SCOPE_AGENT);
            k = (unsigned)__builtin_amdgcn_readfirstlane((int)k);
            if (k >= 128u) break;
            idx_pair(F, s & 7, 1023 - (s >> 3) - 8 * (int)k);
        }
    }
}

constexpr int AT_NSLOT = 5, AT_K = 0, AT_KSZ = 64 * 144, AT_V = AT_NSLOT * AT_KSZ, AT_VSZ = 64 * 192, AT_LUT = AT_V + AT_NSLOT * AT_VSZ, AT_MTAB = AT_LUT + 320 * 4, AT_OST = 0, AT_OSTSZ = 32 * 144;
static_assert(AT_MTAB + 128 <= RING_BYTES && 8 * AT_OSTSZ <= AT_V, "attention LDS");
typedef _Float16 h16x2v __attribute__((ext_vector_type(2)));
__device__ __forceinline__ s16x4 vtr_read(const LAS unsigned char* p) { return __builtin_amdgcn_ds_read_tr16_b64_v4i16((LAS s16x4*)p); }

template <bool ISB>
__device__ __forceinline__ void attn_unit(Frame& F, int b, int h, int qb) {
    const int tid = F.tid, lane = F.lane, wid = F.wave, q = lane & 31, hi = lane >> 5;
    const int q0 = qb * 256, r0 = q0 + wid * 32, t = r0 + q;
    const size_t row = (size_t)b * SEQ + t;
    const h16* Qp; const h16* Kp; const h16* Vp; const h16* Zp; int kvpitch, ycol;
    if (ISB) { Qp = (const h16*)(F.ws + WS_QB) + h * 64; Kp = (const h16*)(F.ws + WS_KB) + h * 64; Vp = (const h16*)(F.ws + WS_VB) + h * 64; Zp = (const h16*)(F.ws + WS_ZB) + h * 64; kvpitch = 512; ycol = 512 + h * 64; }
    else     { Qp = (const h16*)(F.ws + WS_QA) + h * 64; Kp = (const h16*)(F.ws + WS_KVA) + (h >> 2) * 64; Vp = (const h16*)(F.ws + WS_KVA) + 128 + (h >> 2) * 64; Zp = (const h16*)(F.ws + WS_ZA) + h * 64; kvpitch = 256; ycol = h * 64; }
    const unsigned* mrow = (const unsigned*)(F.ws + WS_MASK) + row * 64;
    LAS float* lut = (LAS float*)(F.lds + AT_LUT);
    const int srow = tid >> 3, sch = tid & 7;
    const h16* kg = Kp + ((size_t)b * SEQ + srow) * kvpitch + sch * 8; const h16* vg = Vp + ((size_t)b * SEQ + srow) * kvpitch + sch * 8;
    const int kst = srow * 144 + sch * 16, vst = srow * 192 + sch * 16;
    h16x8 qr[4];
#pragma unroll
    for (int d0 = 0; d0 < 4; ++d0) qr[d0] = *(const h16x8*)(Qp + row * 512 + d0 * 16 + hi * 8);
    h16x8 zpre[4];
#pragma unroll
    for (int i = 0; i < 4; ++i) zpre[i] = *(const h16x8*)(Zp + ((size_t)b * SEQ + r0 + i * 8 + (lane >> 3)) * 512 + (lane & 7) * 8);
    u32x4 kini[4], vini[4]; u32x4 mw4 = {0u, 0u, 0u, 0u};
    if (ISB) { kini[0] = *(const u32x4*)kg; vini[0] = *(const u32x4*)vg; kini[1] = *(const u32x4*)(kg + (size_t)64 * kvpitch); vini[1] = *(const u32x4*)(vg + (size_t)64 * kvpitch); mw4 = *(const u32x4*)mrow; }
    else {
#pragma unroll
        for (int jj = 0; jj < 4; ++jj) { const int kt = 4 * qb - 2 + jj; if (kt >= 0) { kini[jj] = *(const u32x4*)(kg + (size_t)kt * 64 * kvpitch); vini[jj] = *(const u32x4*)(vg + (size_t)kt * 64 * kvpitch); } } }
    for (int i = tid; i < 320; i += NTHREADS) { const int dist = 223 - i; float v;
        if (ISB) v = dist < 0 ? 0.f : (F.relb[t5_bucket(dist > 127 ? 127 : dist) * 16 + 8 + h] - F.relb[31 * 16 + 8 + h]) * LOG2E;
        else v = (dist >= 0 && dist < 128) ? F.relb[t5_bucket(dist) * 16 + h] * LOG2E : -INFINITY;
        lut[i] = v; }
    if (tid < 16) { u32x2 e; e.x = ((tid & 1) ? 0xffffu : 0u) | ((tid & 2) ? 0xffff0000u : 0u); e.y = ((tid & 4) ? 0xffffu : 0u) | ((tid & 8) ? 0xffff0000u : 0u); *(LAS u32x2*)(F.lds + AT_MTAB + tid * 8) = e; }
    {   const float* qg = ISB ? F.qnb : F.qna; float ss = 0.f;
#pragma unroll
        for (int d0 = 0; d0 < 4; ++d0) {
#pragma unroll
            for (int e = 0; e < 8; ++e) { const float f = (float)qr[d0][e]; ss += f * f; } }
        ss += __shfl_xor(ss, 32);
        const float rq = rsqrtf(ss * (1.0f / 64.0f) + RMS_EPS) * QSCALE;
#pragma unroll
        for (int d0 = 0; d0 < 4; ++d0) { const f32x4 g0 = *(const f32x4*)(qg + d0 * 16 + hi * 8), g1 = *(const f32x4*)(qg + d0 * 16 + hi * 8 + 4);
            u32x4 w; w.x = pkh((float)qr[d0][0] * rq * g0[0], (float)qr[d0][1] * rq * g0[1]); w.y = pkh((float)qr[d0][2] * rq * g0[2], (float)qr[d0][3] * rq * g0[3]);
            w.z = pkh((float)qr[d0][4] * rq * g1[0], (float)qr[d0][5] * rq * g1[1]); w.w = pkh((float)qr[d0][6] * rq * g1[2], (float)qr[d0][7] * rq * g1[3]);
            qr[d0] = __builtin_bit_cast(h16x8, w); } }
    float kgn[8];
    {   const float* kgp = (ISB ? F.knb : F.kna) + (tid & 7) * 8; const f32x4 g0 = *(const f32x4*)kgp, g1 = *(const f32x4*)(kgp + 4);
        kgn[0] = g0[0]; kgn[1] = g0[1]; kgn[2] = g0[2]; kgn[3] = g0[3]; kgn[4] = g1[0]; kgn[5] = g1[1]; kgn[6] = g1[2]; kgn[7] = g1[3]; }
#define KNORM(KR) do { const h16x8 kv_ = __builtin_bit_cast(h16x8, KR); float f_[8]; float ss_ = 0.f; \
        _Pragma("unroll") for (int e = 0; e < 8; ++e) { f_[e] = (float)kv_[e]; ss_ += f_[e] * f_[e]; } \
        ss_ += __shfl_xor(ss_, 1); ss_ += __shfl_xor(ss_, 2); ss_ += __shfl_xor(ss_, 4); \
        const float rk_ = rsqrtf(ss_ * (1.0f / 64.0f) + RMS_EPS); \
        KR.x = pkh(f_[0] * rk_ * kgn[0], f_[1] * rk_ * kgn[1]); KR.y = pkh(f_[2] * rk_ * kgn[2], f_[3] * rk_ * kgn[3]); \
        KR.z = pkh(f_[4] * rk_ * kgn[4], f_[5] * rk_ * kgn[5]); KR.w = pkh(f_[6] * rk_ * kgn[6], f_[7] * rk_ * kgn[7]); } while (0)
    float m_run = -INFINITY, l_run = 0.f;
    f32x16 o[2];
#pragma unroll
    for (int r = 0; r < 16; ++r) { o[0][r] = 0.f; o[1][r] = 0.f; }
    const int kfo = q * 144 + hi * 16;
    const int vfo = (4 * hi + ((lane & 15) >> 2)) * 192 + ((lane >> 4) & 1) * 32 + (lane & 3) * 8;
#define ATT_TILE(SLOT, K0) do { const int k0_ = (K0); const LAS unsigned char* kb = F.lds + AT_K + (SLOT) * AT_KSZ + kfo; const LAS unsigned char* vb = F.lds + AT_V + (SLOT) * AT_VSZ + vfo; \
            f32x16 p0, p1; \
            _Pragma("unroll") \
            for (int r = 0; r < 16; ++r) { p0[r] = 0.f; p1[r] = 0.f; } \
            _Pragma("unroll") \
            for (int d0 = 0; d0 < 4; ++d0) { \
                const h16x8 ka = *(const LAS h16x8*)(kb + d0 * 32), kc = *(const LAS h16x8*)(kb + 32 * 144 + d0 * 32); \
                p0 = __builtin_amdgcn_mfma_f32_32x32x16_f16(ka, qr[d0], p0, 0, 0, 0); \
                p1 = __builtin_amdgcn_mfma_f32_32x32x16_f16(kc, qr[d0], p1, 0, 0, 0); \
            } \
 \
            if (!ISB || (r0 - k0_ - 63 < 113)) { \
                const LAS float* lp = lut + (223 - (t - k0_ - 4 * hi)); \
            _Pragma("unroll") \
                for (int r = 0; r < 16; ++r) { const int c = (r & 3) + 8 * (r >> 2); p0[r] += lp[c]; p1[r] += lp[32 + c]; } \
            } \
 \
            h16x2v s2[16]; \
            _Pragma("unroll") \
            for (int j = 0; j < 8; ++j) { s2[j] = __builtin_convertvector((f32x2){p0[2 * j], p0[2 * j + 1]}, h16x2v); s2[8 + j] = __builtin_convertvector((f32x2){p1[2 * j], p1[2 * j + 1]}, h16x2v); } \
            h16x2v m2 = __builtin_elementwise_max(s2[0], s2[1]); \
            _Pragma("unroll") \
            for (int j = 2; j < 16; ++j) m2 = __builtin_elementwise_max(m2, s2[j]); \
            float mx = fmaxf((float)m2.x, (float)m2.y); \
            mx = fmaxf(mx, __shfl_xor(mx, 32)); \
            const float mnew = fmaxf(m_run, mx), muse = (mnew == -INFINITY) ? 0.f : mnew; \
            if (__any(mnew > m_run)) { \
                const float alpha = __builtin_amdgcn_exp2f(m_run - muse); \
                l_run *= alpha; \
            _Pragma("unroll") \
                for (int r = 0; r < 16; ++r) { o[0][r] *= alpha; o[1][r] *= alpha; } \
            } \
            m_run = mnew; \
            const h16 nm = (h16)(-muse); const h16x2v nm2 = {nm, nm}; \
            _Pragma("unroll") \
            for (int j = 0; j < 16; ++j) { const h16x2v a = s2[j] + nm2; s2[j].x = __builtin_exp2f16(a.x); s2[j].y = __builtin_exp2f16(a.y); } \
            if (ISB) { \
                const unsigned mm0 = mw.x >> (4 * hi), mm1 = mw.y >> (4 * hi); \
            _Pragma("unroll") \
                for (int g4 = 0; g4 < 4; ++g4) { \
                    const u32x2 e0 = *(const LAS u32x2*)(F.lds + AT_MTAB + ((mm0 >> (8 * g4)) & 15u) * 8), e1 = *(const LAS u32x2*)(F.lds + AT_MTAB + ((mm1 >> (8 * g4)) & 15u) * 8); \
                    s2[2 * g4] = __builtin_bit_cast(h16x2v, __builtin_bit_cast(unsigned, s2[2 * g4]) & e0.x); s2[2 * g4 + 1] = __builtin_bit_cast(h16x2v, __builtin_bit_cast(unsigned, s2[2 * g4 + 1]) & e0.y); \
                    s2[8 + 2 * g4] = __builtin_bit_cast(h16x2v, __builtin_bit_cast(unsigned, s2[8 + 2 * g4]) & e1.x); s2[8 + 2 * g4 + 1] = __builtin_bit_cast(h16x2v, __builtin_bit_cast(unsigned, s2[8 + 2 * g4 + 1]) & e1.y); \
                } \
            } \
            {   h16x2v a0 = s2[0] + s2[1], a1 = s2[2] + s2[3], a2 = s2[4] + s2[5], a3 = s2[6] + s2[7], a4 = s2[8] + s2[9], a5 = s2[10] + s2[11], a6 = s2[12] + s2[13], a7 = s2[14] + s2[15]; \
                a0 = a0 + a1; a2 = a2 + a3; a4 = a4 + a5; a6 = a6 + a7; \
                l_run += (((float)a0.x + (float)a0.y) + ((float)a2.x + (float)a2.y)) + (((float)a4.x + (float)a4.y) + ((float)a6.x + (float)a6.y)); } \
            u32x4 pk[4]; \
            _Pragma("unroll") \
            for (int s = 0; s < 4; ++s) pk[s] = (u32x4){__builtin_bit_cast(unsigned, s2[4 * s]), __builtin_bit_cast(unsigned, s2[4 * s + 1]), __builtin_bit_cast(unsigned, s2[4 * s + 2]), __builtin_bit_cast(unsigned, s2[4 * s + 3])}; \
            _Pragma("unroll") \
            for (int s = 0; s < 4; ++s) \
            _Pragma("unroll") \
                for (int d1 = 0; d1 < 2; ++d1) { \
                    const s16x4 lo4 = vtr_read(vb + (16 * s) * 192 + d1 * 64), hi4 = vtr_read(vb + (16 * s + 8) * 192 + d1 * 64); \
                    const h16x4 lf = __builtin_bit_cast(h16x4, lo4), hf = __builtin_bit_cast(h16x4, hi4); \
                    const h16x8 vf = {lf[0], lf[1], lf[2], lf[3], hf[0], hf[1], hf[2], hf[3]}; \
                    o[d1] = __builtin_amdgcn_mfma_f32_32x32x16_f16(vf, __builtin_bit_cast(h16x8, pk[s]), o[d1], 0, 0, 0); \
                } \
        } while (0)
    if (ISB) {
        const int npair = 2 * qb + 2;
        u32x4 kreg0 = kini[0], vreg0 = vini[0], kreg1 = kini[1], vreg1 = vini[1];
        u32x4 mw4n = {0u, 0u, 0u, 0u};
        KNORM(kreg0); KNORM(kreg1);
        *(LAS u32x4*)(F.lds + AT_K + kst) = kreg0; *(LAS u32x4*)(F.lds + AT_V + vst) = vreg0; *(LAS u32x4*)(F.lds + AT_K + AT_KSZ + kst) = kreg1; *(LAS u32x4*)(F.lds + AT_V + AT_VSZ + vst) = vreg1;
        __syncthreads();
#pragma unroll 1
        for (int pr = 0; pr < npair; ++pr) {
            const int sb = (pr & 1) * 2, kt = 2 * pr;
            if (pr + 1 < npair) { const size_t go = (size_t)(kt + 2) * 64 * kvpitch; kreg0 = *(const u32x4*)(kg + go); vreg0 = *(const u32x4*)(vg + go); kreg1 = *(const u32x4*)(kg + go + (size_t)64 * kvpitch); vreg1 = *(const u32x4*)(vg + go + (size_t)64 * kvpitch);
                mw4n = *(const u32x4*)(mrow + 2 * (kt + 2)); }
            TSTART(31)
            { const u32x2 mw = {mw4.x, mw4.y}; const int k0 = kt * 64; if (k0 <= r0 + 31) ATT_TILE(sb, k0); }
            { const u32x2 mw = {mw4.z, mw4.w}; const int k0 = kt * 64 + 64; if (k0 <= r0 + 31) ATT_TILE(sb + 1, k0); }
            TSTOP(31)
            TSTART(32)
            if (pr + 1 < npair) { KNORM(kreg0); KNORM(kreg1); const int sn = 2 - sb;
                *(LAS u32x4*)(F.lds + AT_K + sn * AT_KSZ + kst) = kreg0; *(LAS u32x4*)(F.lds + AT_V + sn * AT_VSZ + vst) = vreg0;
                *(LAS u32x4*)(F.lds + AT_K + (sn + 1) * AT_KSZ + kst) = kreg1; *(LAS u32x4*)(F.lds + AT_V + (sn + 1) * AT_VSZ + vst) = vreg1; mw4 = mw4n; }
            TSTOP(32)
            TSTART(33)
            __syncthreads();
            TSTOP(33)
        }
    } else {
#pragma unroll
        for (int jj = 0; jj < 4; ++jj) { const int kt = 4 * qb - 2 + jj; if (kt >= 0) { KNORM(kini[jj]); *(LAS u32x4*)(F.lds + AT_K + jj * AT_KSZ + kst) = kini[jj]; *(LAS u32x4*)(F.lds + AT_V + jj * AT_VSZ + vst) = vini[jj]; } }
        __syncthreads();
        const int base_w = wid >> 1;
        u32x4 kreg, vreg; const u32x2 mw = {0u, 0u};
#pragma unroll 1
        for (int s = 0; s < 3; ++s) {
            if (s < 2) { kreg = *(const u32x4*)(kg + (size_t)(4 * qb + 2 + s) * 64 * kvpitch); vreg = *(const u32x4*)(vg + (size_t)(4 * qb + 2 + s) * 64 * kvpitch); }
            const int j = base_w + s, kt = 4 * qb - 2 + j;
            TSTART(31)
            if (kt >= 0) ATT_TILE((j == 5 ? 0 : j), kt * 64);
            TSTOP(31)
            if (s < 2) { const int sl = (s == 0) ? 4 : 0; KNORM(kreg); *(LAS u32x4*)(F.lds + AT_K + sl * AT_KSZ + kst) = kreg; *(LAS u32x4*)(F.lds + AT_V + sl * AT_VSZ + vst) = vreg; }
            TSTART(33)
            __syncthreads();
            TSTOP(33)
        }
    }
    TSTART(34)
    l_run += __shfl_xor(l_run, 32);
    if (!ISB) l_run += __builtin_amdgcn_exp2f(F.sinks[h] * LOG2E - m_run);
    const float inv = 1.0f / l_run;
    LAS unsigned char* ost = F.lds + AT_OST + wid * AT_OSTSZ;
#pragma unroll
    for (int d1 = 0; d1 < 2; ++d1)
#pragma unroll
        for (int g4 = 0; g4 < 4; ++g4) { u32x2 w; w.x = pkh(o[d1][4 * g4] * inv, o[d1][4 * g4 + 1] * inv); w.y = pkh(o[d1][4 * g4 + 2] * inv, o[d1][4 * g4 + 3] * inv);
            *(LAS u32x2*)(ost + q * 144 + (32 * d1 + 8 * g4 + 4 * hi) * 2) = w; }
    LDS_WAIT(); asm volatile("" ::: "memory");
    h16* Yp = (h16*)(F.ws + WS_Y);
#pragma unroll
    for (int i = 0; i < 4; ++i) { const int rr = i * 8 + (lane >> 3), ch = lane & 7; const size_t grow = (size_t)b * SEQ + r0 + rr;
        const h16x8 ov = *(const LAS h16x8*)(ost + rr * 144 + ch * 16); const h16x8 zv = zpre[i];
        float y[8];
#pragma unroll
        for (int e = 0; e < 8; ++e) { const float z = (float)zv[e]; y[e] = (float)ov[e] * z * sigmoidf_fast(z); }
        u32x4 w; w.x = pkh(y[0], y[1]); w.y = pkh(y[2], y[3]); w.z = pkh(y[4], y[5]); w.w = pkh(y[6], y[7]);
        *(u32x4*)(Yp + grow * 1024 + ycol + ch * 8) = w; }
    __syncthreads();
    TSTOP(34)
#undef KNORM
#undef ATT_TILE
}
__device__ __forceinline__ void p2_mixer_a(Frame& F) {
    __syncthreads();
    for (int v = F.vcu; v < 256; v += F.G) {
        const int bh = v >> 2, j = v & 3, b = bh >> 3, h = bh & 7;
        { TSTART(35) attn_unit<false>(F, b, h, 2 * j); attn_unit<false>(F, b, h, 2 * j + 1); TSTOP(35) }
    }
}
__device__ __forceinline__ void p3_attention_phase(Frame& F) {
    for (int v = F.vcu; v < 256; v += F.G) {
        const int bh = v >> 2, j = v & 3, b = bh >> 3, h = bh & 7;
        { TSTART(36) attn_unit<true>(F, b, h, 7 - j); attn_unit<true>(F, b, h, j); TSTOP(36) }
    }
}

struct Args { const float* in[12]; float* out; unsigned char* ws; int ph_lo, ph_hi; };
constexpr int N_PHASES = 6;
__global__ void __launch_bounds__(NTHREADS, 2) mk_fwd(Args args) {
    extern __shared__ __attribute__((aligned(16))) unsigned char lds_raw[];
    cg::grid_group grid = cg::this_grid();
    Frame F;
    F.lds = (LAS unsigned char*)lds_raw;
    F.tid = threadIdx.x; F.lane = F.tid & 63; F.wave = __builtin_amdgcn_readfirstlane(F.tid >> 6);
    F.G = gridDim.x; { const int bx = blockIdx.x; F.vcu = (F.G % 8 == 0) ? (bx % 8) * (F.G / 8) + bx / 8 : bx; }
    F.ws = args.ws; F.prof = 0ull;
    F.x = args.in[0]; F.norm_g = args.in[1]; F.w_in = args.in[2]; F.qna = args.in[3]; F.kna = args.in[4]; F.sinks = args.in[5];
    F.qnb = args.in[6]; F.knb = args.in[7]; F.relb = args.in[8]; F.wpa = args.in[9]; F.wpb = args.in[10]; F.wout = args.in[11]; F.out = args.out;
    const int lo = args.ph_lo, hi = args.ph_hi;
    if (lo < 0) grid.sync();
    if (F.tid < 64) ((LAS unsigned*)(F.lds + LDSCTL_OFF))[F.tid] = 0u;
    __syncthreads();
    XcdBarrier bar = xcd_barrier_post((unsigned*)(F.ws + WS_CTL), (volatile LAS unsigned*)(F.lds + LDSCTL_OFF) + 8);
#ifdef ONLY_PH
#define IN(k) ((k) == ONLY_PH && lo <= (k) && (k) < hi)
#else
#define IN(k) (lo <= (k) && (k) < hi)
#endif
#ifdef PROBE_SYNC2
#define SEAM(k) do { if (IN(k) && IN((k) + 1)) { xcd_barrier(bar); xcd_barrier(bar); } } while (0)
#else
#define SEAM(k) do { if (IN(k) && IN((k) + 1)) xcd_barrier(bar); } while (0)
#endif
    { TSTART(1) if (IN(0)) { p0_prologue(F); }
    SEAM(0); TSTOP(1) }
    TSTART(2)
    if (IN(1)) {
        pg8::GemmPlain g{(const h16*)(F.ws + WS_H), (const h16*)(F.ws + WS_WIN), 1024, 1024};
        pg8::StaticOrder S; S.init(MROWS, 23 * 256, F.G, (int)blockIdx.x);
        pg8::EpiIn E{F.ws, (h16*)F.out};
        pg8::gemm_phase<pg8::EpiIn, pg8::StaticOrder, pg8::GemmPlain, true, true>(F.lds, g, S, E);
    }
    SEAM(1);
    TSTOP(2)
    { TSTART(3) if (IN(2)) { p2_index_phase(F); p2_mixer_a(F); }
#if defined(PROF_SEG) && defined(PROF_MAXWAVE)
    if (F.lane == 0) atomicMax((unsigned long long*)(F.ws + WS_CTL + 32768), F.prof);
#endif
    SEAM(2); TSTOP(3) }
    { TSTART(4) if (IN(3)) { p3_attention_phase(F); }
    SEAM(3); TSTOP(4) }
    TSTART(5)
    if (IN(4)) {
        pg8::GemmPlain g{(const h16*)(F.ws + WS_Y), (const h16*)(F.ws + WS_WP), 1024, 1024};
        pg8::StaticOrder S; S.init(MROWS, DM, F.G, (int)blockIdx.x);
        pg8::EpiMerge E{(const h16*)F.out, (h16*)(F.ws + WS_MG)};
        pg8::gemm_phase<pg8::EpiMerge, pg8::StaticOrder, pg8::GemmPlain, true, true>(F.lds, g, S, E);
    }
    SEAM(4);
    TSTOP(5)
    TSTART(6)
    if (IN(5)) {
        pg8::GemmPlain g{(const h16*)(F.ws + WS_MG), (const h16*)(F.ws + WS_WO), 1024, 1024};
        pg8::StaticOrder S; S.init(MROWS, DM, F.G, (int)blockIdx.x);
        pg8::EpiOut E{F.x, F.out};
        pg8::gemm_phase<pg8::EpiOut, pg8::StaticOrder, pg8::GemmPlain, true, true>(F.lds, g, S, E);
    }
    TSTOP(6)
#undef IN
#undef SEAM
#ifdef PROF_SEG
#ifdef PROF_MAXWAVE
    if (blockIdx.x == PROF_BLK && F.wave == PROF_WAVE) F.prof = __hip_atomic_load((unsigned long long*)(F.ws + WS_CTL + 32768), __ATOMIC_RELAXED, __HIP_MEMORY_SCOPE_AGENT);
#endif
    if (blockIdx.x == PROF_BLK && F.wave == PROF_WAVE && hi == N_PHASES) { const unsigned long long t1 = __builtin_amdgcn_s_memrealtime() + F.prof * PROF_MULT; while (__builtin_amdgcn_s_memrealtime() < t1) __builtin_amdgcn_s_sleep(8); }
#endif
}

extern "C" void kernel_launch(void* const* d_in, const int* in_sizes, int n_in, void* d_out, int out_size, void* d_ws, size_t ws_size, hipStream_t stream) {
    static int grid = 0;
    if (grid == 0) {
        if (n_in != 12 || in_sizes[0] != MROWS * DM || out_size != MROWS * DM || ws_size < WS_END) { fprintf(stderr, "kernel_launch: unexpected problem (n_in %d, ws %zu)\n", n_in, ws_size); grid = -1; return; }
        int dev = 0, cus = 0, per_cu = 0;
        hipGetDevice(&dev); hipDeviceGetAttribute(&cus, hipDeviceAttributeMultiprocessorCount, dev);
        hipFuncSetAttribute((const void*)mk_fwd, hipFuncAttributeMaxDynamicSharedMemorySize, LDS_BYTES);
        hipOccupancyMaxActiveBlocksPerMultiprocessor(&per_cu, (const void*)mk_fwd, NTHREADS, LDS_BYTES);
        (void)hipGetLastError();
        if (per_cu < 1) { fprintf(stderr, "kernel_launch: occupancy query says %d blocks/CU\n", per_cu); per_cu = 1; }
        grid = cus;
        if (grid > 256) grid = 256;
    }
    if (grid < 0) return;
    (void)hipMemsetAsync((char*)d_ws + WS_CTL, 0, CTL_BYTES, stream);
    Args a{};
    for (int i = 0; i < 12; ++i) a.in[i] = (const float*)d_in[i];
    a.out = (float*)d_out; a.ws = (unsigned char*)d_ws;
#ifdef PROBE_PH
    {
        void* kargs[] = {&a};
        a.ph_lo = 0; a.ph_hi = PROBE_PH + 1;
        (void)hipLaunchCooperativeKernel((const void*)mk_fwd, dim3(grid), dim3(NTHREADS), kargs, LDS_BYTES, stream);
        (void)hipMemsetAsync((char*)d_ws + WS_CTL, 0, CTL_BYTES, stream);
#ifdef PROBE_SPLIT_ONLY
        a.ph_lo = PROBE_PH + 1; a.ph_hi = N_PHASES;
#else
        a.ph_lo = PROBE_PH; a.ph_hi = N_PHASES;
#endif
        (void)hipLaunchCooperativeKernel((const void*)mk_fwd, dim3(grid), dim3(NTHREADS), kargs, LDS_BYTES, stream);
    }
#else
    {
        a.ph_lo = 0; a.ph_hi = N_PHASES;
        void* kargs[] = {&a};
        hipError_t e = hipLaunchCooperativeKernel((const void*)mk_fwd, dim3(grid), dim3(NTHREADS), kargs, LDS_BYTES, stream);
        if (e != hipSuccess) fprintf(stderr, "cooperative launch failed: %s (grid %d)\n", hipGetErrorString(e), grid);
    }
#endif
}
```

```cpp
#include <hip/hip_runtime.h>
#include <cstdio>
#include <cstdint>
#ifdef PROF_SEG
#ifndef PROF_MULT
#define PROF_MULT 4
#endif
#ifndef PROF_BLK
#define PROF_BLK 100
#endif
#ifndef PROF_WAVE
#define PROF_WAVE 3
#endif
#endif

#define LAS __attribute__((address_space(3)))
typedef _Float16 h16;
typedef _Float16 h16x2 __attribute__((ext_vector_type(2)));
typedef _Float16 h16x4 __attribute__((ext_vector_type(4)));
typedef _Float16 h16x8 __attribute__((ext_vector_type(8)));
typedef float f32x2 __attribute__((ext_vector_type(2)));
typedef float f32x4 __attribute__((ext_vector_type(4)));
typedef float f32x16 __attribute__((ext_vector_type(16)));
typedef unsigned u32x2 __attribute__((ext_vector_type(2)));
typedef unsigned u32x4 __attribute__((ext_vector_type(4)));
typedef short s16x4 __attribute__((ext_vector_type(4)));

__device__ __forceinline__ unsigned pkh(float lo, float hi) { const f32x2 v = {lo, hi}; const h16x2 h = __builtin_convertvector(v, h16x2); return __builtin_bit_cast(unsigned, h); }
__device__ __forceinline__ float sigmoidf_fast(float g) { g = fminf(fmaxf(g, -30.f), 30.f); return __builtin_amdgcn_rcpf(1.0f + __builtin_amdgcn_exp2f(-1.4426950408889634f * g)); }

constexpr int NBATCH = 8, SEQ = 2048, DM = 1024, MROWS = NBATCH * SEQ, INW = 5672;
constexpr float RMS_EPS = 1e-6f, LOG2E = 1.4426950408889634f, QSCALE = 0.125f * 1.4426950408889634f;
constexpr float HSCALE = 16.f, WSCALE = 64.f, INV_HW = 1.0f / (16.f * 64.f);
constexpr size_t MiB = 1u << 20;
constexpr size_t WS_H = 0;
constexpr size_t WS_Y = 0, WS_MG = 32 * MiB;
constexpr size_t WS_QH = 32 * MiB, WS_QL = 40 * MiB, WS_KH = 48 * MiB, WS_KL = 49 * MiB, WS_WI = 50 * MiB;
constexpr size_t WS_WIN = 64 * MiB;
constexpr size_t WS_WP = 77 * MiB, WS_WO = 79 * MiB;
constexpr size_t WS_QA = 81 * MiB, WS_KVA = 97 * MiB, WS_ZA = 105 * MiB, WS_QB = 121 * MiB, WS_KB = 137 * MiB, WS_VB = 153 * MiB, WS_ZB = 169 * MiB;
constexpr size_t WS_MASK = 185 * MiB;
constexpr size_t WS_CTL = 190 * MiB, CTL_BYTES = 65536;
constexpr size_t WS_END = 191 * MiB;

namespace pg8 {
#define PG8_LAS __attribute__((address_space(3)))
constexpr int BM = 256, BK = 64, HALF = 128, HTB = HALF * BK * 2  , STAGE_BYTES = 8 * HTB, NXCD = 8, WGM = 8;

__host__ __device__ __forceinline__ int lds_byte(int r, int c) { const int st = (r >> 4) * 2 + (c >> 5), rr = r & 15, cc = c & 31, ob = rr * 64 + cc * 2; return st * 1024 + (ob ^ (((ob >> 9) & 1) << 5)); }
__host__ __device__ __forceinline__ void stage_rc(int b, int& R, int& C) { const int st = b / 1024, sb = b % 1024, swz = sb ^ (((sb >> 9) & 1) << 5); R = (st >> 1) * 16 + swz / 64; C = (st & 1) * 32 + (swz % 64) / 2; }
__host__ __device__ __forceinline__ int perm32(int rho) { const int n = rho >> 4, i = rho & 15; return 8 * (i >> 2) + 4 * n + (i & 3); }

struct Unit { int pm, pn; };

struct StaticOrder {
    int nM, nN, nwg, G, c;
    __host__ __device__ void init(int M, int N, int G_, int c_) { nM = M / BM; nN = N / BM; nwg = nM * nN; G = G_; c = c_; }
    __host__ __device__ bool next(int i, Unit& u) const {
        const long L = (long)i * G + c; if (L >= nwg) return false;
        int wgid = (int)L; { const int q = nwg / NXCD, r = nwg % NXCD, xcd = wgid % NXCD, off = wgid / NXCD; wgid = (xcd < r ? xcd * (q + 1) : r * (q + 1) + (xcd - r) * q) + off; }
        const int nig = WGM * nN, gid = wgid / nig, fm = gid * WGM, gsz = (nM - fm) < WGM ? (nM - fm) : WGM;
        u.pm = fm + ((wgid % nig) % gsz); u.pn = (wgid % nig) / gsz; return true;
    }
    __device__ __forceinline__ void a_ready(const Unit&) const {}
    __device__ __forceinline__ void done(const Unit&) const {}
};

struct GemmPlain { const h16* A; const h16* Bt; int lda, K;
    __device__ __forceinline__ const char* aptr(const Unit& u) const { return (const char*)(A + (size_t)u.pm * BM * lda); }
    __device__ __forceinline__ const char* bptr(const Unit& u) const { return (const char*)(Bt + (size_t)u.pn * BM * K); } };
struct EpiIn {
    static constexpr bool PERM = true, AFTER_DRAIN = false, MID = false;
    unsigned char* ws; h16* G;
    __device__ __forceinline__ void operator()(const f32x4 (&acc)[2][2][4][2], const Unit& u, int wr, int wc, int fr, int fq) const {
        const int pn = u.pn, row0 = u.pm * BM + wr * 64 + fr, cl = wc * 32 + 8 * fq;
        if (pn < 21) {
            h16* base; int ldc, colt;
            if (pn < 2)       { base = (h16*)(ws + WS_QA);  ldc = 512; colt = pn * 256; }
            else if (pn == 2) { base = (h16*)(ws + WS_KVA); ldc = 256; colt = 0; }
            else if (pn < 5)  { base = (h16*)(ws + WS_ZA);  ldc = 512; colt = (pn - 3) * 256; }
            else if (pn < 7)  { base = (h16*)(ws + WS_QB);  ldc = 512; colt = (pn - 5) * 256; }
            else if (pn < 9)  { base = (h16*)(ws + WS_KB);  ldc = 512; colt = (pn - 7) * 256; }
            else if (pn < 11) { base = (h16*)(ws + WS_VB);  ldc = 512; colt = (pn - 9) * 256; }
            else if (pn < 13) { base = (h16*)(ws + WS_ZB);  ldc = 512; colt = (pn - 11) * 256; }
            else              { base = G;                   ldc = 2048; colt = (pn - 13) * 256; }
#pragma unroll
            for (int ai = 0; ai < 2; ++ai)
#pragma unroll
                for (int m = 0; m < 4; ++m) { h16* rowp = base + (size_t)(row0 + ai * HALF + m * 16) * ldc + colt + cl;
#pragma unroll
                    for (int bj = 0; bj < 2; ++bj) { const f32x4 v0 = acc[ai][bj][m][0] * INV_HW, v1 = acc[ai][bj][m][1] * INV_HW;
                        u32x4 w; w.x = pkh(v0[0], v0[1]); w.y = pkh(v0[2], v0[3]); w.z = pkh(v1[0], v1[1]); w.w = pkh(v1[2], v1[3]);
                        *(u32x4*)(rowp + bj * HALF) = w; } }
        } else {
            const int colt = (pn - 21) * 256 + cl;
#pragma unroll
            for (int ai = 0; ai < 2; ++ai)
#pragma unroll
                for (int m = 0; m < 4; ++m) { const size_t r = (size_t)(row0 + ai * HALF + m * 16);
#pragma unroll
                    for (int bj = 0; bj < 2; ++bj) { const int j = colt + bj * HALF; const f32x4 v0 = acc[ai][bj][m][0] * INV_HW, v1 = acc[ai][bj][m][1] * INV_HW;
                        if (j < 288) {
                            u32x4 hi; hi.x = pkh(v0[0] * 16.f, v0[1] * 16.f); hi.y = pkh(v0[2] * 16.f, v0[3] * 16.f); hi.z = pkh(v1[0] * 16.f, v1[1] * 16.f); hi.w = pkh(v1[2] * 16.f, v1[3] * 16.f);
                            if (j < 256) *(u32x4*)((h16*)(ws + WS_QH) + r * 256 + j) = hi; else *(u32x4*)((h16*)(ws + WS_KH) + r * 32 + (j - 256)) = hi;
                        } else if (j < 296) { float* w = (float*)(ws + WS_WI) + r * 8; *(f32x4*)w = v0; *(f32x4*)(w + 4) = v1; }
                    } }
        }
    }
};
struct EpiMerge {
    static constexpr bool PERM = true, AFTER_DRAIN = false, MID = true;
    const h16* G; h16* MG; unsigned long long* prof;
    __device__ __forceinline__ void mid(f32x4 (&acc)[2][2][4][2], const Unit& u, int wr, int wc, int fr, int fq) const {
        const int row0 = u.pm * BM + wr * 64 + fr, col0 = u.pn * BM + wc * 32 + 8 * fq;
#if defined(PROF_SEG) && PROF_SEG == 40
        asm volatile("s_waitcnt vmcnt(0) lgkmcnt(0)" ::: "memory"); const unsigned long long tp0 = __builtin_amdgcn_s_memrealtime();
#endif
#pragma unroll
        for (int ai = 0; ai < 2; ++ai) {
            unsigned ro = (unsigned)(row0 + ai * HALF); asm volatile("" : "+v"(ro));
            h16x8 ga[4][2], gb[4][2];
#pragma unroll
            for (int m = 0; m < 4; ++m)
#pragma unroll
                for (int bj = 0; bj < 2; ++bj) { const h16* gp = G + (size_t)(ro + m * 16) * 2048 + col0 + bj * HALF; ga[m][bj] = *(const h16x8*)gp; gb[m][bj] = *(const h16x8*)(gp + 1024); }
#pragma unroll
            for (int m = 0; m < 4; ++m)
#pragma unroll
                for (int bj = 0; bj < 2; ++bj)
#pragma unroll
                    for (int e = 0; e < 8; ++e) { const float a = fminf(fmaxf((float)ga[m][bj][e], -30.f), 30.f), b = fminf(fmaxf((float)gb[m][bj][e], -30.f), 30.f);
                        const float f = (1.0f + __builtin_amdgcn_exp2f(-LOG2E * b)) * __builtin_amdgcn_rcpf(1.0f + __builtin_amdgcn_exp2f(-LOG2E * a));
                        acc[ai][bj][m][e >> 2][e & 3] *= f; }
            asm volatile("" ::: "memory"); }
#if defined(PROF_SEG) && PROF_SEG == 40
        asm volatile("s_waitcnt vmcnt(0) lgkmcnt(0)" ::: "memory"); *prof += __builtin_amdgcn_s_memrealtime() - tp0;
#endif
    }
    __device__ __forceinline__ void operator()(const f32x4 (&acc)[2][2][4][2], const Unit& u, int wr, int wc, int fr, int fq) const {
        const int row0 = u.pm * BM + wr * 64 + fr, col0 = u.pn * BM + wc * 32 + 8 * fq;
#if defined(PROF_SEG) && PROF_SEG == 41
        asm volatile("s_waitcnt vmcnt(0) lgkmcnt(0)" ::: "memory"); const unsigned long long tp0 = __builtin_amdgcn_s_memrealtime();
#endif
#pragma unroll
        for (int ai = 0; ai < 2; ++ai) {
            unsigned ro = (unsigned)(row0 + ai * HALF); asm volatile("" : "+v"(ro));
            h16x8 gb[4][2];
#pragma unroll
            for (int m = 0; m < 4; ++m)
#pragma unroll
                for (int bj = 0; bj < 2; ++bj) gb[m][bj] = *(const h16x8*)(G + (size_t)(ro + m * 16) * 2048 + 1024 + col0 + bj * HALF);
#pragma unroll
            for (int m = 0; m < 4; ++m)
#pragma unroll
                for (int bj = 0; bj < 2; ++bj) { float o[8];
#pragma unroll
                    for (int e = 0; e < 8; ++e) o[e] = acc[ai][bj][m][e >> 2][e & 3] * sigmoidf_fast((float)gb[m][bj][e]);
                    u32x4 w; w.x = pkh(o[0], o[1]); w.y = pkh(o[2], o[3]); w.z = pkh(o[4], o[5]); w.w = pkh(o[6], o[7]);
                    *(u32x4*)(MG + (size_t)(ro + m * 16) * 1024 + col0 + bj * HALF) = w; }
            asm volatile("" ::: "memory"); }
#if defined(PROF_SEG) && PROF_SEG == 41
        asm volatile("s_waitcnt vmcnt(0) lgkmcnt(0)" ::: "memory"); *prof += __builtin_amdgcn_s_memrealtime() - tp0;
#endif
    }
};
struct EpiOut {
    static constexpr bool PERM = true, AFTER_DRAIN = false, MID = false;
    const float* x; float* out;
    __device__ __forceinline__ void operator()(const f32x4 (&acc)[2][2][4][2], const Unit& u, int wr, int wc, int fr, int fq) const {
        const int row0 = u.pm * BM + wr * 64 + fr, col0 = u.pn * BM + wc * 32 + 8 * fq;
#pragma unroll
        for (int ai = 0; ai < 2; ++ai)
#pragma unroll
            for (int m = 0; m < 4; ++m) { const size_t off = (size_t)(row0 + ai * HALF + m * 16) * DM + col0;
#pragma unroll
                for (int bj = 0; bj < 2; ++bj)
#pragma unroll
                    for (int n = 0; n < 2; ++n) { const f32x4 xv = *(const f32x4*)(x + off + bj * HALF + 4 * n); *(f32x4*)(out + off + bj * HALF + 4 * n) = xv + acc[ai][bj][m][n]; }
                if (m & 1) asm volatile("" ::: "memory"); }
    }
};

template <class Epi, class Sched, class GemmT, bool ALIGN_EPI = false, bool SP2 = false>
__device__ __forceinline__ void gemm_phase(PG8_LAS unsigned char* lds, const GemmT g, const Sched& S, const Epi& E) {
    const int tid = threadIdx.x, wid = __builtin_amdgcn_readfirstlane(tid >> 6), lane = tid & 63, wr = wid >> 2, wc = wid & 3, fr = lane & 15, fq = lane >> 4;
    const int K = g.K, nt = K / BK;
    unsigned voffA[2], voffB[2];
#pragma unroll
    for (int i = 0; i < 2; ++i) { int R, C; stage_rc(tid * 16 + i * 8192, R, C); const int Rb = Epi::PERM ? ((R & ~31) + perm32(R & 31)) : R;
        voffA[i] = (unsigned)(R * g.lda + C) * 2u; voffB[i] = (unsigned)(Rb * K + C) * 2u; }
    const size_t kstep = (size_t)(BK * 2);
    const size_t hstepA = (size_t)HALF * g.lda * 2, hstepB = (size_t)HALF * K * 2;
    const unsigned ldsw = (unsigned)wid * 1024u;
    const int aoff = lds_byte(wr * 64 + fr, fq * 8), boff = lds_byte(wc * 32 + fr, fq * 8);
#define PG8_SA(b, h) (((b) * 2 + (h)) * HTB)
#define PG8_SB(b, h) ((4 + (b) * 2 + (h)) * HTB)
#define PG8_STAGE(bufoff, gbase, voff) do { _Pragma("unroll") for (int _i = 0; _i < 2; ++_i) \
        __builtin_amdgcn_global_load_lds((const unsigned*)((const char*)(gbase) + (voff)[_i]), (PG8_LAS unsigned*)(lds + (bufoff) + ldsw + _i * 8192), 16, 0, 0); } while (0)
#define PG8_LDA(dst, b, h) do { _Pragma("unroll") for (int m = 0; m < 4; ++m) _Pragma("unroll") for (int k = 0; k < 2; ++k) dst[m][k] = *(const PG8_LAS h16x8*)(lds + PG8_SA(b, h) + aoff + m * 2048 + k * 1024); } while (0)
#define PG8_LDB(dst, b, h) do { _Pragma("unroll") for (int n = 0; n < 2; ++n) _Pragma("unroll") for (int k = 0; k < 2; ++k) dst[n][k] = *(const PG8_LAS h16x8*)(lds + PG8_SB(b, h) + boff + n * 2048 + k * 1024); } while (0)
#define PG8_MMA(ai, bj, At, Bt) do { __builtin_amdgcn_s_setprio(1); _Pragma("unroll") for (int m = 0; m < 4; ++m) _Pragma("unroll") for (int n = 0; n < 2; ++n) _Pragma("unroll") for (int k = 0; k < 2; ++k) \
        acc[ai][bj][m][n] = __builtin_amdgcn_mfma_f32_16x16x32_f16(Bt[n][k], At[m][k], acc[ai][bj][m][n], 0, 0, 0); __builtin_amdgcn_s_setprio(0); } while (0)
#define PG8_WAIT_V(n) asm volatile("s_waitcnt vmcnt(" #n ")" ::: "memory")
#define PG8_WAIT_L(n) asm volatile("s_waitcnt lgkmcnt(" #n ")" ::: "memory")
#define PG8_BAR __builtin_amdgcn_s_barrier()
#define PG8_SCHED __builtin_amdgcn_sched_barrier(0)
    Unit cur, nxt; int ui = 0;
    if (!S.next(0, cur)) return;
    f32x4 acc[2][2][4][2];
#pragma unroll
    for (int a = 0; a < 2; ++a)
#pragma unroll
        for (int b = 0; b < 2; ++b)
#pragma unroll
            for (int m = 0; m < 4; ++m)
#pragma unroll
                for (int n = 0; n < 2; ++n) acc[a][b][m][n] = (f32x4){0.f, 0.f, 0.f, 0.f};
    h16x8 At[4][2], B0[2][2], B1[2][2];
    const char* cA = g.aptr(cur); const char* cB = g.bptr(cur);
    S.a_ready(cur);
    if constexpr (SP2) {
        PG8_STAGE(PG8_SB(0, 0), cB, voffB); PG8_STAGE(PG8_SB(0, 1), cB + hstepB, voffB); PG8_STAGE(PG8_SA(0, 0), cA, voffA); PG8_STAGE(PG8_SA(0, 1), cA + hstepA, voffA);
        if (wr == 1) PG8_BAR;
        PG8_WAIT_V(2); PG8_BAR;
        PG8_STAGE(PG8_SB(1, 0), cB + kstep, voffB); PG8_STAGE(PG8_SA(1, 0), cA + kstep, voffA); PG8_STAGE(PG8_SB(1, 1), cB + hstepB + kstep, voffB);
        PG8_WAIT_V(6); PG8_BAR;
    } else {
        PG8_STAGE(PG8_SB(0, 0), cB, voffB); PG8_STAGE(PG8_SA(0, 0), cA, voffA); PG8_STAGE(PG8_SB(0, 1), cB + hstepB, voffB); PG8_STAGE(PG8_SA(0, 1), cA + hstepA, voffA);
        if (wr == 1) PG8_BAR;
        PG8_WAIT_V(4); PG8_BAR;
        PG8_STAGE(PG8_SB(1, 0), cB + kstep, voffB); PG8_STAGE(PG8_SA(1, 0), cA + kstep, voffA); PG8_STAGE(PG8_SB(1, 1), cB + hstepB + kstep, voffB);
        PG8_WAIT_V(6); PG8_BAR;
    }
    for (;;) {
        const bool has_next = S.next(ui + 1, nxt);
        const char* nA = has_next ? g.aptr(nxt) : cA; const char* nB = has_next ? g.bptr(nxt) : cB;
        for (int t = 0; t < nt; t += 2) {
            const bool last = (t == nt - 2);
            const char* a1 = cA + (size_t)(t + 1) * kstep;
            const char* a2 = last ? nA : cA + (size_t)(t + 2) * kstep; const char* b2 = last ? nB : cB + (size_t)(t + 2) * kstep;
            const char* a3 = a2 + kstep; const char* b3 = b2 + kstep;
            if (last && has_next) S.a_ready(nxt);
            if constexpr (Epi::MID) { if (t == nt / 2) E.mid(acc, cur, wr, wc, fr, fq); }
            if constexpr (SP2) {
            PG8_LDB(B0, 0, 0); PG8_LDB(B1, 0, 1); PG8_SCHED; PG8_LDA(At, 0, 0); PG8_STAGE(PG8_SA(1, 1), a1 + hstepA, voffA);
            PG8_WAIT_V(8); PG8_WAIT_L(0); PG8_BAR; PG8_MMA(0, 0, At, B0); PG8_MMA(0, 1, At, B1); PG8_BAR; PG8_SCHED;
            PG8_LDA(At, 0, 1); PG8_STAGE(PG8_SB(0, 0), b2, voffB); PG8_STAGE(PG8_SB(0, 1), b2 + hstepB, voffB); PG8_STAGE(PG8_SA(0, 0), a2, voffA);
            PG8_WAIT_V(8); PG8_WAIT_L(0); PG8_BAR; PG8_MMA(1, 0, At, B0); PG8_MMA(1, 1, At, B1); PG8_BAR; PG8_SCHED;
            PG8_LDB(B0, 1, 0); PG8_LDB(B1, 1, 1); PG8_SCHED; PG8_LDA(At, 1, 0); PG8_STAGE(PG8_SA(0, 1), a2 + hstepA, voffA);
            PG8_WAIT_V(8); PG8_WAIT_L(0); PG8_BAR; PG8_MMA(0, 0, At, B0); PG8_MMA(0, 1, At, B1); PG8_BAR; PG8_SCHED;
            PG8_LDA(At, 1, 1); PG8_STAGE(PG8_SB(1, 0), b3, voffB); PG8_STAGE(PG8_SB(1, 1), b3 + hstepB, voffB); PG8_STAGE(PG8_SA(1, 0), a3, voffA);
            PG8_WAIT_V(8); PG8_WAIT_L(0); PG8_BAR; PG8_MMA(1, 0, At, B0); PG8_MMA(1, 1, At, B1); PG8_BAR; PG8_SCHED;
            } else {
            PG8_LDB(B0, 0, 0); PG8_SCHED; PG8_LDA(At, 0, 0); PG8_STAGE(PG8_SA(1, 1), a1 + hstepA, voffA);
            PG8_WAIT_L(8); PG8_BAR; PG8_WAIT_L(0); PG8_MMA(0, 0, At, B0); PG8_BAR; PG8_SCHED;
            PG8_LDB(B1, 0, 1); PG8_STAGE(PG8_SB(0, 0), b2, voffB);
            PG8_BAR; PG8_WAIT_L(0); PG8_MMA(0, 1, At, B1); PG8_BAR;
            PG8_LDA(At, 0, 1); PG8_STAGE(PG8_SA(0, 0), a2, voffA);
            PG8_BAR; PG8_WAIT_L(0); PG8_MMA(1, 0, At, B0); PG8_BAR; PG8_SCHED;
            PG8_STAGE(PG8_SB(0, 1), b2 + hstepB, voffB);
            PG8_WAIT_V(6); PG8_BAR; PG8_MMA(1, 1, At, B1); PG8_BAR;
            PG8_LDB(B0, 1, 0); PG8_SCHED; PG8_LDA(At, 1, 0); PG8_STAGE(PG8_SA(0, 1), a2 + hstepA, voffA);
            PG8_WAIT_L(8); PG8_BAR; PG8_WAIT_L(0); PG8_MMA(0, 0, At, B0); PG8_BAR; PG8_SCHED;
            PG8_LDB(B1, 1, 1); PG8_STAGE(PG8_SB(1, 0), b3, voffB);
            PG8_BAR; PG8_WAIT_L(0); PG8_MMA(0, 1, At, B1); PG8_BAR;
            PG8_LDA(At, 1, 1); PG8_STAGE(PG8_SA(1, 0), a3, voffA);
            PG8_BAR; PG8_WAIT_L(0); PG8_MMA(1, 0, At, B0); PG8_BAR; PG8_SCHED;
            PG8_STAGE(PG8_SB(1, 1), b3 + hstepB, voffB);
            PG8_WAIT_V(6); PG8_BAR; PG8_MMA(1, 1, At, B1); PG8_BAR;
            }
        }
        if constexpr (ALIGN_EPI) { if (wr == 0) PG8_BAR; }
        if constexpr (!Epi::AFTER_DRAIN) { E(acc, cur, wr, wc, fr, fq); S.done(cur); }
        if (!has_next) break;
#pragma unroll
        for (int a = 0; a < 2; ++a)
#pragma unroll
            for (int b = 0; b < 2; ++b)
#pragma unroll
                for (int m = 0; m < 4; ++m)
#pragma unroll
                    for (int n = 0; n < 2; ++n) acc[a][b][m][n] = (f32x4){0.f, 0.f, 0.f, 0.f};
        cur = nxt; cA = nA; cB = nB; ++ui;
        if constexpr (ALIGN_EPI) { if (wr == 1) PG8_BAR; }
    }
    PG8_WAIT_V(0);
    if constexpr (!ALIGN_EPI) { if (wr == 0) PG8_BAR; }
    PG8_BAR;
    if constexpr (Epi::AFTER_DRAIN) { E.fused(acc, cur, wr, wc, fr, fq, lds, wid, lane); S.done(cur); }
#undef PG8_SA
#undef PG8_SB
#undef PG8_STAGE
#undef PG8_LDA
#undef PG8_LDB
#undef PG8_MMA
#undef PG8_WAIT_V
#undef PG8_WAIT_L
#undef PG8_BAR
#undef PG8_SCHED
}
}

constexpr int NWAVES = 8, NTHREADS = 512;
constexpr int RING_BYTES = 131072, LDSCTL_OFF = 159744, LDS_BYTES = 163840;
#define LDS_WAIT() asm volatile("s_waitcnt lgkmcnt(0)" ::: "memory")
#ifdef PROF_SEG
#define TSTART(id) unsigned long long t0_##id = 0; if ((id) == PROF_SEG) { asm volatile("s_waitcnt vmcnt(0) lgkmcnt(0)" ::: "memory"); t0_##id = __builtin_amdgcn_s_memrealtime(); }
#define TSTOP(id) if ((id) == PROF_SEG) { asm volatile("s_waitcnt vmcnt(0) lgkmcnt(0)" ::: "memory"); F.prof += __builtin_amdgcn_s_memrealtime() - t0_##id; }
#else
#define TSTART(id)
#define TSTOP(id)
#endif

#define XB_TMO      128
#define XB_XCNT(j)  (256  + 64 * (j))
#define XB_XSUB(j)  (1280 + 64 * (j))
#define XB_XGEN(j)  (2304 + 64 * (j))
#define XB_TOP      3328
#define XB_TOPGEN   3392
#define XCD_BAR_WORDS 3456
#define XB_SPIN_CAP (1u << 18)

__device__ __forceinline__ unsigned xb_ld(unsigned* p)              { return __hip_atomic_load(p, __ATOMIC_RELAXED, __HIP_MEMORY_SCOPE_AGENT); }
__device__ __forceinline__ unsigned xb_add(unsigned* p, unsigned v) { return __hip_atomic_fetch_add(p, v, __ATOMIC_RELAXED, __HIP_MEMORY_SCOPE_AGENT); }
__device__ __forceinline__ unsigned xb_xcc_id() { return (unsigned)__builtin_amdgcn_s_getreg((3 << 11) | 20) & 0xFu; }
#define XB_SPIN(cond, bar) do { unsigned _sp = 0; while (cond) { __builtin_amdgcn_s_sleep(1); \
    if ((++_sp & 255u) == 0u) { if (xb_ld(&(bar)[XB_TMO])) break; if (_sp > XB_SPIN_CAP) { atomicAdd(&(bar)[XB_TMO], 1u); break; } } } } while (0)

struct XcdBarrier {
    unsigned* bar; unsigned x;
    volatile LAS unsigned* st;
};

__device__ __forceinline__ XcdBarrier xcd_barrier_post(unsigned* bar, volatile LAS unsigned* st) {
    XcdBarrier b; b.bar = bar; b.x = xb_xcc_id(); b.st = st;
    if (threadIdx.x == 0) (void)xb_add(&bar[XB_XCNT(b.x)], 1u);
    return b;
}
__device__ __forceinline__ void xcd_barrier_complete(unsigned* bar, unsigned x, unsigned& nloc, unsigned& nx) {
    const unsigned G = gridDim.x * gridDim.y * gridDim.z;
    unsigned sum, cnt, mine, sp = 0u;
    for (;;) {
        sum = 0u; cnt = 0u; mine = 0u;
#pragma unroll
        for (unsigned j = 0; j < 16; ++j) { const unsigned c = xb_ld(&bar[XB_XCNT(j)]); sum += c; cnt += (c > 0u) ? 1u : 0u; mine = (j == x) ? c : mine; }
        if (sum == G) break;
        __builtin_amdgcn_s_sleep(1);
        if ((++sp & 255u) == 0u) { if (xb_ld(&bar[XB_TMO])) break; if (sp > XB_SPIN_CAP) { atomicAdd(&bar[XB_TMO], 1u); break; } }
    }
    nloc = mine > 0u ? mine : 1u; nx = cnt > 0u ? cnt : 1u;
}

__device__ __forceinline__ void xcd_barrier(const XcdBarrier& b) {
    asm volatile("s_waitcnt vmcnt(0)" ::: "memory");
    __syncthreads();
    if (threadIdx.x == 0) {
        unsigned* bar = b.bar;
        __builtin_amdgcn_s_waitcnt(0);
        unsigned nloc = b.st[0], nx = b.st[1];
        if (nloc == 0u) { xcd_barrier_complete(bar, b.x, nloc, nx); b.st[0] = nloc; b.st[1] = nx; }
        const unsigned old = xb_add(&bar[XB_XSUB(b.x)], 1u);
        const unsigned gen = old / nloc;
        if (old + 1u == (gen + 1u) * nloc) {
            __builtin_amdgcn_fence(__ATOMIC_RELEASE, "agent");
            asm volatile("s_waitcnt vmcnt(0)" ::: "memory");
            const unsigned og = xb_add(&bar[XB_TOP], 1u);
            const unsigned tg = og / nx;
            if (og + 1u == (tg + 1u) * nx) xb_add(&bar[XB_TOPGEN], 1u);
            else XB_SPIN(xb_ld(&bar[XB_TOPGEN]) == tg, bar);
            __builtin_amdgcn_fence(__ATOMIC_ACQUIRE, "agent");
            xb_add(&bar[XB_XGEN(b.x)], 1u);
            asm volatile("s_waitcnt vmcnt(0)" ::: "memory");
        } else {
            XB_SPIN(xb_ld(&bar[XB_XGEN(b.x)]) == gen, bar);
            __builtin_amdgcn_fence(__ATOMIC_ACQUIRE, "agent");
            asm volatile("s_waitcnt vmcnt(0)" ::: "memory");
        }
    }
    __syncthreads();
}

struct Frame {
    LAS unsigned char* lds;
    int tid, lane, wave, vcu, G;
    unsigned char* ws;
    const float *x, *norm_g, *w_in, *qna, *kna, *sinks, *qnb, *knb, *relb, *wpa, *wpb, *wout;
    float* out;
    unsigned long long prof;
};

__device__ __forceinline__ float wave_sum(float v) {
#pragma unroll
    for (int o = 1; o < 64; o <<= 1) v += __shfl_xor(v, o);
    return v;
}
__device__ __forceinline__ int t5_bucket(int n) {
    if (n < 16) return n < 0 ? 0 : n;
    const int l = 16 + (int)(logf((float)n * 0.0625f) / logf(8.0f) * 16.0f);
    return l > 31 ? 31 : l;
}

__device__ __forceinline__ int win_src_col(int n) { return n < 3328 ? n : (n < 5376 ? n + 296 : (n < 5672 ? n - 2048 : -1)); }
template <bool INPROJ>
__device__ __forceinline__ void p0_transpose_item(const float* W, int srcN, int k0, int n0, h16* WT, int ldk, int kdst0, LAS float* scr, int lane, float scale) {
    const int n = n0 + (lane & 31); const int col = INPROJ ? win_src_col(n) : n;
    float wv_[32];
#pragma unroll
    for (int i = 0; i < 32; ++i) { const int kk = 2 * i + (lane >> 5); wv_[i] = (col >= 0) ? W[(size_t)(k0 + kk) * srcN + col] : 0.f; }
#pragma unroll
    for (int i = 0; i < 32; ++i) { const int kk = 2 * i + (lane >> 5); scr[kk * 33 + (lane & 31)] = wv_[i] * scale; }
    LDS_WAIT(); asm volatile("" ::: "memory");
    const int c = lane & 7;
#pragma unroll
    for (int j = 0; j < 4; ++j) { const int nn = (lane >> 3) + 8 * j; const LAS float* s = scr + (8 * c) * 33 + nn;
        float v[8];
#pragma unroll
        for (int e = 0; e < 8; ++e) v[e] = s[e * 33];
        u32x4 o; o.x = pkh(v[0], v[1]); o.y = pkh(v[2], v[3]); o.z = pkh(v[4], v[5]); o.w = pkh(v[6], v[7]);
        *(u32x4*)(WT + (size_t)(n0 + nn) * ldk + kdst0 + k0 + 8 * c) = o;
    }
    LDS_WAIT(); asm volatile("" ::: "memory");
}
__device__ __forceinline__ void p0_norm_rows4(const float* x, const float* g, h16* H, int m0, int mstride, int lane) {
    f32x4 v[4][4];
#pragma unroll
    for (int r = 0; r < 4; ++r)
#pragma unroll
        for (int j = 0; j < 4; ++j) v[r][j] = __builtin_nontemporal_load((const f32x4*)(x + (size_t)(m0 + r * mstride) * DM) + lane + 64 * j);
    f32x4 gg[4];
#pragma unroll
    for (int j = 0; j < 4; ++j) gg[j] = *((const f32x4*)g + lane + 64 * j) * HSCALE;
#pragma unroll
    for (int r = 0; r < 4; ++r) {
        float s = 0.f;
#pragma unroll
        for (int j = 0; j < 4; ++j) s += (v[r][j].x * v[r][j].x + v[r][j].y * v[r][j].y) + (v[r][j].z * v[r][j].z + v[r][j].w * v[r][j].w);
        const float rs = rsqrtf(wave_sum(s) * (1.0f / DM) + RMS_EPS);
#pragma unroll
        for (int j = 0; j < 4; ++j) { const f32x4 hv = v[r][j] * rs * gg[j]; u32x2 hi; hi.x = pkh(hv.x, hv.y); hi.y = pkh(hv.z, hv.w);
            *((u32x2*)(H + (size_t)(m0 + r * mstride) * 1024) + lane + 64 * j) = hi; }
    }
}
__device__ __forceinline__ void p0_prologue(Frame& F) {
    LAS float* scr = (LAS float*)(F.lds + F.wave * 16384);
    h16* Win = (h16*)(F.ws + WS_WIN); h16* Wp = (h16*)(F.ws + WS_WP); h16* Wo = (h16*)(F.ws + WS_WO); h16* Hb = (h16*)(F.ws + WS_H);
    constexpr int I_IN = 16 * 184, I_P = 8 * 32, I_O = 16 * 32;
    static_assert(I_IN + 2 * I_P + I_O == 62 * 64 && MROWS / 4 == 64 * 64, "prologue shards");
    for (int s = F.vcu >> 2; s < 64; s += (F.G + 3) >> 2) {
        unsigned* ctr = (unsigned*)(F.ws + WS_CTL + 40960) + s * 64;
        for (;;) {
            unsigned k = 0u;
            if (F.lane == 0) k = __hip_atomic_fetch_add(ctr, 1u, __ATOMIC_RELAXED, __HIP_MEMORY_SCOPE_AGENT);
            k = (unsigned)__builtin_amdgcn_readfirstlane((int)k);
            if (k >= 126u) break;
            if (k < 62u) {
                int r = s + 64 * (int)k;
                if (r < I_IN) { p0_transpose_item<true>(F.w_in, INW, 64 * (r / 184), 32 * (r % 184), Win, 1024, 0, scr, F.lane, WSCALE); continue; } r -= I_IN;
                if (r < I_P) { p0_transpose_item<false>(F.wpa, DM, 64 * (r / 32), 32 * (r % 32), Wp, 1024, 0, scr, F.lane, 1.f); continue; } r -= I_P;
                if (r < I_P) { p0_transpose_item<false>(F.wpb, DM, 64 * (r / 32), 32 * (r % 32), Wp, 1024, 512, scr, F.lane, 1.f); continue; } r -= I_P;
                p0_transpose_item<false>(F.wout, DM, 64 * (r / 32), 32 * (r % 32), Wo, 1024, 0, scr, F.lane, 1.f);
            } else p0_norm_rows4(F.x, F.norm_g, Hb, 4 * (s + 64 * ((int)k - 62)), 1, F.lane);
        }
    }
}

constexpr int NBIN = 256, ICAP = 32;
constexpr int IW_VALS = 0, IW_HIST = 16384, IW_LIST = IW_HIST + 2 * NBIN * 4, IW_LMASK = IW_LIST + 2 * ICAP * 8, IW_BYTES = IW_LMASK + 512;
static_assert(8 * IW_BYTES <= LDSCTL_OFF, "indexer LDS");
typedef _Float16 h16x4v __attribute__((ext_vector_type(4)));
__device__ __forceinline__ int idx_bin(float v, float smin, float scale) { const int b = (int)((v - smin) * scale); return b > NBIN - 1 ? NBIN - 1 : b; }
__device__ __forceinline__ float wave_minf(float v) {
#pragma unroll
    for (int o = 1; o < 64; o <<= 1) v = fminf(v, __shfl_xor(v, o));
    return v; }
__device__ __forceinline__ float wave_maxf(float v) {
#pragma unroll
    for (int o = 1; o < 64; o <<= 1) v = fmaxf(v, __shfl_xor(v, o));
    return v; }
__device__ __forceinline__ unsigned lowest_bits64(unsigned long long w, unsigned n, unsigned long long& kept) { kept = 0ull; unsigned took = 0u; while (n && w) { const unsigned long long bit = w & (0ull - w); kept |= bit; w ^= bit; --n; ++took; } return took; }
__device__ __forceinline__ unsigned mbcnt64(unsigned long long m) { return __builtin_amdgcn_mbcnt_hi((unsigned)(m >> 32), __builtin_amdgcn_mbcnt_lo((unsigned)m, 0u)); }
__device__ __forceinline__ void idx_select_exact(LAS unsigned char* wl, const LAS float* vals, LAS unsigned* hist, LAS u32x2* clist, LAS unsigned* lm, int ngroup, float lo, float hi, unsigned need, int lane) {
#pragma unroll 1
    for (int level = 0; level < 64; ++level) {
        if (!(hi > lo)) {
            unsigned taken = 0u;
            for (int g = 0; g < ngroup && taken < need; ++g) { const float v = vals[64 * g + lane]; const unsigned long long tm = __ballot(v >= lo && v <= hi); unsigned long long kept;
                taken += lowest_bits64(tm, need - taken, kept); if (lane == 0 && kept) { atomicOr((unsigned*)&lm[2 * g], (unsigned)kept); atomicOr((unsigned*)&lm[2 * g + 1], (unsigned)(kept >> 32)); } }
            return;
        }
        const float scale = ((float)NBIN - 0.5f) / (hi - lo);
        *(LAS u32x4*)((LAS unsigned char*)hist + lane * 16) = (u32x4){0u, 0u, 0u, 0u};
        asm volatile("s_waitcnt lgkmcnt(0)" ::: "memory");
        for (int g = 0; g < ngroup; ++g) { const float v = vals[64 * g + lane]; if (v >= lo && v <= hi) atomicAdd((unsigned*)&hist[idx_bin(v, lo, scale)], 1u); }
        asm volatile("s_waitcnt lgkmcnt(0)" ::: "memory");
        const u32x4 cw = *(const LAS u32x4*)((const LAS unsigned char*)hist + lane * 16);
        const unsigned cnt[4] = {cw.x, cw.y, cw.z, cw.w}; const unsigned s = (cw.x + cw.y) + (cw.z + cw.w);
        unsigned v = s;
#pragma unroll
        for (int o = 1; o < 64; o <<= 1) { const unsigned tmp = (unsigned)__shfl_down((int)v, o); if (lane + o < 64) v += tmp; }
        const unsigned above = v - s; const bool crit = above < need && need <= above + s;
        unsigned cum = above, b_ = 0, r_ = 0, c_ = 0; bool found = false;
#pragma unroll
        for (int e = 3; e >= 0; --e) { const unsigned cc = cnt[e]; if (!found && cum + cc >= need) { found = true; b_ = 4u * lane + e; r_ = need - cum; c_ = cc; } if (!found) cum += cc; }
        const unsigned long long cm = __ballot(crit); const int cl = cm ? (int)__builtin_ctzll(cm) : 0;
        const int bst = __builtin_amdgcn_readlane((int)b_, cl); const unsigned rr = (unsigned)__builtin_amdgcn_readlane((int)r_, cl), cb = (unsigned)__builtin_amdgcn_readlane((int)c_, cl);
        const bool takeall = cb == rr, uselist = !takeall && cb <= (unsigned)ICAP; const int bsel = takeall ? bst : bst + 1;
        float nlo = INFINITY, nhi = -INFINITY; unsigned nm = 0u;
        for (int g = 0; g < ngroup; ++g) {
            const float v = vals[64 * g + lane]; const bool act = v >= lo && v <= hi; const int bn = idx_bin(v, lo, scale);
            const unsigned long long sm = __ballot(act && bn >= bsel), mm = __ballot(act && !takeall && bn == bst);
            if (lane == 0 && sm) { atomicOr((unsigned*)&lm[2 * g], (unsigned)sm); atomicOr((unsigned*)&lm[2 * g + 1], (unsigned)(sm >> 32)); }
            if (mm) { if (act && !takeall && bn == bst) { nlo = fminf(nlo, v); nhi = fmaxf(nhi, v); const unsigned slot = nm + mbcnt64(mm); if (uselist && slot < (unsigned)ICAP) clist[slot] = (u32x2){__float_as_uint(v), (unsigned)(64 * g + lane)}; }
                nm += (unsigned)__popcll(mm); }
        }
        asm volatile("s_waitcnt lgkmcnt(0)" ::: "memory");
        if (takeall) return;
        if (uselist) {
            const u32x2 me = clist[lane & 31]; const float vj = __uint_as_float(me.x); unsigned rank = 0u;
            for (unsigned i2 = 0; i2 < cb; ++i2) { const u32x2 o = clist[i2]; const float vi = __uint_as_float(o.x); rank += (vi > vj || (vi == vj && o.y < me.y)) ? 1u : 0u; }
            if ((unsigned)lane < cb && rank < rr) atomicOr((unsigned*)&lm[me.y >> 5], 1u << (me.y & 31));
            return;
        }
        lo = wave_minf(nlo); hi = wave_maxf(nhi); need = rr;
    }
}
__device__ __forceinline__ void idx_pair(Frame& F, int b, int u) {
    const int lane = F.lane, k16 = lane & 15, fq = lane >> 4, th = lane >> 5;
    const int ta = 2 * u;
    unsigned* gm = (unsigned*)(F.ws + WS_MASK) + (size_t)(b * SEQ + ta) * 64;
    if (ta < 256) {
        const int lo = lane * 32;
        gm[lane] = (ta >= lo + 31) ? 0xffffffffu : (ta >= lo ? ((2u << (ta - lo)) - 1u) : 0u);
        gm[64 + lane] = (ta + 1 >= lo + 31) ? 0xffffffffu : (ta + 1 >= lo ? ((2u << (ta + 1 - lo)) - 1u) : 0u);
        return;
    }
    LAS unsigned char* wl = F.lds + F.wave * IW_BYTES;
    LAS float* vals = (LAS float*)(wl + IW_VALS);
    LAS unsigned* hist = (LAS unsigned*)(wl + IW_HIST);
    LAS u32x2* clist = (LAS u32x2*)(wl + IW_LIST);
    LAS unsigned* lmask = (LAS unsigned*)(wl + IW_LMASK);
    lmask[lane] = 0u; lmask[64 + lane] = 0u;
    TSTART(20)
    TSTART(21)
    const size_t qrow = (size_t)(b * SEQ + ta + (k16 >> 3));
    const h16x8 qh = *(const h16x8*)((const h16*)(F.ws + WS_QH) + qrow * 256 + (k16 & 7) * 32 + fq * 8);
    h16x4v a2[4];
    {   const f32x4 wv = *(const f32x4*)((const float*)(F.ws + WS_WI) + (size_t)(b * SEQ + ta + (fq >> 1)) * 8 + 4 * (fq & 1));
        const h16x4v w16 = __builtin_convertvector(wv, h16x4v); const h16x4v z16 = {(h16)0.f, (h16)0.f, (h16)0.f, (h16)0.f};
        const int myc = ((k16 & 3) == (fq >> 1)) ? (k16 >> 2) : -1;
#pragma unroll
        for (int c4 = 0; c4 < 4; ++c4) a2[c4] = (myc == c4) ? w16 : z16; }
    const int ngroup = (ta + 1) / 64 + 1;
    const h16* kph = (const h16*)(F.ws + WS_KH) + (size_t)(b * SEQ + k16) * 32 + fq * 8;
    h16x8 kb[4][4];
#define IDX_LOADT(slot, c4, grp) do { const int gg_ = (grp) < 32 ? (grp) : 31; kb[slot][c4] = *(const h16x8*)(kph + (size_t)gg_ * 2048 + (c4) * 512); } while (0)
#pragma unroll
    for (int c4 = 0; c4 < 4; ++c4) { IDX_LOADT(0, c4, 0); IDX_LOADT(1, c4, 1); IDX_LOADT(2, c4, 2); IDX_LOADT(3, c4, 3); }
    float vmin0 = INFINITY, vmax0 = -INFINITY, vmin1 = INFINITY, vmax1 = -INFINITY;
#define IDX_GROUP(slot, grp) do { f32x4 d1_[4]; \
        _Pragma("unroll") for (int c4 = 0; c4 < 4; ++c4) d1_[c4] = __builtin_amdgcn_mfma_f32_16x16x32_f16(qh, kb[slot][c4], (f32x4){0.f, 0.f, 0.f, 0.f}, 0, 0, 0); \
        _Pragma("unroll") for (int c4 = 0; c4 < 4; ++c4) IDX_LOADT(slot, c4, (grp) + 4); \
        h16x4v r_[4]; \
        _Pragma("unroll") for (int c4 = 0; c4 < 4; ++c4) r_[c4] = __builtin_elementwise_max(__builtin_convertvector(d1_[c4], h16x4v), (h16x4v){(h16)0.f, (h16)0.f, (h16)0.f, (h16)0.f});     \
        f32x4 d2 = __builtin_amdgcn_mfma_f32_16x16x16f16(a2[0], r_[0], (f32x4){0.f, 0.f, 0.f, 0.f}, 0, 0, 0); \
        d2 = __builtin_amdgcn_mfma_f32_16x16x16f16(a2[1], r_[1], d2, 0, 0, 0); d2 = __builtin_amdgcn_mfma_f32_16x16x16f16(a2[2], r_[2], d2, 0, 0, 0); d2 = __builtin_amdgcn_mfma_f32_16x16x16f16(a2[3], r_[3], d2, 0, 0, 0); \
        const int key_ = 64 * (grp) + lane; const float sa_ = d2[0] + 0.0f, sb_ = d2[1] + 0.0f; const bool va_ = key_ <= ta, vb_ = key_ <= ta + 1; \
        vals[key_] = va_ ? sa_ : __builtin_nanf(""); vals[2048 + key_] = vb_ ? sb_ : __builtin_nanf(""); \
        if (va_) { vmin0 = fminf(vmin0, sa_); vmax0 = fmaxf(vmax0, sa_); } if (vb_) { vmin1 = fminf(vmin1, sb_); vmax1 = fmaxf(vmax1, sb_); } } while (0)
#pragma unroll 1
    for (int g = 0; g < ngroup; g += 4) { IDX_GROUP(0, g); IDX_GROUP(1, g + 1); IDX_GROUP(2, g + 2); IDX_GROUP(3, g + 3); }
#undef IDX_GROUP
#undef IDX_LOADT
    const int ng2 = (ngroup + 3) & ~3;
    TSTOP(21)
    TSTART(22)
    const float lo0 = wave_minf(vmin0), hi0 = wave_maxf(vmax0), lo1 = wave_minf(vmin1), hi1 = wave_maxf(vmax1);
    unsigned wa0 = 0u, wa1 = 0u;
    bool exact0 = !(hi0 > lo0), exact1 = !(hi1 > lo1);
#ifdef FORCE_SLOW
    exact0 = true; exact1 = true;
#endif
    if (!(exact0 && exact1)) {
        const float sc0 = exact0 ? 0.f : ((float)NBIN - 0.5f) / (hi0 - lo0), sc1 = exact1 ? 0.f : ((float)NBIN - 0.5f) / (hi1 - lo1);
        TSTART(23)
        *(LAS u32x4*)(wl + IW_HIST + lane * 16) = (u32x4){0u, 0u, 0u, 0u}; *(LAS u32x4*)(wl + IW_HIST + 1024 + lane * 16) = (u32x4){0u, 0u, 0u, 0u};
        asm volatile("s_waitcnt lgkmcnt(0)" ::: "memory");
#pragma unroll 4
        for (int g = 0; g < ngroup; ++g) { const float va = vals[64 * g + lane], vb = vals[2048 + 64 * g + lane];
            if (!exact0 && va >= lo0) atomicAdd((unsigned*)&hist[idx_bin(va, lo0, sc0)], 1u);
            if (!exact1 && vb >= lo1) atomicAdd((unsigned*)&hist[NBIN + idx_bin(vb, lo1, sc1)], 1u); }
        asm volatile("s_waitcnt lgkmcnt(0)" ::: "memory");
        TSTART(27)
        int bst; unsigned rr, cb;
        {   const int l5 = lane & 31;
            const u32x4 cw0 = *(const LAS u32x4*)(wl + IW_HIST + th * 1024 + l5 * 32), cw1 = *(const LAS u32x4*)(wl + IW_HIST + th * 1024 + l5 * 32 + 16);
            const unsigned cnt[8] = {cw0.x, cw0.y, cw0.z, cw0.w, cw1.x, cw1.y, cw1.z, cw1.w};
            const unsigned s = ((cw0.x + cw0.y) + (cw0.z + cw0.w)) + ((cw1.x + cw1.y) + (cw1.z + cw1.w));
            unsigned v = s;
#pragma unroll
            for (int o = 1; o < 32; o <<= 1) { const unsigned tmp = (unsigned)__shfl_down((int)v, o, 32); if (l5 + o < 32) v += tmp; }
            const unsigned above = v - s, need = 256u; const bool crit = above < need && need <= above + s;
            unsigned cum = above, b_ = 0, r_ = 0, c_ = 0; bool found = false;
#pragma unroll
            for (int e = 7; e >= 0; --e) { const unsigned cc = cnt[e]; if (!found && cum + cc >= need) { found = true; b_ = 8u * l5 + e; r_ = need - cum; c_ = cc; } if (!found) cum += cc; }
            const unsigned long long cm = __ballot(crit);
            const int cla = (unsigned)cm ? (int)__builtin_ctz((unsigned)cm) : 0, clb = (unsigned)(cm >> 32) ? 32 + (int)__builtin_ctz((unsigned)(cm >> 32)) : 32;
            const int bqa = __builtin_amdgcn_readlane((int)b_, cla), bqb = __builtin_amdgcn_readlane((int)b_, clb);
            const unsigned rqa = (unsigned)__builtin_amdgcn_readlane((int)r_, cla), rqb = (unsigned)__builtin_amdgcn_readlane((int)r_, clb), cqa = (unsigned)__builtin_amdgcn_readlane((int)c_, cla), cqb = (unsigned)__builtin_amdgcn_readlane((int)c_, clb);
            const int bst0 = bqa, bst1 = bqb; const unsigned rr0 = rqa, rr1 = rqb, cb0 = cqa, cb1 = cqb;
            TSTOP(27)
            TSTOP(23)
            TSTART(24)
            const bool ta0 = cb0 == rr0, ta1 = cb1 == rr1; const int bsel0 = ta0 ? bst0 : bst0 + 1, bsel1 = ta1 ? bst1 : bst1 + 1;
            const float is0 = exact0 ? 0.f : (hi0 - lo0) * (1.0f / ((float)NBIN - 0.5f)), is1 = exact1 ? 0.f : (hi1 - lo1) * (1.0f / ((float)NBIN - 0.5f));
            const float thrA0 = exact0 ? INFINITY : lo0 + ((float)bsel0 + 0.02f) * is0, thrB0 = exact0 ? INFINITY : lo0 + ((float)bst0 - 0.02f) * is0;
            const float thrA1 = exact1 ? INFINITY : lo1 + ((float)bsel1 + 0.02f) * is1, thrB1 = exact1 ? INFINITY : lo1 + ((float)bst1 - 0.02f) * is1;
            unsigned zc0 = 0u, zc1 = 0u;
#pragma unroll 4
            for (int g = 0; g < ngroup; ++g) {
                const float va = vals[64 * g + lane], vb = vals[2048 + 64 * g + lane];
                const bool a0 = va >= thrA0, a1 = vb >= thrA1, z0 = va >= thrB0 && !a0, z1 = vb >= thrB1 && !a1;
                const unsigned long long sm0 = __ballot(a0), sm1 = __ballot(a1), zm0 = __ballot(z0), zm1 = __ballot(z1);
                if ((lane >> 1) == g) { wa0 = (lane & 1) ? (unsigned)(sm0 >> 32) : (unsigned)sm0; wa1 = (lane & 1) ? (unsigned)(sm1 >> 32) : (unsigned)sm1; }
                if (zm0 | zm1) {
                    const unsigned s0 = zc0 + mbcnt64(zm0), s1 = zc1 + mbcnt64(zm1);
                    if (z0 && s0 < (unsigned)ICAP) clist[s0] = (u32x2){__float_as_uint(va), (unsigned)(64 * g + lane)};
                    if (z1 && s1 < (unsigned)ICAP) clist[ICAP + s1] = (u32x2){__float_as_uint(vb), (unsigned)(64 * g + lane)};
                    zc0 += (unsigned)__popcll(zm0); zc1 += (unsigned)__popcll(zm1);
                }
            }
            asm volatile("s_waitcnt lgkmcnt(0)" ::: "memory");
            TSTART(28)
            if (zc0 > (unsigned)ICAP) exact0 = true;
            if (zc1 > (unsigned)ICAP) exact1 = true;
            {
                const int j = lane & 31; const unsigned zc = th ? zc1 : zc0; const bool skip = th ? exact1 : exact0;
                const float lo_ = th ? lo1 : lo0, sc_ = th ? sc1 : sc0; const int bst_ = th ? bst1 : bst0, bsel_ = th ? bsel1 : bsel0; const bool tka = th ? ta1 : ta0; const unsigned rr_ = th ? rr1 : rr0;
                const u32x2 me = clist[th * ICAP + j]; const float vj = __uint_as_float(me.x);
                const int bj = idx_bin(vj, lo_, sc_);
                const bool have = !skip && (unsigned)j < zc, selj = have && bj >= bsel_, memj = have && !tka && bj == bst_;
                const float vmj = memj ? vj : -INFINITY; unsigned rank = 0u;
                const unsigned zmax = (zc0 > zc1 ? zc0 : zc1) < (unsigned)ICAP ? (zc0 > zc1 ? zc0 : zc1) : (unsigned)ICAP;
                for (unsigned i2 = 0; i2 < zmax; ++i2) {
                    const float va = __int_as_float(__builtin_amdgcn_readlane(__float_as_int(vmj), (int)i2)), vb2 = __int_as_float(__builtin_amdgcn_readlane(__float_as_int(vmj), (int)i2 + 32));
                    const unsigned ka = (unsigned)__builtin_amdgcn_readlane((int)me.y, (int)i2), kb2 = (unsigned)__builtin_amdgcn_readlane((int)me.y, (int)i2 + 32);
                    const float vi = th ? vb2 : va; const unsigned ki = th ? kb2 : ka;
                    rank += (vi > vj || (vi == vj && ki < me.y)) ? 1u : 0u;
                }
                if (selj || (memj && rank < rr_)) atomicOr((unsigned*)&lmask[th * 64 + (me.y >> 5)], 1u << (me.y & 31));
            }
            TSTOP(28)
            TSTOP(24)
            (void)bst; (void)rr; (void)cb;
        }
    }
    if (exact0) { wa0 = 0u; lmask[lane] = 0u; asm volatile("s_waitcnt lgkmcnt(0)" ::: "memory"); idx_select_exact(wl, vals, hist, clist, lmask, ng2 < 32 ? ngroup : ngroup, lo0, hi0, 256u, lane); }
    if (exact1) { wa1 = 0u; lmask[64 + lane] = 0u; asm volatile("s_waitcnt lgkmcnt(0)" ::: "memory"); idx_select_exact(wl, vals + 2048, hist + NBIN, clist + ICAP, lmask + 64, ngroup, lo1, hi1, 256u, lane); }
    asm volatile("s_waitcnt lgkmcnt(0)" ::: "memory");
    gm[lane] = wa0 | lmask[lane]; gm[64 + lane] = wa1 | lmask[64 + lane];
    TSTOP(22)
    TSTOP(20)
}
__device__ __forceinline__ void p2_index_phase(Frame& F) {
    for (int s = F.vcu >> 2; s < 64; s += (F.G + 3) >> 2) {
        unsigned* ctr = (unsigned*)(F.ws + WS_CTL + 16384) + s * 64;
        for (;;) {
            unsigned k = 0u;
            if (F.lane == 0) k = __hip_atomic_fetch_add(ctr, 1u, __ATOMIC_RELAXED, __HIP_MEMORY_SCOPE_AGENT);
            k = (unsigned)__builtin_amdgcn_readfirstlane((int)k);
            if (k >= 128u) break;
            idx_pair(F, s & 7, 1023 - (s >> 3) - 8 * (int)k);
        }
    }
}

constexpr int AT_NSLOT = 5, AT_K = 0, AT_KSZ = 64 * 144, AT_V = AT_NSLOT * AT_KSZ, AT_VSZ = 64 * 192, AT_LUT = AT_V + AT_NSLOT * AT_VSZ, AT_MTAB = AT_LUT + 320 * 4, AT_OST = 0, AT_OSTSZ = 32 * 144;
static_assert(AT_MTAB + 128 <= RING_BYTES && 8 * AT_OSTSZ <= AT_V, "attention LDS");
typedef _Float16 h16x2v __attribute__((ext_vector_type(2)));
__device__ __forceinline__ s16x4 vtr_read(const LAS unsigned char* p) { return __builtin_amdgcn_ds_read_tr16_b64_v4i16((LAS s16x4*)p); }

template <bool ISB>
__device__ __forceinline__ void attn_unit(Frame& F, int b, int h, int qb) {
    const int tid = F.tid, lane = F.lane, wid = F.wave, q = lane & 31, hi = lane >> 5;
    const int q0 = qb * 256, r0 = q0 + wid * 32, t = r0 + q;
    const size_t row = (size_t)b * SEQ + t;
    const h16* Qp; const h16* Kp; const h16* Vp; const h16* Zp; int kvpitch, ycol;
    if (ISB) { Qp = (const h16*)(F.ws + WS_QB) + h * 64; Kp = (const h16*)(F.ws + WS_KB) + h * 64; Vp = (const h16*)(F.ws + WS_VB) + h * 64; Zp = (const h16*)(F.ws + WS_ZB) + h * 64; kvpitch = 512; ycol = 512 + h * 64; }
    else     { Qp = (const h16*)(F.ws + WS_QA) + h * 64; Kp = (const h16*)(F.ws + WS_KVA) + (h >> 2) * 64; Vp = (const h16*)(F.ws + WS_KVA) + 128 + (h >> 2) * 64; Zp = (const h16*)(F.ws + WS_ZA) + h * 64; kvpitch = 256; ycol = h * 64; }
    const unsigned* mrow = (const unsigned*)(F.ws + WS_MASK) + row * 64;
    LAS float* lut = (LAS float*)(F.lds + AT_LUT);
    const int srow = tid >> 3, sch = tid & 7;
    const h16* kg = Kp + ((size_t)b * SEQ + srow) * kvpitch + sch * 8; const h16* vg = Vp + ((size_t)b * SEQ + srow) * kvpitch + sch * 8;
    const int kst = srow * 144 + sch * 16, vst = srow * 192 + sch * 16;
    h16x8 qr[4];
#pragma unroll
    for (int d0 = 0; d0 < 4; ++d0) qr[d0] = *(const h16x8*)(Qp + row * 512 + d0 * 16 + hi * 8);
    h16x8 zpre[4];
#pragma unroll
    for (int i = 0; i < 4; ++i) zpre[i] = *(const h16x8*)(Zp + ((size_t)b * SEQ + r0 + i * 8 + (lane >> 3)) * 512 + (lane & 7) * 8);
    u32x4 kini[4], vini[4]; u32x4 mw4 = {0u, 0u, 0u, 0u};
    if (ISB) { kini[0] = *(const u32x4*)kg; vini[0] = *(const u32x4*)vg; kini[1] = *(const u32x4*)(kg + (size_t)64 * kvpitch); vini[1] = *(const u32x4*)(vg + (size_t)64 * kvpitch); mw4 = *(const u32x4*)mrow; }
    else {
#pragma unroll
        for (int jj = 0; jj < 4; ++jj) { const int kt = 4 * qb - 2 + jj; if (kt >= 0) { kini[jj] = *(const u32x4*)(kg + (size_t)kt * 64 * kvpitch); vini[jj] = *(const u32x4*)(vg + (size_t)kt * 64 * kvpitch); } } }
    for (int i = tid; i < 320; i += NTHREADS) { const int dist = 223 - i; float v;
        if (ISB) v = dist < 0 ? 0.f : (F.relb[t5_bucket(dist > 127 ? 127 : dist) * 16 + 8 + h] - F.relb[31 * 16 + 8 + h]) * LOG2E;
        else v = (dist >= 0 && dist < 128) ? F.relb[t5_bucket(dist) * 16 + h] * LOG2E : -INFINITY;
        lut[i] = v; }
    if (tid < 16) { u32x2 e; e.x = ((tid & 1) ? 0xffffu : 0u) | ((tid & 2) ? 0xffff0000u : 0u); e.y = ((tid & 4) ? 0xffffu : 0u) | ((tid & 8) ? 0xffff0000u : 0u); *(LAS u32x2*)(F.lds + AT_MTAB + tid * 8) = e; }
    {   const float* qg = ISB ? F.qnb : F.qna; float ss = 0.f;
#pragma unroll
        for (int d0 = 0; d0 < 4; ++d0) {
#pragma unroll
            for (int e = 0; e < 8; ++e) { const float f = (float)qr[d0][e]; ss += f * f; } }
        ss += __shfl_xor(ss, 32);
        const float rq = rsqrtf(ss * (1.0f / 64.0f) + RMS_EPS) * QSCALE;
#pragma unroll
        for (int d0 = 0; d0 < 4; ++d0) { const f32x4 g0 = *(const f32x4*)(qg + d0 * 16 + hi * 8), g1 = *(const f32x4*)(qg + d0 * 16 + hi * 8 + 4);
            u32x4 w; w.x = pkh((float)qr[d0][0] * rq * g0[0], (float)qr[d0][1] * rq * g0[1]); w.y = pkh((float)qr[d0][2] * rq * g0[2], (float)qr[d0][3] * rq * g0[3]);
            w.z = pkh((float)qr[d0][4] * rq * g1[0], (float)qr[d0][5] * rq * g1[1]); w.w = pkh((float)qr[d0][6] * rq * g1[2], (float)qr[d0][7] * rq * g1[3]);
            qr[d0] = __builtin_bit_cast(h16x8, w); } }
    float kgn[8];
    {   const float* kgp = (ISB ? F.knb : F.kna) + (tid & 7) * 8; const f32x4 g0 = *(const f32x4*)kgp, g1 = *(const f32x4*)(kgp + 4);
        kgn[0] = g0[0]; kgn[1] = g0[1]; kgn[2] = g0[2]; kgn[3] = g0[3]; kgn[4] = g1[0]; kgn[5] = g1[1]; kgn[6] = g1[2]; kgn[7] = g1[3]; }
#define KNORM(KR) do { const h16x8 kv_ = __builtin_bit_cast(h16x8, KR); float f_[8]; float ss_ = 0.f; \
        _Pragma("unroll") for (int e = 0; e < 8; ++e) { f_[e] = (float)kv_[e]; ss_ += f_[e] * f_[e]; } \
        ss_ += __shfl_xor(ss_, 1); ss_ += __shfl_xor(ss_, 2); ss_ += __shfl_xor(ss_, 4); \
        const float rk_ = rsqrtf(ss_ * (1.0f / 64.0f) + RMS_EPS); \
        KR.x = pkh(f_[0] * rk_ * kgn[0], f_[1] * rk_ * kgn[1]); KR.y = pkh(f_[2] * rk_ * kgn[2], f_[3] * rk_ * kgn[3]); \
        KR.z = pkh(f_[4] * rk_ * kgn[4], f_[5] * rk_ * kgn[5]); KR.w = pkh(f_[6] * rk_ * kgn[6], f_[7] * rk_ * kgn[7]); } while (0)
    float m_run = -INFINITY, l_run = 0.f;
    f32x16 o[2];
#pragma unroll
    for (int r = 0; r < 16; ++r) { o[0][r] = 0.f; o[1][r] = 0.f; }
    const int kfo = q * 144 + hi * 16;
    const int vfo = (4 * hi + ((lane & 15) >> 2)) * 192 + ((lane >> 4) & 1) * 32 + (lane & 3) * 8;
#define ATT_TILE(SLOT, K0) do { const int k0_ = (K0); const LAS unsigned char* kb = F.lds + AT_K + (SLOT) * AT_KSZ + kfo; const LAS unsigned char* vb = F.lds + AT_V + (SLOT) * AT_VSZ + vfo; \
            f32x16 p0, p1; \
            _Pragma("unroll") \
            for (int r = 0; r < 16; ++r) { p0[r] = 0.f; p1[r] = 0.f; } \
            _Pragma("unroll") \
            for (int d0 = 0; d0 < 4; ++d0) { \
                const h16x8 ka = *(const LAS h16x8*)(kb + d0 * 32), kc = *(const LAS h16x8*)(kb + 32 * 144 + d0 * 32); \
                p0 = __builtin_amdgcn_mfma_f32_32x32x16_f16(ka, qr[d0], p0, 0, 0, 0); \
                p1 = __builtin_amdgcn_mfma_f32_32x32x16_f16(kc, qr[d0], p1, 0, 0, 0); \
            } \
 \
            if (!ISB || (r0 - k0_ - 63 < 113)) { \
                const LAS float* lp = lut + (223 - (t - k0_ - 4 * hi)); \
            _Pragma("unroll") \
                for (int r = 0; r < 16; ++r) { const int c = (r & 3) + 8 * (r >> 2); p0[r] += lp[c]; p1[r] += lp[32 + c]; } \
            } \
 \
            h16x2v s2[16]; \
            _Pragma("unroll") \
            for (int j = 0; j < 8; ++j) { s2[j] = __builtin_convertvector((f32x2){p0[2 * j], p0[2 * j + 1]}, h16x2v); s2[8 + j] = __builtin_convertvector((f32x2){p1[2 * j], p1[2 * j + 1]}, h16x2v); } \
            h16x2v m2 = __builtin_elementwise_max(s2[0], s2[1]); \
            _Pragma("unroll") \
            for (int j = 2; j < 16; ++j) m2 = __builtin_elementwise_max(m2, s2[j]); \
            float mx = fmaxf((float)m2.x, (float)m2.y); \
            mx = fmaxf(mx, __shfl_xor(mx, 32)); \
            const float mnew = fmaxf(m_run, mx), muse = (mnew == -INFINITY) ? 0.f : mnew; \
            if (__any(mnew > m_run)) { \
                const float alpha = __builtin_amdgcn_exp2f(m_run - muse); \
                l_run *= alpha; \
            _Pragma("unroll") \
                for (int r = 0; r < 16; ++r) { o[0][r] *= alpha; o[1][r] *= alpha; } \
            } \
            m_run = mnew; \
            const h16 nm = (h16)(-muse); const h16x2v nm2 = {nm, nm}; \
            _Pragma("unroll") \
            for (int j = 0; j < 16; ++j) { const h16x2v a = s2[j] + nm2; s2[j].x = __builtin_exp2f16(a.x); s2[j].y = __builtin_exp2f16(a.y); } \
            if (ISB) { \
                const unsigned mm0 = mw.x >> (4 * hi), mm1 = mw.y >> (4 * hi); \
            _Pragma("unroll") \
                for (int g4 = 0; g4 < 4; ++g4) { \
                    const u32x2 e0 = *(const LAS u32x2*)(F.lds + AT_MTAB + ((mm0 >> (8 * g4)) & 15u) * 8), e1 = *(const LAS u32x2*)(F.lds + AT_MTAB + ((mm1 >> (8 * g4)) & 15u) * 8); \
                    s2[2 * g4] = __builtin_bit_cast(h16x2v, __builtin_bit_cast(unsigned, s2[2 * g4]) & e0.x); s2[2 * g4 + 1] = __builtin_bit_cast(h16x2v, __builtin_bit_cast(unsigned, s2[2 * g4 + 1]) & e0.y); \
                    s2[8 + 2 * g4] = __builtin_bit_cast(h16x2v, __builtin_bit_cast(unsigned, s2[8 + 2 * g4]) & e1.x); s2[8 + 2 * g4 + 1] = __builtin_bit_cast(h16x2v, __builtin_bit_cast(unsigned, s2[8 + 2 * g4 + 1]) & e1.y); \
                } \
            } \
            {   h16x2v a0 = s2[0] + s2[1], a1 = s2[2] + s2[3], a2 = s2[4] + s2[5], a3 = s2[6] + s2[7], a4 = s2[8] + s2[9], a5 = s2[10] + s2[11], a6 = s2[12] + s2[13], a7 = s2[14] + s2[15]; \
                a0 = a0 + a1; a2 = a2 + a3; a4 = a4 + a5; a6 = a6 + a7; \
                l_run += (((float)a0.x + (float)a0.y) + ((float)a2.x + (float)a2.y)) + (((float)a4.x + (float)a4.y) + ((float)a6.x + (float)a6.y)); } \
            u32x4 pk[4]; \
            _Pragma("unroll") \
            for (int s = 0; s < 4; ++s) pk[s] = (u32x4){__builtin_bit_cast(unsigned, s2[4 * s]), __builtin_bit_cast(unsigned, s2[4 * s + 1]), __builtin_bit_cast(unsigned, s2[4 * s + 2]), __builtin_bit_cast(unsigned, s2[4 * s + 3])}; \
            _Pragma("unroll") \
            for (int s = 0; s < 4; ++s) \
            _Pragma("unroll") \
                for (int d1 = 0; d1 < 2; ++d1) { \
                    const s16x4 lo4 = vtr_read(vb + (16 * s) * 192 + d1 * 64), hi4 = vtr_read(vb + (16 * s + 8) * 192 + d1 * 64); \
                    const h16x4 lf = __builtin_bit_cast(h16x4, lo4), hf = __builtin_bit_cast(h16x4, hi4); \
                    const h16x8 vf = {lf[0], lf[1], lf[2], lf[3], hf[0], hf[1], hf[2], hf[3]}; \
                    o[d1] = __builtin_amdgcn_mfma_f32_32x32x16_f16(vf, __builtin_bit_cast(h16x8, pk[s]), o[d1], 0, 0, 0); \
                } \
        } while (0)
    if (ISB) {
        const int npair = 2 * qb + 2;
        u32x4 kreg0 = kini[0], vreg0 = vini[0], kreg1 = kini[1], vreg1 = vini[1];
        u32x4 mw4n = {0u, 0u, 0u, 0u};
        KNORM(kreg0); KNORM(kreg1);
        *(LAS u32x4*)(F.lds + AT_K + kst) = kreg0; *(LAS u32x4*)(F.lds + AT_V + vst) = vreg0; *(LAS u32x4*)(F.lds + AT_K + AT_KSZ + kst) = kreg1; *(LAS u32x4*)(F.lds + AT_V + AT_VSZ + vst) = vreg1;
        __syncthreads();
#pragma unroll 1
        for (int pr = 0; pr < npair; ++pr) {
            const int sb = (pr & 1) * 2, kt = 2 * pr;
            if (pr + 1 < npair) { const size_t go = (size_t)(kt + 2) * 64 * kvpitch; kreg0 = *(const u32x4*)(kg + go); vreg0 = *(const u32x4*)(vg + go); kreg1 = *(const u32x4*)(kg + go + (size_t)64 * kvpitch); vreg1 = *(const u32x4*)(vg + go + (size_t)64 * kvpitch);
                mw4n = *(const u32x4*)(mrow + 2 * (kt + 2)); }
            TSTART(31)
            { const u32x2 mw = {mw4.x, mw4.y}; const int k0 = kt * 64; if (k0 <= r0 + 31) ATT_TILE(sb, k0); }
            { const u32x2 mw = {mw4.z, mw4.w}; const int k0 = kt * 64 + 64; if (k0 <= r0 + 31) ATT_TILE(sb + 1, k0); }
            TSTOP(31)
            TSTART(32)
            if (pr + 1 < npair) { KNORM(kreg0); KNORM(kreg1); const int sn = 2 - sb;
                *(LAS u32x4*)(F.lds + AT_K + sn * AT_KSZ + kst) = kreg0; *(LAS u32x4*)(F.lds + AT_V + sn * AT_VSZ + vst) = vreg0;
                *(LAS u32x4*)(F.lds + AT_K + (sn + 1) * AT_KSZ + kst) = kreg1; *(LAS u32x4*)(F.lds + AT_V + (sn + 1) * AT_VSZ + vst) = vreg1; mw4 = mw4n; }
            TSTOP(32)
            TSTART(33)
            __syncthreads();
            TSTOP(33)
        }
    } else {
#pragma unroll
        for (int jj = 0; jj < 4; ++jj) { const int kt = 4 * qb - 2 + jj; if (kt >= 0) { KNORM(kini[jj]); *(LAS u32x4*)(F.lds + AT_K + jj * AT_KSZ + kst) = kini[jj]; *(LAS u32x4*)(F.lds + AT_V + jj * AT_VSZ + vst) = vini[jj]; } }
        __syncthreads();
        const int base_w = wid >> 1;
        u32x4 kreg, vreg; const u32x2 mw = {0u, 0u};
#pragma unroll 1
        for (int s = 0; s < 3; ++s) {
            if (s < 2) { kreg = *(const u32x4*)(kg + (size_t)(4 * qb + 2 + s) * 64 * kvpitch); vreg = *(const u32x4*)(vg + (size_t)(4 * qb + 2 + s) * 64 * kvpitch); }
            const int j = base_w + s, kt = 4 * qb - 2 + j;
            TSTART(31)
            if (kt >= 0) ATT_TILE((j == 5 ? 0 : j), kt * 64);
            TSTOP(31)
            if (s < 2) { const int sl = (s == 0) ? 4 : 0; KNORM(kreg); *(LAS u32x4*)(F.lds + AT_K + sl * AT_KSZ + kst) = kreg; *(LAS u32x4*)(F.lds + AT_V + sl * AT_VSZ + vst) = vreg; }
            TSTART(33)
            __syncthreads();
            TSTOP(33)
        }
    }
    TSTART(34)
    l_run += __shfl_xor(l_run, 32);
    if (!ISB) l_run += __builtin_amdgcn_exp2f(F.sinks[h] * LOG2E - m_run);
    const float inv = 1.0f / l_run;
    LAS unsigned char* ost = F.lds + AT_OST + wid * AT_OSTSZ;
#pragma unroll
    for (int d1 = 0; d1 < 2; ++d1)
#pragma unroll
        for (int g4 = 0; g4 < 4; ++g4) { u32x2 w; w.x = pkh(o[d1][4 * g4] * inv, o[d1][4 * g4 + 1] * inv); w.y = pkh(o[d1][4 * g4 + 2] * inv, o[d1][4 * g4 + 3] * inv);
            *(LAS u32x2*)(ost + q * 144 + (32 * d1 + 8 * g4 + 4 * hi) * 2) = w; }
    LDS_WAIT(); asm volatile("" ::: "memory");
    h16* Yp = (h16*)(F.ws + WS_Y);
#pragma unroll
    for (int i = 0; i < 4; ++i) { const int rr = i * 8 + (lane >> 3), ch = lane & 7; const size_t grow = (size_t)b * SEQ + r0 + rr;
        const h16x8 ov = *(const LAS h16x8*)(ost + rr * 144 + ch * 16); const h16x8 zv = zpre[i];
        float y[8];
#pragma unroll
        for (int e = 0; e < 8; ++e) { const float z = (float)zv[e]; y[e] = (float)ov[e] * z * sigmoidf_fast(z); }
        u32x4 w; w.x = pkh(y[0], y[1]); w.y = pkh(y[2], y[3]); w.z = pkh(y[4], y[5]); w.w = pkh(y[6], y[7]);
        *(u32x4*)(Yp + grow * 1024 + ycol + ch * 8) = w; }
    __syncthreads();
    TSTOP(34)
#undef KNORM
#undef ATT_TILE
}
__device__ __forceinline__ void p2_mixer_a(Frame& F) {
    __syncthreads();
    for (int v = F.vcu; v < 256; v += F.G) {
        const int bh = v >> 2, j = v & 3, b = bh >> 3, h = bh & 7;
        { TSTART(35) attn_unit<false>(F, b, h, 2 * j); attn_unit<false>(F, b, h, 2 * j + 1); TSTOP(35) }
    }
}
__device__ __forceinline__ void p3_attention_phase(Frame& F) {
    for (int v = F.vcu; v < 256; v += F.G) {
        const int bh = v >> 2, j = v & 3, b = bh >> 3, h = bh & 7;
        { TSTART(36) attn_unit<true>(F, b, h, 7 - j); attn_unit<true>(F, b, h, j); TSTOP(36) }
    }
}

struct Args { const float* in[12]; float* out; unsigned char* ws; int ph_lo, ph_hi; };
constexpr int N_PHASES = 6;
__global__ void __launch_bounds__(NTHREADS, 2) mk_fwd(Args args) {
    extern __shared__ __attribute__((aligned(16))) unsigned char lds_raw[];
    Frame F;
    F.lds = (LAS unsigned char*)lds_raw;
    F.tid = threadIdx.x; F.lane = F.tid & 63; F.wave = __builtin_amdgcn_readfirstlane(F.tid >> 6);
    F.G = gridDim.x; { const int bx = blockIdx.x; F.vcu = (F.G % 8 == 0) ? (bx % 8) * (F.G / 8) + bx / 8 : bx; }
    F.ws = args.ws; F.prof = 0ull;
    F.x = args.in[0]; F.norm_g = args.in[1]; F.w_in = args.in[2]; F.qna = args.in[3]; F.kna = args.in[4]; F.sinks = args.in[5];
    F.qnb = args.in[6]; F.knb = args.in[7]; F.relb = args.in[8]; F.wpa = args.in[9]; F.wpb = args.in[10]; F.wout = args.in[11]; F.out = args.out;
    const int lo = args.ph_lo, hi = args.ph_hi;
    if (F.tid < 64) ((LAS unsigned*)(F.lds + LDSCTL_OFF))[F.tid] = 0u;
    __syncthreads();
    XcdBarrier bar = xcd_barrier_post((unsigned*)(F.ws + WS_CTL), (volatile LAS unsigned*)(F.lds + LDSCTL_OFF) + 8);
#ifdef ONLY_PH
#define IN(k) ((k) == ONLY_PH && lo <= (k) && (k) < hi)
#else
#define IN(k) (lo <= (k) && (k) < hi)
#endif
#ifdef PROBE_SYNC2
#define SEAM(k) do { if (IN(k) && IN((k) + 1)) { xcd_barrier(bar); xcd_barrier(bar); } } while (0)
#else
#define SEAM(k) do { if (IN(k) && IN((k) + 1)) xcd_barrier(bar); } while (0)
#endif
    { TSTART(1) if (IN(0)) { p0_prologue(F); }
    SEAM(0); TSTOP(1) }
    TSTART(2)
    if (IN(1)) {
        pg8::GemmPlain g{(const h16*)(F.ws + WS_H), (const h16*)(F.ws + WS_WIN), 1024, 1024};
        pg8::StaticOrder S; S.init(MROWS, 23 * 256, F.G, (int)blockIdx.x);
        pg8::EpiIn E{F.ws, (h16*)F.out};
        pg8::gemm_phase<pg8::EpiIn, pg8::StaticOrder, pg8::GemmPlain, true, true>(F.lds, g, S, E);
    }
    SEAM(1);
    TSTOP(2)
    { TSTART(3) if (IN(2)) { p2_index_phase(F); p2_mixer_a(F); }
#if defined(PROF_SEG) && defined(PROF_MAXWAVE)
    if (F.lane == 0) atomicMax((unsigned long long*)(F.ws + WS_CTL + 32768), F.prof);
#endif
    SEAM(2); TSTOP(3) }
    { TSTART(4) if (IN(3)) { p3_attention_phase(F); }
    SEAM(3); TSTOP(4) }
    TSTART(5)
    if (IN(4)) {
        pg8::GemmPlain g{(const h16*)(F.ws + WS_Y), (const h16*)(F.ws + WS_WP), 1024, 1024};
        pg8::StaticOrder S; S.init(MROWS, DM, F.G, (int)blockIdx.x);
        pg8::EpiMerge E{(const h16*)F.out, (h16*)(F.ws + WS_MG), &F.prof};
        pg8::gemm_phase<pg8::EpiMerge, pg8::StaticOrder, pg8::GemmPlain, true, true>(F.lds, g, S, E);
    }
    SEAM(4);
    TSTOP(5)
    TSTART(6)
    if (IN(5)) {
        pg8::GemmPlain g{(const h16*)(F.ws + WS_MG), (const h16*)(F.ws + WS_WO), 1024, 1024};
        pg8::StaticOrder S; S.init(MROWS, DM, F.G, (int)blockIdx.x);
        pg8::EpiOut E{F.x, F.out};
        pg8::gemm_phase<pg8::EpiOut, pg8::StaticOrder, pg8::GemmPlain, true, true>(F.lds, g, S, E);
    }
    TSTOP(6)
#undef IN
#undef SEAM
#ifdef PROF_SEG
#ifdef PROF_MAXWAVE
    if (blockIdx.x == PROF_BLK && F.wave == PROF_WAVE) F.prof = __hip_atomic_load((unsigned long long*)(F.ws + WS_CTL + 32768), __ATOMIC_RELAXED, __HIP_MEMORY_SCOPE_AGENT);
#endif
    if (blockIdx.x == PROF_BLK && F.wave == PROF_WAVE && hi == N_PHASES) { const unsigned long long t1 = __builtin_amdgcn_s_memrealtime() + F.prof * PROF_MULT; while (__builtin_amdgcn_s_memrealtime() < t1) __builtin_amdgcn_s_sleep(8); }
#endif
}

extern "C" void kernel_launch(void* const* d_in, const int* in_sizes, int n_in, void* d_out, int out_size, void* d_ws, size_t ws_size, hipStream_t stream) {
    static int grid = 0;
    if (grid == 0) {
        if (n_in != 12 || in_sizes[0] != MROWS * DM || out_size != MROWS * DM || ws_size < WS_END) { fprintf(stderr, "kernel_launch: unexpected problem (n_in %d, ws %zu)\n", n_in, ws_size); grid = -1; return; }
        int dev = 0, cus = 0, per_cu = 0;
        hipGetDevice(&dev); hipDeviceGetAttribute(&cus, hipDeviceAttributeMultiprocessorCount, dev);
        hipFuncSetAttribute((const void*)mk_fwd, hipFuncAttributeMaxDynamicSharedMemorySize, LDS_BYTES);
        hipOccupancyMaxActiveBlocksPerMultiprocessor(&per_cu, (const void*)mk_fwd, NTHREADS, LDS_BYTES);
        (void)hipGetLastError();
        if (per_cu < 1) { fprintf(stderr, "kernel_launch: occupancy query says %d blocks/CU\n", per_cu); per_cu = 1; }
        grid = cus * (per_cu < 1 ? per_cu : 1);
        if (grid > 256) grid = 256;
    }
    if (grid < 0) return;
    (void)hipMemsetAsync((char*)d_ws + WS_CTL, 0, CTL_BYTES, stream);
    Args a{};
    for (int i = 0; i < 12; ++i) a.in[i] = (const float*)d_in[i];
    a.out = (float*)d_out; a.ws = (unsigned char*)d_ws;
#ifdef PROBE_PH
    {
        void* kargs[] = {&a};
        a.ph_lo = 0; a.ph_hi = PROBE_PH + 1;
        (void)hipLaunchCooperativeKernel((const void*)mk_fwd, dim3(grid), dim3(NTHREADS), kargs, LDS_BYTES, stream);
        (void)hipMemsetAsync((char*)d_ws + WS_CTL, 0, CTL_BYTES, stream);
#ifdef PROBE_SPLIT_ONLY
        a.ph_lo = PROBE_PH + 1; a.ph_hi = N_PHASES;
#else
        a.ph_lo = PROBE_PH; a.ph_hi = N_PHASES;
#endif
        (void)hipLaunchCooperativeKernel((const void*)mk_fwd, dim3(grid), dim3(NTHREADS), kargs, LDS_BYTES, stream);
    }
#else
    {
        a.ph_lo = 0; a.ph_hi = N_PHASES;
        void* kargs[] = {&a};
        hipError_t e = hipLaunchCooperativeKernel((const void*)mk_fwd, dim3(grid), dim3(NTHREADS), kargs, LDS_BYTES, stream);
        if (e != hipSuccess) fprintf(stderr, "cooperative launch failed: %s (grid %d)\n", hipGetErrorString(e), grid);
    }
#endif
}
```
